# Optimizing an MI355X kernel written in HIP

```python
import math
import jax, jax.numpy as jnp
from jax import lax
import numpy as np

D_MODEL = 1024
BATCH = 16
SEQ = 256
DEPTH = 2
DEC_BATCH = 4
DEC_SEQ = 2048
PAST_LEN = 256

GRID_W = 64
HEAD_DIM = 64
N_HEADS_A = 8
N_KV_A = 2
REP_A = N_HEADS_A // N_KV_A
N_HEADS_C = 4
SSM_WIDTH = 256
SSM_GROUP = 16
SSM_GROUPS = SSM_WIDTH // SSM_GROUP
SSM_STATE = 64
NA_WIN_R = 8
NA_WIN_C = 16
Q_BLOCK = 128
D_FF = -(-8 * D_MODEL // (3 * 256)) * 256
ROPE_THETA = 10000.0
ROT_HALF = HEAD_DIM // 2
ROT_FREQS = ROT_HALF // 2
WIDTH_A = N_HEADS_A * HEAD_DIM
KV_WIDTH_A = N_KV_A * HEAD_DIM
WIDTH_C = N_HEADS_C * HEAD_DIM
N_BRANCH = 3
IN_WIDTH = WIDTH_A + 2 * KV_WIDTH_A + SSM_WIDTH + 3 * WIDTH_C + N_BRANCH * D_MODEL
EPS = 1e-6

kernel_name = "hybrid_flow_backbone_ctx_prefix_step"

F32 = jnp.float32


def rms_norm(x, g):
    x32 = x.astype(F32)
    y = x32 * lax.rsqrt(jnp.mean(x32 * x32, axis=-1, keepdims=True) + EPS) * g.astype(F32)
    return y.astype(x.dtype)


def adaln(cvec, lp):
    m = jax.nn.silu(cvec) @ lp["w_mod"] + lp["b_mod"]
    return jnp.split(m, 6, axis=-1)


def modulate(h, shift, scale):
    return h * (1 + scale[:, None, :]) + shift[:, None, :]


def axial_rope_tables(L):
    t = jnp.arange(L)
    row = (t // GRID_W).astype(F32)
    col = (t % GRID_W).astype(F32)
    inv = 1.0 / (ROPE_THETA ** (jnp.arange(ROT_FREQS, dtype=F32) / ROT_FREQS))
    ar = row[:, None] * inv[None]
    ac = col[:, None] * inv[None]
    return jnp.cos(ar), jnp.sin(ar), jnp.cos(ac), jnp.sin(ac)


def _rot(xs, cos, sin):
    x1, x2 = xs[..., :ROT_FREQS], xs[..., ROT_FREQS:]
    return jnp.concatenate([x1 * cos - x2 * sin, x2 * cos + x1 * sin], axis=-1)


def apply_axial_rope(x, tables):
    cr, sr, cc, sc = tables
    shp = (x.shape[1],) + (1,) * (x.ndim - 3) + (ROT_FREQS,)
    cr, sr, cc, sc = (a.reshape(shp) for a in (cr, sr, cc, sc))
    x32 = x.astype(F32)
    out = jnp.concatenate([_rot(x32[..., :ROT_HALF], cr, sr), _rot(x32[..., ROT_HALF:], cc, sc)], axis=-1)
    return out.astype(x.dtype)


def blocked_attention(q, k, v):
    bsz, lq, g, r, hd = q.shape
    nb = lq // Q_BLOCK
    qb = jnp.moveaxis(q.reshape(bsz, nb, Q_BLOCK, g, r, hd), 1, 0)
    scale = HEAD_DIM ** -0.5

    def block(qi):
        s = jnp.einsum('bqgrd,bkgd->bgrqk', qi, k).astype(F32) * scale
        p = jax.nn.softmax(s, axis=-1).astype(v.dtype)
        return jnp.einsum('bgrqk,bkgd->bqgrd', p, v)

    o = lax.map(block, qb)
    return jnp.moveaxis(o, 0, 1).reshape(bsz, lq, g, r, hd)


def neighborhood_attention(q, k, v, ck, cv, bias_table):
    bsz, L, H, hd = q.shape
    rows = L // GRID_W
    wr = min(NA_WIN_R, rows)
    wc = NA_WIN_C
    nw = wr * wc
    t = jnp.arange(L)
    r = t // GRID_W
    col = t % GRID_W
    rs = jnp.clip(r - wr // 2, 0, rows - wr)
    cs = jnp.clip(col - wc // 2, 0, GRID_W - wc)
    kr = rs[:, None] + jnp.arange(wr)[None]
    kc = cs[:, None] + jnp.arange(wc)[None]
    idx = (kr[:, :, None] * GRID_W + kc[:, None, :]).reshape(L, nw)
    dr = kr - r[:, None] + (NA_WIN_R - 1)
    dc = kc - col[:, None] + (NA_WIN_C - 1)
    bias = bias_table[:, dr[:, :, None], dc[:, None, :]].reshape(H, L, nw)
    nb = L // Q_BLOCK
    qb = jnp.moveaxis(q.reshape(bsz, nb, Q_BLOCK, H, hd), 1, 0)
    ib = idx.reshape(nb, Q_BLOCK, nw)
    bb = jnp.moveaxis(bias.reshape(H, nb, Q_BLOCK, nw), 1, 0)
    scale = HEAD_DIM ** -0.5

    def block(args):
        qi, ii, bi = args
        kg = jnp.take(k, ii, axis=1)
        vg = jnp.take(v, ii, axis=1)
        s_loc = jnp.einsum('bqhd,bqwhd->bhqw', qi, kg).astype(F32) * scale + bi[None].astype(F32)
        s_ctx = jnp.einsum('bqhd,bkhd->bhqk', qi, ck).astype(F32) * scale
        p = jax.nn.softmax(jnp.concatenate([s_loc, s_ctx], axis=-1), axis=-1).astype(v.dtype)
        return (jnp.einsum('bhqw,bqwhd->bqhd', p[..., :nw], vg)
                + jnp.einsum('bhqk,bkhd->bqhd', p[..., nw:], cv))

    o = lax.map(block, (qb, ib, bb))
    return jnp.moveaxis(o, 0, 1).reshape(bsz, L, H, hd)


def _scan_combine(e1, e2):
    a1, b1 = e1
    a2, b2 = e2
    return a1 * a2, a2 * b1 + b2


def ssm_scan(u32, lam_re, lam_im, log_step, b_re, b_im, c_re, c_im, h0, reverse):
    step = jnp.exp(log_step.astype(F32))
    lam = lax.complex(lam_re.astype(F32), lam_im.astype(F32))
    lam_bar = jnp.exp(lam * step[:, None])
    b = lax.complex(b_re.astype(F32), b_im.astype(F32))
    b_bar = ((lam_bar - 1) / lam)[..., None] * b
    cmat = lax.complex(c_re.astype(F32), c_im.astype(F32))
    bu = jnp.einsum('blgc,gpc->blgp', u32.astype(jnp.complex64), b_bar)
    if reverse:
        bu = jnp.flip(bu, axis=1)
    bu = bu.at[:, 0].add(lam_bar[None] * h0)
    a = jnp.broadcast_to(lam_bar, bu.shape)
    _, h = lax.associative_scan(_scan_combine, (a, bu), axis=1)
    h_final = h[:, -1]
    if reverse:
        h = jnp.flip(h, axis=1)
    y = jnp.real(jnp.einsum('blgp,gcp->blgc', h, cmat))
    return y, h_final


def s5_mixer(u, lp, state):
    bsz, L, _ = u.shape
    u32 = u.astype(F32).reshape(bsz, L, SSM_GROUPS, SSM_GROUP)
    st = state.astype(F32)
    ys, finals = [], []
    for d in range(2):
        h0 = lax.complex(st[:, d, 0], st[:, d, 1])
        y, hf = ssm_scan(u32, lp["ssm_lam_re"][d], lp["ssm_lam_im"][d], lp["ssm_log_step"][d],
                         lp["ssm_b_re"][d], lp["ssm_b_im"][d], lp["ssm_c_re"][d], lp["ssm_c_im"][d],
                         h0, reverse=(d == 1))
        ys.append(y)
        finals.append(jnp.stack([jnp.real(hf), jnp.imag(hf)], axis=1))
    y = (ys[0] + ys[1]).reshape(bsz, L, SSM_WIDTH) + lp["ssm_d"].astype(F32) * u32.reshape(bsz, L, SSM_WIDTH)
    y = jax.nn.gelu(y)
    y = y * jax.nn.sigmoid(y @ lp["ssm_w_glu"].astype(F32))
    return y.astype(u.dtype), jnp.stack(finals, axis=1)


def project_inputs(h, lp):
    bsz, L, _ = h.shape
    p = h @ lp["w_in"]
    sizes = [WIDTH_A, KV_WIDTH_A, KV_WIDTH_A, SSM_WIDTH, WIDTH_C, WIDTH_C, WIDTH_C]
    offs = [int(o) for o in np.cumsum(sizes)]
    qa, ka, va, u, qc, kc, vc, g = jnp.split(p, offs, axis=-1)
    qa = rms_norm(qa.reshape(bsz, L, N_KV_A, REP_A, HEAD_DIM), lp["qn_g"])
    ka = rms_norm(ka.reshape(bsz, L, N_KV_A, HEAD_DIM), lp["kn_g"])
    va = va.reshape(bsz, L, N_KV_A, HEAD_DIM)
    qc = qc.reshape(bsz, L, N_HEADS_C, HEAD_DIM)
    kc = kc.reshape(bsz, L, N_HEADS_C, HEAD_DIM)
    vc = vc.reshape(bsz, L, N_HEADS_C, HEAD_DIM)
    g = g.reshape(bsz, L, N_BRANCH, D_MODEL)
    return qa, ka, va, u, qc, kc, vc, g


def merge_branches(oa, ob, oc, g, lp):
    bsz, L = oa.shape[:2]
    gs = jax.nn.sigmoid(g)
    merged = (gs[:, :, 0] * (oa.reshape(bsz, L, WIDTH_A) @ lp["w_br_a"])
              + gs[:, :, 1] * (ob @ lp["w_br_b"])
              + gs[:, :, 2] * (oc.reshape(bsz, L, WIDTH_C) @ lp["w_br_c"]))
    return merged @ lp["w_out"]


def swiglu(h, lp):
    gu = h @ lp["w_ffn_gu"]
    gt, up = jnp.split(gu, 2, axis=-1)
    return (jax.nn.silu(gt) * up) @ lp["w_ffn_d"]


def trunk_layer(x, cvec, lp, mix_fn):
    sh1, sc1, gt1, sh2, sc2, gt2 = adaln(cvec, lp)
    h = modulate(rms_norm(x, lp["norm1_g"]), sh1, sc1)
    qa, ka, va, u, qc, kc, vc, g = project_inputs(h, lp)
    oa, ob, oc, aux = mix_fn(qa, ka, va, u, qc, kc, vc)
    x = x + gt1[:, None, :] * merge_branches(oa, ob, oc, g, lp)
    h2 = modulate(rms_norm(x, lp["norm2_g"]), sh2, sc2)
    x = x + gt2[:, None, :] * swiglu(h2, lp)
    return x, aux


def setup_inputs(seed: int = 0) -> dict:
    key = jax.random.key(seed)
    ks = iter(jax.random.split(key, 48))
    nrm = lambda shape, s=1.0: jax.random.normal(next(ks), shape, F32) * s
    D = D_MODEL
    n_idx = jnp.arange(SSM_STATE, dtype=F32)
    inp = {}
    inp["x_prompt"] = nrm((BATCH, SEQ, D))
    inp["x_sample"] = nrm((DEC_BATCH, DEC_SEQ, D))
    inp["c"] = nrm((DEC_BATCH, D))
    inp["cache_ga_k"] = nrm((DEC_BATCH, DEPTH, PAST_LEN, N_KV_A, HEAD_DIM))
    inp["cache_ga_v"] = nrm((DEC_BATCH, DEPTH, PAST_LEN, N_KV_A, HEAD_DIM))
    inp["cache_na_k"] = nrm((DEC_BATCH, DEPTH, PAST_LEN, N_HEADS_C, HEAD_DIM))
    inp["cache_na_v"] = nrm((DEC_BATCH, DEPTH, PAST_LEN, N_HEADS_C, HEAD_DIM))
    inp["state_ssm"] = nrm((DEC_BATCH, DEPTH, 2, 2, SSM_GROUPS, SSM_STATE), 0.1)
    inp["c_ctx"] = nrm((D,))
    inp["w_mod"] = nrm((DEPTH, D, 6 * D), 0.5 * D ** -0.5)
    inp["b_mod"] = nrm((DEPTH, 6 * D), 0.02)
    inp["norm1_g"] = 1.0 + nrm((DEPTH, D), 0.01)
    inp["w_in"] = nrm((DEPTH, D, IN_WIDTH), D ** -0.5)
    inp["qn_g"] = 1.0 + nrm((DEPTH, HEAD_DIM), 0.01)
    inp["kn_g"] = 1.0 + nrm((DEPTH, HEAD_DIM), 0.01)
    inp["ssm_lam_re"] = -0.5 + nrm((DEPTH, 2, SSM_GROUPS, SSM_STATE), 0.01)
    inp["ssm_lam_im"] = math.pi * n_idx + nrm((DEPTH, 2, SSM_GROUPS, SSM_STATE), 0.01)
    inp["ssm_log_step"] = jax.random.uniform(next(ks), (DEPTH, 2, SSM_GROUPS), F32,
                                             minval=math.log(1e-3), maxval=math.log(1e-1))
    inp["ssm_b_re"] = nrm((DEPTH, 2, SSM_GROUPS, SSM_STATE, SSM_GROUP), (2 * SSM_GROUP) ** -0.5)
    inp["ssm_b_im"] = nrm((DEPTH, 2, SSM_GROUPS, SSM_STATE, SSM_GROUP), (2 * SSM_GROUP) ** -0.5)
    inp["ssm_c_re"] = nrm((DEPTH, 2, SSM_GROUPS, SSM_GROUP, SSM_STATE), SSM_STATE ** -0.5)
    inp["ssm_c_im"] = nrm((DEPTH, 2, SSM_GROUPS, SSM_GROUP, SSM_STATE), SSM_STATE ** -0.5)
    inp["ssm_d"] = nrm((DEPTH, SSM_WIDTH))
    inp["ssm_w_glu"] = nrm((DEPTH, SSM_WIDTH, SSM_WIDTH), SSM_WIDTH ** -0.5)
    inp["na_bias"] = nrm((DEPTH, N_HEADS_C, 2 * NA_WIN_R - 1, 2 * NA_WIN_C - 1), 0.02)
    inp["w_br_a"] = nrm((DEPTH, WIDTH_A, D), WIDTH_A ** -0.5)
    inp["w_br_b"] = nrm((DEPTH, SSM_WIDTH, D), SSM_WIDTH ** -0.5)
    inp["w_br_c"] = nrm((DEPTH, WIDTH_C, D), WIDTH_C ** -0.5)
    inp["w_out"] = nrm((DEPTH, D, D), D ** -0.5)
    inp["norm2_g"] = 1.0 + nrm((DEPTH, D), 0.01)
    inp["w_ffn_gu"] = nrm((DEPTH, D, 2 * D_FF), D ** -0.5)
    inp["w_ffn_d"] = nrm((DEPTH, D_FF, D), D_FF ** -0.5)
    inp["final_g"] = 1.0 + nrm((D,), 0.01)
    return inp


def reference(x_prompt, x_sample, c, cache_ga_k, cache_ga_v, cache_na_k, cache_na_v, state_ssm, c_ctx,
              w_mod, b_mod, norm1_g, w_in, qn_g, kn_g, ssm_lam_re, ssm_lam_im, ssm_log_step,
              ssm_b_re, ssm_b_im, ssm_c_re, ssm_c_im, ssm_d, ssm_w_glu, na_bias,
              w_br_a, w_br_b, w_br_c, w_out, norm2_g, w_ffn_gu, w_ffn_d, final_g):
    def layer_params(i):
        return dict(w_mod=w_mod[i], b_mod=b_mod[i], norm1_g=norm1_g[i], w_in=w_in[i], qn_g=qn_g[i],
                    kn_g=kn_g[i], ssm_lam_re=ssm_lam_re[i], ssm_lam_im=ssm_lam_im[i],
                    ssm_log_step=ssm_log_step[i], ssm_b_re=ssm_b_re[i], ssm_b_im=ssm_b_im[i],
                    ssm_c_re=ssm_c_re[i], ssm_c_im=ssm_c_im[i], ssm_d=ssm_d[i], ssm_w_glu=ssm_w_glu[i],
                    na_bias=na_bias[i], w_br_a=w_br_a[i], w_br_b=w_br_b[i], w_br_c=w_br_c[i],
                    w_out=w_out[i], norm2_g=norm2_g[i], w_ffn_gu=w_ffn_gu[i], w_ffn_d=w_ffn_d[i])

    xp = x_prompt
    bp = xp.shape[0]
    cvec_ctx = c_ctx[None, :]
    zero_state = jnp.zeros((bp, 2, 2, SSM_GROUPS, SSM_STATE), F32)
    ga_k, ga_v, na_k, na_v, ssm_st = [], [], [], [], []
    for i in range(DEPTH):
        lp = layer_params(i)

        def ctx_mix(qa, ka, va, u, qc, kc, vc, lp=lp):
            oa = blocked_attention(qa, ka, va)
            ob, st = s5_mixer(u, lp, zero_state)
            oc = blocked_attention(qc[:, :, :, None, :], kc, vc)[:, :, :, 0, :]
            return oa, ob, oc, (ka, va, kc, vc, st)

        xp, (ka_i, va_i, kc_i, vc_i, st_i) = trunk_layer(xp, cvec_ctx, lp, ctx_mix)
        ga_k.append(ka_i)
        ga_v.append(va_i)
        na_k.append(kc_i)
        na_v.append(vc_i)
        ssm_st.append(st_i)
    y_prompt = rms_norm(xp, final_g)
    new_ga_k = jnp.stack(ga_k, axis=1)
    new_ga_v = jnp.stack(ga_v, axis=1)
    new_na_k = jnp.stack(na_k, axis=1)
    new_na_v = jnp.stack(na_v, axis=1)
    new_ssm = jnp.stack(ssm_st, axis=1)

    xs = x_sample
    rope = axial_rope_tables(xs.shape[1])
    for i in range(DEPTH):
        lp = layer_params(i)
        cka, cva = cache_ga_k[:, i], cache_ga_v[:, i]
        ckc, cvc = cache_na_k[:, i], cache_na_v[:, i]
        st0 = state_ssm[:, i]

        def lat_mix(qa, ka, va, u, qc, kc, vc, lp=lp, cka=cka, cva=cva, ckc=ckc, cvc=cvc, st0=st0):
            qr = apply_axial_rope(qa, rope)
            kr = apply_axial_rope(ka, rope)
            oa = blocked_attention(qr, jnp.concatenate([cka.astype(kr.dtype), kr], axis=1),
                                   jnp.concatenate([cva.astype(va.dtype), va], axis=1))
            ob, _ = s5_mixer(u, lp, st0)
            oc = neighborhood_attention(qc, kc, vc, ckc.astype(kc.dtype), cvc.astype(vc.dtype), lp["na_bias"])
            return oa, ob, oc, None

        xs, _ = trunk_layer(xs, c, lp, lat_mix)
    y_sample = rms_norm(xs, final_g)

    return (y_prompt, y_sample, new_ga_k, new_ga_v, new_na_k, new_na_v, new_ssm)
```

```cpp
#include <hip/hip_runtime.h>
#include <hip/hip_cooperative_groups.h>
#include <hip/hip_bf16.h>
#include <cstdio>
#include <cstdint>
namespace cg = cooperative_groups;

#define DBG_SSM_F32 1
#ifndef MK_MULTI
#define MK_MULTI 0
#endif

namespace pg8 {
#define PG8_LAS __attribute__((address_space(3)))
typedef unsigned short bf16_t;
typedef short bf16x8 __attribute__((ext_vector_type(8)));
typedef float f32x4 __attribute__((ext_vector_type(4)));
typedef unsigned u32x4 __attribute__((ext_vector_type(4)));
constexpr int BM = 256, BK = 64, HALF = 128, HTB = HALF * BK * 2  , STAGE_BYTES = 8 * HTB, NXCD = 8, WGM = 8;

__host__ __device__ __forceinline__ int lds_byte(int r, int c) { const int st = (r >> 4) * 2 + (c >> 5), rr = r & 15, cc = c & 31, ob = rr * 64 + cc * 2; return st * 1024 + (ob ^ (((ob >> 9) & 1) << 5)); }
__host__ __device__ __forceinline__ void stage_rc(int b, int& R, int& C) { const int st = b / 1024, sb = b % 1024, swz = sb ^ (((sb >> 9) & 1) << 5); R = (st >> 1) * 16 + swz / 64; C = (st & 1) * 32 + (swz % 64) / 2; }
__host__ __device__ __forceinline__ int perm32(int rho) { const int n = rho >> 4, i = rho & 15; return 8 * (i >> 2) + 4 * n + (i & 3); }

struct Unit { int pm, pn; };
struct Gemm { const bf16_t* A; const bf16_t* Bt; int M, N, K; };

struct StaticOrder {
    int nM, nN, nwg, G, c;
    __host__ __device__ void init(int M, int N, int G_, int c_) { nM = M / BM; nN = N / BM; nwg = nM * nN; G = G_; c = c_; }
    __host__ __device__ bool next(int i, Unit& u) const {
        const long L = (long)i * G + c; if (L >= nwg) return false;
        int wgid = (int)L; { const int q = nwg / NXCD, r = nwg % NXCD, xcd = wgid % NXCD, off = wgid / NXCD; wgid = (xcd < r ? xcd * (q + 1) : r * (q + 1) + (xcd - r) * q) + off; }
        const int nig = WGM * nN, gid = wgid / nig, fm = gid * WGM, gsz = (nM - fm) < WGM ? (nM - fm) : WGM;
        u.pm = fm + ((wgid % nig) % gsz); u.pn = (wgid % nig) / gsz; return true;
    }
    __device__ __forceinline__ void a_ready(const Unit&) const {}
    __device__ __forceinline__ void done(const Unit&) const {}
};

__device__ __forceinline__ unsigned cvt_pk_bf16(float lo, float hi) { unsigned r; asm volatile("v_cvt_pk_bf16_f32 %0, %1, %2" : "=v"(r) : "v"(lo), "v"(hi)); return r; }
typedef float f32x2 __attribute__((ext_vector_type(2)));
template <class Epi, class Sched, bool ALIGN_EPI = false, bool SP2 = false>
__device__ __forceinline__ void gemm_phase(PG8_LAS unsigned char* lds, const Gemm g, const Sched& S, const Epi& E, const int wid) {
    int lane; asm volatile("v_mbcnt_lo_u32_b32 %0, -1, 0\n\tv_mbcnt_hi_u32_b32 %0, -1, %0" : "=v"(lane)); const int tid = wid * 64 + lane, wr = wid >> 2, wc = wid & 3, fr = lane & 15, fq = lane >> 4;
    const int K = g.K, nt = K / BK;
    unsigned voffA[2], voffB[2];
#pragma unroll
    for (int i = 0; i < 2; ++i) { int R, C; stage_rc(tid * 16 + i * 8192, R, C); const int Rb = Epi::PERM ? ((R & ~31) + perm32(R & 31)) : R;
        voffA[i] = (unsigned)(R * K + C) * 2u; voffB[i] = (unsigned)(Rb * K + C) * 2u; }
    const size_t kstep = (size_t)(BK * 2);
    const size_t hstep = (size_t)HALF * K * 2;
    const size_t tstep = 2 * hstep;
    const unsigned ldsw = (unsigned)wid * 1024u;
    const int aoff = lds_byte(wr * 64 + fr, fq * 8), boff = lds_byte(wc * 32 + fr, fq * 8);
#define PG8_SA(b, h) (((b) * 2 + (h)) * HTB)
#define PG8_SB(b, h) ((4 + (b) * 2 + (h)) * HTB)
#define PG8_STAGE(bufoff, gbase, voff) do { _Pragma("unroll") for (int _i = 0; _i < 2; ++_i) \
        __builtin_amdgcn_global_load_lds((const unsigned*)((const char*)(gbase) + (voff)[_i]), (PG8_LAS unsigned*)(lds + (bufoff) + ldsw + _i * 8192), 16, 0, 0); } while (0)
#define PG8_LDA(dst, b, h) do { _Pragma("unroll") for (int m = 0; m < 4; ++m) _Pragma("unroll") for (int k = 0; k < 2; ++k) dst[m][k] = *(const PG8_LAS bf16x8*)(lds + PG8_SA(b, h) + aoff + m * 2048 + k * 1024); } while (0)
#define PG8_LDB(dst, b, h) do { _Pragma("unroll") for (int n = 0; n < 2; ++n) _Pragma("unroll") for (int k = 0; k < 2; ++k) dst[n][k] = *(const PG8_LAS bf16x8*)(lds + PG8_SB(b, h) + boff + n * 2048 + k * 1024); } while (0)
#define PG8_MMA(ai, bj, At, Bt) do { __builtin_amdgcn_s_setprio(1); _Pragma("unroll") for (int m = 0; m < 4; ++m) _Pragma("unroll") for (int n = 0; n < 2; ++n) _Pragma("unroll") for (int k = 0; k < 2; ++k) \
        acc[ai][bj][m][n] = __builtin_amdgcn_mfma_f32_16x16x32_bf16(Bt[n][k], At[m][k], acc[ai][bj][m][n], 0, 0, 0); __builtin_amdgcn_s_setprio(0); } while (0)
#define PG8_WAIT_V(n) asm volatile("s_waitcnt vmcnt(" #n ")" ::: "memory")
#define PG8_WAIT_L(n) asm volatile("s_waitcnt lgkmcnt(" #n ")" ::: "memory")
#define PG8_BAR __builtin_amdgcn_s_barrier()
#define PG8_SCHED __builtin_amdgcn_sched_barrier(0)
    Unit cur, nxt; int ui = 0;
    if (!S.next(0, cur)) return;
    f32x4 acc[2][2][4][2];
#pragma unroll
    for (int a = 0; a < 2; ++a)
#pragma unroll
        for (int b = 0; b < 2; ++b)
#pragma unroll
            for (int m = 0; m < 4; ++m)
#pragma unroll
                for (int n = 0; n < 2; ++n) acc[a][b][m][n] = (f32x4){0.f, 0.f, 0.f, 0.f};
    bf16x8 At[4][2], B0[2][2], B1[2][2];
    const char* cA = (const char*)g.A + (size_t)cur.pm * tstep; const char* cB = (const char*)g.Bt + (size_t)cur.pn * tstep;
    S.a_ready(cur);
    if constexpr (SP2) {
        PG8_STAGE(PG8_SB(0, 0), cB, voffB); PG8_STAGE(PG8_SB(0, 1), cB + hstep, voffB); PG8_STAGE(PG8_SA(0, 0), cA, voffA); PG8_STAGE(PG8_SA(0, 1), cA + hstep, voffA);
        if (wr == 1) PG8_BAR;
        PG8_WAIT_V(2); PG8_BAR;
        PG8_STAGE(PG8_SB(1, 0), cB + kstep, voffB); PG8_STAGE(PG8_SA(1, 0), cA + kstep, voffA); PG8_STAGE(PG8_SB(1, 1), cB + hstep + kstep, voffB);
        PG8_WAIT_V(6); PG8_BAR;
    } else {
        PG8_STAGE(PG8_SB(0, 0), cB, voffB); PG8_STAGE(PG8_SA(0, 0), cA, voffA); PG8_STAGE(PG8_SB(0, 1), cB + hstep, voffB); PG8_STAGE(PG8_SA(0, 1), cA + hstep, voffA);
        if (wr == 1) PG8_BAR;
        PG8_WAIT_V(4); PG8_BAR;
        PG8_STAGE(PG8_SB(1, 0), cB + kstep, voffB); PG8_STAGE(PG8_SA(1, 0), cA + kstep, voffA); PG8_STAGE(PG8_SB(1, 1), cB + hstep + kstep, voffB);
        PG8_WAIT_V(6); PG8_BAR;
    }
    for (;;) {
        const bool has_next = S.next(ui + 1, nxt);
        const char* nA = has_next ? (const char*)g.A + (size_t)nxt.pm * tstep : cA; const char* nB = has_next ? (const char*)g.Bt + (size_t)nxt.pn * tstep : cB;
        for (int t = 0; t < nt; t += 2) {
            const bool last = (t == nt - 2);
            const char* a1 = cA + (size_t)(t + 1) * kstep;
            const char* a2 = last ? nA : cA + (size_t)(t + 2) * kstep; const char* b2 = last ? nB : cB + (size_t)(t + 2) * kstep;
            const char* a3 = a2 + kstep; const char* b3 = b2 + kstep;
            if (last && has_next) S.a_ready(nxt);
            if constexpr (SP2) {
            PG8_LDB(B0, 0, 0); PG8_LDB(B1, 0, 1); PG8_SCHED; PG8_LDA(At, 0, 0); PG8_STAGE(PG8_SA(1, 1), a1 + hstep, voffA);
            PG8_WAIT_V(8); PG8_WAIT_L(0); PG8_BAR; PG8_MMA(0, 0, At, B0); PG8_MMA(0, 1, At, B1); PG8_BAR; PG8_SCHED;
            PG8_LDA(At, 0, 1); PG8_STAGE(PG8_SB(0, 0), b2, voffB); PG8_STAGE(PG8_SB(0, 1), b2 + hstep, voffB); PG8_STAGE(PG8_SA(0, 0), a2, voffA);
            PG8_WAIT_V(8); PG8_WAIT_L(0); PG8_BAR; PG8_MMA(1, 0, At, B0); PG8_MMA(1, 1, At, B1); PG8_BAR; PG8_SCHED;
            PG8_LDB(B0, 1, 0); PG8_LDB(B1, 1, 1); PG8_SCHED; PG8_LDA(At, 1, 0); PG8_STAGE(PG8_SA(0, 1), a2 + hstep, voffA);
            PG8_WAIT_V(8); PG8_WAIT_L(0); PG8_BAR; PG8_MMA(0, 0, At, B0); PG8_MMA(0, 1, At, B1); PG8_BAR; PG8_SCHED;
            PG8_LDA(At, 1, 1); PG8_STAGE(PG8_SB(1, 0), b3, voffB); PG8_STAGE(PG8_SB(1, 1), b3 + hstep, voffB); PG8_STAGE(PG8_SA(1, 0), a3, voffA);
            PG8_WAIT_V(8); PG8_WAIT_L(0); PG8_BAR; PG8_MMA(1, 0, At, B0); PG8_MMA(1, 1, At, B1); PG8_BAR; PG8_SCHED;
            } else {
            PG8_LDB(B0, 0, 0); PG8_SCHED; PG8_LDA(At, 0, 0); PG8_STAGE(PG8_SA(1, 1), a1 + hstep, voffA);
            PG8_WAIT_L(8); PG8_BAR; PG8_WAIT_L(0); PG8_MMA(0, 0, At, B0); PG8_BAR; PG8_SCHED;
            PG8_LDB(B1, 0, 1); PG8_STAGE(PG8_SB(0, 0), b2, voffB);
            PG8_BAR; PG8_WAIT_L(0); PG8_MMA(0, 1, At, B1); PG8_BAR;
            PG8_LDA(At, 0, 1); PG8_STAGE(PG8_SA(0, 0), a2, voffA);
            PG8_BAR; PG8_WAIT_L(0); PG8_MMA(1, 0, At, B0); PG8_BAR; PG8_SCHED;
            PG8_STAGE(PG8_SB(0, 1), b2 + hstep, voffB);
            PG8_WAIT_V(6); PG8_BAR; PG8_MMA(1, 1, At, B1); PG8_BAR;
            PG8_LDB(B0, 1, 0); PG8_SCHED; PG8_LDA(At, 1, 0); PG8_STAGE(PG8_SA(0, 1), a2 + hstep, voffA);
            PG8_WAIT_L(8); PG8_BAR; PG8_WAIT_L(0); PG8_MMA(0, 0, At, B0); PG8_BAR; PG8_SCHED;
            PG8_LDB(B1, 1, 1); PG8_STAGE(PG8_SB(1, 0), b3, voffB);
            PG8_BAR; PG8_WAIT_L(0); PG8_MMA(0, 1, At, B1); PG8_BAR;
            PG8_LDA(At, 1, 1); PG8_STAGE(PG8_SA(1, 0), a3, voffA);
            PG8_BAR; PG8_WAIT_L(0); PG8_MMA(1, 0, At, B0); PG8_BAR; PG8_SCHED;
            PG8_STAGE(PG8_SB(1, 1), b3 + hstep, voffB);
            PG8_WAIT_V(6); PG8_BAR; PG8_MMA(1, 1, At, B1); PG8_BAR;
            }
        }
        if constexpr (ALIGN_EPI) { if (wr == 0) PG8_BAR; }
        if constexpr (!Epi::AFTER_DRAIN) { E(acc, cur, wr, wc, fr, fq); S.done(cur); }
        if (!has_next) break;
#pragma unroll
        for (int a = 0; a < 2; ++a)
#pragma unroll
            for (int b = 0; b < 2; ++b)
#pragma unroll
                for (int m = 0; m < 4; ++m)
#pragma unroll
                    for (int n = 0; n < 2; ++n) acc[a][b][m][n] = (f32x4){0.f, 0.f, 0.f, 0.f};
        cur = nxt; cA = nA; cB = nB; ++ui;
        if constexpr (ALIGN_EPI) { if (wr == 1) PG8_BAR; }
    }
    PG8_WAIT_V(0);
    if constexpr (!ALIGN_EPI) { if (wr == 0) PG8_BAR; }
    PG8_BAR;
    if constexpr (Epi::AFTER_DRAIN) { E.fused(acc, cur, wr, wc, fr, fq, lds, wid, lane); S.done(cur); }
#undef PG8_SA
#undef PG8_SB
#undef PG8_STAGE
#undef PG8_LDA
#undef PG8_LDB
#undef PG8_MMA
#undef PG8_WAIT_V
#undef PG8_WAIT_L
#undef PG8_BAR
#undef PG8_SCHED
}
}

#define LAS __attribute__((address_space(3)))
typedef unsigned short bf16;
typedef short bf16x8 __attribute__((ext_vector_type(8)));
typedef short s16x4 __attribute__((ext_vector_type(4)));
typedef float f32x4 __attribute__((ext_vector_type(4)));
typedef float f32x16 __attribute__((ext_vector_type(16)));
typedef unsigned u32x4 __attribute__((ext_vector_type(4)));
typedef unsigned u32x2 __attribute__((ext_vector_type(2)));
typedef float f32x2_t __attribute__((ext_vector_type(2)));
typedef __bf16 bf16x2_t __attribute__((ext_vector_type(2)));

constexpr int M_TOK = 12288, M_CTX = 4096, DM = 1024, NIN = 4864, DFF = 2816, NGU = 5632;
constexpr float EPS = 1e-6f, LOG2E = 1.4426950408889634f, C2 = 0.125f * 1.4426950408889634f;
constexpr size_t MiB = 1u << 20;
constexpr size_t WS_ROPE = 0, WS_QKG = 16384, WS_PTRS = 20480, WS_MOD = 65536, WS_SSMF = 512 * 1024, WS_CKAK = 1 * MiB, WS_CKAV = 1 * MiB + 512 * 1024, WS_CKCK = 2 * MiB, WS_CKCV = 3 * MiB;
constexpr size_t WS_W = 4 * MiB;
constexpr size_t W_IN = WS_W, W_BRA = W_IN + 2ull * NIN * DM * 2, W_BRB = W_BRA + 2ull * DM * 512 * 2, W_BRC = W_BRB + 2ull * DM * 256 * 2, W_OUT = W_BRC + 2ull * DM * 256 * 2,
                 W_GU = W_OUT + 2ull * DM * DM * 2, W_FD = W_GU + 2ull * NGU * DM * 2, W_GLU = W_FD + 2ull * DM * DFF * 2, W_END = W_GLU + 2ull * 256 * 256 * 2;
constexpr size_t WS_H = 65 * MiB;
constexpr size_t WS_QKVU = 89 * MiB;
constexpr size_t WS_QA = WS_QKVU, WS_KA = WS_QA + 12 * MiB, WS_VA = WS_KA + 3 * MiB, WS_U = WS_VA + 3 * MiB, WS_QC = WS_U + 12 * MiB, WS_KC = WS_QC + 6 * MiB, WS_VC = WS_KC + 6 * MiB;
constexpr size_t WS_GATES = 137 * MiB;
constexpr size_t WS_OA = 209 * MiB, WS_OB = 221 * MiB, WS_OC = 227 * MiB, WS_PAR = 233 * MiB, WS_END = 235 * MiB;
constexpr int P_N1G = 0, P_N2G = 2048, P_FING = 4096, P_SSM0 = 5120, P_LAMR = 37888, P_LAMI = 41984, P_LSTEP = 46080, P_BRE = 46144, P_BIM = 111680, P_CRE = 177216, P_CIM = 242752, P_SSMD = 308288, P_NAB = 308800;
static_assert(W_END <= WS_H, "weights fit");
constexpr size_t O_YP = 0, O_YS = 4194304, O_GAK = 12582912, O_GAV = 13631488, O_NAK = 14680064, O_NAV = 16777216, O_SSM = 18874368;
constexpr int LDS_BYTES = 147456;

__device__ __forceinline__ unsigned cvtpk(float lo, float hi) { f32x2_t v = {lo, hi}; bf16x2_t b = __builtin_convertvector(v, bf16x2_t); return __builtin_bit_cast(unsigned, b); }
__device__ __forceinline__ float bf2f(unsigned b) { return __uint_as_float(b << 16); }
__device__ __forceinline__ float sigmoidf_(float v) { return 1.0f / (1.0f + __expf(-v)); }
template <int K> __device__ __forceinline__ float xor_shfl(float v) {
    return __uint_as_float((unsigned)__builtin_amdgcn_ds_swizzle((int)__float_as_uint(v), (K << 10) | 0x1F));
}
__device__ __forceinline__ float sum_xor32(float v) { auto rr = __builtin_amdgcn_permlane32_swap(__float_as_uint(v), __float_as_uint(v), false, false); return __uint_as_float(rr[0]) + __uint_as_float(rr[1]); }
__device__ __forceinline__ float wave_sum(float v) {
    v += xor_shfl<1>(v); v += xor_shfl<2>(v); v += xor_shfl<4>(v); v += xor_shfl<8>(v); v += xor_shfl<16>(v);
    return sum_xor32(v);
}
__device__ __forceinline__ int crow(int r, int hi) { return (r & 3) + 8 * (r >> 2) + 4 * hi; }
__device__ __forceinline__ int clampi(int v, int lo, int hi) { return v < lo ? lo : (v > hi ? hi : v); }
#define FRESH_LANE() ({ int l__; asm volatile("v_mbcnt_lo_u32_b32 %0, -1, 0\n\tv_mbcnt_hi_u32_b32 %0, -1, %0" : "=v"(l__)); l__; })
#ifndef DBG_SSM
#define DBG_SSM 1.0f
#endif
#ifndef DBG_GAK
#define DBG_GAK 1.0f
#endif
#ifndef DBG_GAV
#define DBG_GAV 1.0f
#endif
#define VM_WAIT0() asm volatile("s_waitcnt vmcnt(0)" ::: "memory")

using pg8::Unit;
struct EpiIn {
    static constexpr bool PERM = false, AFTER_DRAIN = false;
    unsigned char* ws; float* out; int layer;
    __device__ __forceinline__ void operator()(const f32x4 (&acc)[2][2][4][2], const Unit& u, int wr, int wc, int fr_, int fq_) const {
        const int ln_ = FRESH_LANE(), fr = ln_ & 15, fq = ln_ >> 4;
        const int pn = u.pn; const bool ctx = u.pm < 16;
        const int rb = u.pm * 256 + wr * 64 + fr;
        if (pn >= 7) {
#pragma unroll
            for (int ai = 0; ai < 2; ++ai)
#pragma unroll
                for (int m = 0; m < 4; ++m) {
                    const int row = rb + ai * 128 + m * 16;
                    bf16* gp = (bf16*)(ws + WS_GATES) + (size_t)row * 3072 + (pn - 7) * 256 + 64 * wc + 4 * fq;
#pragma unroll
                    for (int bj = 0; bj < 2; ++bj)
#pragma unroll
                        for (int n = 0; n < 2; ++n) { const f32x4 v = acc[ai][bj][m][n]; u32x2 w; w.x = cvtpk(sigmoidf_(v[0]), sigmoidf_(v[1])); w.y = cvtpk(sigmoidf_(v[2]), sigmoidf_(v[3])); *(u32x2*)(gp + 32 * bj + 16 * n) = w; }
                }
        } else if (pn == 3) {
#pragma unroll
            for (int ai = 0; ai < 2; ++ai)
#pragma unroll
                for (int m = 0; m < 4; ++m) {
                    const int row = rb + ai * 128 + m * 16;
                    float* up = (float*)(ws + WS_U) + (size_t)row * 256 + 64 * wc + 4 * fq;
#pragma unroll
                    for (int bj = 0; bj < 2; ++bj)
#pragma unroll
                        for (int n = 0; n < 2; ++n) *(f32x4*)(up + 32 * bj + 16 * n) = acc[ai][bj][m][n];
                }
        } else if (pn >= 4) {
            bf16* base = (bf16*)(ws + (pn == 4 ? WS_QC : (pn == 5 ? WS_KC : WS_VC)));
            const float sc = pn == 4 ? C2 : 1.0f;
            float* ob = out + (pn == 5 ? O_NAK : O_NAV);
#pragma unroll
            for (int ai = 0; ai < 2; ++ai)
#pragma unroll
                for (int m = 0; m < 4; ++m) {
                    const int row = rb + ai * 128 + m * 16;
                    int b, t; size_t hrow;
                    if (ctx) { b = row >> 8; t = row & 255; hrow = (size_t)(b * 4 + wc) * 256 + t; } else { const int r2 = row - 4096; b = r2 >> 11; t = r2 & 2047; hrow = (size_t)4096 * 4 + (size_t)(b * 4 + wc) * 2048 + t; }
                    bf16* dp = base + hrow * 64 + 4 * fq;
#pragma unroll
                    for (int bj = 0; bj < 2; ++bj)
#pragma unroll
                        for (int n = 0; n < 2; ++n) { const f32x4 v = acc[ai][bj][m][n] * sc; u32x2 w; w.x = cvtpk(v[0], v[1]); w.y = cvtpk(v[2], v[3]); *(u32x2*)(dp + 32 * bj + 16 * n) = w; }
                    if (ctx && pn >= 5) { float* op = ob + ((size_t)(b * 2 + layer) * 256 + t) * 256 + wc * 64 + 4 * fq;
#pragma unroll
                        for (int bj = 0; bj < 2; ++bj)
#pragma unroll
                            for (int n = 0; n < 2; ++n) *(f32x4*)(op + 32 * bj + 16 * n) = acc[ai][bj][m][n]; }
                }
        } else {
            const bool isQ = pn < 2, isV = (pn == 2 && wc >= 2);
            const int h = isQ ? 4 * pn + wc : (wc & 1);
            const float* gsrc = (const float*)(ws + WS_QKG) + (layer * 2 + (isQ ? 0 : 1)) * 64 + 4 * fq;
            f32x4 gg[2][2];
#pragma unroll
            for (int bj = 0; bj < 2; ++bj)
#pragma unroll
                for (int n = 0; n < 2; ++n) gg[bj][n] = *(const f32x4*)(gsrc + 32 * bj + 16 * n);
            bf16* base = (bf16*)(ws + (isQ ? WS_QA : (isV ? WS_VA : WS_KA)));
            const int nh = isQ ? 8 : 2;
            float* ob = out + (isV ? O_GAV : O_GAK);
#pragma unroll
            for (int ai = 0; ai < 2; ++ai)
#pragma unroll
                for (int m = 0; m < 4; ++m) {
                    const int row = rb + ai * 128 + m * 16;
                    f32x4 v[2][2];
#pragma unroll
                    for (int bj = 0; bj < 2; ++bj)
#pragma unroll
                        for (int n = 0; n < 2; ++n) v[bj][n] = acc[ai][bj][m][n];
                    if (!isV) {
                        float ss = 0.f;
#pragma unroll
                        for (int bj = 0; bj < 2; ++bj)
#pragma unroll
                            for (int n = 0; n < 2; ++n) ss += (v[bj][n][0] * v[bj][n][0] + v[bj][n][1] * v[bj][n][1]) + (v[bj][n][2] * v[bj][n][2] + v[bj][n][3] * v[bj][n][3]);
                        ss += xor_shfl<16>(ss); ss = sum_xor32(ss);
                        const float rstd = rsqrtf(ss * (1.0f / 64.0f) + EPS);
#pragma unroll
                        for (int bj = 0; bj < 2; ++bj)
#pragma unroll
                            for (int n = 0; n < 2; ++n) v[bj][n] = v[bj][n] * rstd * gg[bj][n];
                    }
                    int b, t; size_t hrow;
                    if (ctx) { b = row >> 8; t = row & 255; hrow = (size_t)(b * nh + h) * 256 + t; }
                    else {
                        const int r2 = row - 4096; b = r2 >> 11; t = r2 & 2047; hrow = (size_t)4096 * nh + (size_t)(b * nh + h) * 2048 + t;
                        if (!isV) {
#pragma unroll
                            for (int bj = 0; bj < 2; ++bj) {
                                const int pos = bj ? (t & 63) : (t >> 6);
                                const float* tp = (const float*)(ws + WS_ROPE) + (pos * 16 + 4 * fq) * 2;
                                const f32x4 c01 = *(const f32x4*)tp, c23 = *(const f32x4*)(tp + 4);
                                const f32x4 cs = {c01[0], c01[2], c23[0], c23[2]}, sn = {c01[1], c01[3], c23[1], c23[3]};
                                const f32x4 x1 = v[bj][0], x2 = v[bj][1];
                                v[bj][0] = x1 * cs - x2 * sn; v[bj][1] = x2 * cs + x1 * sn;
                            }
                        }
                    }
                    if (ctx && !isQ) { float* op = ob + ((size_t)(b * 2 + layer) * 256 + t) * 128 + h * 64 + 4 * fq;
#pragma unroll
                        for (int bj = 0; bj < 2; ++bj)
#pragma unroll
                            for (int n = 0; n < 2; ++n) *(f32x4*)(op + 32 * bj + 16 * n) = v[bj][n] * (isV ? DBG_GAV : DBG_GAK); }
                    const float sc = isQ ? C2 : 1.0f;
                    bf16* dp = base + hrow * 64 + 4 * fq;
#pragma unroll
                    for (int bj = 0; bj < 2; ++bj)
#pragma unroll
                        for (int n = 0; n < 2; ++n) { const f32x4 x = v[bj][n] * sc; u32x2 w; w.x = cvtpk(x[0], x[1]); w.y = cvtpk(x[2], x[3]); *(u32x2*)(dp + 32 * bj + 16 * n) = w; }
                }
        }
        VM_WAIT0();
    }
};

struct EpiRes {
    static constexpr bool PERM = false, AFTER_DRAIN = false;
    const float* xc; const float* xl; float* xo; const float* mod;
    __device__ __forceinline__ void operator()(const f32x4 (&acc)[2][2][4][2], const Unit& u, int wr, int wc, int fr_, int fq_) const {
        const int ln_ = FRESH_LANE(), fr = ln_ & 15, fq = ln_ >> 4;
        const int cv = u.pm < 16 ? 0 : 1 + ((u.pm - 16) >> 3);
        const int col0 = u.pn * 256 + wc * 32 + 4 * fq;
        f32x4 gv[2][2];
#pragma unroll
        for (int bj = 0; bj < 2; ++bj)
#pragma unroll
            for (int n = 0; n < 2; ++n) gv[bj][n] = *(const f32x4*)(mod + cv * 6144 + col0 + bj * 128 + n * 16);
#pragma unroll
        for (int ai = 0; ai < 2; ++ai)
#pragma unroll
            for (int m = 0; m < 4; ++m) {
                const int row = u.pm * 256 + ai * 128 + wr * 64 + m * 16 + fr;
                const float* xs = row < 4096 ? xc + (size_t)row * 1024 : xl + (size_t)(row - 4096) * 1024;
                float* xd = xo + (size_t)row * 1024;
#pragma unroll
                for (int bj = 0; bj < 2; ++bj)
#pragma unroll
                    for (int n = 0; n < 2; ++n) { const int c = col0 + bj * 128 + n * 16; const f32x4 xv = *(const f32x4*)(xs + c); *(f32x4*)(xd + c) = xv + gv[bj][n] * acc[ai][bj][m][n]; }
                asm volatile("" ::: "memory");
            }
        VM_WAIT0();
    }
};

struct EpiSwiglu {
    static constexpr bool PERM = false, AFTER_DRAIN = false;
    bf16* ACT;
    __device__ __forceinline__ void operator()(const f32x4 (&acc)[2][2][4][2], const Unit& u, int wr, int wc, int fr_, int fq_) const {
        const int ln_ = FRESH_LANE(), fr = ln_ & 15, fq = ln_ >> 4;
#pragma unroll
        for (int ai = 0; ai < 2; ++ai)
#pragma unroll
            for (int m = 0; m < 4; ++m) {
                const int row = u.pm * 256 + ai * 128 + wr * 64 + m * 16 + fr;
                bf16* ap = ACT + (size_t)row * DFF + u.pn * 128 + wc * 32 + 4 * fq;
#pragma unroll
                for (int n = 0; n < 2; ++n) { const f32x4 g = acc[ai][0][m][n], up = acc[ai][1][m][n]; f32x4 r;
#pragma unroll
                    for (int i = 0; i < 4; ++i) r[i] = g[i] * sigmoidf_(g[i]) * up[i];
                    u32x2 w; w.x = cvtpk(r[0], r[1]); w.y = cvtpk(r[2], r[3]); *(u32x2*)(ap + 16 * n) = w; }
                asm volatile("" ::: "memory");
            }
        VM_WAIT0();
    }
};

struct EpiGlu {
    static constexpr bool PERM = false, AFTER_DRAIN = false;
    bf16* OB;
    __device__ __forceinline__ void operator()(const f32x4 (&acc)[2][2][4][2], const Unit& u, int wr, int wc, int fr_, int fq_) const {
        const int ln_ = FRESH_LANE(), fr = ln_ & 15, fq = ln_ >> 4;
#pragma unroll
        for (int ai = 0; ai < 2; ++ai)
#pragma unroll
            for (int m = 0; m < 4; ++m) {
                const int row = u.pm * 256 + ai * 128 + wr * 64 + m * 16 + fr;
                bf16* p = OB + (size_t)row * 256 + wc * 32 + 4 * fq;
#pragma unroll
                for (int bj = 0; bj < 2; ++bj)
#pragma unroll
                    for (int n = 0; n < 2; ++n) { bf16* q = p + bj * 128 + n * 16; const u32x2 yv = *(const u32x2*)q; const f32x4 a = acc[ai][bj][m][n];
                        const float y0 = bf2f(yv.x & 0xffffu), y1 = bf2f(yv.x >> 16), y2 = bf2f(yv.y & 0xffffu), y3 = bf2f(yv.y >> 16);
                        u32x2 w; w.x = cvtpk(y0 * sigmoidf_(a[0]), y1 * sigmoidf_(a[1])); w.y = cvtpk(y2 * sigmoidf_(a[2]), y3 * sigmoidf_(a[3])); *(u32x2*)q = w; }
                asm volatile("" ::: "memory");
            }
        VM_WAIT0();
    }
};

template <int MODE> struct EpiBr {
    static constexpr bool PERM = false, AFTER_DRAIN = false;
    const bf16* G; float* MF; bf16* MG;
    __device__ __forceinline__ void operator()(const f32x4 (&acc)[2][2][4][2], const Unit& u, int wr, int wc, int fr_, int fq_) const {
        const int ln_ = FRESH_LANE(), fr = ln_ & 15, fq = ln_ >> 4;
        const int col0 = u.pn * 256 + wc * 32 + 4 * fq;
#pragma unroll
        for (int ai = 0; ai < 2; ++ai)
#pragma unroll
            for (int m = 0; m < 4; ++m) {
                const int row = u.pm * 256 + ai * 128 + wr * 64 + m * 16 + fr;
#pragma unroll
                for (int bj = 0; bj < 2; ++bj)
#pragma unroll
                    for (int n = 0; n < 2; ++n) { const int c = col0 + bj * 128 + n * 16; const u32x2 gv = *(const u32x2*)(G + (size_t)row * 3072 + c); const f32x4 a = acc[ai][bj][m][n];
                        f32x4 r = {bf2f(gv.x & 0xffffu) * a[0], bf2f(gv.x >> 16) * a[1], bf2f(gv.y & 0xffffu) * a[2], bf2f(gv.y >> 16) * a[3]};
#ifdef DBG_ZERO_BR
                        if (MODE == DBG_ZERO_BR) r = r * 0.0f;
#endif
                        float* mp = MF + (size_t)row * 1024 + c;
                        if (MODE >= 1) r = r + *(const f32x4*)mp;
                        if (MODE <= 1) *(f32x4*)mp = r;
                        else { u32x2 w; w.x = cvtpk(r[0], r[1]); w.y = cvtpk(r[2], r[3]); *(u32x2*)(MG + (size_t)row * 1024 + c) = w; } }
                asm volatile("" ::: "memory");
            }
        VM_WAIT0();
    }
};

namespace att {
constexpr int SLOTB = 8192, LDS_K = 0, LDS_V = 16384, LDS_WS = 32768, LDS_OST = 34816, LDS_BIAS = 67584;
constexpr float THR = 8.0f;
#define SBAR() __builtin_amdgcn_sched_barrier(0)
__device__ __forceinline__ void glds16(const void* gsrc, unsigned lds_dst) { unsigned keep;
    asm volatile("s_mov_b32 %0, m0\n\ts_mov_b32 m0, %2\n\ts_nop 0\n\tglobal_load_lds_dwordx4 %1, off\n\ts_mov_b32 m0, %0" : "=&s"(keep) : "v"(gsrc), "s"(lds_dst) : "memory"); }
#define WAIT_BAR0() asm volatile("s_waitcnt vmcnt(0) lgkmcnt(0)\n\ts_barrier" ::: "memory")
typedef LAS const char* lds_cptr;
__device__ __forceinline__ void qkt(f32x16& p0, f32x16& p1, lds_cptr kb, const bf16x8* qr, const f32x16& negm) {
#pragma unroll
    for (int d0 = 0; d0 < 4; ++d0) {
        const bf16x8 b0 = *(const LAS bf16x8*)(kb + d0 * 2048);
        const bf16x8 b1 = *(const LAS bf16x8*)(kb + d0 * 2048 + 512);
        if (d0 == 0) { p0 = __builtin_amdgcn_mfma_f32_32x32x16_bf16(b0, qr[0], negm, 0, 0, 0); p1 = __builtin_amdgcn_mfma_f32_32x32x16_bf16(b1, qr[0], negm, 0, 0, 0); }
        else { p0 = __builtin_amdgcn_mfma_f32_32x32x16_bf16(b0, qr[d0], p0, 0, 0, 0); p1 = __builtin_amdgcn_mfma_f32_32x32x16_bf16(b1, qr[d0], p1, 0, 0, 0); }
    }
}
__device__ __forceinline__ float rowmax(const f32x16& p0, const f32x16& p1) {
    float a = fmaxf(fmaxf(p0[0], p0[1]), p1[0]), b = fmaxf(fmaxf(p0[2], p0[3]), p1[1]); a = fmaxf(fmaxf(a, p1[2]), p1[3]);
#pragma unroll
    for (int r = 4; r < 16; r += 4) { a = fmaxf(fmaxf(a, p0[r]), p0[r + 1]); b = fmaxf(fmaxf(b, p0[r + 2]), p0[r + 3]); a = fmaxf(fmaxf(a, p1[r]), p1[r + 1]); b = fmaxf(fmaxf(b, p1[r + 2]), p1[r + 3]); }
    const float m = fmaxf(a, b);
    auto rr = __builtin_amdgcn_permlane32_swap(__float_as_uint(m), __float_as_uint(m), false, false);
    return fmaxf(__uint_as_float(rr[0]), __uint_as_float(rr[1]));
}
__device__ __forceinline__ void pv(f32x16* o, int vb, bf16x8 pa0, bf16x8 pa1, bf16x8 pa2, bf16x8 pa3) {
#pragma unroll
    for (int d0 = 0; d0 < 2; ++d0) { s16x4 lo[4], hi[4];
#pragma unroll
        for (int ks = 0; ks < 4; ++ks) {
            asm volatile("ds_read_b64_tr_b16 %0,%1 offset:%c2" : "=&v"(lo[ks]) : "v"(vb), "i"(d0 * 4096 + ks * 1024) : "memory");
            asm volatile("ds_read_b64_tr_b16 %0,%1 offset:%c2" : "=&v"(hi[ks]) : "v"(vb), "i"(d0 * 4096 + ks * 1024 + 512) : "memory"); }
        asm volatile("s_waitcnt lgkmcnt(0)" ::: "memory"); SBAR();
#define PK(k) (bf16x8){lo[k][0], lo[k][1], lo[k][2], lo[k][3], hi[k][0], hi[k][1], hi[k][2], hi[k][3]}
        o[d0] = __builtin_amdgcn_mfma_f32_32x32x16_bf16(pa0, PK(0), o[d0], 0, 0, 0);
        o[d0] = __builtin_amdgcn_mfma_f32_32x32x16_bf16(pa1, PK(1), o[d0], 0, 0, 0);
        o[d0] = __builtin_amdgcn_mfma_f32_32x32x16_bf16(pa2, PK(2), o[d0], 0, 0, 0);
        o[d0] = __builtin_amdgcn_mfma_f32_32x32x16_bf16(pa3, PK(3), o[d0], 0, 0, 0);
#undef PK
    }
}
template <bool NA>
__device__ __forceinline__ void attn_unit(const bf16* Qw, const bf16* Kc, const bf16* Vc, const bf16* Kl, const bf16* Vl, int NT,
                                          bf16* Ow, int opitch, char* shm, int qrow, int rlo, const float* biasg, const int wid) {
    const int lane = FRESH_LANE(), tid = wid * 64 + lane, r32 = lane & 31, hi = lane >> 5;
    const unsigned lds0 = (unsigned)(uintptr_t)shm;
    const lds_cptr shm3 = (lds_cptr)shm;
    LAS float* wsf = (LAS float*)(shm3 + LDS_WS) + wid * 64;
    LAS float* bias_s = (LAS float*)(shm3 + LDS_BIAS);
    if (NA) { if (tid < 465) bias_s[tid] = biasg[tid] * LOG2E; }
    const int koff = lane * 64 + wid * 8;
    const int voff = (16 * (wid & 3) + (lane >> 2)) * 64 + (wid >> 2) * 32 + (lane & 3) * 8;
    const unsigned kdst = lds0 + LDS_K + wid * 1024, vdst = lds0 + LDS_V + wid * 1024;
#define ATT_DMA(t, slot) do { const bf16* kt_ = (t) < 4 ? Kc + (t) * 4096 : Kl + ((t) - 4) * 4096; const bf16* vt_ = (t) < 4 ? Vc + (t) * 4096 : Vl + ((t) - 4) * 4096; \
        glds16(kt_ + koff, (unsigned)__builtin_amdgcn_readfirstlane(kdst + (slot))); glds16(vt_ + voff, (unsigned)__builtin_amdgcn_readfirstlane(vdst + (slot))); } while (0)
    ATT_DMA(0, 0);
    bf16x8 qr[4];
#pragma unroll
    for (int d0 = 0; d0 < 4; ++d0) qr[d0] = *(const bf16x8*)(Qw + (size_t)r32 * 64 + d0 * 16 + hi * 8);
    float mhat = 0.f, l_reg = 0.f; f32x16 o[2]; o[0] = f32x16{}; o[1] = f32x16{}; f32x16 negm = f32x16{};
    const lds_cptr kp0 = shm3 + LDS_K + hi * 1024 + r32 * 16;
    const int vb0 = (int)(lds0 + LDS_V) + ((lane >> 4) & 1) * 32 + (lane & 3) * 8 + (4 * hi + ((lane & 15) >> 2)) * 64;
    const int qc = (wid & 1) * 32 + r32, cs = clampi(qc - 8, 0, 48), rs = clampi(qrow - 4, 0, 24);
    for (int t = 0; t < NT; ++t) {
        WAIT_BAR0();
        const int slot = (t & 1) * SLOTB;
        if (t + 1 < NT) ATT_DMA(t + 1, SLOTB - slot);
        f32x16 p0, p1;
        qkt(p0, p1, kp0 + slot, qr, negm);
        if (NA && t >= 4) {
            const int kr = rlo + t - 4;
            if (kr < rs || kr >= rs + 8) {
#pragma unroll
                for (int r = 0; r < 16; ++r) { p0[r] = -INFINITY; p1[r] = -INFINITY; }
            } else {
                const LAS float* brow = bias_s + (kr - qrow + 7) * 31;
#pragma unroll
                for (int r = 0; r < 16; ++r) {
                    const int kc = crow(r, hi);
                    const int i0 = clampi(kc - qc + 15, 0, 30), i1 = clampi(kc + 32 - qc + 15, 0, 30);
                    const float b0 = brow[i0], b1 = brow[i1];
                    p0[r] = ((unsigned)(kc - cs) < 16u) ? p0[r] + b0 : -INFINITY;
                    p1[r] = ((unsigned)(kc + 32 - cs) < 16u) ? p1[r] + b1 : -INFINITY;
                }
            }
        }
        const float rm = rowmax(p0, p1);
        if (t == 0 || __any(rm > THR)) {
            const float dl = (t == 0) ? rm : fmaxf(rm, 0.f);
            mhat += dl;
#pragma unroll
            for (int r = 0; r < 16; ++r) { p0[r] -= dl; p1[r] -= dl; negm[r] = -mhat; }
            if (t > 0) {
                const float f = __builtin_amdgcn_exp2f(-dl); l_reg *= f;
                if (hi == 0) wsf[r32] = f;
                asm volatile("s_waitcnt lgkmcnt(0)" ::: "memory");
#pragma unroll
                for (int r = 0; r < 16; ++r) { const float fr_ = wsf[crow(r, hi)]; o[0][r] *= fr_; o[1][r] *= fr_; }
                asm volatile("s_waitcnt lgkmcnt(0)" ::: "memory");
            }
        }
        float sacc = 0.f;
#pragma unroll
        for (int r = 0; r < 16; ++r) { p0[r] = __builtin_amdgcn_exp2f(p0[r]); p1[r] = __builtin_amdgcn_exp2f(p1[r]); sacc += p0[r] + p1[r]; }
        l_reg += sacc;
        u32x4 pw0, pw1, pw2, pw3;
        pw0 = (u32x4){cvtpk(p0[0], p0[1]), cvtpk(p0[2], p0[3]), cvtpk(p0[4], p0[5]), cvtpk(p0[6], p0[7])};
        pw1 = (u32x4){cvtpk(p0[8], p0[9]), cvtpk(p0[10], p0[11]), cvtpk(p0[12], p0[13]), cvtpk(p0[14], p0[15])};
        pw2 = (u32x4){cvtpk(p1[0], p1[1]), cvtpk(p1[2], p1[3]), cvtpk(p1[4], p1[5]), cvtpk(p1[6], p1[7])};
        pw3 = (u32x4){cvtpk(p1[8], p1[9]), cvtpk(p1[10], p1[11]), cvtpk(p1[12], p1[13]), cvtpk(p1[14], p1[15])};
        SBAR();
        pv(o, vb0 + slot, __builtin_bit_cast(bf16x8, pw0), __builtin_bit_cast(bf16x8, pw1), __builtin_bit_cast(bf16x8, pw2), __builtin_bit_cast(bf16x8, pw3));
    }
    { auto rr = __builtin_amdgcn_permlane32_swap(__float_as_uint(l_reg), __float_as_uint(l_reg), false, false); l_reg = __uint_as_float(rr[0]) + __uint_as_float(rr[1]); }
    if (hi == 0) wsf[32 + r32] = l_reg; asm volatile("s_waitcnt lgkmcnt(0)" ::: "memory");
    float rli[16];
#pragma unroll
    for (int r = 0; r < 16; ++r) rli[r] = __builtin_amdgcn_rcpf(wsf[32 + crow(r, hi)]);
    { LAS bf16* stg = (LAS bf16*)(shm3 + LDS_OST) + wid * 2048;
#pragma unroll
      for (int r = 0; r < 16; ++r) { const int orow = crow(r, hi);
#pragma unroll
          for (int d0 = 0; d0 < 2; ++d0) stg[orow * 64 + d0 * 32 + r32] = (bf16)(cvtpk(o[d0][r] * rli[r], 0.f) & 0xffffu); }
      asm volatile("s_waitcnt lgkmcnt(0)" ::: "memory");
#pragma unroll
      for (int i = 0; i < 4; ++i) { const int row = i * 8 + (lane >> 3), ch = lane & 7; const u32x4 v = *(const LAS u32x4*)(stg + row * 64 + ch * 8); *(u32x4*)(Ow + (size_t)row * opitch + ch * 8) = v; } }
    asm volatile("s_waitcnt vmcnt(0) lgkmcnt(0)\n\ts_barrier" ::: "memory");
#undef ATT_DMA
}
#undef SBAR
#undef WAIT_BAR0
}

struct SsmArgs { const float *lam_re, *lam_im, *log_step, *b_re, *b_im, *c_re, *c_im;
                 const float* U; float* YF; float* YB; float* F; const float* h0; float* out_ssm; int layer; };
constexpr int SSM_PITCH = 132, SSM_WAVE_BYTES = 32 * SSM_PITCH * 4;
__device__ __forceinline__ void split8(const float* v, bf16x8& h, bf16x8& l) {
    unsigned hw[4], lw[4];
#pragma unroll
    for (int i = 0; i < 4; ++i) { const unsigned w = cvtpk(v[2 * i], v[2 * i + 1]); hw[i] = w; const float r0 = v[2 * i] - bf2f(w & 0xffffu), r1 = v[2 * i + 1] - bf2f(w >> 16); lw[i] = cvtpk(r0, r1); }
    h = __builtin_bit_cast(bf16x8, (u32x4){hw[0], hw[1], hw[2], hw[3]}); l = __builtin_bit_cast(bf16x8, (u32x4){lw[0], lw[1], lw[2], lw[3]});
}
__device__ __forceinline__ void ssm_unit(const SsmArgs& A, int mode, int b, int g, int d, int k, LAS float* buf) {
    const int lane = FRESH_LANE();
    const int hi = lane >> 5, l31 = lane & 31, fr = lane & 15, fq = lane >> 4;
    const int gd = d * 16 + g;
    const float step = expf(A.log_step[gd]);
    float ar[2], ai[2], cr[2], ci[2];
#pragma unroll
    for (int q = 0; q < 2; ++q) { const int p = l31 + 32 * q; const float lr = A.lam_re[gd * 64 + p], li = A.lam_im[gd * 64 + p];
        const float e = expf(lr * step); float s, c; sincosf(li * step, &s, &c); ar[q] = e * c; ai[q] = e * s;
        const float den = 1.0f / (lr * lr + li * li), xr = ar[q] - 1.0f; cr[q] = (xr * lr + ai[q] * li) * den; ci[q] = (ai[q] * lr - xr * li) * den; }
    bf16x8 Bh[4], Bl[4];
#pragma unroll
    for (int q = 0; q < 2; ++q) { const int p = l31 + 32 * q; const float* br = A.b_re + ((size_t)gd * 64 + p) * 16 + 8 * hi; const float* bi = A.b_im + ((size_t)gd * 64 + p) * 16 + 8 * hi;
        const f32x4 r0 = *(const f32x4*)br, r1 = *(const f32x4*)(br + 4), i0 = *(const f32x4*)bi, i1 = *(const f32x4*)(bi + 4);
        float vr[8], vi[8];
#pragma unroll
        for (int j = 0; j < 4; ++j) { vr[j] = cr[q] * r0[j] - ci[q] * i0[j]; vi[j] = cr[q] * i0[j] + ci[q] * r0[j]; vr[4 + j] = cr[q] * r1[j] - ci[q] * i1[j]; vi[4 + j] = cr[q] * i1[j] + ci[q] * r1[j]; }
        split8(vr, Bh[q], Bl[q]); split8(vi, Bh[2 + q], Bl[2 + q]); }
    bf16x8 Cf[4];
#pragma unroll
    for (int ks = 0; ks < 4; ++ks) { const float* cp = (ks < 2 ? A.c_re : A.c_im) + ((size_t)gd * 16 + fr) * 64 + 32 * (ks & 1) + 8 * fq; const float sg = ks < 2 ? 1.0f : -1.0f;
        const f32x4 c0 = *(const f32x4*)cp * sg, c1 = *(const f32x4*)(cp + 4) * sg;
        Cf[ks] = __builtin_bit_cast(bf16x8, (u32x4){cvtpk(c0[0], c0[1]), cvtpk(c0[2], c0[3]), cvtpk(c1[0], c1[1]), cvtpk(c1[2], c1[3])}); }
    const float sar = hi ? ar[1] : ar[0], sai = hi ? ai[1] : ai[0];
    const int L = mode == 0 ? 256 : 2048; const int seqrow0 = mode == 0 ? b * 256 : 4096 + b * 2048;
    float hr = 0.f, hm = 0.f;
    if (mode == 2) {
        const size_t so = ((((size_t)(b * 2 + A.layer) * 2 + d) * 2) * 16 + g) * 64 + lane;
        hr = A.h0[so]; hm = A.h0[so + 16 * 64];
        float pr = sar, pi = sai;
#pragma unroll
        for (int i = 0; i < 8; ++i) { const float nr = pr * pr - pi * pi, ni = 2.0f * pr * pi; pr = nr; pi = ni; }
        for (int kk = 0; kk < k; ++kk) { const size_t fo = ((((size_t)(b * 16 + g) * 2 + d) * 8 + kk) * 2) * 64 + lane; const float fr_ = A.F[fo], fi_ = A.F[fo + 64];
            const float nr = pr * hr - pi * hm + fr_, ni = pr * hm + pi * hr + fi_; hr = nr; hm = ni; }
    }
    float* Y = A.YF + (size_t)d * ((size_t)M_TOK * 256);
#ifdef DBG_SSM_F32
    float dbre[16], dbim[16];
    { const float ccr = hi ? cr[1] : cr[0], cci = hi ? ci[1] : ci[0]; const float* br = A.b_re + ((size_t)gd * 64 + lane) * 16; const float* bi = A.b_im + ((size_t)gd * 64 + lane) * 16;
#pragma unroll
      for (int c = 0; c < 16; ++c) { dbre[c] = ccr * br[c] - cci * bi[c]; dbim[c] = ccr * bi[c] + cci * br[c]; } }
#endif
    for (int sc = 0; sc < 8; ++sc) {
        const int s0 = 256 * k + 32 * sc;
#ifdef DBG_SSM_F32
        for (int j = 0; j < 32; ++j) { const int s = s0 + j; const int t = d ? L - 1 - s : s; const float* up = A.U + (size_t)(seqrow0 + t) * 256 + g * 16; float a_r = 0.f, a_i = 0.f;
#pragma unroll
            for (int c = 0; c < 16; ++c) { const float uv = up[c]; a_r = fmaf(dbre[c], uv, a_r); a_i = fmaf(dbim[c], uv, a_i); }
            buf[j * SSM_PITCH + lane] = a_r; buf[j * SSM_PITCH + 64 + lane] = a_i; }
#else
        { const int s = s0 + l31; const int t = d ? L - 1 - s : s;
          const float* up = A.U + (size_t)(seqrow0 + t) * 256 + g * 16 + 8 * hi;
          const f32x4 x0 = *(const f32x4*)up, x1 = *(const f32x4*)(up + 4);
          const float xv[8] = {x0[0], x0[1], x0[2], x0[3], x1[0], x1[1], x1[2], x1[3]};
          bf16x8 ah, al; split8(xv, ah, al);
#pragma unroll
          for (int n = 0; n < 4; ++n) { f32x16 D = f32x16{};
              D = __builtin_amdgcn_mfma_f32_32x32x16_bf16(ah, Bh[n], D, 0, 0, 0); D = __builtin_amdgcn_mfma_f32_32x32x16_bf16(al, Bh[n], D, 0, 0, 0); D = __builtin_amdgcn_mfma_f32_32x32x16_bf16(ah, Bl[n], D, 0, 0, 0);
#pragma unroll
              for (int r = 0; r < 16; ++r) buf[crow(r, hi) * SSM_PITCH + 32 * n + l31] = D[r]; } }
#endif
#pragma unroll
        for (int j = 0; j < 32; ++j) { const float re = buf[j * SSM_PITCH + lane], im = buf[j * SSM_PITCH + 64 + lane];
            const float nr = fmaf(sar, hr, fmaf(-sai, hm, re)), ni = fmaf(sar, hm, fmaf(sai, hr, im)); hr = nr; hm = ni;
            if (mode != 1) { buf[j * SSM_PITCH + lane] = hr; buf[j * SSM_PITCH + 64 + lane] = hm; } }
        if (mode != 1) {
#pragma unroll
            for (int rt = 0; rt < 2; ++rt) { f32x4 acc = {0.f, 0.f, 0.f, 0.f};
#pragma unroll
                for (int ks = 0; ks < 4; ++ks) { const LAS float* hp = buf + (16 * rt + fr) * SSM_PITCH + 32 * ks + 8 * fq; const f32x4 h0 = *(const LAS f32x4*)hp, h1 = *(const LAS f32x4*)(hp + 4);
                    const bf16x8 ahh = __builtin_bit_cast(bf16x8, (u32x4){cvtpk(h0[0], h0[1]), cvtpk(h0[2], h0[3]), cvtpk(h1[0], h1[1]), cvtpk(h1[2], h1[3])});
                    acc = __builtin_amdgcn_mfma_f32_16x16x32_bf16(ahh, Cf[ks], acc, 0, 0, 0); }
#pragma unroll
                for (int r = 0; r < 4; ++r) { const int s = s0 + 16 * rt + 4 * fq + r; const int t = d ? L - 1 - s : s; Y[(size_t)(seqrow0 + t) * 256 + g * 16 + fr] = acc[r]; } }
        }
    }
    if (mode == 0) { const size_t so = ((((size_t)(b * 2 + A.layer) * 2 + d) * 2) * 16 + g) * 64 + lane; A.out_ssm[so] = hr * DBG_SSM; A.out_ssm[so + 16 * 64] = hm * DBG_SSM; }
    if (mode == 1) { const size_t fo = ((((size_t)(b * 16 + g) * 2 + d) * 8 + k) * 2) * 64 + lane; A.F[fo] = hr; A.F[fo + 64] = hm; }
}

__device__ __forceinline__ void norm_mod_rows(const float* xc, const float* xl, const float* g, const float* mod, int sh_off, int sc_off, bf16* H, int gw, int NGW, int lane) {
    for (int row = gw; row < M_TOK; row += NGW) {
        const float* xr = row < 4096 ? xc + (size_t)row * 1024 : xl + (size_t)(row - 4096) * 1024;
        const int cv = row < 4096 ? 0 : 1 + ((row - 4096) >> 11);
        f32x4 v[4]; float ss = 0.f;
#pragma unroll
        for (int j = 0; j < 4; ++j) { v[j] = *(const f32x4*)(xr + 4 * (lane + 64 * j)); ss += (v[j][0] * v[j][0] + v[j][1] * v[j][1]) + (v[j][2] * v[j][2] + v[j][3] * v[j][3]); }
        const float rstd = rsqrtf(wave_sum(ss) * (1.0f / 1024.0f) + EPS);
        const float* mp = mod + cv * 6144;
#pragma unroll
        for (int j = 0; j < 4; ++j) { const int c = 4 * (lane + 64 * j); const f32x4 gg = *(const f32x4*)(g + c), sc = *(const f32x4*)(mp + sc_off + c), sh = *(const f32x4*)(mp + sh_off + c);
            const f32x4 o = v[j] * rstd * gg * (sc + 1.0f) + sh; u32x2 w; w.x = cvtpk(o[0], o[1]); w.y = cvtpk(o[2], o[3]); *(u32x2*)(H + (size_t)row * 1024 + c) = w; }
    }
}
__device__ __forceinline__ void final_norm_rows(float* x, const float* g, int gw, int NGW, int lane) {
    for (int row = gw; row < M_TOK; row += NGW) {
        float* xr = x + (size_t)row * 1024;
        f32x4 v[4]; float ss = 0.f;
#pragma unroll
        for (int j = 0; j < 4; ++j) { v[j] = *(const f32x4*)(xr + 4 * (lane + 64 * j)); ss += (v[j][0] * v[j][0] + v[j][1] * v[j][1]) + (v[j][2] * v[j][2] + v[j][3] * v[j][3]); }
        const float rstd = rsqrtf(wave_sum(ss) * (1.0f / 1024.0f) + EPS);
#ifdef DBG_SCALE_S
        const float dsc = row >= 4096 ? DBG_SCALE_S : DBG_SCALE_P;
#else
        const float dsc = 1.0f;
#endif
#pragma unroll
        for (int j = 0; j < 4; ++j) { const int c = 4 * (lane + 64 * j); *(f32x4*)(xr + c) = v[j] * (rstd * dsc) * *(const f32x4*)(g + c); }
    }
}

__device__ __forceinline__ int maprow(int mode, int n) {
    if (mode == 1) { const int lc = n & 255; return (n & ~255) + 128 * ((lc >> 5) & 1) + 32 * (lc >> 6) + (lc & 31); }
    if (mode == 2) { if (n < DFF) return 256 * (n >> 7) + (n & 127); const int n2 = n - DFF; return 256 * (n2 >> 7) + 128 + (n2 & 127); }
    return n;
}
__device__ __forceinline__ void transpose_item(const float* W, int K, int N, bf16* WT, int mode, LAS float* scr, int item, int lane) {
    const int nblk = N / 32, kb = item / nblk, nb = item % nblk, k0 = 64 * kb, n0 = 32 * nb;
#pragma unroll 8
    for (int i = 0; i < 32; ++i) { const int kk = 2 * i + (lane >> 5); scr[kk * 33 + (lane & 31)] = W[(size_t)(k0 + kk) * N + n0 + (lane & 31)]; }
    asm volatile("s_waitcnt lgkmcnt(0)" ::: "memory");
    const int c = lane & 7;
#pragma unroll
    for (int j = 0; j < 4; ++j) { const int n = (lane >> 3) + 8 * j; const LAS float* s = scr + (8 * c) * 33 + n;
        u32x4 o; o.x = cvtpk(s[0 * 33], s[1 * 33]); o.y = cvtpk(s[2 * 33], s[3 * 33]); o.z = cvtpk(s[4 * 33], s[5 * 33]); o.w = cvtpk(s[6 * 33], s[7 * 33]);
        *(u32x4*)(WT + (size_t)maprow(mode, n0 + n) * K + k0 + 8 * c) = o; }
    asm volatile("s_waitcnt lgkmcnt(0)" ::: "memory");
}

struct Args { const float* in[33]; float* out; unsigned char* ws; int ph_lo, ph_hi; };
constexpr int N_PHASES = 22;

__global__ void __launch_bounds__(512, 2) mega_fwd(Args args) {
    extern __shared__ __attribute__((aligned(16))) unsigned char lds[];
    LAS unsigned char* L = (LAS unsigned char*)lds;
    cg::grid_group grid = cg::this_grid();
    const int wave0 = __builtin_amdgcn_readfirstlane(threadIdx.x >> 6);
    for (int ph = args.ph_lo; ph < args.ph_hi; ++ph) {
        if (ph > args.ph_lo) grid.sync();
        int wave = wave0; asm volatile("" : "+s"(wave)); int G = gridDim.x; asm volatile("" : "+s"(G)); int bx = blockIdx.x; asm volatile("" : "+s"(bx));
    const int gw = bx * 8 + wave, NGW = G * 8;
    unsigned char* ws = args.ws; asm volatile("" : "+s"(ws)); float* out = args.out; asm volatile("" : "+s"(out));
    float* MOD = (float*)(ws + WS_MOD); float* ROPE = (float*)(ws + WS_ROPE);
    bf16* Hb = (bf16*)(ws + WS_H); float* YF = (float*)(ws + WS_H); float* YB = YF + (size_t)M_TOK * 256;
    bf16 *QA = (bf16*)(ws + WS_QA), *KA = (bf16*)(ws + WS_KA), *VA = (bf16*)(ws + WS_VA), *QC = (bf16*)(ws + WS_QC), *KC = (bf16*)(ws + WS_KC), *VC = (bf16*)(ws + WS_VC);
    float* Ub = (float*)(ws + WS_U); float* MF = (float*)(ws + WS_QKVU);
    bf16* GATES = (bf16*)(ws + WS_GATES); bf16* ACT = (bf16*)(ws + WS_GATES);
    bf16 *OA = (bf16*)(ws + WS_OA), *OB = (bf16*)(ws + WS_OB), *OC = (bf16*)(ws + WS_OC);
    bf16 *CKAK = (bf16*)(ws + WS_CKAK), *CKAV = (bf16*)(ws + WS_CKAV), *CKCK = (bf16*)(ws + WS_CKCK), *CKCV = (bf16*)(ws + WS_CKCV);
    float* SSMF = (float*)(ws + WS_SSMF);

        if (ph == 0) {
            const int lane = FRESH_LANE(), tid = wave * 64 + lane;
            LAS float* S = (LAS float*)(L + 69632);
            LAS float* red = (LAS float*)(L + 90112);
            if (bx < 192) {
                for (int i = tid; i < 5 * 1024; i += 512) { const int cv = i >> 10, kx = i & 1023; const float c = cv == 0 ? args.in[8][kx] : args.in[2][(cv - 1) * 1024 + kx]; S[i] = c / (1.0f + __expf(-c)); }
                __syncthreads();
                for (int item = bx; item < 192; item += G) {
                    const int l = item / 96, col = (item % 96) * 64 + lane;
                    const float* wp = args.in[9] + (size_t)l * 1024 * 6144 + col;
                    float a0 = 0.f, a1 = 0.f, a2 = 0.f, a3 = 0.f, a4 = 0.f;
#pragma unroll 16
                    for (int kk = 0; kk < 128; ++kk) { const int kx = wave * 128 + kk; const float w = wp[(size_t)kx * 6144];
                        a0 += S[kx] * w; a1 += S[1024 + kx] * w; a2 += S[2048 + kx] * w; a3 += S[3072 + kx] * w; a4 += S[4096 + kx] * w; }
                    red[(wave * 5 + 0) * 64 + lane] = a0; red[(wave * 5 + 1) * 64 + lane] = a1; red[(wave * 5 + 2) * 64 + lane] = a2; red[(wave * 5 + 3) * 64 + lane] = a3; red[(wave * 5 + 4) * 64 + lane] = a4;
                    __syncthreads();
                    if (wave < 5) { float s = args.in[10][l * 6144 + col];
#pragma unroll
                        for (int w8 = 0; w8 < 8; ++w8) s += red[(w8 * 5 + wave) * 64 + lane];
                        MOD[(l * 5 + wave) * 6144 + col] = s; }
                    __syncthreads();
                }
            }
            if (bx == G - 2 && tid < 256) { const int ll = tid >> 7, qk = (tid >> 6) & 1, e = tid & 63; ((float*)(ws + WS_QKG))[tid] = (qk ? args.in[14] : args.in[13])[ll * 64 + e]; }
            { const int gtid = bx * 512 + tid, NTH = G * 512;
#define CPY(idx, off, n) for (int i = gtid; i < (n) / 4; i += NTH) ((f32x4*)(ws + WS_PAR) + (off) / 4)[i] = ((const f32x4*)args.in[idx])[i];
              CPY(11, P_N1G, 2048) CPY(29, P_N2G, 2048) CPY(32, P_FING, 1024) CPY(7, P_SSM0, 32768) CPY(15, P_LAMR, 4096) CPY(16, P_LAMI, 4096) CPY(17, P_LSTEP, 64)
              CPY(18, P_BRE, 65536) CPY(19, P_BIM, 65536) CPY(20, P_CRE, 65536) CPY(21, P_CIM, 65536) CPY(22, P_SSMD, 512) CPY(24, P_NAB, 3720)
#undef CPY
            }
            if (bx == G - 1) { for (int i = tid; i < 1024; i += 512) { const int pos = i >> 4, f = i & 15; const float inv = 1.0f / powf(10000.0f, (float)f / 16.0f); const float ang = (float)pos * inv; ROPE[2 * i] = cosf(ang); ROPE[2 * i + 1] = sinf(ang); } }
            for (int it = bx * 512 + tid; it < 196608; it += G * 512) {
                const float* src; bf16* dst; int e;
                if (it < 65536) { const bool isv = it >= 32768; e = (it & 32767) * 8; const int d = e & 63, t = (e >> 6) & 255, h = (e >> 14) & 1, b = (e >> 15) & 3, l = e >> 17;
                    src = (isv ? args.in[4] : args.in[3]) + ((((size_t)(b * 2 + l) * 256 + t) * 2 + h) * 64 + d); dst = (isv ? CKAV : CKAK) + e; }
                else { const int i2 = it - 65536; const bool isv = i2 >= 65536; e = (i2 & 65535) * 8; const int d = e & 63, t = (e >> 6) & 255, h = (e >> 14) & 3, b = (e >> 16) & 3, l = e >> 18;
                    src = (isv ? args.in[6] : args.in[5]) + ((((size_t)(b * 2 + l) * 256 + t) * 4 + h) * 64 + d); dst = (isv ? CKCV : CKCK) + e; }
                const f32x4 a = *(const f32x4*)src, c = *(const f32x4*)(src + 4);
                *(u32x4*)dst = (u32x4){cvtpk(a[0], a[1]), cvtpk(a[2], a[3]), cvtpk(c[0], c[1]), cvtpk(c[2], c[3])};
            }
            LAS float* scr = (LAS float*)(L + wave * 8448);
            for (int it = gw; it < 15424; it += NGW) {
                const int l = it / 7712; int r = it % 7712;
                if (r < 2432) { transpose_item(args.in[12] + (size_t)l * DM * NIN, DM, NIN, (bf16*)(ws + W_IN) + (size_t)l * NIN * DM, 1, scr, r, lane); continue; } r -= 2432;
                if (r < 256) { transpose_item(args.in[25] + (size_t)l * 512 * DM, 512, DM, (bf16*)(ws + W_BRA) + (size_t)l * DM * 512, 0, scr, r, lane); continue; } r -= 256;
                if (r < 128) { transpose_item(args.in[26] + (size_t)l * 256 * DM, 256, DM, (bf16*)(ws + W_BRB) + (size_t)l * DM * 256, 0, scr, r, lane); continue; } r -= 128;
                if (r < 128) { transpose_item(args.in[27] + (size_t)l * 256 * DM, 256, DM, (bf16*)(ws + W_BRC) + (size_t)l * DM * 256, 0, scr, r, lane); continue; } r -= 128;
                if (r < 512) { transpose_item(args.in[28] + (size_t)l * DM * DM, DM, DM, (bf16*)(ws + W_OUT) + (size_t)l * DM * DM, 0, scr, r, lane); continue; } r -= 512;
                if (r < 2816) { transpose_item(args.in[30] + (size_t)l * DM * NGU, DM, NGU, (bf16*)(ws + W_GU) + (size_t)l * NGU * DM, 2, scr, r, lane); continue; } r -= 2816;
                if (r < 1408) { transpose_item(args.in[31] + (size_t)l * DFF * DM, DFF, DM, (bf16*)(ws + W_FD) + (size_t)l * DM * DFF, 0, scr, r, lane); continue; } r -= 1408;
                transpose_item(args.in[23] + (size_t)l * 256 * 256, 256, 256, (bf16*)(ws + W_GLU) + (size_t)l * 256 * 256, 0, scr, r, lane);
            }
            __syncthreads();
            continue;
        }
        const float* const PAR = (const float*)(ws + WS_PAR);
        if (ph == N_PHASES - 1) { const int lane = FRESH_LANE(); final_norm_rows(out, PAR + P_FING, gw, NGW, lane); continue; }
        const int l = (ph - 1) / 10, sp = (ph - 1) % 10;
        const float* modl = MOD + (size_t)l * 5 * 6144;
        const float* xc_in = args.in[0]; const float* xl_in = args.in[1];
        const float* xc_cur = out; const float* xl_cur = out + (size_t)4096 * 1024;
        pg8::StaticOrder S;
        switch (sp) {
        case 0: {
            const bool first = (l == 0); const int lane = FRESH_LANE();
            norm_mod_rows(first ? xc_in : xc_cur, first ? xl_in : xl_cur, PAR + P_N1G + l * 1024, modl, 0, 1024, Hb, gw, NGW, lane);
        } break;
        case 1: {
            pg8::Gemm g{Hb, (const bf16*)(ws + W_IN) + (size_t)l * NIN * DM, M_TOK, NIN, DM}; S.init(M_TOK, NIN, G, bx);
            EpiIn E{ws, out, l};

#ifndef CUT_IN
            pg8::gemm_phase<EpiIn, pg8::StaticOrder, true, true>(L, g, S, E, wave);
#endif

        } break;
        case 2: {
            SsmArgs SA{PAR + P_LAMR + l * 2048, PAR + P_LAMI + l * 2048, PAR + P_LSTEP + l * 32, PAR + P_BRE + (size_t)l * 32768, PAR + P_BIM + (size_t)l * 32768, PAR + P_CRE + (size_t)l * 32768, PAR + P_CIM + (size_t)l * 32768,
                       Ub, YF, YB, SSMF, PAR + P_SSM0, out + O_SSM, l};
            for (int item = bx; item < 768; item += G) {
                if (item < 256) {
                    const int b = item >> 6, h = (item >> 3) & 7, qb = item & 7, kvh = h >> 2;
                    const bf16* Qw = QA + ((size_t)4096 * 8 + (size_t)(b * 8 + h) * 2048 + qb * 256 + wave * 32) * 64;
                    const size_t co = ((size_t)((l * 4 + b) * 2 + kvh) * 256) * 64, lo = ((size_t)4096 * 2 + (size_t)(b * 2 + kvh) * 2048) * 64;
                    bf16* Ow = OA + ((size_t)4096 + b * 2048 + qb * 256 + wave * 32) * 512 + h * 64;

#ifndef CUT_ATT
                    att::attn_unit<false>(Qw, CKAK + co, CKAV + co, KA + lo, VA + lo, 36, Ow, 512, (char*)lds, 0, 0, nullptr, wave);
#endif

                } else if (item < 384) {
                    const int i = item - 256, b = i >> 5, h = (i >> 3) & 3, qb = i & 7, r0 = 4 * qb;
                    const int rlo = clampi(r0 - 4, 0, 24), rhi = clampi(r0 - 1, 0, 24) + 7, NT = 4 + rhi - rlo + 1;
                    const bf16* Qw = QC + ((size_t)4096 * 4 + (size_t)(b * 4 + h) * 2048 + qb * 256 + wave * 32) * 64;
                    const size_t co = ((size_t)((l * 4 + b) * 4 + h) * 256) * 64, lo = ((size_t)4096 * 4 + (size_t)(b * 4 + h) * 2048 + rlo * 64) * 64;
                    bf16* Ow = OC + ((size_t)4096 + b * 2048 + qb * 256 + wave * 32) * 256 + h * 64;

#ifndef CUT_NA
                    att::attn_unit<true>(Qw, CKCK + co, CKCV + co, KC + lo, VC + lo, NT, Ow, 256, (char*)lds, r0 + (wave >> 1), rlo, PAR + P_NAB + (size_t)(l * 4 + h) * 465, wave);
#endif

                } else if (item < 512) {
                    const int i = item - 384, b = i >> 3, h = i & 7, kvh = h >> 2;
                    const bf16* Qw = QA + ((size_t)(b * 8 + h) * 256 + wave * 32) * 64;
                    const size_t co = ((size_t)(b * 2 + kvh) * 256) * 64;
                    bf16* Ow = OA + ((size_t)b * 256 + wave * 32) * 512 + h * 64;

#ifndef CUT_ATT
 att::attn_unit<false>(Qw, KA + co, VA + co, KA, VA, 4, Ow, 512, (char*)lds, 0, 0, nullptr, wave);
#endif

                } else if (item < 576) {
                    const int i = item - 512, b = i >> 2, h = i & 3;
                    const bf16* Qw = QC + ((size_t)(b * 4 + h) * 256 + wave * 32) * 64;
                    const size_t co = ((size_t)(b * 4 + h) * 256) * 64;
                    bf16* Ow = OC + ((size_t)b * 256 + wave * 32) * 256 + h * 64;

#ifndef CUT_ATT
 att::attn_unit<false>(Qw, KC + co, VC + co, KC, VC, 4, Ow, 256, (char*)lds, 0, 0, nullptr, wave);
#endif

                } else {
                    const int wu = (item - 576) * 8 + wave;
                    LAS float* buf = (LAS float*)(L + wave * SSM_WAVE_BYTES);

#ifndef CUT_SSM
                    if (wu < 512) ssm_unit(SA, 0, wu >> 5, (wu >> 1) & 15, wu & 1, 0, buf);
                    else { const int w2 = wu - 512; ssm_unit(SA, 1, w2 >> 8, (w2 >> 4) & 15, (w2 >> 3) & 1, w2 & 7, buf); }
#endif
                    asm volatile("s_waitcnt vmcnt(0) lgkmcnt(0)" ::: "memory");
                    __syncthreads();
                }
            }
        } break;
        case 3: {
            SsmArgs SA{PAR + P_LAMR + l * 2048, PAR + P_LAMI + l * 2048, PAR + P_LSTEP + l * 32, PAR + P_BRE + (size_t)l * 32768, PAR + P_BIM + (size_t)l * 32768, PAR + P_CRE + (size_t)l * 32768, PAR + P_CIM + (size_t)l * 32768,
                       Ub, YF, YB, SSMF, PAR + P_SSM0, out + O_SSM, l};
            LAS float* buf = (LAS float*)(L + wave * SSM_WAVE_BYTES);

#ifndef CUT_SSM
            for (int wu = wave * G + bx; wu < 1024; wu += 8 * G) ssm_unit(SA, 2, wu >> 8, (wu >> 4) & 15, (wu >> 3) & 1, wu & 7, buf);
#endif
            asm volatile("s_waitcnt vmcnt(0) lgkmcnt(0)" ::: "memory");
            __syncthreads();
        } break;
        case 4: {
            pg8::StaticOrder SG; SG.init(M_TOK, 256, G, bx); Unit ug;
            if (SG.next(0, ug)) {
                const int tid = wave * 64 + FRESH_LANE();
                const float* dv = PAR + P_SSMD + l * 256;
                for (int i = 0; i < 32; ++i) { const int idx = tid + 512 * i, r = idx >> 6, c = (idx & 63) * 4; const size_t o = (size_t)(ug.pm * 256 + r) * 256 + c;
                    const f32x4 y = *(const f32x4*)(YF + o) + *(const f32x4*)(YB + o) + *(const f32x4*)(dv + c) * *(const f32x4*)(Ub + o); f32x4 q;
#pragma unroll
                    for (int j = 0; j < 4; ++j) { const float v = y[j]; q[j] = 0.5f * v * (1.0f + tanhf(0.7978845608028654f * (v + 0.044715f * v * v * v))); }
                    u32x2 w; w.x = cvtpk(q[0], q[1]); w.y = cvtpk(q[2], q[3]); *(u32x2*)(OB + o) = w; }
                __threadfence(); __syncthreads();
                pg8::Gemm g{OB, (const bf16*)(ws + W_GLU) + (size_t)l * 256 * 256, M_TOK, 256, 256};
                EpiGlu E{OB};
                pg8::gemm_phase<EpiGlu, pg8::StaticOrder, true, true>(L, g, SG, E, wave);
            }
        } break;
        case 5: {
            S.init(M_TOK, DM, G, bx);
            { pg8::Gemm g{OA, (const bf16*)(ws + W_BRA) + (size_t)l * DM * 512, M_TOK, DM, 512}; EpiBr<0> E{GATES, MF, nullptr}; pg8::gemm_phase<EpiBr<0>, pg8::StaticOrder, true, true>(L, g, S, E, wave); }
            { pg8::Gemm g{OC, (const bf16*)(ws + W_BRC) + (size_t)l * DM * 256, M_TOK, DM, 256}; EpiBr<1> E{GATES + 2048, MF, nullptr}; pg8::gemm_phase<EpiBr<1>, pg8::StaticOrder, true, true>(L, g, S, E, wave); }
            { pg8::Gemm g{OB, (const bf16*)(ws + W_BRB) + (size_t)l * DM * 256, M_TOK, DM, 256}; EpiBr<2> E{GATES + 1024, MF, Hb}; pg8::gemm_phase<EpiBr<2>, pg8::StaticOrder, true, true>(L, g, S, E, wave); }
        } break;
        case 6: {
            S.init(M_TOK, DM, G, bx);
            pg8::Gemm g{Hb, (const bf16*)(ws + W_OUT) + (size_t)l * DM * DM, M_TOK, DM, DM};
            EpiRes E{l == 0 ? xc_in : xc_cur, l == 0 ? xl_in : xl_cur, out, modl + 2048};
            pg8::gemm_phase<EpiRes, pg8::StaticOrder, true, true>(L, g, S, E, wave);
        } break;
        case 7: {
            const int lane = FRESH_LANE();
            norm_mod_rows(xc_cur, xl_cur, PAR + P_N2G + l * 1024, modl, 3072, 4096, Hb, gw, NGW, lane);
        } break;
        case 8: {
            pg8::Gemm g{Hb, (const bf16*)(ws + W_GU) + (size_t)l * NGU * DM, M_TOK, NGU, DM}; S.init(M_TOK, NGU, G, bx);
            EpiSwiglu E{ACT};
            pg8::gemm_phase<EpiSwiglu, pg8::StaticOrder, true, true>(L, g, S, E, wave);
        } break;
        case 9: {
            S.init(M_TOK, DM, G, bx);
            pg8::Gemm g{ACT, (const bf16*)(ws + W_FD) + (size_t)l * DM * DFF, M_TOK, DM, DFF};
            EpiRes E{xc_cur, xl_cur, out, modl + 5120};
            pg8::gemm_phase<EpiRes, pg8::StaticOrder, true, true>(L, g, S, E, wave);
        } break;
        }
    }
}

extern "C" void kernel_launch(void* const* d_in, const int* in_sizes, int n_in, void* d_out, int out_size, void* d_ws, size_t ws_size, hipStream_t stream) {
    static int grid = 0;
    if (grid == 0) {
        if (n_in != 33 || ws_size < WS_END) { fprintf(stderr, "kernel_launch: unexpected n_in %d / ws_size %zu\n", n_in, ws_size); grid = -1; return; }
        int dev = 0, cus = 0, per_cu = 0;
        hipGetDevice(&dev); hipDeviceGetAttribute(&cus, hipDeviceAttributeMultiprocessorCount, dev);
        if (hipFuncSetAttribute((const void*)mega_fwd, hipFuncAttributeMaxDynamicSharedMemorySize, LDS_BYTES) != hipSuccess) { fprintf(stderr, "kernel_launch: hipFuncSetAttribute failed\n"); grid = -1; return; }
        if (hipOccupancyMaxActiveBlocksPerMultiprocessor(&per_cu, (const void*)mega_fwd, 512, LDS_BYTES) != hipSuccess || per_cu < 1) { fprintf(stderr, "kernel_launch: occupancy query says %d\n", per_cu); per_cu = 1; }
        (void)hipGetLastError();
        grid = cus * 1;
        fprintf(stderr, "kernel_launch: cus %d per_cu %d grid %d ws %zu\n", cus, per_cu, grid, ws_size);
    }
    if (grid < 0) return;
    Args a{};
    for (int i = 0; i < 33; ++i) a.in[i] = (const float*)d_in[i];
    a.out = (float*)d_out; a.ws = (unsigned char*)d_ws;
#if MK_MULTI
    for (int ph = 0; ph < N_PHASES; ++ph) { a.ph_lo = ph; a.ph_hi = ph + 1; hipLaunchKernelGGL(mega_fwd, dim3(grid), dim3(512), LDS_BYTES, stream, a); }
#else
    a.ph_lo = 0; a.ph_hi = N_PHASES;
    void* kargs[] = {&a};
    hipError_t e = hipLaunchCooperativeKernel((const void*)mega_fwd, dim3(grid), dim3(512), kargs, LDS_BYTES, stream);
    if (e != hipSuccess) fprintf(stderr, "cooperative launch failed: %s (grid %d)\n", hipGetErrorString(e), grid);
#endif
}
```

```cpp
#include <hip/hip_runtime.h>
#include <hip/hip_cooperative_groups.h>
#include <hip/hip_bf16.h>
#include <cstdio>
#include <cstdint>
namespace cg = cooperative_groups;

#ifndef MK_MULTI
#define MK_MULTI 0
#endif

namespace pg8 {
#define PG8_LAS __attribute__((address_space(3)))
typedef unsigned short bf16_t;
typedef short bf16x8 __attribute__((ext_vector_type(8)));
typedef float f32x4 __attribute__((ext_vector_type(4)));
typedef unsigned u32x4 __attribute__((ext_vector_type(4)));
constexpr int BM = 256, BK = 64, HALF = 128, HTB = HALF * BK * 2  , STAGE_BYTES = 8 * HTB, NXCD = 8, WGM = 8;

__host__ __device__ __forceinline__ int lds_byte(int r, int c) { const int st = (r >> 4) * 2 + (c >> 5), rr = r & 15, cc = c & 31, ob = rr * 64 + cc * 2; return st * 1024 + (ob ^ (((ob >> 9) & 1) << 5)); }
__host__ __device__ __forceinline__ void stage_rc(int b, int& R, int& C) { const int st = b / 1024, sb = b % 1024, swz = sb ^ (((sb >> 9) & 1) << 5); R = (st >> 1) * 16 + swz / 64; C = (st & 1) * 32 + (swz % 64) / 2; }
__host__ __device__ __forceinline__ int perm32(int rho) { const int n = rho >> 4, i = rho & 15; return 8 * (i >> 2) + 4 * n + (i & 3); }

struct Unit { int pm, pn; };
struct Gemm { const bf16_t* A; const bf16_t* Bt; int M, N, K; };

struct StaticOrder {
    int nM, nN, nwg, G, c;
    __host__ __device__ void init(int M, int N, int G_, int c_) { nM = M / BM; nN = N / BM; nwg = nM * nN; G = G_; c = c_; }
    __host__ __device__ bool next(int i, Unit& u) const {
        const long L = (long)i * G + c; if (L >= nwg) return false;
        int wgid = (int)L; { const int q = nwg / NXCD, r = nwg % NXCD, xcd = wgid % NXCD, off = wgid / NXCD; wgid = (xcd < r ? xcd * (q + 1) : r * (q + 1) + (xcd - r) * q) + off; }
        const int nig = WGM * nN, gid = wgid / nig, fm = gid * WGM, gsz = (nM - fm) < WGM ? (nM - fm) : WGM;
        u.pm = fm + ((wgid % nig) % gsz); u.pn = (wgid % nig) / gsz; return true;
    }
    __device__ __forceinline__ void a_ready(const Unit&) const {}
    __device__ __forceinline__ void done(const Unit&) const {}
};

__device__ __forceinline__ unsigned cvt_pk_bf16(float lo, float hi) { unsigned r; asm volatile("v_cvt_pk_bf16_f32 %0, %1, %2" : "=v"(r) : "v"(lo), "v"(hi)); return r; }
typedef float f32x2 __attribute__((ext_vector_type(2)));
template <class Epi, class Sched, bool ALIGN_EPI = false, bool SP2 = false>
__device__ __forceinline__ void gemm_phase(PG8_LAS unsigned char* lds, const Gemm g, const Sched& S, const Epi& E, const int wid) {
    int lane; asm volatile("v_mbcnt_lo_u32_b32 %0, -1, 0\n\tv_mbcnt_hi_u32_b32 %0, -1, %0" : "=v"(lane)); const int tid = wid * 64 + lane, wr = wid >> 2, wc = wid & 3, fr = lane & 15, fq = lane >> 4;
    const int K = g.K, nt = K / BK;
    unsigned voffA[2], voffB[2];
#pragma unroll
    for (int i = 0; i < 2; ++i) { int R, C; stage_rc(tid * 16 + i * 8192, R, C); const int Rb = Epi::PERM ? ((R & ~31) + perm32(R & 31)) : R;
        voffA[i] = (unsigned)(R * K + C) * 2u; voffB[i] = (unsigned)(Rb * K + C) * 2u; }
    const size_t kstep = (size_t)(BK * 2);
    const size_t hstep = (size_t)HALF * K * 2;
    const size_t tstep = 2 * hstep;
    const unsigned ldsw = (unsigned)wid * 1024u;
    const int aoff = lds_byte(wr * 64 + fr, fq * 8), boff = lds_byte(wc * 32 + fr, fq * 8);
#define PG8_SA(b, h) (((b) * 2 + (h)) * HTB)
#define PG8_SB(b, h) ((4 + (b) * 2 + (h)) * HTB)
#define PG8_STAGE(bufoff, gbase, voff) do { _Pragma("unroll") for (int _i = 0; _i < 2; ++_i) \
        __builtin_amdgcn_global_load_lds((const unsigned*)((const char*)(gbase) + (voff)[_i]), (PG8_LAS unsigned*)(lds + (bufoff) + ldsw + _i * 8192), 16, 0, 0); } while (0)
#define PG8_LDA(dst, b, h) do { _Pragma("unroll") for (int m = 0; m < 4; ++m) _Pragma("unroll") for (int k = 0; k < 2; ++k) dst[m][k] = *(const PG8_LAS bf16x8*)(lds + PG8_SA(b, h) + aoff + m * 2048 + k * 1024); } while (0)
#define PG8_LDB(dst, b, h) do { _Pragma("unroll") for (int n = 0; n < 2; ++n) _Pragma("unroll") for (int k = 0; k < 2; ++k) dst[n][k] = *(const PG8_LAS bf16x8*)(lds + PG8_SB(b, h) + boff + n * 2048 + k * 1024); } while (0)
#define PG8_MMA(ai, bj, At, Bt) do { __builtin_amdgcn_s_setprio(1); _Pragma("unroll") for (int m = 0; m < 4; ++m) _Pragma("unroll") for (int n = 0; n < 2; ++n) _Pragma("unroll") for (int k = 0; k < 2; ++k) \
        acc[ai][bj][m][n] = __builtin_amdgcn_mfma_f32_16x16x32_bf16(Bt[n][k], At[m][k], acc[ai][bj][m][n], 0, 0, 0); __builtin_amdgcn_s_setprio(0); } while (0)
#define PG8_WAIT_V(n) asm volatile("s_waitcnt vmcnt(" #n ")" ::: "memory")
#define PG8_WAIT_L(n) asm volatile("s_waitcnt lgkmcnt(" #n ")" ::: "memory")
#define PG8_BAR __builtin_amdgcn_s_barrier()
#define PG8_SCHED __builtin_amdgcn_sched_barrier(0)
    Unit cur, nxt; int ui = 0;
    if (!S.next(0, cur)) return;
    f32x4 acc[2][2][4][2];
#pragma unroll
    for (int a = 0; a < 2; ++a)
#pragma unroll
        for (int b = 0; b < 2; ++b)
#pragma unroll
            for (int m = 0; m < 4; ++m)
#pragma unroll
                for (int n = 0; n < 2; ++n) acc[a][b][m][n] = (f32x4){0.f, 0.f, 0.f, 0.f};
    bf16x8 At[4][2], B0[2][2], B1[2][2];
    const char* cA = (const char*)g.A + (size_t)cur.pm * tstep; const char* cB = (const char*)g.Bt + (size_t)cur.pn * tstep;
    S.a_ready(cur);
    if constexpr (SP2) {
        PG8_STAGE(PG8_SB(0, 0), cB, voffB); PG8_STAGE(PG8_SB(0, 1), cB + hstep, voffB); PG8_STAGE(PG8_SA(0, 0), cA, voffA); PG8_STAGE(PG8_SA(0, 1), cA + hstep, voffA);
        if (wr == 1) PG8_BAR;
        PG8_WAIT_V(2); PG8_BAR;
        PG8_STAGE(PG8_SB(1, 0), cB + kstep, voffB); PG8_STAGE(PG8_SA(1, 0), cA + kstep, voffA); PG8_STAGE(PG8_SB(1, 1), cB + hstep + kstep, voffB);
        PG8_WAIT_V(6); PG8_BAR;
    } else {
        PG8_STAGE(PG8_SB(0, 0), cB, voffB); PG8_STAGE(PG8_SA(0, 0), cA, voffA); PG8_STAGE(PG8_SB(0, 1), cB + hstep, voffB); PG8_STAGE(PG8_SA(0, 1), cA + hstep, voffA);
        if (wr == 1) PG8_BAR;
        PG8_WAIT_V(4); PG8_BAR;
        PG8_STAGE(PG8_SB(1, 0), cB + kstep, voffB); PG8_STAGE(PG8_SA(1, 0), cA + kstep, voffA); PG8_STAGE(PG8_SB(1, 1), cB + hstep + kstep, voffB);
        PG8_WAIT_V(6); PG8_BAR;
    }
    for (;;) {
        const bool has_next = S.next(ui + 1, nxt);
        const char* nA = has_next ? (const char*)g.A + (size_t)nxt.pm * tstep : cA; const char* nB = has_next ? (const char*)g.Bt + (size_t)nxt.pn * tstep : cB;
        for (int t = 0; t < nt; t += 2) {
            const bool last = (t == nt - 2);
            const char* a1 = cA + (size_t)(t + 1) * kstep;
            const char* a2 = last ? nA : cA + (size_t)(t + 2) * kstep; const char* b2 = last ? nB : cB + (size_t)(t + 2) * kstep;
            const char* a3 = a2 + kstep; const char* b3 = b2 + kstep;
            if (last && has_next) S.a_ready(nxt);
            if constexpr (SP2) {
            PG8_LDB(B0, 0, 0); PG8_LDB(B1, 0, 1); PG8_SCHED; PG8_LDA(At, 0, 0); PG8_STAGE(PG8_SA(1, 1), a1 + hstep, voffA);
            PG8_WAIT_V(8); PG8_WAIT_L(0); PG8_BAR; PG8_MMA(0, 0, At, B0); PG8_MMA(0, 1, At, B1); PG8_BAR; PG8_SCHED;
            PG8_LDA(At, 0, 1); PG8_STAGE(PG8_SB(0, 0), b2, voffB); PG8_STAGE(PG8_SB(0, 1), b2 + hstep, voffB); PG8_STAGE(PG8_SA(0, 0), a2, voffA);
            PG8_WAIT_V(8); PG8_WAIT_L(0); PG8_BAR; PG8_MMA(1, 0, At, B0); PG8_MMA(1, 1, At, B1); PG8_BAR; PG8_SCHED;
            PG8_LDB(B0, 1, 0); PG8_LDB(B1, 1, 1); PG8_SCHED; PG8_LDA(At, 1, 0); PG8_STAGE(PG8_SA(0, 1), a2 + hstep, voffA);
            PG8_WAIT_V(8); PG8_WAIT_L(0); PG8_BAR; PG8_MMA(0, 0, At, B0); PG8_MMA(0, 1, At, B1); PG8_BAR; PG8_SCHED;
            PG8_LDA(At, 1, 1); PG8_STAGE(PG8_SB(1, 0), b3, voffB); PG8_STAGE(PG8_SB(1, 1), b3 + hstep, voffB); PG8_STAGE(PG8_SA(1, 0), a3, voffA);
            PG8_WAIT_V(8); PG8_WAIT_L(0); PG8_BAR; PG8_MMA(1, 0, At, B0); PG8_MMA(1, 1, At, B1); PG8_BAR; PG8_SCHED;
            } else {
            PG8_LDB(B0, 0, 0); PG8_SCHED; PG8_LDA(At, 0, 0); PG8_STAGE(PG8_SA(1, 1), a1 + hstep, voffA);
            PG8_WAIT_L(8); PG8_BAR; PG8_WAIT_L(0); PG8_MMA(0, 0, At, B0); PG8_BAR; PG8_SCHED;
            PG8_LDB(B1, 0, 1); PG8_STAGE(PG8_SB(0, 0), b2, voffB);
            PG8_BAR; PG8_WAIT_L(0); PG8_MMA(0, 1, At, B1); PG8_BAR;
            PG8_LDA(At, 0, 1); PG8_STAGE(PG8_SA(0, 0), a2, voffA);
            PG8_BAR; PG8_WAIT_L(0); PG8_MMA(1, 0, At, B0); PG8_BAR; PG8_SCHED;
            PG8_STAGE(PG8_SB(0, 1), b2 + hstep, voffB);
            PG8_WAIT_V(6); PG8_BAR; PG8_MMA(1, 1, At, B1); PG8_BAR;
            PG8_LDB(B0, 1, 0); PG8_SCHED; PG8_LDA(At, 1, 0); PG8_STAGE(PG8_SA(0, 1), a2 + hstep, voffA);
            PG8_WAIT_L(8); PG8_BAR; PG8_WAIT_L(0); PG8_MMA(0, 0, At, B0); PG8_BAR; PG8_SCHED;
            PG8_LDB(B1, 1, 1); PG8_STAGE(PG8_SB(1, 0), b3, voffB);
            PG8_BAR; PG8_WAIT_L(0); PG8_MMA(0, 1, At, B1); PG8_BAR;
            PG8_LDA(At, 1, 1); PG8_STAGE(PG8_SA(1, 0), a3, voffA);
            PG8_BAR; PG8_WAIT_L(0); PG8_MMA(1, 0, At, B0); PG8_BAR; PG8_SCHED;
            PG8_STAGE(PG8_SB(1, 1), b3 + hstep, voffB);
            PG8_WAIT_V(6); PG8_BAR; PG8_MMA(1, 1, At, B1); PG8_BAR;
            }
        }
        if constexpr (ALIGN_EPI) { if (wr == 0) PG8_BAR; }
        if constexpr (!Epi::AFTER_DRAIN) { E(acc, cur, wr, wc, fr, fq); S.done(cur); }
        if (!has_next) break;
#pragma unroll
        for (int a = 0; a < 2; ++a)
#pragma unroll
            for (int b = 0; b < 2; ++b)
#pragma unroll
                for (int m = 0; m < 4; ++m)
#pragma unroll
                    for (int n = 0; n < 2; ++n) acc[a][b][m][n] = (f32x4){0.f, 0.f, 0.f, 0.f};
        cur = nxt; cA = nA; cB = nB; ++ui;
        if constexpr (ALIGN_EPI) { if (wr == 1) PG8_BAR; }
    }
    PG8_WAIT_V(0);
    if constexpr (!ALIGN_EPI) { if (wr == 0) PG8_BAR; }
    PG8_BAR;
    if constexpr (Epi::AFTER_DRAIN) { E.fused(acc, cur, wr, wc, fr, fq, lds, wid, lane); S.done(cur); }
#undef PG8_SA
#undef PG8_SB
#undef PG8_STAGE
#undef PG8_LDA
#undef PG8_LDB
#undef PG8_MMA
#undef PG8_WAIT_V
#undef PG8_WAIT_L
#undef PG8_BAR
#undef PG8_SCHED
}
}

#define LAS __attribute__((address_space(3)))
typedef unsigned short bf16;
typedef short bf16x8 __attribute__((ext_vector_type(8)));
typedef short s16x4 __attribute__((ext_vector_type(4)));
typedef float f32x4 __attribute__((ext_vector_type(4)));
typedef float f32x16 __attribute__((ext_vector_type(16)));
typedef unsigned u32x4 __attribute__((ext_vector_type(4)));
typedef unsigned u32x2 __attribute__((ext_vector_type(2)));
typedef float f32x2_t __attribute__((ext_vector_type(2)));
typedef __bf16 bf16x2_t __attribute__((ext_vector_type(2)));

constexpr int M_TOK = 12288, M_CTX = 4096, DM = 1024, NIN = 4864, DFF = 2816, NGU = 5632;
constexpr float EPS = 1e-6f, LOG2E = 1.4426950408889634f, C2 = 0.125f * 1.4426950408889634f;
constexpr size_t MiB = 1u << 20;
constexpr size_t WS_ROPE = 0, WS_QKG = 16384, WS_PTRS = 20480, WS_MOD = 65536, WS_SSMF = 512 * 1024, WS_CKAK = 1 * MiB, WS_CKAV = 1 * MiB + 512 * 1024, WS_CKCK = 2 * MiB, WS_CKCV = 3 * MiB;
constexpr size_t WS_W = 4 * MiB;
constexpr size_t W_IN = WS_W, W_BRA = W_IN + 2ull * NIN * DM * 2, W_BRB = W_BRA + 2ull * DM * 512 * 2, W_BRC = W_BRB + 2ull * DM * 256 * 2, W_OUT = W_BRC + 2ull * DM * 256 * 2,
                 W_GU = W_OUT + 2ull * DM * DM * 2, W_FD = W_GU + 2ull * NGU * DM * 2, W_GLU = W_FD + 2ull * DM * DFF * 2, W_END = W_GLU + 2ull * 256 * 256 * 2;
constexpr size_t WS_H = 65 * MiB;
constexpr size_t WS_QKVU = 89 * MiB;
constexpr size_t WS_QA = WS_QKVU, WS_KA = WS_QA + 12 * MiB, WS_VA = WS_KA + 3 * MiB, WS_U = WS_VA + 3 * MiB, WS_QC = WS_U + 12 * MiB, WS_KC = WS_QC + 6 * MiB, WS_VC = WS_KC + 6 * MiB;
constexpr size_t WS_GATES = 137 * MiB;
constexpr size_t WS_OA = 209 * MiB, WS_OB = 221 * MiB, WS_OC = 227 * MiB, WS_PAR = 233 * MiB, WS_END = 235 * MiB;
constexpr int P_N1G = 0, P_N2G = 2048, P_FING = 4096, P_SSM0 = 5120, P_LAMR = 37888, P_LAMI = 41984, P_LSTEP = 46080, P_BRE = 46144, P_BIM = 111680, P_CRE = 177216, P_CIM = 242752, P_SSMD = 308288, P_NAB = 308800;
static_assert(W_END <= WS_H, "weights fit");
constexpr size_t O_YP = 0, O_YS = 4194304, O_GAK = 12582912, O_GAV = 13631488, O_NAK = 14680064, O_NAV = 16777216, O_SSM = 18874368;
constexpr int LDS_BYTES = 147456;

__device__ __forceinline__ unsigned cvtpk(float lo, float hi) { f32x2_t v = {lo, hi}; bf16x2_t b = __builtin_convertvector(v, bf16x2_t); return __builtin_bit_cast(unsigned, b); }
__device__ __forceinline__ float bf2f(unsigned b) { return __uint_as_float(b << 16); }
__device__ __forceinline__ float sigmoidf_(float v) { return 1.0f / (1.0f + __expf(-v)); }
template <int K> __device__ __forceinline__ float xor_shfl(float v) {
    return __uint_as_float((unsigned)__builtin_amdgcn_ds_swizzle((int)__float_as_uint(v), (K << 10) | 0x1F));
}
__device__ __forceinline__ float sum_xor32(float v) { auto rr = __builtin_amdgcn_permlane32_swap(__float_as_uint(v), __float_as_uint(v), false, false); return __uint_as_float(rr[0]) + __uint_as_float(rr[1]); }
__device__ __forceinline__ float wave_sum(float v) {
    v += xor_shfl<1>(v); v += xor_shfl<2>(v); v += xor_shfl<4>(v); v += xor_shfl<8>(v); v += xor_shfl<16>(v);
    return sum_xor32(v);
}
__device__ __forceinline__ int crow(int r, int hi) { return (r & 3) + 8 * (r >> 2) + 4 * hi; }
__device__ __forceinline__ int clampi(int v, int lo, int hi) { return v < lo ? lo : (v > hi ? hi : v); }
#define FRESH_LANE() ({ int l__; asm volatile("v_mbcnt_lo_u32_b32 %0, -1, 0\n\tv_mbcnt_hi_u32_b32 %0, -1, %0" : "=v"(l__)); l__; })
#ifndef DBG_SSM
#define DBG_SSM 1.0f
#endif
#ifndef DBG_GAK
#define DBG_GAK 1.0f
#endif
#ifndef DBG_GAV
#define DBG_GAV 1.0f
#endif
#define VM_WAIT0() asm volatile("s_waitcnt vmcnt(0)" ::: "memory")

using pg8::Unit;
struct EpiIn {
    static constexpr bool PERM = false, AFTER_DRAIN = false;
    unsigned char* ws; float* out; int layer;
    __device__ __forceinline__ void operator()(const f32x4 (&acc)[2][2][4][2], const Unit& u, int wr, int wc, int fr_, int fq_) const {
        const int ln_ = FRESH_LANE(), fr = ln_ & 15, fq = ln_ >> 4;
        const int pn = u.pn; const bool ctx = u.pm < 16;
        const int rb = u.pm * 256 + wr * 64 + fr;
        if (pn >= 7) {
#pragma unroll
            for (int ai = 0; ai < 2; ++ai)
#pragma unroll
                for (int m = 0; m < 4; ++m) {
                    const int row = rb + ai * 128 + m * 16;
                    bf16* gp = (bf16*)(ws + WS_GATES) + (size_t)row * 3072 + (pn - 7) * 256 + 64 * wc + 4 * fq;
#pragma unroll
                    for (int bj = 0; bj < 2; ++bj)
#pragma unroll
                        for (int n = 0; n < 2; ++n) { const f32x4 v = acc[ai][bj][m][n]; u32x2 w; w.x = cvtpk(sigmoidf_(v[0]), sigmoidf_(v[1])); w.y = cvtpk(sigmoidf_(v[2]), sigmoidf_(v[3])); *(u32x2*)(gp + 32 * bj + 16 * n) = w; }
                }
        } else if (pn == 3) {
#pragma unroll
            for (int ai = 0; ai < 2; ++ai)
#pragma unroll
                for (int m = 0; m < 4; ++m) {
                    const int row = rb + ai * 128 + m * 16;
                    float* up = (float*)(ws + WS_U) + (size_t)row * 256 + 64 * wc + 4 * fq;
#pragma unroll
                    for (int bj = 0; bj < 2; ++bj)
#pragma unroll
                        for (int n = 0; n < 2; ++n) *(f32x4*)(up + 32 * bj + 16 * n) = acc[ai][bj][m][n];
                }
        } else if (pn >= 4) {
            bf16* base = (bf16*)(ws + (pn == 4 ? WS_QC : (pn == 5 ? WS_KC : WS_VC)));
            const float sc = pn == 4 ? C2 : 1.0f;
            float* ob = out + (pn == 5 ? O_NAK : O_NAV);
#pragma unroll
            for (int ai = 0; ai < 2; ++ai)
#pragma unroll
                for (int m = 0; m < 4; ++m) {
                    const int row = rb + ai * 128 + m * 16;
                    int b, t; size_t hrow;
                    if (ctx) { b = row >> 8; t = row & 255; hrow = (size_t)(b * 4 + wc) * 256 + t; } else { const int r2 = row - 4096; b = r2 >> 11; t = r2 & 2047; hrow = (size_t)4096 * 4 + (size_t)(b * 4 + wc) * 2048 + t; }
                    bf16* dp = base + hrow * 64 + 4 * fq;
#pragma unroll
                    for (int bj = 0; bj < 2; ++bj)
#pragma unroll
                        for (int n = 0; n < 2; ++n) { const f32x4 v = acc[ai][bj][m][n] * sc; u32x2 w; w.x = cvtpk(v[0], v[1]); w.y = cvtpk(v[2], v[3]); *(u32x2*)(dp + 32 * bj + 16 * n) = w; }
                    if (ctx && pn >= 5) { float* op = ob + ((size_t)(b * 2 + layer) * 256 + t) * 256 + wc * 64 + 4 * fq;
#pragma unroll
                        for (int bj = 0; bj < 2; ++bj)
#pragma unroll
                            for (int n = 0; n < 2; ++n) *(f32x4*)(op + 32 * bj + 16 * n) = acc[ai][bj][m][n]; }
                }
        } else {
            const bool isQ = pn < 2, isV = (pn == 2 && wc >= 2);
            const int h = isQ ? 4 * pn + wc : (wc & 1);
            const float* gsrc = (const float*)(ws + WS_QKG) + (layer * 2 + (isQ ? 0 : 1)) * 64 + 4 * fq;
            f32x4 gg[2][2];
#pragma unroll
            for (int bj = 0; bj < 2; ++bj)
#pragma unroll
                for (int n = 0; n < 2; ++n) gg[bj][n] = *(const f32x4*)(gsrc + 32 * bj + 16 * n);
            bf16* base = (bf16*)(ws + (isQ ? WS_QA : (isV ? WS_VA : WS_KA)));
            const int nh = isQ ? 8 : 2;
            float* ob = out + (isV ? O_GAV : O_GAK);
#pragma unroll
            for (int ai = 0; ai < 2; ++ai)
#pragma unroll
                for (int m = 0; m < 4; ++m) {
                    const int row = rb + ai * 128 + m * 16;
                    f32x4 v[2][2];
#pragma unroll
                    for (int bj = 0; bj < 2; ++bj)
#pragma unroll
                        for (int n = 0; n < 2; ++n) v[bj][n] = acc[ai][bj][m][n];
                    if (!isV) {
                        float ss = 0.f;
#pragma unroll
                        for (int bj = 0; bj < 2; ++bj)
#pragma unroll
                            for (int n = 0; n < 2; ++n) ss += (v[bj][n][0] * v[bj][n][0] + v[bj][n][1] * v[bj][n][1]) + (v[bj][n][2] * v[bj][n][2] + v[bj][n][3] * v[bj][n][3]);
                        ss += xor_shfl<16>(ss); ss = sum_xor32(ss);
                        const float rstd = rsqrtf(ss * (1.0f / 64.0f) + EPS);
#pragma unroll
                        for (int bj = 0; bj < 2; ++bj)
#pragma unroll
                            for (int n = 0; n < 2; ++n) v[bj][n] = v[bj][n] * rstd * gg[bj][n];
                    }
                    int b, t; size_t hrow;
                    if (ctx) { b = row >> 8; t = row & 255; hrow = (size_t)(b * nh + h) * 256 + t; }
                    else {
                        const int r2 = row - 4096; b = r2 >> 11; t = r2 & 2047; hrow = (size_t)4096 * nh + (size_t)(b * nh + h) * 2048 + t;
                        if (!isV) {
#pragma unroll
                            for (int bj = 0; bj < 2; ++bj) {
                                const int pos = bj ? (t & 63) : (t >> 6);
                                const float* tp = (const float*)(ws + WS_ROPE) + (pos * 16 + 4 * fq) * 2;
                                const f32x4 c01 = *(const f32x4*)tp, c23 = *(const f32x4*)(tp + 4);
                                const f32x4 cs = {c01[0], c01[2], c23[0], c23[2]}, sn = {c01[1], c01[3], c23[1], c23[3]};
                                const f32x4 x1 = v[bj][0], x2 = v[bj][1];
                                v[bj][0] = x1 * cs - x2 * sn; v[bj][1] = x2 * cs + x1 * sn;
                            }
                        }
                    }
                    if (ctx && !isQ) { float* op = ob + ((size_t)(b * 2 + layer) * 256 + t) * 128 + h * 64 + 4 * fq;
#pragma unroll
                        for (int bj = 0; bj < 2; ++bj)
#pragma unroll
                            for (int n = 0; n < 2; ++n) *(f32x4*)(op + 32 * bj + 16 * n) = v[bj][n] * (isV ? DBG_GAV : DBG_GAK); }
                    const float sc = isQ ? C2 : 1.0f;
                    bf16* dp = base + hrow * 64 + 4 * fq;
#pragma unroll
                    for (int bj = 0; bj < 2; ++bj)
#pragma unroll
                        for (int n = 0; n < 2; ++n) { const f32x4 x = v[bj][n] * sc; u32x2 w; w.x = cvtpk(x[0], x[1]); w.y = cvtpk(x[2], x[3]); *(u32x2*)(dp + 32 * bj + 16 * n) = w; }
                }
        }
        VM_WAIT0();
    }
};

struct EpiRes {
    static constexpr bool PERM = false, AFTER_DRAIN = false;
    const float* xc; const float* xl; float* xo; const float* mod;
    __device__ __forceinline__ void operator()(const f32x4 (&acc)[2][2][4][2], const Unit& u, int wr, int wc, int fr_, int fq_) const {
        const int ln_ = FRESH_LANE(), fr = ln_ & 15, fq = ln_ >> 4;
        const int cv = u.pm < 16 ? 0 : 1 + ((u.pm - 16) >> 3);
        const int col0 = u.pn * 256 + wc * 32 + 4 * fq;
        f32x4 gv[2][2];
#pragma unroll
        for (int bj = 0; bj < 2; ++bj)
#pragma unroll
            for (int n = 0; n < 2; ++n) gv[bj][n] = *(const f32x4*)(mod + cv * 6144 + col0 + bj * 128 + n * 16);
#pragma unroll
        for (int ai = 0; ai < 2; ++ai)
#pragma unroll
            for (int m = 0; m < 4; ++m) {
                const int row = u.pm * 256 + ai * 128 + wr * 64 + m * 16 + fr;
                const float* xs = row < 4096 ? xc + (size_t)row * 1024 : xl + (size_t)(row - 4096) * 1024;
                float* xd = xo + (size_t)row * 1024;
#pragma unroll
                for (int bj = 0; bj < 2; ++bj)
#pragma unroll
                    for (int n = 0; n < 2; ++n) { const int c = col0 + bj * 128 + n * 16; const f32x4 xv = *(const f32x4*)(xs + c); *(f32x4*)(xd + c) = xv + gv[bj][n] * acc[ai][bj][m][n]; }
                asm volatile("" ::: "memory");
            }
        VM_WAIT0();
    }
};

struct EpiSwiglu {
    static constexpr bool PERM = false, AFTER_DRAIN = false;
    bf16* ACT;
    __device__ __forceinline__ void operator()(const f32x4 (&acc)[2][2][4][2], const Unit& u, int wr, int wc, int fr_, int fq_) const {
        const int ln_ = FRESH_LANE(), fr = ln_ & 15, fq = ln_ >> 4;
#pragma unroll
        for (int ai = 0; ai < 2; ++ai)
#pragma unroll
            for (int m = 0; m < 4; ++m) {
                const int row = u.pm * 256 + ai * 128 + wr * 64 + m * 16 + fr;
                bf16* ap = ACT + (size_t)row * DFF + u.pn * 128 + wc * 32 + 4 * fq;
#pragma unroll
                for (int n = 0; n < 2; ++n) { const f32x4 g = acc[ai][0][m][n], up = acc[ai][1][m][n]; f32x4 r;
#pragma unroll
                    for (int i = 0; i < 4; ++i) r[i] = g[i] * sigmoidf_(g[i]) * up[i];
                    u32x2 w; w.x = cvtpk(r[0], r[1]); w.y = cvtpk(r[2], r[3]); *(u32x2*)(ap + 16 * n) = w; }
                asm volatile("" ::: "memory");
            }
        VM_WAIT0();
    }
};

struct EpiGlu {
    static constexpr bool PERM = false, AFTER_DRAIN = false;
    bf16* OB;
    __device__ __forceinline__ void operator()(const f32x4 (&acc)[2][2][4][2], const Unit& u, int wr, int wc, int fr_, int fq_) const {
        const int ln_ = FRESH_LANE(), fr = ln_ & 15, fq = ln_ >> 4;
#pragma unroll
        for (int ai = 0; ai < 2; ++ai)
#pragma unroll
            for (int m = 0; m < 4; ++m) {
                const int row = u.pm * 256 + ai * 128 + wr * 64 + m * 16 + fr;
                bf16* p = OB + (size_t)row * 256 + wc * 32 + 4 * fq;
#pragma unroll
                for (int bj = 0; bj < 2; ++bj)
#pragma unroll
                    for (int n = 0; n < 2; ++n) { bf16* q = p + bj * 128 + n * 16; const u32x2 yv = *(const u32x2*)q; const f32x4 a = acc[ai][bj][m][n];
                        const float y0 = bf2f(yv.x & 0xffffu), y1 = bf2f(yv.x >> 16), y2 = bf2f(yv.y & 0xffffu), y3 = bf2f(yv.y >> 16);
                        u32x2 w; w.x = cvtpk(y0 * sigmoidf_(a[0]), y1 * sigmoidf_(a[1])); w.y = cvtpk(y2 * sigmoidf_(a[2]), y3 * sigmoidf_(a[3])); *(u32x2*)q = w; }
                asm volatile("" ::: "memory");
            }
        VM_WAIT0();
    }
};

template <int MODE> struct EpiBr {
    static constexpr bool PERM = false, AFTER_DRAIN = false;
    const bf16* G; float* MF; bf16* MG;
    __device__ __forceinline__ void operator()(const f32x4 (&acc)[2][2][4][2], const Unit& u, int wr, int wc, int fr_, int fq_) const {
        const int ln_ = FRESH_LANE(), fr = ln_ & 15, fq = ln_ >> 4;
        const int col0 = u.pn * 256 + wc * 32 + 4 * fq;
#pragma unroll
        for (int ai = 0; ai < 2; ++ai)
#pragma unroll
            for (int m = 0; m < 4; ++m) {
                const int row = u.pm * 256 + ai * 128 + wr * 64 + m * 16 + fr;
#pragma unroll
                for (int bj = 0; bj < 2; ++bj)
#pragma unroll
                    for (int n = 0; n < 2; ++n) { const int c = col0 + bj * 128 + n * 16; const u32x2 gv = *(const u32x2*)(G + (size_t)row * 3072 + c); const f32x4 a = acc[ai][bj][m][n];
                        f32x4 r = {bf2f(gv.x & 0xffffu) * a[0], bf2f(gv.x >> 16) * a[1], bf2f(gv.y & 0xffffu) * a[2], bf2f(gv.y >> 16) * a[3]};
#ifdef DBG_ZERO_BR
                        if (MODE == DBG_ZERO_BR) r = r * 0.0f;
#endif
                        float* mp = MF + (size_t)row * 1024 + c;
                        if (MODE >= 1) r = r + *(const f32x4*)mp;
                        if (MODE <= 1) *(f32x4*)mp = r;
                        else { u32x2 w; w.x = cvtpk(r[0], r[1]); w.y = cvtpk(r[2], r[3]); *(u32x2*)(MG + (size_t)row * 1024 + c) = w; } }
                asm volatile("" ::: "memory");
            }
        VM_WAIT0();
    }
};

namespace att {
constexpr int SLOTB = 8192, LDS_K = 0, LDS_V = 16384, LDS_WS = 32768, LDS_OST = 34816, LDS_BIAS = 67584;
constexpr float THR = 8.0f;
#define SBAR() __builtin_amdgcn_sched_barrier(0)
__device__ __forceinline__ void glds16(const void* gsrc, unsigned lds_dst) { unsigned keep;
    asm volatile("s_mov_b32 %0, m0\n\ts_mov_b32 m0, %2\n\ts_nop 0\n\tglobal_load_lds_dwordx4 %1, off\n\ts_mov_b32 m0, %0" : "=&s"(keep) : "v"(gsrc), "s"(lds_dst) : "memory"); }
#define WAIT_BAR0() asm volatile("s_waitcnt vmcnt(0) lgkmcnt(0)\n\ts_barrier" ::: "memory")
typedef LAS const char* lds_cptr;
__device__ __forceinline__ void qkt(f32x16& p0, f32x16& p1, lds_cptr kb, const bf16x8* qr, const f32x16& negm) {
#pragma unroll
    for (int d0 = 0; d0 < 4; ++d0) {
        const bf16x8 b0 = *(const LAS bf16x8*)(kb + d0 * 2048);
        const bf16x8 b1 = *(const LAS bf16x8*)(kb + d0 * 2048 + 512);
        if (d0 == 0) { p0 = __builtin_amdgcn_mfma_f32_32x32x16_bf16(b0, qr[0], negm, 0, 0, 0); p1 = __builtin_amdgcn_mfma_f32_32x32x16_bf16(b1, qr[0], negm, 0, 0, 0); }
        else { p0 = __builtin_amdgcn_mfma_f32_32x32x16_bf16(b0, qr[d0], p0, 0, 0, 0); p1 = __builtin_amdgcn_mfma_f32_32x32x16_bf16(b1, qr[d0], p1, 0, 0, 0); }
    }
}
__device__ __forceinline__ float rowmax(const f32x16& p0, const f32x16& p1) {
    float a = fmaxf(fmaxf(p0[0], p0[1]), p1[0]), b = fmaxf(fmaxf(p0[2], p0[3]), p1[1]); a = fmaxf(fmaxf(a, p1[2]), p1[3]);
#pragma unroll
    for (int r = 4; r < 16; r += 4) { a = fmaxf(fmaxf(a, p0[r]), p0[r + 1]); b = fmaxf(fmaxf(b, p0[r + 2]), p0[r + 3]); a = fmaxf(fmaxf(a, p1[r]), p1[r + 1]); b = fmaxf(fmaxf(b, p1[r + 2]), p1[r + 3]); }
    const float m = fmaxf(a, b);
    auto rr = __builtin_amdgcn_permlane32_swap(__float_as_uint(m), __float_as_uint(m), false, false);
    return fmaxf(__uint_as_float(rr[0]), __uint_as_float(rr[1]));
}
__device__ __forceinline__ void pv(f32x16* o, int vb, bf16x8 pa0, bf16x8 pa1, bf16x8 pa2, bf16x8 pa3) {
#pragma unroll
    for (int d0 = 0; d0 < 2; ++d0) { s16x4 lo[4], hi[4];
#pragma unroll
        for (int ks = 0; ks < 4; ++ks) {
            asm volatile("ds_read_b64_tr_b16 %0,%1 offset:%c2" : "=&v"(lo[ks]) : "v"(vb), "i"(d0 * 4096 + ks * 1024) : "memory");
            asm volatile("ds_read_b64_tr_b16 %0,%1 offset:%c2" : "=&v"(hi[ks]) : "v"(vb), "i"(d0 * 4096 + ks * 1024 + 512) : "memory"); }
        asm volatile("s_waitcnt lgkmcnt(0)" ::: "memory"); SBAR();
#define PK(k) (bf16x8){lo[k][0], lo[k][1], lo[k][2], lo[k][3], hi[k][0], hi[k][1], hi[k][2], hi[k][3]}
        o[d0] = __builtin_amdgcn_mfma_f32_32x32x16_bf16(pa0, PK(0), o[d0], 0, 0, 0);
        o[d0] = __builtin_amdgcn_mfma_f32_32x32x16_bf16(pa1, PK(1), o[d0], 0, 0, 0);
        o[d0] = __builtin_amdgcn_mfma_f32_32x32x16_bf16(pa2, PK(2), o[d0], 0, 0, 0);
        o[d0] = __builtin_amdgcn_mfma_f32_32x32x16_bf16(pa3, PK(3), o[d0], 0, 0, 0);
#undef PK
    }
}
template <bool NA>
__device__ __forceinline__ void attn_unit(const bf16* Qw, const bf16* Kc, const bf16* Vc, const bf16* Kl, const bf16* Vl, int NT,
                                          bf16* Ow, int opitch, char* shm, int qrow, int rlo, const float* biasg, const int wid) {
    const int lane = FRESH_LANE(), tid = wid * 64 + lane, r32 = lane & 31, hi = lane >> 5;
    const unsigned lds0 = (unsigned)(uintptr_t)shm;
    const lds_cptr shm3 = (lds_cptr)shm;
    LAS float* wsf = (LAS float*)(shm3 + LDS_WS) + wid * 64;
    LAS float* bias_s = (LAS float*)(shm3 + LDS_BIAS);
    if (NA) { if (tid < 465) bias_s[tid] = biasg[tid] * LOG2E; }
    const int koff = lane * 64 + wid * 8;
    const int voff = (16 * (wid & 3) + (lane >> 2)) * 64 + (wid >> 2) * 32 + (lane & 3) * 8;
    const unsigned kdst = lds0 + LDS_K + wid * 1024, vdst = lds0 + LDS_V + wid * 1024;
#define ATT_DMA(t, slot) do { const bf16* kt_ = (t) < 4 ? Kc + (t) * 4096 : Kl + ((t) - 4) * 4096; const bf16* vt_ = (t) < 4 ? Vc + (t) * 4096 : Vl + ((t) - 4) * 4096; \
        glds16(kt_ + koff, (unsigned)__builtin_amdgcn_readfirstlane(kdst + (slot))); glds16(vt_ + voff, (unsigned)__builtin_amdgcn_readfirstlane(vdst + (slot))); } while (0)
    ATT_DMA(0, 0);
    bf16x8 qr[4];
#pragma unroll
    for (int d0 = 0; d0 < 4; ++d0) qr[d0] = *(const bf16x8*)(Qw + (size_t)r32 * 64 + d0 * 16 + hi * 8);
    float mhat = 0.f, l_reg = 0.f; f32x16 o[2]; o[0] = f32x16{}; o[1] = f32x16{}; f32x16 negm = f32x16{};
    const lds_cptr kp0 = shm3 + LDS_K + hi * 1024 + r32 * 16;
    const int vb0 = (int)(lds0 + LDS_V) + ((lane >> 4) & 1) * 32 + (lane & 3) * 8 + (4 * hi + ((lane & 15) >> 2)) * 64;
    const int qc = (wid & 1) * 32 + r32, cs = clampi(qc - 8, 0, 48), rs = clampi(qrow - 4, 0, 24);
    for (int t = 0; t < NT; ++t) {
        WAIT_BAR0();
        const int slot = (t & 1) * SLOTB;
        if (t + 1 < NT) ATT_DMA(t + 1, SLOTB - slot);
        f32x16 p0, p1;
        qkt(p0, p1, kp0 + slot, qr, negm);
        if (NA && t >= 4) {
            const int kr = rlo + t - 4;
            if (kr < rs || kr >= rs + 8) {
#pragma unroll
                for (int r = 0; r < 16; ++r) { p0[r] = -INFINITY; p1[r] = -INFINITY; }
            } else {
                const LAS float* brow = bias_s + (kr - qrow + 7) * 31;
#pragma unroll
                for (int r = 0; r < 16; ++r) {
                    const int kc = crow(r, hi);
                    const int i0 = clampi(kc - qc + 15, 0, 30), i1 = clampi(kc + 32 - qc + 15, 0, 30);
                    const float b0 = brow[i0], b1 = brow[i1];
                    p0[r] = ((unsigned)(kc - cs) < 16u) ? p0[r] + b0 : -INFINITY;
                    p1[r] = ((unsigned)(kc + 32 - cs) < 16u) ? p1[r] + b1 : -INFINITY;
                }
            }
        }
        const float rm = rowmax(p0, p1);
        if (t == 0 || __any(rm > THR)) {
            const float dl = (t == 0) ? rm : fmaxf(rm, 0.f);
            mhat += dl;
#pragma unroll
            for (int r = 0; r < 16; ++r) { p0[r] -= dl; p1[r] -= dl; negm[r] = -mhat; }
            if (t > 0) {
                const float f = __builtin_amdgcn_exp2f(-dl); l_reg *= f;
                if (hi == 0) wsf[r32] = f;
                asm volatile("s_waitcnt lgkmcnt(0)" ::: "memory");
#pragma unroll
                for (int r = 0; r < 16; ++r) { const float fr_ = wsf[crow(r, hi)]; o[0][r] *= fr_; o[1][r] *= fr_; }
                asm volatile("s_waitcnt lgkmcnt(0)" ::: "memory");
            }
        }
        float sacc = 0.f;
#pragma unroll
        for (int r = 0; r < 16; ++r) { p0[r] = __builtin_amdgcn_exp2f(p0[r]); p1[r] = __builtin_amdgcn_exp2f(p1[r]); sacc += p0[r] + p1[r]; }
        l_reg += sacc;
        u32x4 pw0, pw1, pw2, pw3;
        pw0 = (u32x4){cvtpk(p0[0], p0[1]), cvtpk(p0[2], p0[3]), cvtpk(p0[4], p0[5]), cvtpk(p0[6], p0[7])};
        pw1 = (u32x4){cvtpk(p0[8], p0[9]), cvtpk(p0[10], p0[11]), cvtpk(p0[12], p0[13]), cvtpk(p0[14], p0[15])};
        pw2 = (u32x4){cvtpk(p1[0], p1[1]), cvtpk(p1[2], p1[3]), cvtpk(p1[4], p1[5]), cvtpk(p1[6], p1[7])};
        pw3 = (u32x4){cvtpk(p1[8], p1[9]), cvtpk(p1[10], p1[11]), cvtpk(p1[12], p1[13]), cvtpk(p1[14], p1[15])};
        SBAR();
        pv(o, vb0 + slot, __builtin_bit_cast(bf16x8, pw0), __builtin_bit_cast(bf16x8, pw1), __builtin_bit_cast(bf16x8, pw2), __builtin_bit_cast(bf16x8, pw3));
    }
    { auto rr = __builtin_amdgcn_permlane32_swap(__float_as_uint(l_reg), __float_as_uint(l_reg), false, false); l_reg = __uint_as_float(rr[0]) + __uint_as_float(rr[1]); }
    if (hi == 0) wsf[32 + r32] = l_reg; asm volatile("s_waitcnt lgkmcnt(0)" ::: "memory");
    float rli[16];
#pragma unroll
    for (int r = 0; r < 16; ++r) rli[r] = __builtin_amdgcn_rcpf(wsf[32 + crow(r, hi)]);
    { LAS bf16* stg = (LAS bf16*)(shm3 + LDS_OST) + wid * 2048;
#pragma unroll
      for (int r = 0; r < 16; ++r) { const int orow = crow(r, hi);
#pragma unroll
          for (int d0 = 0; d0 < 2; ++d0) stg[orow * 64 + d0 * 32 + r32] = (bf16)(cvtpk(o[d0][r] * rli[r], 0.f) & 0xffffu); }
      asm volatile("s_waitcnt lgkmcnt(0)" ::: "memory");
#pragma unroll
      for (int i = 0; i < 4; ++i) { const int row = i * 8 + (lane >> 3), ch = lane & 7; const u32x4 v = *(const LAS u32x4*)(stg + row * 64 + ch * 8); *(u32x4*)(Ow + (size_t)row * opitch + ch * 8) = v; } }
    asm volatile("s_waitcnt vmcnt(0) lgkmcnt(0)\n\ts_barrier" ::: "memory");
#undef ATT_DMA
}
#undef SBAR
#undef WAIT_BAR0
}

struct SsmArgs { const float *lam_re, *lam_im, *log_step, *b_re, *b_im, *c_re, *c_im;
                 const float* U; float* YF; float* YB; float* F; const float* h0; float* out_ssm; int layer; };
constexpr int SSM_PITCH = 132, SSM_WAVE_BYTES = 32 * SSM_PITCH * 4;
__device__ __forceinline__ void split8(const float* v, bf16x8& h, bf16x8& l) {
    unsigned hw[4], lw[4];
#pragma unroll
    for (int i = 0; i < 4; ++i) { const unsigned w = cvtpk(v[2 * i], v[2 * i + 1]); hw[i] = w; const float r0 = v[2 * i] - bf2f(w & 0xffffu), r1 = v[2 * i + 1] - bf2f(w >> 16); lw[i] = cvtpk(r0, r1); }
    h = __builtin_bit_cast(bf16x8, (u32x4){hw[0], hw[1], hw[2], hw[3]}); l = __builtin_bit_cast(bf16x8, (u32x4){lw[0], lw[1], lw[2], lw[3]});
}
__device__ __forceinline__ void ssm_unit(const SsmArgs& A, int mode, int b, int g, int d, int k, LAS float* buf) {
    const int lane = FRESH_LANE();
    const int hi = lane >> 5, l31 = lane & 31, fr = lane & 15, fq = lane >> 4;
    const int gd = d * 16 + g;
    const float step = expf(A.log_step[gd]);
    float ar[2], ai[2], cr[2], ci[2];
#pragma unroll
    for (int q = 0; q < 2; ++q) { const int p = l31 + 32 * q; const float lr = A.lam_re[gd * 64 + p], li = A.lam_im[gd * 64 + p];
        const float e = expf(lr * step); float s, c; sincosf(li * step, &s, &c); ar[q] = e * c; ai[q] = e * s;
        const float den = 1.0f / (lr * lr + li * li), xr = ar[q] - 1.0f; cr[q] = (xr * lr + ai[q] * li) * den; ci[q] = (ai[q] * lr - xr * li) * den; }
    float Bf[4][8];
#pragma unroll
    for (int q = 0; q < 2; ++q) { const int p = l31 + 32 * q; const float* br = A.b_re + ((size_t)gd * 64 + p) * 16; const float* bi = A.b_im + ((size_t)gd * 64 + p) * 16;
#pragma unroll
        for (int c4 = 0; c4 < 4; ++c4) { const f32x4 r = *(const f32x4*)(br + 4 * c4), im = *(const f32x4*)(bi + 4 * c4);
#pragma unroll
            for (int h2 = 0; h2 < 2; ++h2) { const float re_ = hi ? r[2 * h2 + 1] : r[2 * h2], im_ = hi ? im[2 * h2 + 1] : im[2 * h2];
                Bf[q][2 * c4 + h2] = cr[q] * re_ - ci[q] * im_; Bf[2 + q][2 * c4 + h2] = cr[q] * im_ + ci[q] * re_; } } }
    bf16x8 Cf[4];
#pragma unroll
    for (int ks = 0; ks < 4; ++ks) { const float* cp = (ks < 2 ? A.c_re : A.c_im) + ((size_t)gd * 16 + fr) * 64 + 32 * (ks & 1) + 8 * fq; const float sg = ks < 2 ? 1.0f : -1.0f;
        const f32x4 c0 = *(const f32x4*)cp * sg, c1 = *(const f32x4*)(cp + 4) * sg;
        Cf[ks] = __builtin_bit_cast(bf16x8, (u32x4){cvtpk(c0[0], c0[1]), cvtpk(c0[2], c0[3]), cvtpk(c1[0], c1[1]), cvtpk(c1[2], c1[3])}); }
    const float sar = hi ? ar[1] : ar[0], sai = hi ? ai[1] : ai[0];
    const int L = mode == 0 ? 256 : 2048; const int seqrow0 = mode == 0 ? b * 256 : 4096 + b * 2048;
    float hr = 0.f, hm = 0.f;
    if (mode == 2) {
        const size_t so = ((((size_t)(b * 2 + A.layer) * 2 + d) * 2) * 16 + g) * 64 + lane;
        hr = A.h0[so]; hm = A.h0[so + 16 * 64];
        float pr = sar, pi = sai;
#pragma unroll
        for (int i = 0; i < 8; ++i) { const float nr = pr * pr - pi * pi, ni = 2.0f * pr * pi; pr = nr; pi = ni; }
        for (int kk = 0; kk < k; ++kk) { const size_t fo = ((((size_t)(b * 16 + g) * 2 + d) * 8 + kk) * 2) * 64 + lane; const float fr_ = A.F[fo], fi_ = A.F[fo + 64];
            const float nr = pr * hr - pi * hm + fr_, ni = pr * hm + pi * hr + fi_; hr = nr; hm = ni; }
    }
    float* Y = A.YF + (size_t)d * ((size_t)M_TOK * 256);
#ifdef DBG_SSM_F32
    float dbre[16], dbim[16];
    { const float ccr = hi ? cr[1] : cr[0], cci = hi ? ci[1] : ci[0]; const float* br = A.b_re + ((size_t)gd * 64 + lane) * 16; const float* bi = A.b_im + ((size_t)gd * 64 + lane) * 16;
#pragma unroll
      for (int c = 0; c < 16; ++c) { dbre[c] = ccr * br[c] - cci * bi[c]; dbim[c] = ccr * bi[c] + cci * br[c]; } }
#endif
    for (int sc = 0; sc < 8; ++sc) {
        const int s0 = 256 * k + 32 * sc;
#ifdef DBG_SSM_F32
        for (int j = 0; j < 32; ++j) { const int s = s0 + j; const int t = d ? L - 1 - s : s; const float* up = A.U + (size_t)(seqrow0 + t) * 256 + g * 16; float a_r = 0.f, a_i = 0.f;
#pragma unroll
            for (int c = 0; c < 16; ++c) { const float uv = up[c]; a_r = fmaf(dbre[c], uv, a_r); a_i = fmaf(dbim[c], uv, a_i); }
            buf[j * SSM_PITCH + lane] = a_r; buf[j * SSM_PITCH + 64 + lane] = a_i; }
#else
        { const int s = s0 + l31; const int t = d ? L - 1 - s : s;
          const float* up = A.U + (size_t)(seqrow0 + t) * 256 + g * 16;
          float ua[8];
#pragma unroll
          for (int c4 = 0; c4 < 4; ++c4) { const f32x4 x = *(const f32x4*)(up + 4 * c4); ua[2 * c4] = hi ? x[1] : x[0]; ua[2 * c4 + 1] = hi ? x[3] : x[2]; }
#pragma unroll
          for (int n = 0; n < 4; ++n) { f32x16 D = f32x16{};
#pragma unroll
              for (int kk = 0; kk < 8; ++kk) D = __builtin_amdgcn_mfma_f32_32x32x2f32(ua[kk], Bf[n][kk], D, 0, 0, 0);
#pragma unroll
              for (int r = 0; r < 16; ++r) buf[crow(r, hi) * SSM_PITCH + 32 * n + l31] = D[r]; } }
#endif
#pragma unroll
        for (int j = 0; j < 32; ++j) { const float re = buf[j * SSM_PITCH + lane], im = buf[j * SSM_PITCH + 64 + lane];
            const float nr = fmaf(sar, hr, fmaf(-sai, hm, re)), ni = fmaf(sar, hm, fmaf(sai, hr, im)); hr = nr; hm = ni;
            if (mode != 1) { buf[j * SSM_PITCH + lane] = hr; buf[j * SSM_PITCH + 64 + lane] = hm; } }
        if (mode != 1) {
#pragma unroll
            for (int rt = 0; rt < 2; ++rt) { f32x4 acc = {0.f, 0.f, 0.f, 0.f};
#pragma unroll
                for (int ks = 0; ks < 4; ++ks) { const LAS float* hp = buf + (16 * rt + fr) * SSM_PITCH + 32 * ks + 8 * fq; const f32x4 h0 = *(const LAS f32x4*)hp, h1 = *(const LAS f32x4*)(hp + 4);
                    const bf16x8 ahh = __builtin_bit_cast(bf16x8, (u32x4){cvtpk(h0[0], h0[1]), cvtpk(h0[2], h0[3]), cvtpk(h1[0], h1[1]), cvtpk(h1[2], h1[3])});
                    acc = __builtin_amdgcn_mfma_f32_16x16x32_bf16(ahh, Cf[ks], acc, 0, 0, 0); }
#pragma unroll
                for (int r = 0; r < 4; ++r) { const int s = s0 + 16 * rt + 4 * fq + r; const int t = d ? L - 1 - s : s; Y[(size_t)(seqrow0 + t) * 256 + g * 16 + fr] = acc[r]; } }
        }
    }
    if (mode == 0) { const size_t so = ((((size_t)(b * 2 + A.layer) * 2 + d) * 2) * 16 + g) * 64 + lane; A.out_ssm[so] = hr * DBG_SSM; A.out_ssm[so + 16 * 64] = hm * DBG_SSM; }
    if (mode == 1) { const size_t fo = ((((size_t)(b * 16 + g) * 2 + d) * 8 + k) * 2) * 64 + lane; A.F[fo] = hr; A.F[fo + 64] = hm; }
}

__device__ __forceinline__ void norm_mod_rows(const float* xc, const float* xl, const float* g, const float* mod, int sh_off, int sc_off, bf16* H, int gw, int NGW, int lane) {
    for (int row = gw; row < M_TOK; row += NGW) {
        const float* xr = row < 4096 ? xc + (size_t)row * 1024 : xl + (size_t)(row - 4096) * 1024;
        const int cv = row < 4096 ? 0 : 1 + ((row - 4096) >> 11);
        f32x4 v[4]; float ss = 0.f;
#pragma unroll
        for (int j = 0; j < 4; ++j) { v[j] = *(const f32x4*)(xr + 4 * (lane + 64 * j)); ss += (v[j][0] * v[j][0] + v[j][1] * v[j][1]) + (v[j][2] * v[j][2] + v[j][3] * v[j][3]); }
        const float rstd = rsqrtf(wave_sum(ss) * (1.0f / 1024.0f) + EPS);
        const float* mp = mod + cv * 6144;
#pragma unroll
        for (int j = 0; j < 4; ++j) { const int c = 4 * (lane + 64 * j); const f32x4 gg = *(const f32x4*)(g + c), sc = *(const f32x4*)(mp + sc_off + c), sh = *(const f32x4*)(mp + sh_off + c);
            const f32x4 o = v[j] * rstd * gg * (sc + 1.0f) + sh; u32x2 w; w.x = cvtpk(o[0], o[1]); w.y = cvtpk(o[2], o[3]); *(u32x2*)(H + (size_t)row * 1024 + c) = w; }
    }
}
__device__ __forceinline__ void final_norm_rows(float* x, const float* g, int gw, int NGW, int lane) {
    for (int row = gw; row < M_TOK; row += NGW) {
        float* xr = x + (size_t)row * 1024;
        f32x4 v[4]; float ss = 0.f;
#pragma unroll
        for (int j = 0; j < 4; ++j) { v[j] = *(const f32x4*)(xr + 4 * (lane + 64 * j)); ss += (v[j][0] * v[j][0] + v[j][1] * v[j][1]) + (v[j][2] * v[j][2] + v[j][3] * v[j][3]); }
        const float rstd = rsqrtf(wave_sum(ss) * (1.0f / 1024.0f) + EPS);
#ifdef DBG_SCALE_S
        const float dsc = row >= 4096 ? DBG_SCALE_S : DBG_SCALE_P;
#else
        const float dsc = 1.0f;
#endif
#pragma unroll
        for (int j = 0; j < 4; ++j) { const int c = 4 * (lane + 64 * j); *(f32x4*)(xr + c) = v[j] * (rstd * dsc) * *(const f32x4*)(g + c); }
    }
}

__device__ __forceinline__ int maprow(int mode, int n) {
    if (mode == 1) { const int lc = n & 255; return (n & ~255) + 128 * ((lc >> 5) & 1) + 32 * (lc >> 6) + (lc & 31); }
    if (mode == 2) { if (n < DFF) return 256 * (n >> 7) + (n & 127); const int n2 = n - DFF; return 256 * (n2 >> 7) + 128 + (n2 & 127); }
    return n;
}
__device__ __forceinline__ void transpose_item(const float* W, int K, int N, bf16* WT, int mode, LAS float* scr, int item, int lane) {
    const int nblk = N / 32, kb = item / nblk, nb = item % nblk, k0 = 64 * kb, n0 = 32 * nb;
#pragma unroll 8
    for (int i = 0; i < 32; ++i) { const int kk = 2 * i + (lane >> 5); scr[kk * 33 + (lane & 31)] = W[(size_t)(k0 + kk) * N + n0 + (lane & 31)]; }
    asm volatile("s_waitcnt lgkmcnt(0)" ::: "memory");
    const int c = lane & 7;
#pragma unroll
    for (int j = 0; j < 4; ++j) { const int n = (lane >> 3) + 8 * j; const LAS float* s = scr + (8 * c) * 33 + n;
        u32x4 o; o.x = cvtpk(s[0 * 33], s[1 * 33]); o.y = cvtpk(s[2 * 33], s[3 * 33]); o.z = cvtpk(s[4 * 33], s[5 * 33]); o.w = cvtpk(s[6 * 33], s[7 * 33]);
        *(u32x4*)(WT + (size_t)maprow(mode, n0 + n) * K + k0 + 8 * c) = o; }
    asm volatile("s_waitcnt lgkmcnt(0)" ::: "memory");
}

struct Args { const float* in[33]; float* out; unsigned char* ws; int ph_lo, ph_hi; };
constexpr int N_PHASES = 22;

__global__ void __launch_bounds__(512, 2) mega_fwd(Args args) {
    extern __shared__ __attribute__((aligned(16))) unsigned char lds[];
    LAS unsigned char* L = (LAS unsigned char*)lds;
    cg::grid_group grid = cg::this_grid();
    const int wave0 = __builtin_amdgcn_readfirstlane(threadIdx.x >> 6);
    for (int ph = args.ph_lo; ph < args.ph_hi; ++ph) {
        if (ph > args.ph_lo) grid.sync();
        int wave = wave0; asm volatile("" : "+s"(wave)); int G = gridDim.x; asm volatile("" : "+s"(G)); int bx = blockIdx.x; asm volatile("" : "+s"(bx));
    const int gw = bx * 8 + wave, NGW = G * 8;
    unsigned char* ws = args.ws; asm volatile("" : "+s"(ws)); float* out = args.out; asm volatile("" : "+s"(out));
    float* MOD = (float*)(ws + WS_MOD); float* ROPE = (float*)(ws + WS_ROPE);
    bf16* Hb = (bf16*)(ws + WS_H); float* YF = (float*)(ws + WS_H); float* YB = YF + (size_t)M_TOK * 256;
    bf16 *QA = (bf16*)(ws + WS_QA), *KA = (bf16*)(ws + WS_KA), *VA = (bf16*)(ws + WS_VA), *QC = (bf16*)(ws + WS_QC), *KC = (bf16*)(ws + WS_KC), *VC = (bf16*)(ws + WS_VC);
    float* Ub = (float*)(ws + WS_U); float* MF = (float*)(ws + WS_QKVU);
    bf16* GATES = (bf16*)(ws + WS_GATES); bf16* ACT = (bf16*)(ws + WS_GATES);
    bf16 *OA = (bf16*)(ws + WS_OA), *OB = (bf16*)(ws + WS_OB), *OC = (bf16*)(ws + WS_OC);
    bf16 *CKAK = (bf16*)(ws + WS_CKAK), *CKAV = (bf16*)(ws + WS_CKAV), *CKCK = (bf16*)(ws + WS_CKCK), *CKCV = (bf16*)(ws + WS_CKCV);
    float* SSMF = (float*)(ws + WS_SSMF);

        if (ph == 0) {
            const int lane = FRESH_LANE(), tid = wave * 64 + lane;
            LAS float* S = (LAS float*)(L + 69632);
            LAS float* red = (LAS float*)(L + 90112);
            if (bx < 192) {
                for (int i = tid; i < 5 * 1024; i += 512) { const int cv = i >> 10, kx = i & 1023; const float c = cv == 0 ? args.in[8][kx] : args.in[2][(cv - 1) * 1024 + kx]; S[i] = c / (1.0f + __expf(-c)); }
                __syncthreads();
                for (int item = bx; item < 192; item += G) {
                    const int l = item / 96, col = (item % 96) * 64 + lane;
                    const float* wp = args.in[9] + (size_t)l * 1024 * 6144 + col;
                    float a0 = 0.f, a1 = 0.f, a2 = 0.f, a3 = 0.f, a4 = 0.f;
#pragma unroll 16
                    for (int kk = 0; kk < 128; ++kk) { const int kx = wave * 128 + kk; const float w = wp[(size_t)kx * 6144];
                        a0 += S[kx] * w; a1 += S[1024 + kx] * w; a2 += S[2048 + kx] * w; a3 += S[3072 + kx] * w; a4 += S[4096 + kx] * w; }
                    red[(wave * 5 + 0) * 64 + lane] = a0; red[(wave * 5 + 1) * 64 + lane] = a1; red[(wave * 5 + 2) * 64 + lane] = a2; red[(wave * 5 + 3) * 64 + lane] = a3; red[(wave * 5 + 4) * 64 + lane] = a4;
                    __syncthreads();
                    if (wave < 5) { float s = args.in[10][l * 6144 + col];
#pragma unroll
                        for (int w8 = 0; w8 < 8; ++w8) s += red[(w8 * 5 + wave) * 64 + lane];
                        MOD[(l * 5 + wave) * 6144 + col] = s; }
                    __syncthreads();
                }
            }
            if (bx == G - 2 && tid < 256) { const int ll = tid >> 7, qk = (tid >> 6) & 1, e = tid & 63; ((float*)(ws + WS_QKG))[tid] = (qk ? args.in[14] : args.in[13])[ll * 64 + e]; }
            { const int gtid = bx * 512 + tid, NTH = G * 512;
#define CPY(idx, off, n) for (int i = gtid; i < (n) / 4; i += NTH) ((f32x4*)(ws + WS_PAR) + (off) / 4)[i] = ((const f32x4*)args.in[idx])[i];
              CPY(11, P_N1G, 2048) CPY(29, P_N2G, 2048) CPY(32, P_FING, 1024) CPY(7, P_SSM0, 32768) CPY(15, P_LAMR, 4096) CPY(16, P_LAMI, 4096) CPY(17, P_LSTEP, 64)
              CPY(18, P_BRE, 65536) CPY(19, P_BIM, 65536) CPY(20, P_CRE, 65536) CPY(21, P_CIM, 65536) CPY(22, P_SSMD, 512) CPY(24, P_NAB, 3720)
#undef CPY
            }
            if (bx == G - 1) { for (int i = tid; i < 1024; i += 512) { const int pos = i >> 4, f = i & 15; const float inv = 1.0f / powf(10000.0f, (float)f / 16.0f); const float ang = (float)pos * inv; ROPE[2 * i] = cosf(ang); ROPE[2 * i + 1] = sinf(ang); } }
            for (int it = bx * 512 + tid; it < 196608; it += G * 512) {
                const float* src; bf16* dst; int e;
                if (it < 65536) { const bool isv = it >= 32768; e = (it & 32767) * 8; const int d = e & 63, t = (e >> 6) & 255, h = (e >> 14) & 1, b = (e >> 15) & 3, l = e >> 17;
                    src = (isv ? args.in[4] : args.in[3]) + ((((size_t)(b * 2 + l) * 256 + t) * 2 + h) * 64 + d); dst = (isv ? CKAV : CKAK) + e; }
                else { const int i2 = it - 65536; const bool isv = i2 >= 65536; e = (i2 & 65535) * 8; const int d = e & 63, t = (e >> 6) & 255, h = (e >> 14) & 3, b = (e >> 16) & 3, l = e >> 18;
                    src = (isv ? args.in[6] : args.in[5]) + ((((size_t)(b * 2 + l) * 256 + t) * 4 + h) * 64 + d); dst = (isv ? CKCV : CKCK) + e; }
                const f32x4 a = *(const f32x4*)src, c = *(const f32x4*)(src + 4);
                *(u32x4*)dst = (u32x4){cvtpk(a[0], a[1]), cvtpk(a[2], a[3]), cvtpk(c[0], c[1]), cvtpk(c[2], c[3])};
            }
            LAS float* scr = (LAS float*)(L + wave * 8448);
            for (int it = gw; it < 15424; it += NGW) {
                const int l = it / 7712; int r = it % 7712;
                if (r < 2432) { transpose_item(args.in[12] + (size_t)l * DM * NIN, DM, NIN, (bf16*)(ws + W_IN) + (size_t)l * NIN * DM, 1, scr, r, lane); continue; } r -= 2432;
                if (r < 256) { transpose_item(args.in[25] + (size_t)l * 512 * DM, 512, DM, (bf16*)(ws + W_BRA) + (size_t)l * DM * 512, 0, scr, r, lane); continue; } r -= 256;
                if (r < 128) { transpose_item(args.in[26] + (size_t)l * 256 * DM, 256, DM, (bf16*)(ws + W_BRB) + (size_t)l * DM * 256, 0, scr, r, lane); continue; } r -= 128;
                if (r < 128) { transpose_item(args.in[27] + (size_t)l * 256 * DM, 256, DM, (bf16*)(ws + W_BRC) + (size_t)l * DM * 256, 0, scr, r, lane); continue; } r -= 128;
                if (r < 512) { transpose_item(args.in[28] + (size_t)l * DM * DM, DM, DM, (bf16*)(ws + W_OUT) + (size_t)l * DM * DM, 0, scr, r, lane); continue; } r -= 512;
                if (r < 2816) { transpose_item(args.in[30] + (size_t)l * DM * NGU, DM, NGU, (bf16*)(ws + W_GU) + (size_t)l * NGU * DM, 2, scr, r, lane); continue; } r -= 2816;
                if (r < 1408) { transpose_item(args.in[31] + (size_t)l * DFF * DM, DFF, DM, (bf16*)(ws + W_FD) + (size_t)l * DM * DFF, 0, scr, r, lane); continue; } r -= 1408;
                transpose_item(args.in[23] + (size_t)l * 256 * 256, 256, 256, (bf16*)(ws + W_GLU) + (size_t)l * 256 * 256, 0, scr, r, lane);
            }
            __syncthreads();
            continue;
        }
        const float* const PAR = (const float*)(ws + WS_PAR);
        if (ph == N_PHASES - 1) { const int lane = FRESH_LANE(); final_norm_rows(out, PAR + P_FING, gw, NGW, lane); continue; }
        const int l = (ph - 1) / 10, sp = (ph - 1) % 10;
        const float* modl = MOD + (size_t)l * 5 * 6144;
        const float* xc_in = args.in[0]; const float* xl_in = args.in[1];
        const float* xc_cur = out; const float* xl_cur = out + (size_t)4096 * 1024;
        pg8::StaticOrder S;
        switch (sp) {
        case 0: {
            const bool first = (l == 0); const int lane = FRESH_LANE();
            norm_mod_rows(first ? xc_in : xc_cur, first ? xl_in : xl_cur, PAR + P_N1G + l * 1024, modl, 0, 1024, Hb, gw, NGW, lane);
        } break;
        case 1: {
            pg8::Gemm g{Hb, (const bf16*)(ws + W_IN) + (size_t)l * NIN * DM, M_TOK, NIN, DM}; S.init(M_TOK, NIN, G, bx);
            EpiIn E{ws, out, l};

#ifndef CUT_IN
            pg8::gemm_phase<EpiIn, pg8::StaticOrder, true, true>(L, g, S, E, wave);
#endif

        } break;
        case 2: {
            SsmArgs SA{PAR + P_LAMR + l * 2048, PAR + P_LAMI + l * 2048, PAR + P_LSTEP + l * 32, PAR + P_BRE + (size_t)l * 32768, PAR + P_BIM + (size_t)l * 32768, PAR + P_CRE + (size_t)l * 32768, PAR + P_CIM + (size_t)l * 32768,
                       Ub, YF, YB, SSMF, PAR + P_SSM0, out + O_SSM, l};
            for (int item = bx; item < 768; item += G) {
                if (item < 256) {
                    const int b = item >> 6, h = (item >> 3) & 7, qb = item & 7, kvh = h >> 2;
                    const bf16* Qw = QA + ((size_t)4096 * 8 + (size_t)(b * 8 + h) * 2048 + qb * 256 + wave * 32) * 64;
                    const size_t co = ((size_t)((l * 4 + b) * 2 + kvh) * 256) * 64, lo = ((size_t)4096 * 2 + (size_t)(b * 2 + kvh) * 2048) * 64;
                    bf16* Ow = OA + ((size_t)4096 + b * 2048 + qb * 256 + wave * 32) * 512 + h * 64;

#ifndef CUT_ATT
                    att::attn_unit<false>(Qw, CKAK + co, CKAV + co, KA + lo, VA + lo, 36, Ow, 512, (char*)lds, 0, 0, nullptr, wave);
#endif

                } else if (item < 384) {
                    const int i = item - 256, b = i >> 5, h = (i >> 3) & 3, qb = i & 7, r0 = 4 * qb;
                    const int rlo = clampi(r0 - 4, 0, 24), rhi = clampi(r0 - 1, 0, 24) + 7, NT = 4 + rhi - rlo + 1;
                    const bf16* Qw = QC + ((size_t)4096 * 4 + (size_t)(b * 4 + h) * 2048 + qb * 256 + wave * 32) * 64;
                    const size_t co = ((size_t)((l * 4 + b) * 4 + h) * 256) * 64, lo = ((size_t)4096 * 4 + (size_t)(b * 4 + h) * 2048 + rlo * 64) * 64;
                    bf16* Ow = OC + ((size_t)4096 + b * 2048 + qb * 256 + wave * 32) * 256 + h * 64;

#ifndef CUT_NA
                    att::attn_unit<true>(Qw, CKCK + co, CKCV + co, KC + lo, VC + lo, NT, Ow, 256, (char*)lds, r0 + (wave >> 1), rlo, PAR + P_NAB + (size_t)(l * 4 + h) * 465, wave);
#endif

                } else if (item < 512) {
                    const int i = item - 384, b = i >> 3, h = i & 7, kvh = h >> 2;
                    const bf16* Qw = QA + ((size_t)(b * 8 + h) * 256 + wave * 32) * 64;
                    const size_t co = ((size_t)(b * 2 + kvh) * 256) * 64;
                    bf16* Ow = OA + ((size_t)b * 256 + wave * 32) * 512 + h * 64;

#ifndef CUT_ATT
 att::attn_unit<false>(Qw, KA + co, VA + co, KA, VA, 4, Ow, 512, (char*)lds, 0, 0, nullptr, wave);
#endif

                } else if (item < 576) {
                    const int i = item - 512, b = i >> 2, h = i & 3;
                    const bf16* Qw = QC + ((size_t)(b * 4 + h) * 256 + wave * 32) * 64;
                    const size_t co = ((size_t)(b * 4 + h) * 256) * 64;
                    bf16* Ow = OC + ((size_t)b * 256 + wave * 32) * 256 + h * 64;

#ifndef CUT_ATT
 att::attn_unit<false>(Qw, KC + co, VC + co, KC, VC, 4, Ow, 256, (char*)lds, 0, 0, nullptr, wave);
#endif

                } else {
                    const int wu = (item - 576) * 8 + wave;
                    LAS float* buf = (LAS float*)(L + wave * SSM_WAVE_BYTES);

#ifndef CUT_SSM
                    if (wu < 512) ssm_unit(SA, 0, wu >> 5, (wu >> 1) & 15, wu & 1, 0, buf);
                    else { const int w2 = wu - 512; ssm_unit(SA, 1, w2 >> 8, (w2 >> 4) & 15, (w2 >> 3) & 1, w2 & 7, buf); }
#endif
                    asm volatile("s_waitcnt vmcnt(0) lgkmcnt(0)" ::: "memory");
                    __syncthreads();
                }
            }
        } break;
        case 3: {
            SsmArgs SA{PAR + P_LAMR + l * 2048, PAR + P_LAMI + l * 2048, PAR + P_LSTEP + l * 32, PAR + P_BRE + (size_t)l * 32768, PAR + P_BIM + (size_t)l * 32768, PAR + P_CRE + (size_t)l * 32768, PAR + P_CIM + (size_t)l * 32768,
                       Ub, YF, YB, SSMF, PAR + P_SSM0, out + O_SSM, l};
            LAS float* buf = (LAS float*)(L + wave * SSM_WAVE_BYTES);

#ifndef CUT_SSM
            for (int wu = wave * G + bx; wu < 1024; wu += 8 * G) ssm_unit(SA, 2, wu >> 8, (wu >> 4) & 15, (wu >> 3) & 1, wu & 7, buf);
#endif
            asm volatile("s_waitcnt vmcnt(0) lgkmcnt(0)" ::: "memory");
            __syncthreads();
        } break;
        case 4: {
            pg8::StaticOrder SG; SG.init(M_TOK, 256, G, bx); Unit ug;
            if (SG.next(0, ug)) {
                const int tid = wave * 64 + FRESH_LANE();
                const float* dv = PAR + P_SSMD + l * 256;
                for (int i = 0; i < 32; ++i) { const int idx = tid + 512 * i, r = idx >> 6, c = (idx & 63) * 4; const size_t o = (size_t)(ug.pm * 256 + r) * 256 + c;
                    const f32x4 y = *(const f32x4*)(YF + o) + *(const f32x4*)(YB + o) + *(const f32x4*)(dv + c) * *(const f32x4*)(Ub + o); f32x4 q;
#pragma unroll
                    for (int j = 0; j < 4; ++j) { const float v = y[j]; q[j] = 0.5f * v * (1.0f + tanhf(0.7978845608028654f * (v + 0.044715f * v * v * v))); }
                    u32x2 w; w.x = cvtpk(q[0], q[1]); w.y = cvtpk(q[2], q[3]); *(u32x2*)(OB + o) = w; }
                __threadfence(); __syncthreads();
                pg8::Gemm g{OB, (const bf16*)(ws + W_GLU) + (size_t)l * 256 * 256, M_TOK, 256, 256};
                EpiGlu E{OB};
                pg8::gemm_phase<EpiGlu, pg8::StaticOrder, true, true>(L, g, SG, E, wave);
            }
        } break;
        case 5: {
            S.init(M_TOK, DM, G, bx);
            { pg8::Gemm g{OA, (const bf16*)(ws + W_BRA) + (size_t)l * DM * 512, M_TOK, DM, 512}; EpiBr<0> E{GATES, MF, nullptr}; pg8::gemm_phase<EpiBr<0>, pg8::StaticOrder, true, true>(L, g, S, E, wave); }
            { pg8::Gemm g{OC, (const bf16*)(ws + W_BRC) + (size_t)l * DM * 256, M_TOK, DM, 256}; EpiBr<1> E{GATES + 2048, MF, nullptr}; pg8::gemm_phase<EpiBr<1>, pg8::StaticOrder, true, true>(L, g, S, E, wave); }
            { pg8::Gemm g{OB, (const bf16*)(ws + W_BRB) + (size_t)l * DM * 256, M_TOK, DM, 256}; EpiBr<2> E{GATES + 1024, MF, Hb}; pg8::gemm_phase<EpiBr<2>, pg8::StaticOrder, true, true>(L, g, S, E, wave); }
        } break;
        case 6: {
            S.init(M_TOK, DM, G, bx);
            pg8::Gemm g{Hb, (const bf16*)(ws + W_OUT) + (size_t)l * DM * DM, M_TOK, DM, DM};
            EpiRes E{l == 0 ? xc_in : xc_cur, l == 0 ? xl_in : xl_cur, out, modl + 2048};
            pg8::gemm_phase<EpiRes, pg8::StaticOrder, true, true>(L, g, S, E, wave);
        } break;
        case 7: {
            const int lane = FRESH_LANE();
            norm_mod_rows(xc_cur, xl_cur, PAR + P_N2G + l * 1024, modl, 3072, 4096, Hb, gw, NGW, lane);
        } break;
        case 8: {
            pg8::Gemm g{Hb, (const bf16*)(ws + W_GU) + (size_t)l * NGU * DM, M_TOK, NGU, DM}; S.init(M_TOK, NGU, G, bx);
            EpiSwiglu E{ACT};
            pg8::gemm_phase<EpiSwiglu, pg8::StaticOrder, true, true>(L, g, S, E, wave);
        } break;
        case 9: {
            S.init(M_TOK, DM, G, bx);
            pg8::Gemm g{ACT, (const bf16*)(ws + W_FD) + (size_t)l * DM * DFF, M_TOK, DM, DFF};
            EpiRes E{xc_cur, xl_cur, out, modl + 5120};
            pg8::gemm_phase<EpiRes, pg8::StaticOrder, true, true>(L, g, S, E, wave);
        } break;
        }
    }
}

extern "C" void kernel_launch(void* const* d_in, const int* in_sizes, int n_in, void* d_out, int out_size, void* d_ws, size_t ws_size, hipStream_t stream) {
    static int grid = 0;
    if (grid == 0) {
        if (n_in != 33 || ws_size < WS_END) { fprintf(stderr, "kernel_launch: unexpected n_in %d / ws_size %zu\n", n_in, ws_size); grid = -1; return; }
        int dev = 0, cus = 0, per_cu = 0;
        hipGetDevice(&dev); hipDeviceGetAttribute(&cus, hipDeviceAttributeMultiprocessorCount, dev);
        if (hipFuncSetAttribute((const void*)mega_fwd, hipFuncAttributeMaxDynamicSharedMemorySize, LDS_BYTES) != hipSuccess) { fprintf(stderr, "kernel_launch: hipFuncSetAttribute failed\n"); grid = -1; return; }
        if (hipOccupancyMaxActiveBlocksPerMultiprocessor(&per_cu, (const void*)mega_fwd, 512, LDS_BYTES) != hipSuccess || per_cu < 1) { fprintf(stderr, "kernel_launch: occupancy query says %d\n", per_cu); per_cu = 1; }
        (void)hipGetLastError();
        grid = cus * 1;
        fprintf(stderr, "kernel_launch: cus %d per_cu %d grid %d ws %zu\n", cus, per_cu, grid, ws_size);
    }
    if (grid < 0) return;
    Args a{};
    for (int i = 0; i < 33; ++i) a.in[i] = (const float*)d_in[i];
    a.out = (float*)d_out; a.ws = (unsigned char*)d_ws;
#if MK_MULTI
    for (int ph = 0; ph < N_PHASES; ++ph) { a.ph_lo = ph; a.ph_hi = ph + 1; hipLaunchKernelGGL(mega_fwd, dim3(grid), dim3(512), LDS_BYTES, stream, a); }
#else
    a.ph_lo = 0; a.ph_hi = N_PHASES;
    void* kargs[] = {&a};
    hipError_t e = hipLaunchCooperativeKernel((const void*)mega_fwd, dim3(grid), dim3(512), kargs, LDS_BYTES, stream);
    if (e != hipSuccess) fprintf(stderr, "cooperative launch failed: %s (grid %d)\n", hipGetErrorString(e), grid);
#endif
}
```

```cpp
#include <hip/hip_runtime.h>
#include <hip/hip_cooperative_groups.h>
#include <hip/hip_bf16.h>
#include <cstdio>
#include <cstdint>
namespace cg = cooperative_groups;

#ifndef MK_MULTI
#define MK_MULTI 0
#endif

namespace pg8 {
#define PG8_LAS __attribute__((address_space(3)))
typedef unsigned short bf16_t;
typedef short bf16x8 __attribute__((ext_vector_type(8)));
typedef float f32x4 __attribute__((ext_vector_type(4)));
typedef unsigned u32x4 __attribute__((ext_vector_type(4)));
constexpr int BM = 256, BK = 64, HALF = 128, HTB = HALF * BK * 2  , STAGE_BYTES = 8 * HTB, NXCD = 8, WGM = 8;

__host__ __device__ __forceinline__ int lds_byte(int r, int c) { const int st = (r >> 4) * 2 + (c >> 5), rr = r & 15, cc = c & 31, ob = rr * 64 + cc * 2; return st * 1024 + (ob ^ (((ob >> 9) & 1) << 5)); }
__host__ __device__ __forceinline__ void stage_rc(int b, int& R, int& C) { const int st = b / 1024, sb = b % 1024, swz = sb ^ (((sb >> 9) & 1) << 5); R = (st >> 1) * 16 + swz / 64; C = (st & 1) * 32 + (swz % 64) / 2; }
__host__ __device__ __forceinline__ int perm32(int rho) { const int n = rho >> 4, i = rho & 15; return 8 * (i >> 2) + 4 * n + (i & 3); }

struct Unit { int pm, pn; };
struct Gemm { const bf16_t* A; const bf16_t* Bt; int M, N, K; };

struct StaticOrder {
    int nM, nN, nwg, G, c;
    __host__ __device__ void init(int M, int N, int G_, int c_) { nM = M / BM; nN = N / BM; nwg = nM * nN; G = G_; c = c_; }
    __host__ __device__ bool next(int i, Unit& u) const {
        const long L = (long)i * G + c; if (L >= nwg) return false;
        int wgid = (int)L; { const int q = nwg / NXCD, r = nwg % NXCD, xcd = wgid % NXCD, off = wgid / NXCD; wgid = (xcd < r ? xcd * (q + 1) : r * (q + 1) + (xcd - r) * q) + off; }
        const int nig = WGM * nN, gid = wgid / nig, fm = gid * WGM, gsz = (nM - fm) < WGM ? (nM - fm) : WGM;
        u.pm = fm + ((wgid % nig) % gsz); u.pn = (wgid % nig) / gsz; return true;
    }
    __device__ __forceinline__ void a_ready(const Unit&) const {}
    __device__ __forceinline__ void done(const Unit&) const {}
};

__device__ __forceinline__ unsigned cvt_pk_bf16(float lo, float hi) { unsigned r; asm volatile("v_cvt_pk_bf16_f32 %0, %1, %2" : "=v"(r) : "v"(lo), "v"(hi)); return r; }
typedef float f32x2 __attribute__((ext_vector_type(2)));
template <class Epi, class Sched, bool ALIGN_EPI = false, bool SP2 = false>
__device__ __forceinline__ void gemm_phase(PG8_LAS unsigned char* lds, const Gemm g, const Sched& S, const Epi& E, const int wid) {
    int lane; asm volatile("v_mbcnt_lo_u32_b32 %0, -1, 0\n\tv_mbcnt_hi_u32_b32 %0, -1, %0" : "=v"(lane)); const int tid = wid * 64 + lane, wr = wid >> 2, wc = wid & 3, fr = lane & 15, fq = lane >> 4;
    const int K = g.K, nt = K / BK;
    unsigned voffA[2], voffB[2];
#pragma unroll
    for (int i = 0; i < 2; ++i) { int R, C; stage_rc(tid * 16 + i * 8192, R, C); const int Rb = Epi::PERM ? ((R & ~31) + perm32(R & 31)) : R;
        voffA[i] = (unsigned)(R * K + C) * 2u; voffB[i] = (unsigned)(Rb * K + C) * 2u; }
    const size_t kstep = (size_t)(BK * 2);
    const size_t hstep = (size_t)HALF * K * 2;
    const size_t tstep = 2 * hstep;
    const unsigned ldsw = (unsigned)wid * 1024u;
    const int aoff = lds_byte(wr * 64 + fr, fq * 8), boff = lds_byte(wc * 32 + fr, fq * 8);
#define PG8_SA(b, h) (((b) * 2 + (h)) * HTB)
#define PG8_SB(b, h) ((4 + (b) * 2 + (h)) * HTB)
#define PG8_STAGE(bufoff, gbase, voff) do { _Pragma("unroll") for (int _i = 0; _i < 2; ++_i) \
        __builtin_amdgcn_global_load_lds((const unsigned*)((const char*)(gbase) + (voff)[_i]), (PG8_LAS unsigned*)(lds + (bufoff) + ldsw + _i * 8192), 16, 0, 0); } while (0)
#define PG8_LDA(dst, b, h) do { _Pragma("unroll") for (int m = 0; m < 4; ++m) _Pragma("unroll") for (int k = 0; k < 2; ++k) dst[m][k] = *(const PG8_LAS bf16x8*)(lds + PG8_SA(b, h) + aoff + m * 2048 + k * 1024); } while (0)
#define PG8_LDB(dst, b, h) do { _Pragma("unroll") for (int n = 0; n < 2; ++n) _Pragma("unroll") for (int k = 0; k < 2; ++k) dst[n][k] = *(const PG8_LAS bf16x8*)(lds + PG8_SB(b, h) + boff + n * 2048 + k * 1024); } while (0)
#define PG8_MMA(ai, bj, At, Bt) do { __builtin_amdgcn_s_setprio(1); _Pragma("unroll") for (int m = 0; m < 4; ++m) _Pragma("unroll") for (int n = 0; n < 2; ++n) _Pragma("unroll") for (int k = 0; k < 2; ++k) \
        acc[ai][bj][m][n] = __builtin_amdgcn_mfma_f32_16x16x32_bf16(Bt[n][k], At[m][k], acc[ai][bj][m][n], 0, 0, 0); __builtin_amdgcn_s_setprio(0); } while (0)
#define PG8_WAIT_V(n) asm volatile("s_waitcnt vmcnt(" #n ")" ::: "memory")
#define PG8_WAIT_L(n) asm volatile("s_waitcnt lgkmcnt(" #n ")" ::: "memory")
#define PG8_BAR __builtin_amdgcn_s_barrier()
#define PG8_SCHED __builtin_amdgcn_sched_barrier(0)
    Unit cur, nxt; int ui = 0;
    if (!S.next(0, cur)) return;
    f32x4 acc[2][2][4][2];
#pragma unroll
    for (int a = 0; a < 2; ++a)
#pragma unroll
        for (int b = 0; b < 2; ++b)
#pragma unroll
            for (int m = 0; m < 4; ++m)
#pragma unroll
                for (int n = 0; n < 2; ++n) acc[a][b][m][n] = (f32x4){0.f, 0.f, 0.f, 0.f};
    bf16x8 At[4][2], B0[2][2], B1[2][2];
    const char* cA = (const char*)g.A + (size_t)cur.pm * tstep; const char* cB = (const char*)g.Bt + (size_t)cur.pn * tstep;
    S.a_ready(cur);
    if constexpr (SP2) {
        PG8_STAGE(PG8_SB(0, 0), cB, voffB); PG8_STAGE(PG8_SB(0, 1), cB + hstep, voffB); PG8_STAGE(PG8_SA(0, 0), cA, voffA); PG8_STAGE(PG8_SA(0, 1), cA + hstep, voffA);
        if (wr == 1) PG8_BAR;
        PG8_WAIT_V(2); PG8_BAR;
        PG8_STAGE(PG8_SB(1, 0), cB + kstep, voffB); PG8_STAGE(PG8_SA(1, 0), cA + kstep, voffA); PG8_STAGE(PG8_SB(1, 1), cB + hstep + kstep, voffB);
        PG8_WAIT_V(6); PG8_BAR;
    } else {
        PG8_STAGE(PG8_SB(0, 0), cB, voffB); PG8_STAGE(PG8_SA(0, 0), cA, voffA); PG8_STAGE(PG8_SB(0, 1), cB + hstep, voffB); PG8_STAGE(PG8_SA(0, 1), cA + hstep, voffA);
        if (wr == 1) PG8_BAR;
        PG8_WAIT_V(4); PG8_BAR;
        PG8_STAGE(PG8_SB(1, 0), cB + kstep, voffB); PG8_STAGE(PG8_SA(1, 0), cA + kstep, voffA); PG8_STAGE(PG8_SB(1, 1), cB + hstep + kstep, voffB);
        PG8_WAIT_V(6); PG8_BAR;
    }
    for (;;) {
        const bool has_next = S.next(ui + 1, nxt);
        const char* nA = has_next ? (const char*)g.A + (size_t)nxt.pm * tstep : cA; const char* nB = has_next ? (const char*)g.Bt + (size_t)nxt.pn * tstep : cB;
        for (int t = 0; t < nt; t += 2) {
            const bool last = (t == nt - 2);
            const char* a1 = cA + (size_t)(t + 1) * kstep;
            const char* a2 = last ? nA : cA + (size_t)(t + 2) * kstep; const char* b2 = last ? nB : cB + (size_t)(t + 2) * kstep;
            const char* a3 = a2 + kstep; const char* b3 = b2 + kstep;
            if (last && has_next) S.a_ready(nxt);
            if constexpr (SP2) {
            PG8_LDB(B0, 0, 0); PG8_LDB(B1, 0, 1); PG8_SCHED; PG8_LDA(At, 0, 0); PG8_STAGE(PG8_SA(1, 1), a1 + hstep, voffA);
            PG8_WAIT_V(8); PG8_WAIT_L(0); PG8_BAR; PG8_MMA(0, 0, At, B0); PG8_MMA(0, 1, At, B1); PG8_BAR; PG8_SCHED;
            PG8_LDA(At, 0, 1); PG8_STAGE(PG8_SB(0, 0), b2, voffB); PG8_STAGE(PG8_SB(0, 1), b2 + hstep, voffB); PG8_STAGE(PG8_SA(0, 0), a2, voffA);
            PG8_WAIT_V(8); PG8_WAIT_L(0); PG8_BAR; PG8_MMA(1, 0, At, B0); PG8_MMA(1, 1, At, B1); PG8_BAR; PG8_SCHED;
            PG8_LDB(B0, 1, 0); PG8_LDB(B1, 1, 1); PG8_SCHED; PG8_LDA(At, 1, 0); PG8_STAGE(PG8_SA(0, 1), a2 + hstep, voffA);
            PG8_WAIT_V(8); PG8_WAIT_L(0); PG8_BAR; PG8_MMA(0, 0, At, B0); PG8_MMA(0, 1, At, B1); PG8_BAR; PG8_SCHED;
            PG8_LDA(At, 1, 1); PG8_STAGE(PG8_SB(1, 0), b3, voffB); PG8_STAGE(PG8_SB(1, 1), b3 + hstep, voffB); PG8_STAGE(PG8_SA(1, 0), a3, voffA);
            PG8_WAIT_V(8); PG8_WAIT_L(0); PG8_BAR; PG8_MMA(1, 0, At, B0); PG8_MMA(1, 1, At, B1); PG8_BAR; PG8_SCHED;
            } else {
            PG8_LDB(B0, 0, 0); PG8_SCHED; PG8_LDA(At, 0, 0); PG8_STAGE(PG8_SA(1, 1), a1 + hstep, voffA);
            PG8_WAIT_L(8); PG8_BAR; PG8_WAIT_L(0); PG8_MMA(0, 0, At, B0); PG8_BAR; PG8_SCHED;
            PG8_LDB(B1, 0, 1); PG8_STAGE(PG8_SB(0, 0), b2, voffB);
            PG8_BAR; PG8_WAIT_L(0); PG8_MMA(0, 1, At, B1); PG8_BAR;
            PG8_LDA(At, 0, 1); PG8_STAGE(PG8_SA(0, 0), a2, voffA);
            PG8_BAR; PG8_WAIT_L(0); PG8_MMA(1, 0, At, B0); PG8_BAR; PG8_SCHED;
            PG8_STAGE(PG8_SB(0, 1), b2 + hstep, voffB);
            PG8_WAIT_V(6); PG8_BAR; PG8_MMA(1, 1, At, B1); PG8_BAR;
            PG8_LDB(B0, 1, 0); PG8_SCHED; PG8_LDA(At, 1, 0); PG8_STAGE(PG8_SA(0, 1), a2 + hstep, voffA);
            PG8_WAIT_L(8); PG8_BAR; PG8_WAIT_L(0); PG8_MMA(0, 0, At, B0); PG8_BAR; PG8_SCHED;
            PG8_LDB(B1, 1, 1); PG8_STAGE(PG8_SB(1, 0), b3, voffB);
            PG8_BAR; PG8_WAIT_L(0); PG8_MMA(0, 1, At, B1); PG8_BAR;
            PG8_LDA(At, 1, 1); PG8_STAGE(PG8_SA(1, 0), a3, voffA);
            PG8_BAR; PG8_WAIT_L(0); PG8_MMA(1, 0, At, B0); PG8_BAR; PG8_SCHED;
            PG8_STAGE(PG8_SB(1, 1), b3 + hstep, voffB);
            PG8_WAIT_V(6); PG8_BAR; PG8_MMA(1, 1, At, B1); PG8_BAR;
            }
        }
        if constexpr (ALIGN_EPI) { if (wr == 0) PG8_BAR; }
        if constexpr (!Epi::AFTER_DRAIN) { E(acc, cur, wr, wc, fr, fq); S.done(cur); }
        if (!has_next) break;
#pragma unroll
        for (int a = 0; a < 2; ++a)
#pragma unroll
            for (int b = 0; b < 2; ++b)
#pragma unroll
                for (int m = 0; m < 4; ++m)
#pragma unroll
                    for (int n = 0; n < 2; ++n) acc[a][b][m][n] = (f32x4){0.f, 0.f, 0.f, 0.f};
        cur = nxt; cA = nA; cB = nB; ++ui;
        if constexpr (ALIGN_EPI) { if (wr == 1) PG8_BAR; }
    }
    PG8_WAIT_V(0);
    if constexpr (!ALIGN_EPI) { if (wr == 0) PG8_BAR; }
    PG8_BAR;
    if constexpr (Epi::AFTER_DRAIN) { E.fused(acc, cur, wr, wc, fr, fq, lds, wid, lane); S.done(cur); }
#undef PG8_SA
#undef PG8_SB
#undef PG8_STAGE
#undef PG8_LDA
#undef PG8_LDB
#undef PG8_MMA
#undef PG8_WAIT_V
#undef PG8_WAIT_L
#undef PG8_BAR
#undef PG8_SCHED
}
}

#define LAS __attribute__((address_space(3)))
typedef unsigned short bf16;
typedef short bf16x8 __attribute__((ext_vector_type(8)));
typedef short s16x4 __attribute__((ext_vector_type(4)));
typedef float f32x4 __attribute__((ext_vector_type(4)));
typedef float f32x16 __attribute__((ext_vector_type(16)));
typedef unsigned u32x4 __attribute__((ext_vector_type(4)));
typedef unsigned u32x2 __attribute__((ext_vector_type(2)));
typedef float f32x2_t __attribute__((ext_vector_type(2)));
typedef __bf16 bf16x2_t __attribute__((ext_vector_type(2)));

constexpr int M_TOK = 12288, M_CTX = 4096, DM = 1024, NIN = 4864, DFF = 2816, NGU = 5632;
constexpr float EPS = 1e-6f, LOG2E = 1.4426950408889634f, C2 = 0.125f * 1.4426950408889634f;
constexpr size_t MiB = 1u << 20;
constexpr size_t WS_ROPE = 0, WS_QKG = 16384, WS_BAR = 32768, WS_MOD = 65536, WS_SSMF = 512 * 1024, WS_CKAK = 1 * MiB, WS_CKAV = 1 * MiB + 512 * 1024, WS_CKCK = 2 * MiB, WS_CKCV = 3 * MiB;
constexpr size_t WS_W = 4 * MiB;
constexpr size_t W_IN = WS_W, W_BRA = W_IN + 2ull * NIN * DM * 2, W_BRB = W_BRA + 2ull * DM * 512 * 2, W_BRC = W_BRB + 2ull * DM * 256 * 2, W_OUT = W_BRC + 2ull * DM * 256 * 2,
                 W_GU = W_OUT + 2ull * DM * DM * 2, W_FD = W_GU + 2ull * NGU * DM * 2, W_GLU = W_FD + 2ull * DM * DFF * 2, W_END = W_GLU + 2ull * 256 * 256 * 2;
constexpr size_t WS_H = 65 * MiB;
constexpr size_t WS_QKVU = 89 * MiB;
constexpr size_t WS_QA = WS_QKVU, WS_KA = WS_QA + 12 * MiB, WS_VA = WS_KA + 3 * MiB, WS_U = WS_VA + 3 * MiB, WS_QC = WS_U + 12 * MiB, WS_KC = WS_QC + 6 * MiB, WS_VC = WS_KC + 6 * MiB;
constexpr size_t WS_GATES = 137 * MiB;
constexpr size_t WS_OA = 209 * MiB, WS_OB = 221 * MiB, WS_OC = 227 * MiB, WS_PAR = 233 * MiB, WS_END = 235 * MiB;
constexpr int P_N1G = 0, P_N2G = 2048, P_FING = 4096, P_SSM0 = 5120, P_LAMR = 37888, P_LAMI = 41984, P_LSTEP = 46080, P_BRE = 46144, P_BIM = 111680, P_CRE = 177216, P_CIM = 242752, P_SSMD = 308288, P_NAB = 308800;
static_assert(W_END <= WS_H, "weights fit");
constexpr size_t O_YP = 0, O_YS = 4194304, O_GAK = 12582912, O_GAV = 13631488, O_NAK = 14680064, O_NAV = 16777216, O_SSM = 18874368;
constexpr int LDS_BYTES = 147456;

__device__ __forceinline__ unsigned cvtpk(float lo, float hi) { f32x2_t v = {lo, hi}; bf16x2_t b = __builtin_convertvector(v, bf16x2_t); return __builtin_bit_cast(unsigned, b); }
__device__ __forceinline__ float bf2f(unsigned b) { return __uint_as_float(b << 16); }
__device__ __forceinline__ float sigmoidf_(float v) { return 1.0f / (1.0f + __expf(-v)); }
template <int K> __device__ __forceinline__ float xor_shfl(float v) {
    return __uint_as_float((unsigned)__builtin_amdgcn_ds_swizzle((int)__float_as_uint(v), (K << 10) | 0x1F));
}
__device__ __forceinline__ float sum_xor32(float v) { auto rr = __builtin_amdgcn_permlane32_swap(__float_as_uint(v), __float_as_uint(v), false, false); return __uint_as_float(rr[0]) + __uint_as_float(rr[1]); }
__device__ __forceinline__ float wave_sum(float v) {
    v += xor_shfl<1>(v); v += xor_shfl<2>(v); v += xor_shfl<4>(v); v += xor_shfl<8>(v); v += xor_shfl<16>(v);
    return sum_xor32(v);
}
__device__ __forceinline__ int crow(int r, int hi) { return (r & 3) + 8 * (r >> 2) + 4 * hi; }
__device__ __forceinline__ int clampi(int v, int lo, int hi) { return v < lo ? lo : (v > hi ? hi : v); }
#define FRESH_LANE() ({ int l__; asm volatile("v_mbcnt_lo_u32_b32 %0, -1, 0\n\tv_mbcnt_hi_u32_b32 %0, -1, %0" : "=v"(l__)); l__; })
#ifndef DBG_SSM
#define DBG_SSM 1.0f
#endif
#ifndef DBG_GAK
#define DBG_GAK 1.0f
#endif
#ifndef DBG_GAV
#define DBG_GAV 1.0f
#endif
#define VM_WAIT0() asm volatile("s_waitcnt vmcnt(0)" ::: "memory")

#define XB_TMO      128
#define XB_XCNT(j)  (256  + 64 * (j))
#define XB_XSUB(j)  (1280 + 64 * (j))
#define XB_XGEN(j)  (2304 + 64 * (j))
#define XB_TOP      3328
#define XB_TOPGEN   3392
#define XCD_BAR_WORDS 3456
#define XB_SPIN_CAP (1u << 18)

__device__ __forceinline__ unsigned xb_ld(unsigned* p)              { return __hip_atomic_load(p, __ATOMIC_RELAXED, __HIP_MEMORY_SCOPE_AGENT); }
__device__ __forceinline__ unsigned xb_add(unsigned* p, unsigned v) { return __hip_atomic_fetch_add(p, v, __ATOMIC_RELAXED, __HIP_MEMORY_SCOPE_AGENT); }
__device__ __forceinline__ unsigned xb_xcc_id() { return (unsigned)__builtin_amdgcn_s_getreg((3 << 11) | 20) & 0xFu; }
#define XB_SPIN(cond, bar) do { unsigned _sp = 0; while (cond) { __builtin_amdgcn_s_sleep(1); \
    if ((++_sp & 255u) == 0u) { if (xb_ld(&(bar)[XB_TMO])) break; if (_sp > XB_SPIN_CAP) { atomicAdd(&(bar)[XB_TMO], 1u); break; } } } } while (0)

struct XcdBarrier {
    unsigned* bar; unsigned x;
    volatile LAS unsigned* st;
};

__device__ __forceinline__ XcdBarrier xcd_barrier_post(unsigned* bar, volatile LAS unsigned* st) {
    XcdBarrier b; b.bar = bar; b.x = xb_xcc_id(); b.st = st;
    if (threadIdx.x == 0) (void)xb_add(&bar[XB_XCNT(b.x)], 1u);
    return b;
}
__device__ __forceinline__ void xcd_barrier_complete(unsigned* bar, unsigned x, unsigned& nloc, unsigned& nx) {
    const unsigned G = gridDim.x * gridDim.y * gridDim.z;
    unsigned sum, cnt, mine, sp = 0u;
    for (;;) {
        sum = 0u; cnt = 0u; mine = 0u;
#pragma unroll
        for (unsigned j = 0; j < 16; ++j) { const unsigned c = xb_ld(&bar[XB_XCNT(j)]); sum += c; cnt += (c > 0u) ? 1u : 0u; mine = (j == x) ? c : mine; }
        if (sum == G) break;
        __builtin_amdgcn_s_sleep(1);
        if ((++sp & 255u) == 0u) { if (xb_ld(&bar[XB_TMO])) break; if (sp > XB_SPIN_CAP) { atomicAdd(&bar[XB_TMO], 1u); break; } }
    }
    nloc = mine > 0u ? mine : 1u; nx = cnt > 0u ? cnt : 1u;
}

__device__ __forceinline__ void xcd_barrier(const XcdBarrier& b) {
    asm volatile("s_waitcnt vmcnt(0)" ::: "memory");
    __syncthreads();
    if (threadIdx.x == 0) {
        unsigned* bar = b.bar;
        __builtin_amdgcn_s_waitcnt(0);
        unsigned nloc = b.st[0], nx = b.st[1];
        if (nloc == 0u) { xcd_barrier_complete(bar, b.x, nloc, nx); b.st[0] = nloc; b.st[1] = nx; }
        const unsigned old = xb_add(&bar[XB_XSUB(b.x)], 1u);
        const unsigned gen = old / nloc;
        if (old + 1u == (gen + 1u) * nloc) {
            __builtin_amdgcn_fence(__ATOMIC_RELEASE, "agent");
            asm volatile("s_waitcnt vmcnt(0)" ::: "memory");
            const unsigned og = xb_add(&bar[XB_TOP], 1u);
            const unsigned tg = og / nx;
            if (og + 1u == (tg + 1u) * nx) xb_add(&bar[XB_TOPGEN], 1u);
            else XB_SPIN(xb_ld(&bar[XB_TOPGEN]) == tg, bar);
            __builtin_amdgcn_fence(__ATOMIC_ACQUIRE, "agent");
            xb_add(&bar[XB_XGEN(b.x)], 1u);
            asm volatile("s_waitcnt vmcnt(0)" ::: "memory");
        } else {
            XB_SPIN(xb_ld(&bar[XB_XGEN(b.x)]) == gen, bar);
            __builtin_amdgcn_fence(__ATOMIC_ACQUIRE, "agent");
            asm volatile("s_waitcnt vmcnt(0)" ::: "memory");
        }
    }
    __syncthreads();
}
using pg8::Unit;
struct EpiIn {
    static constexpr bool PERM = false, AFTER_DRAIN = false;
    unsigned char* ws; float* out; int layer;
    __device__ __forceinline__ void operator()(const f32x4 (&acc)[2][2][4][2], const Unit& u, int wr, int wc, int fr_, int fq_) const {
        const int ln_ = FRESH_LANE(), fr = ln_ & 15, fq = ln_ >> 4;
        const int pn = u.pn; const bool ctx = u.pm < 16;
        const int rb = u.pm * 256 + wr * 64 + fr;
        if (pn >= 7) {
#pragma unroll
            for (int ai = 0; ai < 2; ++ai)
#pragma unroll
                for (int m = 0; m < 4; ++m) {
                    const int row = rb + ai * 128 + m * 16;
                    bf16* gp = (bf16*)(ws + WS_GATES) + (size_t)row * 3072 + (pn - 7) * 256 + 64 * wc + 4 * fq;
#pragma unroll
                    for (int bj = 0; bj < 2; ++bj)
#pragma unroll
                        for (int n = 0; n < 2; ++n) { const f32x4 v = acc[ai][bj][m][n]; u32x2 w; w.x = cvtpk(sigmoidf_(v[0]), sigmoidf_(v[1])); w.y = cvtpk(sigmoidf_(v[2]), sigmoidf_(v[3])); *(u32x2*)(gp + 32 * bj + 16 * n) = w; }
                }
        } else if (pn == 3) {
#pragma unroll
            for (int ai = 0; ai < 2; ++ai)
#pragma unroll
                for (int m = 0; m < 4; ++m) {
                    const int row = rb + ai * 128 + m * 16;
                    float* up = (float*)(ws + WS_U) + (size_t)row * 256 + 64 * wc + 4 * fq;
#pragma unroll
                    for (int bj = 0; bj < 2; ++bj)
#pragma unroll
                        for (int n = 0; n < 2; ++n) *(f32x4*)(up + 32 * bj + 16 * n) = acc[ai][bj][m][n];
                }
        } else if (pn >= 4) {
            bf16* base = (bf16*)(ws + (pn == 4 ? WS_QC : (pn == 5 ? WS_KC : WS_VC)));
            const float sc = pn == 4 ? C2 : 1.0f;
            float* ob = out + (pn == 5 ? O_NAK : O_NAV);
#pragma unroll
            for (int ai = 0; ai < 2; ++ai)
#pragma unroll
                for (int m = 0; m < 4; ++m) {
                    const int row = rb + ai * 128 + m * 16;
                    int b, t; size_t hrow;
                    if (ctx) { b = row >> 8; t = row & 255; hrow = (size_t)(b * 4 + wc) * 256 + t; } else { const int r2 = row - 4096; b = r2 >> 11; t = r2 & 2047; hrow = (size_t)4096 * 4 + (size_t)(b * 4 + wc) * 2048 + t; }
                    bf16* dp = base + hrow * 64 + 4 * fq;
#pragma unroll
                    for (int bj = 0; bj < 2; ++bj)
#pragma unroll
                        for (int n = 0; n < 2; ++n) { const f32x4 v = acc[ai][bj][m][n] * sc; u32x2 w; w.x = cvtpk(v[0], v[1]); w.y = cvtpk(v[2], v[3]); *(u32x2*)(dp + 32 * bj + 16 * n) = w; }
                    if (ctx && pn >= 5) { float* op = ob + ((size_t)(b * 2 + layer) * 256 + t) * 256 + wc * 64 + 4 * fq;
#pragma unroll
                        for (int bj = 0; bj < 2; ++bj)
#pragma unroll
                            for (int n = 0; n < 2; ++n) *(f32x4*)(op + 32 * bj + 16 * n) = acc[ai][bj][m][n]; }
                }
        } else {
            const bool isQ = pn < 2, isV = (pn == 2 && wc >= 2);
            const int h = isQ ? 4 * pn + wc : (wc & 1);
            const float* gsrc = (const float*)(ws + WS_QKG) + (layer * 2 + (isQ ? 0 : 1)) * 64 + 4 * fq;
            f32x4 gg[2][2];
#pragma unroll
            for (int bj = 0; bj < 2; ++bj)
#pragma unroll
                for (int n = 0; n < 2; ++n) gg[bj][n] = *(const f32x4*)(gsrc + 32 * bj + 16 * n);
            bf16* base = (bf16*)(ws + (isQ ? WS_QA : (isV ? WS_VA : WS_KA)));
            const int nh = isQ ? 8 : 2;
            float* ob = out + (isV ? O_GAV : O_GAK);
#pragma unroll
            for (int ai = 0; ai < 2; ++ai)
#pragma unroll
                for (int m = 0; m < 4; ++m) {
                    const int row = rb + ai * 128 + m * 16;
                    f32x4 v[2][2];
#pragma unroll
                    for (int bj = 0; bj < 2; ++bj)
#pragma unroll
                        for (int n = 0; n < 2; ++n) v[bj][n] = acc[ai][bj][m][n];
                    if (!isV) {
                        float ss = 0.f;
#pragma unroll
                        for (int bj = 0; bj < 2; ++bj)
#pragma unroll
                            for (int n = 0; n < 2; ++n) ss += (v[bj][n][0] * v[bj][n][0] + v[bj][n][1] * v[bj][n][1]) + (v[bj][n][2] * v[bj][n][2] + v[bj][n][3] * v[bj][n][3]);
                        ss += xor_shfl<16>(ss); ss = sum_xor32(ss);
                        const float rstd = rsqrtf(ss * (1.0f / 64.0f) + EPS);
#pragma unroll
                        for (int bj = 0; bj < 2; ++bj)
#pragma unroll
                            for (int n = 0; n < 2; ++n) v[bj][n] = v[bj][n] * rstd * gg[bj][n];
                    }
                    int b, t; size_t hrow;
                    if (ctx) { b = row >> 8; t = row & 255; hrow = (size_t)(b * nh + h) * 256 + t; }
                    else {
                        const int r2 = row - 4096; b = r2 >> 11; t = r2 & 2047; hrow = (size_t)4096 * nh + (size_t)(b * nh + h) * 2048 + t;
                        if (!isV) {
#pragma unroll
                            for (int bj = 0; bj < 2; ++bj) {
                                const int pos = bj ? (t & 63) : (t >> 6);
                                const float* tp = (const float*)(ws + WS_ROPE) + (pos * 16 + 4 * fq) * 2;
                                const f32x4 c01 = *(const f32x4*)tp, c23 = *(const f32x4*)(tp + 4);
                                const f32x4 cs = {c01[0], c01[2], c23[0], c23[2]}, sn = {c01[1], c01[3], c23[1], c23[3]};
                                const f32x4 x1 = v[bj][0], x2 = v[bj][1];
                                v[bj][0] = x1 * cs - x2 * sn; v[bj][1] = x2 * cs + x1 * sn;
                            }
                        }
                    }
                    if (ctx && !isQ) { float* op = ob + ((size_t)(b * 2 + layer) * 256 + t) * 128 + h * 64 + 4 * fq;
#pragma unroll
                        for (int bj = 0; bj < 2; ++bj)
#pragma unroll
                            for (int n = 0; n < 2; ++n) *(f32x4*)(op + 32 * bj + 16 * n) = v[bj][n] * (isV ? DBG_GAV : DBG_GAK); }
                    const float sc = isQ ? C2 : 1.0f;
                    bf16* dp = base + hrow * 64 + 4 * fq;
#pragma unroll
                    for (int bj = 0; bj < 2; ++bj)
#pragma unroll
                        for (int n = 0; n < 2; ++n) { const f32x4 x = v[bj][n] * sc; u32x2 w; w.x = cvtpk(x[0], x[1]); w.y = cvtpk(x[2], x[3]); *(u32x2*)(dp + 32 * bj + 16 * n) = w; }
                }
        }
        VM_WAIT0();
    }
};

struct EpiRes {
    static constexpr bool PERM = false, AFTER_DRAIN = false;
    const float* xc; const float* xl; float* xo; const float* mod;
    __device__ __forceinline__ void operator()(const f32x4 (&acc)[2][2][4][2], const Unit& u, int wr, int wc, int fr_, int fq_) const {
        const int ln_ = FRESH_LANE(), fr = ln_ & 15, fq = ln_ >> 4;
        const int cv = u.pm < 16 ? 0 : 1 + ((u.pm - 16) >> 3);
        const int col0 = u.pn * 256 + wc * 32 + 4 * fq;
        f32x4 gv[2][2];
#pragma unroll
        for (int bj = 0; bj < 2; ++bj)
#pragma unroll
            for (int n = 0; n < 2; ++n) gv[bj][n] = *(const f32x4*)(mod + cv * 6144 + col0 + bj * 128 + n * 16);
#pragma unroll
        for (int ai = 0; ai < 2; ++ai)
#pragma unroll
            for (int m = 0; m < 4; ++m) {
                const int row = u.pm * 256 + ai * 128 + wr * 64 + m * 16 + fr;
                const float* xs = row < 4096 ? xc + (size_t)row * 1024 : xl + (size_t)(row - 4096) * 1024;
                float* xd = xo + (size_t)row * 1024;
#pragma unroll
                for (int bj = 0; bj < 2; ++bj)
#pragma unroll
                    for (int n = 0; n < 2; ++n) { const int c = col0 + bj * 128 + n * 16; const f32x4 xv = *(const f32x4*)(xs + c); *(f32x4*)(xd + c) = xv + gv[bj][n] * acc[ai][bj][m][n]; }
                asm volatile("" ::: "memory");
            }
        VM_WAIT0();
    }
};

struct EpiSwiglu {
    static constexpr bool PERM = false, AFTER_DRAIN = false;
    bf16* ACT;
    __device__ __forceinline__ void operator()(const f32x4 (&acc)[2][2][4][2], const Unit& u, int wr, int wc, int fr_, int fq_) const {
        const int ln_ = FRESH_LANE(), fr = ln_ & 15, fq = ln_ >> 4;
#pragma unroll
        for (int ai = 0; ai < 2; ++ai)
#pragma unroll
            for (int m = 0; m < 4; ++m) {
                const int row = u.pm * 256 + ai * 128 + wr * 64 + m * 16 + fr;
                bf16* ap = ACT + (size_t)row * DFF + u.pn * 128 + wc * 32 + 4 * fq;
#pragma unroll
                for (int n = 0; n < 2; ++n) { const f32x4 g = acc[ai][0][m][n], up = acc[ai][1][m][n]; f32x4 r;
#pragma unroll
                    for (int i = 0; i < 4; ++i) r[i] = g[i] * sigmoidf_(g[i]) * up[i];
                    u32x2 w; w.x = cvtpk(r[0], r[1]); w.y = cvtpk(r[2], r[3]); *(u32x2*)(ap + 16 * n) = w; }
                asm volatile("" ::: "memory");
            }
        VM_WAIT0();
    }
};

struct EpiGlu {
    static constexpr bool PERM = false, AFTER_DRAIN = false;
    bf16* OB;
    __device__ __forceinline__ void operator()(const f32x4 (&acc)[2][2][4][2], const Unit& u, int wr, int wc, int fr_, int fq_) const {
        const int ln_ = FRESH_LANE(), fr = ln_ & 15, fq = ln_ >> 4;
#pragma unroll
        for (int ai = 0; ai < 2; ++ai)
#pragma unroll
            for (int m = 0; m < 4; ++m) {
                const int row = u.pm * 256 + ai * 128 + wr * 64 + m * 16 + fr;
                bf16* p = OB + (size_t)row * 256 + wc * 32 + 4 * fq;
#pragma unroll
                for (int bj = 0; bj < 2; ++bj)
#pragma unroll
                    for (int n = 0; n < 2; ++n) { bf16* q = p + bj * 128 + n * 16; const u32x2 yv = *(const u32x2*)q; const f32x4 a = acc[ai][bj][m][n];
                        const float y0 = bf2f(yv.x & 0xffffu), y1 = bf2f(yv.x >> 16), y2 = bf2f(yv.y & 0xffffu), y3 = bf2f(yv.y >> 16);
                        u32x2 w; w.x = cvtpk(y0 * sigmoidf_(a[0]), y1 * sigmoidf_(a[1])); w.y = cvtpk(y2 * sigmoidf_(a[2]), y3 * sigmoidf_(a[3])); *(u32x2*)q = w; }
                asm volatile("" ::: "memory");
            }
        VM_WAIT0();
    }
};

template <int MODE> struct EpiBr {
    static constexpr bool PERM = false, AFTER_DRAIN = false;
    const bf16* G; float* MF; bf16* MG;
    __device__ __forceinline__ void operator()(const f32x4 (&acc)[2][2][4][2], const Unit& u, int wr, int wc, int fr_, int fq_) const {
        const int ln_ = FRESH_LANE(), fr = ln_ & 15, fq = ln_ >> 4;
        const int col0 = u.pn * 256 + wc * 32 + 4 * fq;
#pragma unroll
        for (int ai = 0; ai < 2; ++ai)
#pragma unroll
            for (int m = 0; m < 4; ++m) {
                const int row = u.pm * 256 + ai * 128 + wr * 64 + m * 16 + fr;
#pragma unroll
                for (int bj = 0; bj < 2; ++bj)
#pragma unroll
                    for (int n = 0; n < 2; ++n) { const int c = col0 + bj * 128 + n * 16; const u32x2 gv = *(const u32x2*)(G + (size_t)row * 3072 + c); const f32x4 a = acc[ai][bj][m][n];
                        f32x4 r = {bf2f(gv.x & 0xffffu) * a[0], bf2f(gv.x >> 16) * a[1], bf2f(gv.y & 0xffffu) * a[2], bf2f(gv.y >> 16) * a[3]};
#ifdef DBG_ZERO_BR
                        if (MODE == DBG_ZERO_BR) r = r * 0.0f;
#endif
                        float* mp = MF + (size_t)row * 1024 + c;
                        if (MODE >= 1) r = r + *(const f32x4*)mp;
                        if (MODE <= 1) *(f32x4*)mp = r;
                        else { u32x2 w; w.x = cvtpk(r[0], r[1]); w.y = cvtpk(r[2], r[3]); *(u32x2*)(MG + (size_t)row * 1024 + c) = w; } }
                asm volatile("" ::: "memory");
            }
        VM_WAIT0();
    }
};

namespace att {
constexpr int SLOTB = 8192, LDS_K = 0, LDS_V = 16384, LDS_WS = 32768, LDS_OST = 34816, LDS_BIAS = 67584;
constexpr float THR = 8.0f;
#define SBAR() __builtin_amdgcn_sched_barrier(0)
__device__ __forceinline__ void glds16(const void* gsrc, unsigned lds_dst) { unsigned keep;
    asm volatile("s_mov_b32 %0, m0\n\ts_mov_b32 m0, %2\n\ts_nop 0\n\tglobal_load_lds_dwordx4 %1, off\n\ts_mov_b32 m0, %0" : "=&s"(keep) : "v"(gsrc), "s"(lds_dst) : "memory"); }
#define WAIT_BAR0() asm volatile("s_waitcnt vmcnt(0) lgkmcnt(0)\n\ts_barrier" ::: "memory")
typedef LAS const char* lds_cptr;
__device__ __forceinline__ void qkt(f32x16& p0, f32x16& p1, lds_cptr kb, const bf16x8* qr, const f32x16& negm) {
#pragma unroll
    for (int d0 = 0; d0 < 4; ++d0) {
        const bf16x8 b0 = *(const LAS bf16x8*)(kb + d0 * 2048);
        const bf16x8 b1 = *(const LAS bf16x8*)(kb + d0 * 2048 + 512);
        if (d0 == 0) { p0 = __builtin_amdgcn_mfma_f32_32x32x16_bf16(b0, qr[0], negm, 0, 0, 0); p1 = __builtin_amdgcn_mfma_f32_32x32x16_bf16(b1, qr[0], negm, 0, 0, 0); }
        else { p0 = __builtin_amdgcn_mfma_f32_32x32x16_bf16(b0, qr[d0], p0, 0, 0, 0); p1 = __builtin_amdgcn_mfma_f32_32x32x16_bf16(b1, qr[d0], p1, 0, 0, 0); }
    }
}
__device__ __forceinline__ float rowmax(const f32x16& p0, const f32x16& p1) {
    float a = fmaxf(fmaxf(p0[0], p0[1]), p1[0]), b = fmaxf(fmaxf(p0[2], p0[3]), p1[1]); a = fmaxf(fmaxf(a, p1[2]), p1[3]);
#pragma unroll
    for (int r = 4; r < 16; r += 4) { a = fmaxf(fmaxf(a, p0[r]), p0[r + 1]); b = fmaxf(fmaxf(b, p0[r + 2]), p0[r + 3]); a = fmaxf(fmaxf(a, p1[r]), p1[r + 1]); b = fmaxf(fmaxf(b, p1[r + 2]), p1[r + 3]); }
    const float m = fmaxf(a, b);
    auto rr = __builtin_amdgcn_permlane32_swap(__float_as_uint(m), __float_as_uint(m), false, false);
    return fmaxf(__uint_as_float(rr[0]), __uint_as_float(rr[1]));
}
__device__ __forceinline__ void pv(f32x16* o, int vb, bf16x8 pa0, bf16x8 pa1, bf16x8 pa2, bf16x8 pa3) {
#pragma unroll
    for (int d0 = 0; d0 < 2; ++d0) { s16x4 lo[4], hi[4];
#pragma unroll
        for (int ks = 0; ks < 4; ++ks) {
            asm volatile("ds_read_b64_tr_b16 %0,%1 offset:%c2" : "=&v"(lo[ks]) : "v"(vb), "i"(d0 * 4096 + ks * 1024) : "memory");
            asm volatile("ds_read_b64_tr_b16 %0,%1 offset:%c2" : "=&v"(hi[ks]) : "v"(vb), "i"(d0 * 4096 + ks * 1024 + 512) : "memory"); }
        asm volatile("s_waitcnt lgkmcnt(0)" ::: "memory"); SBAR();
#define PK(k) (bf16x8){lo[k][0], lo[k][1], lo[k][2], lo[k][3], hi[k][0], hi[k][1], hi[k][2], hi[k][3]}
        o[d0] = __builtin_amdgcn_mfma_f32_32x32x16_bf16(pa0, PK(0), o[d0], 0, 0, 0);
        o[d0] = __builtin_amdgcn_mfma_f32_32x32x16_bf16(pa1, PK(1), o[d0], 0, 0, 0);
        o[d0] = __builtin_amdgcn_mfma_f32_32x32x16_bf16(pa2, PK(2), o[d0], 0, 0, 0);
        o[d0] = __builtin_amdgcn_mfma_f32_32x32x16_bf16(pa3, PK(3), o[d0], 0, 0, 0);
#undef PK
    }
}
template <bool NA>
__device__ __forceinline__ void attn_unit(const bf16* Qw, const bf16* Kc, const bf16* Vc, const bf16* Kl, const bf16* Vl, int NT,
                                          bf16* Ow, int opitch, char* shm, int qrow, int rlo, const float* biasg, const int wid) {
    const int lane = FRESH_LANE(), tid = wid * 64 + lane, r32 = lane & 31, hi = lane >> 5;
    const unsigned lds0 = (unsigned)(uintptr_t)shm;
    const lds_cptr shm3 = (lds_cptr)shm;
    LAS float* wsf = (LAS float*)(shm3 + LDS_WS) + wid * 64;
    LAS float* bias_s = (LAS float*)(shm3 + LDS_BIAS);
    if (NA) { if (tid < 465) bias_s[tid] = biasg[tid] * LOG2E; }
    const int koff = lane * 64 + wid * 8;
    const int voff = (16 * (wid & 3) + (lane >> 2)) * 64 + (wid >> 2) * 32 + (lane & 3) * 8;
    const unsigned kdst = lds0 + LDS_K + wid * 1024, vdst = lds0 + LDS_V + wid * 1024;
#define ATT_DMA(t, slot) do { const bf16* kt_ = (t) < 4 ? Kc + (t) * 4096 : Kl + ((t) - 4) * 4096; const bf16* vt_ = (t) < 4 ? Vc + (t) * 4096 : Vl + ((t) - 4) * 4096; \
        glds16(kt_ + koff, (unsigned)__builtin_amdgcn_readfirstlane(kdst + (slot))); glds16(vt_ + voff, (unsigned)__builtin_amdgcn_readfirstlane(vdst + (slot))); } while (0)
    ATT_DMA(0, 0);
    bf16x8 qr[4];
#pragma unroll
    for (int d0 = 0; d0 < 4; ++d0) qr[d0] = *(const bf16x8*)(Qw + (size_t)r32 * 64 + d0 * 16 + hi * 8);
    float mhat = 0.f, l_reg = 0.f; f32x16 o[2]; o[0] = f32x16{}; o[1] = f32x16{}; f32x16 negm = f32x16{};
    const lds_cptr kp0 = shm3 + LDS_K + hi * 1024 + r32 * 16;
    const int vb0 = (int)(lds0 + LDS_V) + ((lane >> 4) & 1) * 32 + (lane & 3) * 8 + (4 * hi + ((lane & 15) >> 2)) * 64;
    const int qc = (wid & 1) * 32 + r32, cs = clampi(qc - 8, 0, 48), rs = clampi(qrow - 4, 0, 24);
    for (int t = 0; t < NT; ++t) {
        WAIT_BAR0();
        const int slot = (t & 1) * SLOTB;
        if (t + 1 < NT) ATT_DMA(t + 1, SLOTB - slot);
        f32x16 p0, p1;
        qkt(p0, p1, kp0 + slot, qr, negm);
        if (NA && t >= 4) {
            const int kr = rlo + t - 4;
            if (kr < rs || kr >= rs + 8) {
#pragma unroll
                for (int r = 0; r < 16; ++r) { p0[r] = -INFINITY; p1[r] = -INFINITY; }
            } else {
                const LAS float* brow = bias_s + (kr - qrow + 7) * 31;
#pragma unroll
                for (int r = 0; r < 16; ++r) {
                    const int kc = crow(r, hi);
                    const int i0 = clampi(kc - qc + 15, 0, 30), i1 = clampi(kc + 32 - qc + 15, 0, 30);
                    const float b0 = brow[i0], b1 = brow[i1];
                    p0[r] = ((unsigned)(kc - cs) < 16u) ? p0[r] + b0 : -INFINITY;
                    p1[r] = ((unsigned)(kc + 32 - cs) < 16u) ? p1[r] + b1 : -INFINITY;
                }
            }
        }
        const float rm = rowmax(p0, p1);
        if (t == 0 || __any(rm > THR)) {
            const float dl = (t == 0) ? rm : fmaxf(rm, 0.f);
            mhat += dl;
#pragma unroll
            for (int r = 0; r < 16; ++r) { p0[r] -= dl; p1[r] -= dl; negm[r] = -mhat; }
            if (t > 0) {
                const float f = __builtin_amdgcn_exp2f(-dl); l_reg *= f;
                if (hi == 0) wsf[r32] = f;
                asm volatile("s_waitcnt lgkmcnt(0)" ::: "memory");
#pragma unroll
                for (int r = 0; r < 16; ++r) { const float fr_ = wsf[crow(r, hi)]; o[0][r] *= fr_; o[1][r] *= fr_; }
                asm volatile("s_waitcnt lgkmcnt(0)" ::: "memory");
            }
        }
        float sacc = 0.f;
#pragma unroll
        for (int r = 0; r < 16; ++r) { p0[r] = __builtin_amdgcn_exp2f(p0[r]); p1[r] = __builtin_amdgcn_exp2f(p1[r]); sacc += p0[r] + p1[r]; }
        l_reg += sacc;
        u32x4 pw0, pw1, pw2, pw3;
        pw0 = (u32x4){cvtpk(p0[0], p0[1]), cvtpk(p0[2], p0[3]), cvtpk(p0[4], p0[5]), cvtpk(p0[6], p0[7])};
        pw1 = (u32x4){cvtpk(p0[8], p0[9]), cvtpk(p0[10], p0[11]), cvtpk(p0[12], p0[13]), cvtpk(p0[14], p0[15])};
        pw2 = (u32x4){cvtpk(p1[0], p1[1]), cvtpk(p1[2], p1[3]), cvtpk(p1[4], p1[5]), cvtpk(p1[6], p1[7])};
        pw3 = (u32x4){cvtpk(p1[8], p1[9]), cvtpk(p1[10], p1[11]), cvtpk(p1[12], p1[13]), cvtpk(p1[14], p1[15])};
        SBAR();
        pv(o, vb0 + slot, __builtin_bit_cast(bf16x8, pw0), __builtin_bit_cast(bf16x8, pw1), __builtin_bit_cast(bf16x8, pw2), __builtin_bit_cast(bf16x8, pw3));
    }
    { auto rr = __builtin_amdgcn_permlane32_swap(__float_as_uint(l_reg), __float_as_uint(l_reg), false, false); l_reg = __uint_as_float(rr[0]) + __uint_as_float(rr[1]); }
    if (hi == 0) wsf[32 + r32] = l_reg; asm volatile("s_waitcnt lgkmcnt(0)" ::: "memory");
    float rli[16];
#pragma unroll
    for (int r = 0; r < 16; ++r) rli[r] = __builtin_amdgcn_rcpf(wsf[32 + crow(r, hi)]);
    { LAS bf16* stg = (LAS bf16*)(shm3 + LDS_OST) + wid * 2048;
#pragma unroll
      for (int r = 0; r < 16; ++r) { const int orow = crow(r, hi);
#pragma unroll
          for (int d0 = 0; d0 < 2; ++d0) stg[orow * 64 + d0 * 32 + r32] = (bf16)(cvtpk(o[d0][r] * rli[r], 0.f) & 0xffffu); }
      asm volatile("s_waitcnt lgkmcnt(0)" ::: "memory");
#pragma unroll
      for (int i = 0; i < 4; ++i) { const int row = i * 8 + (lane >> 3), ch = lane & 7; const u32x4 v = *(const LAS u32x4*)(stg + row * 64 + ch * 8); *(u32x4*)(Ow + (size_t)row * opitch + ch * 8) = v; } }
    asm volatile("s_waitcnt vmcnt(0) lgkmcnt(0)\n\ts_barrier" ::: "memory");
#undef ATT_DMA
}
#undef SBAR
#undef WAIT_BAR0
}

struct SsmArgs { const float *lam_re, *lam_im, *log_step, *b_re, *b_im, *c_re, *c_im;
                 const float* U; float* YF; float* YB; float* F; const float* h0; float* out_ssm; int layer; };
constexpr int SSM_PITCH = 132, SSM_WAVE_BYTES = 32 * SSM_PITCH * 4;
__device__ __forceinline__ void split8(const float* v, bf16x8& h, bf16x8& l) {
    unsigned hw[4], lw[4];
#pragma unroll
    for (int i = 0; i < 4; ++i) { const unsigned w = cvtpk(v[2 * i], v[2 * i + 1]); hw[i] = w; const float r0 = v[2 * i] - bf2f(w & 0xffffu), r1 = v[2 * i + 1] - bf2f(w >> 16); lw[i] = cvtpk(r0, r1); }
    h = __builtin_bit_cast(bf16x8, (u32x4){hw[0], hw[1], hw[2], hw[3]}); l = __builtin_bit_cast(bf16x8, (u32x4){lw[0], lw[1], lw[2], lw[3]});
}
__device__ __forceinline__ void ssm_unit(const SsmArgs& A, int mode, int b, int g, int d, int k, LAS float* buf) {
    const int lane = FRESH_LANE();
    const int hi = lane >> 5, l31 = lane & 31, fr = lane & 15, fq = lane >> 4;
    const int gd = d * 16 + g;
    const float step = expf(A.log_step[gd]);
    float ar[2], ai[2], cr[2], ci[2];
#pragma unroll
    for (int q = 0; q < 2; ++q) { const int p = l31 + 32 * q; const float lr = A.lam_re[gd * 64 + p], li = A.lam_im[gd * 64 + p];
        const float e = expf(lr * step); float s, c; sincosf(li * step, &s, &c); ar[q] = e * c; ai[q] = e * s;
        const float den = 1.0f / (lr * lr + li * li), xr = ar[q] - 1.0f; cr[q] = (xr * lr + ai[q] * li) * den; ci[q] = (ai[q] * lr - xr * li) * den; }
    float Bf[4][8];
#pragma unroll
    for (int q = 0; q < 2; ++q) { const int p = l31 + 32 * q; const float* br = A.b_re + ((size_t)gd * 64 + p) * 16; const float* bi = A.b_im + ((size_t)gd * 64 + p) * 16;
#pragma unroll
        for (int c4 = 0; c4 < 4; ++c4) { const f32x4 r = *(const f32x4*)(br + 4 * c4), im = *(const f32x4*)(bi + 4 * c4);
#pragma unroll
            for (int h2 = 0; h2 < 2; ++h2) { const float re_ = hi ? r[2 * h2 + 1] : r[2 * h2], im_ = hi ? im[2 * h2 + 1] : im[2 * h2];
                Bf[q][2 * c4 + h2] = cr[q] * re_ - ci[q] * im_; Bf[2 + q][2 * c4 + h2] = cr[q] * im_ + ci[q] * re_; } } }
    bf16x8 Cf[4];
#pragma unroll
    for (int ks = 0; ks < 4; ++ks) { const float* cp = (ks < 2 ? A.c_re : A.c_im) + ((size_t)gd * 16 + fr) * 64 + 32 * (ks & 1) + 8 * fq; const float sg = ks < 2 ? 1.0f : -1.0f;
        const f32x4 c0 = *(const f32x4*)cp * sg, c1 = *(const f32x4*)(cp + 4) * sg;
        Cf[ks] = __builtin_bit_cast(bf16x8, (u32x4){cvtpk(c0[0], c0[1]), cvtpk(c0[2], c0[3]), cvtpk(c1[0], c1[1]), cvtpk(c1[2], c1[3])}); }
    const float sar = hi ? ar[1] : ar[0], sai = hi ? ai[1] : ai[0];
    const int L = mode == 0 ? 256 : 2048; const int seqrow0 = mode == 0 ? b * 256 : 4096 + b * 2048;
    float hr = 0.f, hm = 0.f;
    if (mode == 2) {
        const size_t so = ((((size_t)(b * 2 + A.layer) * 2 + d) * 2) * 16 + g) * 64 + lane;
        hr = A.h0[so]; hm = A.h0[so + 16 * 64];
        float pr = sar, pi = sai;
#pragma unroll
        for (int i = 0; i < 8; ++i) { const float nr = pr * pr - pi * pi, ni = 2.0f * pr * pi; pr = nr; pi = ni; }
        for (int kk = 0; kk < k; ++kk) { const size_t fo = ((((size_t)(b * 16 + g) * 2 + d) * 8 + kk) * 2) * 64 + lane; const float fr_ = A.F[fo], fi_ = A.F[fo + 64];
            const float nr = pr * hr - pi * hm + fr_, ni = pr * hm + pi * hr + fi_; hr = nr; hm = ni; }
    }
    float* Y = A.YF + (size_t)d * ((size_t)M_TOK * 256);
#ifdef DBG_SSM_F32
    float dbre[16], dbim[16];
    { const float ccr = hi ? cr[1] : cr[0], cci = hi ? ci[1] : ci[0]; const float* br = A.b_re + ((size_t)gd * 64 + lane) * 16; const float* bi = A.b_im + ((size_t)gd * 64 + lane) * 16;
#pragma unroll
      for (int c = 0; c < 16; ++c) { dbre[c] = ccr * br[c] - cci * bi[c]; dbim[c] = ccr * bi[c] + cci * br[c]; } }
#endif
    for (int sc = 0; sc < 8; ++sc) {
        const int s0 = 256 * k + 32 * sc;
#ifdef DBG_SSM_F32
        for (int j = 0; j < 32; ++j) { const int s = s0 + j; const int t = d ? L - 1 - s : s; const float* up = A.U + (size_t)(seqrow0 + t) * 256 + g * 16; float a_r = 0.f, a_i = 0.f;
#pragma unroll
            for (int c = 0; c < 16; ++c) { const float uv = up[c]; a_r = fmaf(dbre[c], uv, a_r); a_i = fmaf(dbim[c], uv, a_i); }
            buf[j * SSM_PITCH + lane] = a_r; buf[j * SSM_PITCH + 64 + lane] = a_i; }
#else
        { const int s = s0 + l31; const int t = d ? L - 1 - s : s;
          const float* up = A.U + (size_t)(seqrow0 + t) * 256 + g * 16;
          float ua[8];
#pragma unroll
          for (int c4 = 0; c4 < 4; ++c4) { const f32x4 x = *(const f32x4*)(up + 4 * c4); ua[2 * c4] = hi ? x[1] : x[0]; ua[2 * c4 + 1] = hi ? x[3] : x[2]; }
#pragma unroll
          for (int n = 0; n < 4; ++n) { f32x16 D = f32x16{};
#pragma unroll
              for (int kk = 0; kk < 8; ++kk) D = __builtin_amdgcn_mfma_f32_32x32x2f32(ua[kk], Bf[n][kk], D, 0, 0, 0);
#pragma unroll
              for (int r = 0; r < 16; ++r) buf[crow(r, hi) * SSM_PITCH + 32 * n + l31] = D[r]; } }
#endif
#pragma unroll
        for (int j = 0; j < 32; ++j) { const float re = buf[j * SSM_PITCH + lane], im = buf[j * SSM_PITCH + 64 + lane];
            const float nr = fmaf(sar, hr, fmaf(-sai, hm, re)), ni = fmaf(sar, hm, fmaf(sai, hr, im)); hr = nr; hm = ni;
            if (mode != 1) { buf[j * SSM_PITCH + lane] = hr; buf[j * SSM_PITCH + 64 + lane] = hm; } }
        if (mode != 1) {
#pragma unroll
            for (int rt = 0; rt < 2; ++rt) { f32x4 acc = {0.f, 0.f, 0.f, 0.f};
#pragma unroll
                for (int ks = 0; ks < 4; ++ks) { const LAS float* hp = buf + (16 * rt + fr) * SSM_PITCH + 32 * ks + 8 * fq; const f32x4 h0 = *(const LAS f32x4*)hp, h1 = *(const LAS f32x4*)(hp + 4);
                    const bf16x8 ahh = __builtin_bit_cast(bf16x8, (u32x4){cvtpk(h0[0], h0[1]), cvtpk(h0[2], h0[3]), cvtpk(h1[0], h1[1]), cvtpk(h1[2], h1[3])});
                    acc = __builtin_amdgcn_mfma_f32_16x16x32_bf16(ahh, Cf[ks], acc, 0, 0, 0); }
#pragma unroll
                for (int r = 0; r < 4; ++r) { const int s = s0 + 16 * rt + 4 * fq + r; const int t = d ? L - 1 - s : s; Y[(size_t)(seqrow0 + t) * 256 + g * 16 + fr] = acc[r]; } }
        }
    }
    if (mode == 0) { const size_t so = ((((size_t)(b * 2 + A.layer) * 2 + d) * 2) * 16 + g) * 64 + lane; A.out_ssm[so] = hr * DBG_SSM; A.out_ssm[so + 16 * 64] = hm * DBG_SSM; }
    if (mode == 1) { const size_t fo = ((((size_t)(b * 16 + g) * 2 + d) * 8 + k) * 2) * 64 + lane; A.F[fo] = hr; A.F[fo + 64] = hm; }
}

__device__ __forceinline__ void norm_mod_rows(const float* xc, const float* xl, const float* g, const float* mod, int sh_off, int sc_off, bf16* H, int gw, int NGW, int lane) {
    for (int row = gw; row < M_TOK; row += NGW) {
        const float* xr = row < 4096 ? xc + (size_t)row * 1024 : xl + (size_t)(row - 4096) * 1024;
        const int cv = row < 4096 ? 0 : 1 + ((row - 4096) >> 11);
        f32x4 v[4]; float ss = 0.f;
#pragma unroll
        for (int j = 0; j < 4; ++j) { v[j] = *(const f32x4*)(xr + 4 * (lane + 64 * j)); ss += (v[j][0] * v[j][0] + v[j][1] * v[j][1]) + (v[j][2] * v[j][2] + v[j][3] * v[j][3]); }
        const float rstd = rsqrtf(wave_sum(ss) * (1.0f / 1024.0f) + EPS);
        const float* mp = mod + cv * 6144;
#pragma unroll
        for (int j = 0; j < 4; ++j) { const int c = 4 * (lane + 64 * j); const f32x4 gg = *(const f32x4*)(g + c), sc = *(const f32x4*)(mp + sc_off + c), sh = *(const f32x4*)(mp + sh_off + c);
            const f32x4 o = v[j] * rstd * gg * (sc + 1.0f) + sh; u32x2 w; w.x = cvtpk(o[0], o[1]); w.y = cvtpk(o[2], o[3]); *(u32x2*)(H + (size_t)row * 1024 + c) = w; }
    }
}
__device__ __forceinline__ void final_norm_rows(float* x, const float* g, int gw, int NGW, int lane) {
    for (int row = gw; row < M_TOK; row += NGW) {
        float* xr = x + (size_t)row * 1024;
        f32x4 v[4]; float ss = 0.f;
#pragma unroll
        for (int j = 0; j < 4; ++j) { v[j] = *(const f32x4*)(xr + 4 * (lane + 64 * j)); ss += (v[j][0] * v[j][0] + v[j][1] * v[j][1]) + (v[j][2] * v[j][2] + v[j][3] * v[j][3]); }
        const float rstd = rsqrtf(wave_sum(ss) * (1.0f / 1024.0f) + EPS);
#ifdef DBG_SCALE_S
        const float dsc = row >= 4096 ? DBG_SCALE_S : DBG_SCALE_P;
#else
        const float dsc = 1.0f;
#endif
#pragma unroll
        for (int j = 0; j < 4; ++j) { const int c = 4 * (lane + 64 * j); *(f32x4*)(xr + c) = v[j] * (rstd * dsc) * *(const f32x4*)(g + c); }
    }
}

__device__ __forceinline__ int maprow(int mode, int n) {
    if (mode == 1) { const int lc = n & 255; return (n & ~255) + 128 * ((lc >> 5) & 1) + 32 * (lc >> 6) + (lc & 31); }
    if (mode == 2) { if (n < DFF) return 256 * (n >> 7) + (n & 127); const int n2 = n - DFF; return 256 * (n2 >> 7) + 128 + (n2 & 127); }
    return n;
}
__device__ __forceinline__ void transpose_item(const float* W, int K, int N, bf16* WT, int mode, LAS float* scr, int item, int lane) {
    const int nblk = N / 32, kb = item / nblk, nb = item % nblk, k0 = 64 * kb, n0 = 32 * nb;
#pragma unroll 8
    for (int i = 0; i < 32; ++i) { const int kk = 2 * i + (lane >> 5); scr[kk * 33 + (lane & 31)] = W[(size_t)(k0 + kk) * N + n0 + (lane & 31)]; }
    asm volatile("s_waitcnt lgkmcnt(0)" ::: "memory");
    const int c = lane & 7;
#pragma unroll
    for (int j = 0; j < 4; ++j) { const int n = (lane >> 3) + 8 * j; const LAS float* s = scr + (8 * c) * 33 + n;
        u32x4 o; o.x = cvtpk(s[0 * 33], s[1 * 33]); o.y = cvtpk(s[2 * 33], s[3 * 33]); o.z = cvtpk(s[4 * 33], s[5 * 33]); o.w = cvtpk(s[6 * 33], s[7 * 33]);
        *(u32x4*)(WT + (size_t)maprow(mode, n0 + n) * K + k0 + 8 * c) = o; }
    asm volatile("s_waitcnt lgkmcnt(0)" ::: "memory");
}

struct Args { const float* in[33]; float* out; unsigned char* ws; int ph_lo, ph_hi; };
constexpr int N_PHASES = 22;

__global__ void __launch_bounds__(512, 2) mega_fwd(Args args) {
    extern __shared__ __attribute__((aligned(16))) unsigned char lds[];
    LAS unsigned char* L = (LAS unsigned char*)lds;
    cg::grid_group grid = cg::this_grid();
    unsigned* barw = (unsigned*)(args.ws + WS_BAR);
    volatile LAS unsigned* bst = (volatile LAS unsigned*)((LAS unsigned char*)lds + LDS_BYTES - 64);
    if (threadIdx.x == 0) { bst[0] = 0u; bst[1] = 0u; }
    if (blockIdx.x == 0) for (int i = threadIdx.x; i < XCD_BAR_WORDS; i += 512) barw[i] = 0u;
    __syncthreads();
    XcdBarrier xbar; xbar.bar = barw; xbar.x = 0; xbar.st = bst;
    const int wave0 = __builtin_amdgcn_readfirstlane(threadIdx.x >> 6);
#ifdef DBG_XSYNC
    for (int i = 0; i < DBG_XSYNC; ++i) grid.sync();
#endif
    for (int ph = args.ph_lo; ph < args.ph_hi; ++ph) {
        if (ph > args.ph_lo) { if (ph == args.ph_lo + 1) { grid.sync(); xbar = xcd_barrier_post(barw, bst); } else xcd_barrier(xbar); }
        int wave = wave0; asm volatile("" : "+s"(wave)); int G = gridDim.x; asm volatile("" : "+s"(G)); int bx = blockIdx.x; asm volatile("" : "+s"(bx));
    const int gw = bx * 8 + wave, NGW = G * 8;
    unsigned char* ws = args.ws; asm volatile("" : "+s"(ws)); float* out = args.out; asm volatile("" : "+s"(out));
    float* MOD = (float*)(ws + WS_MOD); float* ROPE = (float*)(ws + WS_ROPE);
    bf16* Hb = (bf16*)(ws + WS_H); float* YF = (float*)(ws + WS_H); float* YB = YF + (size_t)M_TOK * 256;
    bf16 *QA = (bf16*)(ws + WS_QA), *KA = (bf16*)(ws + WS_KA), *VA = (bf16*)(ws + WS_VA), *QC = (bf16*)(ws + WS_QC), *KC = (bf16*)(ws + WS_KC), *VC = (bf16*)(ws + WS_VC);
    float* Ub = (float*)(ws + WS_U); float* MF = (float*)(ws + WS_QKVU);
    bf16* GATES = (bf16*)(ws + WS_GATES); bf16* ACT = (bf16*)(ws + WS_GATES);
    bf16 *OA = (bf16*)(ws + WS_OA), *OB = (bf16*)(ws + WS_OB), *OC = (bf16*)(ws + WS_OC);
    bf16 *CKAK = (bf16*)(ws + WS_CKAK), *CKAV = (bf16*)(ws + WS_CKAV), *CKCK = (bf16*)(ws + WS_CKCK), *CKCV = (bf16*)(ws + WS_CKCV);
    float* SSMF = (float*)(ws + WS_SSMF);

        if (ph == 0) {
            const int lane = FRESH_LANE(), tid = wave * 64 + lane;
            LAS float* S = (LAS float*)(L + 69632);
            LAS float* red = (LAS float*)(L + 90112);
            if (bx < 192) {
                for (int i = tid; i < 5 * 1024; i += 512) { const int cv = i >> 10, kx = i & 1023; const float c = cv == 0 ? args.in[8][kx] : args.in[2][(cv - 1) * 1024 + kx]; S[i] = c / (1.0f + __expf(-c)); }
                __syncthreads();
                for (int item = bx; item < 192; item += G) {
                    const int l = item / 96, col = (item % 96) * 64 + lane;
                    const float* wp = args.in[9] + (size_t)l * 1024 * 6144 + col;
                    float a0 = 0.f, a1 = 0.f, a2 = 0.f, a3 = 0.f, a4 = 0.f;
#pragma unroll 16
                    for (int kk = 0; kk < 128; ++kk) { const int kx = wave * 128 + kk; const float w = wp[(size_t)kx * 6144];
                        a0 += S[kx] * w; a1 += S[1024 + kx] * w; a2 += S[2048 + kx] * w; a3 += S[3072 + kx] * w; a4 += S[4096 + kx] * w; }
                    red[(wave * 5 + 0) * 64 + lane] = a0; red[(wave * 5 + 1) * 64 + lane] = a1; red[(wave * 5 + 2) * 64 + lane] = a2; red[(wave * 5 + 3) * 64 + lane] = a3; red[(wave * 5 + 4) * 64 + lane] = a4;
                    __syncthreads();
                    if (wave < 5) { float s = args.in[10][l * 6144 + col];
#pragma unroll
                        for (int w8 = 0; w8 < 8; ++w8) s += red[(w8 * 5 + wave) * 64 + lane];
                        MOD[(l * 5 + wave) * 6144 + col] = s; }
                    __syncthreads();
                }
            }
            if (bx == G - 2 && tid < 256) { const int ll = tid >> 7, qk = (tid >> 6) & 1, e = tid & 63; ((float*)(ws + WS_QKG))[tid] = (qk ? args.in[14] : args.in[13])[ll * 64 + e]; }
            { const int gtid = bx * 512 + tid, NTH = G * 512;
#define CPY(idx, off, n) for (int i = gtid; i < (n) / 4; i += NTH) ((f32x4*)(ws + WS_PAR) + (off) / 4)[i] = ((const f32x4*)args.in[idx])[i];
              CPY(11, P_N1G, 2048) CPY(29, P_N2G, 2048) CPY(32, P_FING, 1024) CPY(7, P_SSM0, 32768) CPY(15, P_LAMR, 4096) CPY(16, P_LAMI, 4096) CPY(17, P_LSTEP, 64)
              CPY(18, P_BRE, 65536) CPY(19, P_BIM, 65536) CPY(20, P_CRE, 65536) CPY(21, P_CIM, 65536) CPY(22, P_SSMD, 512) CPY(24, P_NAB, 3720)
#undef CPY
            }
            if (bx == G - 1) { for (int i = tid; i < 1024; i += 512) { const int pos = i >> 4, f = i & 15; const float inv = 1.0f / powf(10000.0f, (float)f / 16.0f); const float ang = (float)pos * inv; ROPE[2 * i] = cosf(ang); ROPE[2 * i + 1] = sinf(ang); } }
            for (int it = bx * 512 + tid; it < 196608; it += G * 512) {
                const float* src; bf16* dst; int e;
                if (it < 65536) { const bool isv = it >= 32768; e = (it & 32767) * 8; const int d = e & 63, t = (e >> 6) & 255, h = (e >> 14) & 1, b = (e >> 15) & 3, l = e >> 17;
                    src = (isv ? args.in[4] : args.in[3]) + ((((size_t)(b * 2 + l) * 256 + t) * 2 + h) * 64 + d); dst = (isv ? CKAV : CKAK) + e; }
                else { const int i2 = it - 65536; const bool isv = i2 >= 65536; e = (i2 & 65535) * 8; const int d = e & 63, t = (e >> 6) & 255, h = (e >> 14) & 3, b = (e >> 16) & 3, l = e >> 18;
                    src = (isv ? args.in[6] : args.in[5]) + ((((size_t)(b * 2 + l) * 256 + t) * 4 + h) * 64 + d); dst = (isv ? CKCV : CKCK) + e; }
                const f32x4 a = *(const f32x4*)src, c = *(const f32x4*)(src + 4);
                *(u32x4*)dst = (u32x4){cvtpk(a[0], a[1]), cvtpk(a[2], a[3]), cvtpk(c[0], c[1]), cvtpk(c[2], c[3])};
            }
            LAS float* scr = (LAS float*)(L + wave * 8448);
            for (int it = gw; it < 15424; it += NGW) {
                const int l = it / 7712; int r = it % 7712;
                if (r < 2432) { transpose_item(args.in[12] + (size_t)l * DM * NIN, DM, NIN, (bf16*)(ws + W_IN) + (size_t)l * NIN * DM, 1, scr, r, lane); continue; } r -= 2432;
                if (r < 256) { transpose_item(args.in[25] + (size_t)l * 512 * DM, 512, DM, (bf16*)(ws + W_BRA) + (size_t)l * DM * 512, 0, scr, r, lane); continue; } r -= 256;
                if (r < 128) { transpose_item(args.in[26] + (size_t)l * 256 * DM, 256, DM, (bf16*)(ws + W_BRB) + (size_t)l * DM * 256, 0, scr, r, lane); continue; } r -= 128;
                if (r < 128) { transpose_item(args.in[27] + (size_t)l * 256 * DM, 256, DM, (bf16*)(ws + W_BRC) + (size_t)l * DM * 256, 0, scr, r, lane); continue; } r -= 128;
                if (r < 512) { transpose_item(args.in[28] + (size_t)l * DM * DM, DM, DM, (bf16*)(ws + W_OUT) + (size_t)l * DM * DM, 0, scr, r, lane); continue; } r -= 512;
                if (r < 2816) { transpose_item(args.in[30] + (size_t)l * DM * NGU, DM, NGU, (bf16*)(ws + W_GU) + (size_t)l * NGU * DM, 2, scr, r, lane); continue; } r -= 2816;
                if (r < 1408) { transpose_item(args.in[31] + (size_t)l * DFF * DM, DFF, DM, (bf16*)(ws + W_FD) + (size_t)l * DM * DFF, 0, scr, r, lane); continue; } r -= 1408;
                transpose_item(args.in[23] + (size_t)l * 256 * 256, 256, 256, (bf16*)(ws + W_GLU) + (size_t)l * 256 * 256, 0, scr, r, lane);
            }
            __syncthreads();
            continue;
        }
        const float* const PAR = (const float*)(ws + WS_PAR);
        if (ph == N_PHASES - 1) { const int lane = FRESH_LANE(); final_norm_rows(out, PAR + P_FING, gw, NGW, lane); continue; }
        const int l = (ph - 1) / 10, sp = (ph - 1) % 10;
        const float* modl = MOD + (size_t)l * 5 * 6144;
        const float* xc_in = args.in[0]; const float* xl_in = args.in[1];
        const float* xc_cur = out; const float* xl_cur = out + (size_t)4096 * 1024;
        pg8::StaticOrder S;
#ifdef DBG_DUP
        for (int rep = 0; rep < ((sp == DBG_DUP) ? 2 : 1); ++rep) {
        if (rep) xcd_barrier(xbar);
#endif
        switch (sp) {
        case 0: {
            const bool first = (l == 0); const int lane = FRESH_LANE();
            norm_mod_rows(first ? xc_in : xc_cur, first ? xl_in : xl_cur, PAR + P_N1G + l * 1024, modl, 0, 1024, Hb, gw, NGW, lane);
        } break;
        case 1: {
            pg8::Gemm g{Hb, (const bf16*)(ws + W_IN) + (size_t)l * NIN * DM, M_TOK, NIN, DM}; S.init(M_TOK, NIN, G, bx);
            EpiIn E{ws, out, l};

#ifndef CUT_IN
            pg8::gemm_phase<EpiIn, pg8::StaticOrder, true, true>(L, g, S, E, wave);
#endif

        } break;
        case 2: {
            SsmArgs SA{PAR + P_LAMR + l * 2048, PAR + P_LAMI + l * 2048, PAR + P_LSTEP + l * 32, PAR + P_BRE + (size_t)l * 32768, PAR + P_BIM + (size_t)l * 32768, PAR + P_CRE + (size_t)l * 32768, PAR + P_CIM + (size_t)l * 32768,
                       Ub, YF, YB, SSMF, PAR + P_SSM0, out + O_SSM, l};
            for (int item = bx; item < 768; item += G) {
                if (item < 256) {
                    const int b = item >> 6, h = (item >> 3) & 7, qb = item & 7, kvh = h >> 2;
                    const bf16* Qw = QA + ((size_t)4096 * 8 + (size_t)(b * 8 + h) * 2048 + qb * 256 + wave * 32) * 64;
                    const size_t co = ((size_t)((l * 4 + b) * 2 + kvh) * 256) * 64, lo = ((size_t)4096 * 2 + (size_t)(b * 2 + kvh) * 2048) * 64;
                    bf16* Ow = OA + ((size_t)4096 + b * 2048 + qb * 256 + wave * 32) * 512 + h * 64;

#ifndef CUT_ATT
                    att::attn_unit<false>(Qw, CKAK + co, CKAV + co, KA + lo, VA + lo, 36, Ow, 512, (char*)lds, 0, 0, nullptr, wave);
#endif

                } else if (item < 384) {
                    const int i = item - 256, b = i >> 5, h = (i >> 3) & 3, qb = i & 7, r0 = 4 * qb;
                    const int rlo = clampi(r0 - 4, 0, 24), rhi = clampi(r0 - 1, 0, 24) + 7, NT = 4 + rhi - rlo + 1;
                    const bf16* Qw = QC + ((size_t)4096 * 4 + (size_t)(b * 4 + h) * 2048 + qb * 256 + wave * 32) * 64;
                    const size_t co = ((size_t)((l * 4 + b) * 4 + h) * 256) * 64, lo = ((size_t)4096 * 4 + (size_t)(b * 4 + h) * 2048 + rlo * 64) * 64;
                    bf16* Ow = OC + ((size_t)4096 + b * 2048 + qb * 256 + wave * 32) * 256 + h * 64;

#ifndef CUT_NA
                    att::attn_unit<true>(Qw, CKCK + co, CKCV + co, KC + lo, VC + lo, NT, Ow, 256, (char*)lds, r0 + (wave >> 1), rlo, PAR + P_NAB + (size_t)(l * 4 + h) * 465, wave);
#endif

                } else if (item < 512) {
                    const int i = item - 384, b = i >> 3, h = i & 7, kvh = h >> 2;
                    const bf16* Qw = QA + ((size_t)(b * 8 + h) * 256 + wave * 32) * 64;
                    const size_t co = ((size_t)(b * 2 + kvh) * 256) * 64;
                    bf16* Ow = OA + ((size_t)b * 256 + wave * 32) * 512 + h * 64;

#ifndef CUT_ATT
 att::attn_unit<false>(Qw, KA + co, VA + co, KA, VA, 4, Ow, 512, (char*)lds, 0, 0, nullptr, wave);
#endif

                } else if (item < 576) {
                    const int i = item - 512, b = i >> 2, h = i & 3;
                    const bf16* Qw = QC + ((size_t)(b * 4 + h) * 256 + wave * 32) * 64;
                    const size_t co = ((size_t)(b * 4 + h) * 256) * 64;
                    bf16* Ow = OC + ((size_t)b * 256 + wave * 32) * 256 + h * 64;

#ifndef CUT_ATT
 att::attn_unit<false>(Qw, KC + co, VC + co, KC, VC, 4, Ow, 256, (char*)lds, 0, 0, nullptr, wave);
#endif

                } else {
                    const int wu = (item - 576) * 8 + wave;
                    LAS float* buf = (LAS float*)(L + wave * SSM_WAVE_BYTES);

#ifndef CUT_SSM
                    if (wu < 512) ssm_unit(SA, 0, wu >> 5, (wu >> 1) & 15, wu & 1, 0, buf);
                    else { const int w2 = wu - 512; ssm_unit(SA, 1, w2 >> 8, (w2 >> 4) & 15, (w2 >> 3) & 1, w2 & 7, buf); }
#endif
                    asm volatile("s_waitcnt vmcnt(0) lgkmcnt(0)" ::: "memory");
                    __syncthreads();
                }
            }
        } break;
        case 3: {
            SsmArgs SA{PAR + P_LAMR + l * 2048, PAR + P_LAMI + l * 2048, PAR + P_LSTEP + l * 32, PAR + P_BRE + (size_t)l * 32768, PAR + P_BIM + (size_t)l * 32768, PAR + P_CRE + (size_t)l * 32768, PAR + P_CIM + (size_t)l * 32768,
                       Ub, YF, YB, SSMF, PAR + P_SSM0, out + O_SSM, l};
            LAS float* buf = (LAS float*)(L + wave * SSM_WAVE_BYTES);

#ifndef CUT_SSM
            for (int wu = wave * G + bx; wu < 1024; wu += 8 * G) ssm_unit(SA, 2, wu >> 8, (wu >> 4) & 15, (wu >> 3) & 1, wu & 7, buf);
#endif
            asm volatile("s_waitcnt vmcnt(0) lgkmcnt(0)" ::: "memory");
            __syncthreads();
        } break;
        case 4: {
            pg8::StaticOrder SG; SG.init(M_TOK, 256, G, bx); Unit ug;
            if (SG.next(0, ug)) {
                const int tid = wave * 64 + FRESH_LANE();
                const float* dv = PAR + P_SSMD + l * 256;
                for (int i = 0; i < 32; ++i) { const int idx = tid + 512 * i, r = idx >> 6, c = (idx & 63) * 4; const size_t o = (size_t)(ug.pm * 256 + r) * 256 + c;
                    const f32x4 y = *(const f32x4*)(YF + o) + *(const f32x4*)(YB + o) + *(const f32x4*)(dv + c) * *(const f32x4*)(Ub + o); f32x4 q;
#pragma unroll
                    for (int j = 0; j < 4; ++j) { const float v = y[j]; q[j] = 0.5f * v * (1.0f + tanhf(0.7978845608028654f * (v + 0.044715f * v * v * v))); }
                    u32x2 w; w.x = cvtpk(q[0], q[1]); w.y = cvtpk(q[2], q[3]); *(u32x2*)(OB + o) = w; }
                __threadfence(); __syncthreads();
                pg8::Gemm g{OB, (const bf16*)(ws + W_GLU) + (size_t)l * 256 * 256, M_TOK, 256, 256};
                EpiGlu E{OB};
                pg8::gemm_phase<EpiGlu, pg8::StaticOrder, true, true>(L, g, SG, E, wave);
            }
        } break;
        case 5: {
            S.init(M_TOK, DM, G, bx);
            { pg8::Gemm g{OA, (const bf16*)(ws + W_BRA) + (size_t)l * DM * 512, M_TOK, DM, 512}; EpiBr<0> E{GATES, MF, nullptr}; pg8::gemm_phase<EpiBr<0>, pg8::StaticOrder, true, true>(L, g, S, E, wave); }
            { pg8::Gemm g{OC, (const bf16*)(ws + W_BRC) + (size_t)l * DM * 256, M_TOK, DM, 256}; EpiBr<1> E{GATES + 2048, MF, nullptr}; pg8::gemm_phase<EpiBr<1>, pg8::StaticOrder, true, true>(L, g, S, E, wave); }
            { pg8::Gemm g{OB, (const bf16*)(ws + W_BRB) + (size_t)l * DM * 256, M_TOK, DM, 256}; EpiBr<2> E{GATES + 1024, MF, Hb}; pg8::gemm_phase<EpiBr<2>, pg8::StaticOrder, true, true>(L, g, S, E, wave); }
        } break;
        case 6: {
            S.init(M_TOK, DM, G, bx);
            pg8::Gemm g{Hb, (const bf16*)(ws + W_OUT) + (size_t)l * DM * DM, M_TOK, DM, DM};
            EpiRes E{l == 0 ? xc_in : xc_cur, l == 0 ? xl_in : xl_cur, out, modl + 2048};
            pg8::gemm_phase<EpiRes, pg8::StaticOrder, true, true>(L, g, S, E, wave);
        } break;
        case 7: {
            const int lane = FRESH_LANE();
            norm_mod_rows(xc_cur, xl_cur, PAR + P_N2G + l * 1024, modl, 3072, 4096, Hb, gw, NGW, lane);
        } break;
        case 8: {
            pg8::Gemm g{Hb, (const bf16*)(ws + W_GU) + (size_t)l * NGU * DM, M_TOK, NGU, DM}; S.init(M_TOK, NGU, G, bx);
            EpiSwiglu E{ACT};
            pg8::gemm_phase<EpiSwiglu, pg8::StaticOrder, true, true>(L, g, S, E, wave);
        } break;
        case 9: {
            S.init(M_TOK, DM, G, bx);
            pg8::Gemm g{ACT, (const bf16*)(ws + W_FD) + (size_t)l * DM * DFF, M_TOK, DM, DFF};
            EpiRes E{xc_cur, xl_cur, out, modl + 5120};
            pg8::gemm_phase<EpiRes, pg8::StaticOrder, true, true>(L, g, S, E, wave);
        } break;
        }
#ifdef DBG_DUP
        }
#endif
    }
}

extern "C" void kernel_launch(void* const* d_in, const int* in_sizes, int n_in, void* d_out, int out_size, void* d_ws, size_t ws_size, hipStream_t stream) {
    static int grid = 0;
    if (grid == 0) {
        if (n_in != 33 || ws_size < WS_END) { fprintf(stderr, "kernel_launch: unexpected n_in %d / ws_size %zu\n", n_in, ws_size); grid = -1; return; }
        int dev = 0, cus = 0, per_cu = 0;
        hipGetDevice(&dev); hipDeviceGetAttribute(&cus, hipDeviceAttributeMultiprocessorCount, dev);
        if (hipFuncSetAttribute((const void*)mega_fwd, hipFuncAttributeMaxDynamicSharedMemorySize, LDS_BYTES) != hipSuccess) { fprintf(stderr, "kernel_launch: hipFuncSetAttribute failed\n"); grid = -1; return; }
        if (hipOccupancyMaxActiveBlocksPerMultiprocessor(&per_cu, (const void*)mega_fwd, 512, LDS_BYTES) != hipSuccess || per_cu < 1) { fprintf(stderr, "kernel_launch: occupancy query says %d\n", per_cu); per_cu = 1; }
        (void)hipGetLastError();
        grid = cus * 1;
        fprintf(stderr, "kernel_launch: cus %d per_cu %d grid %d ws %zu\n", cus, per_cu, grid, ws_size);
    }
    if (grid < 0) return;
    Args a{};
    for (int i = 0; i < 33; ++i) a.in[i] = (const float*)d_in[i];
    a.out = (float*)d_out; a.ws = (unsigned char*)d_ws;
#if MK_MULTI
    for (int ph = 0; ph < N_PHASES; ++ph) { a.ph_lo = ph; a.ph_hi = ph + 1; hipLaunchKernelGGL(mega_fwd, dim3(grid), dim3(512), LDS_BYTES, stream, a); }
#else
    a.ph_lo = 0; a.ph_hi = N_PHASES;
    void* kargs[] = {&a};
    hipError_t e = hipLaunchCooperativeKernel((const void*)mega_fwd, dim3(grid), dim3(512), kargs, LDS_BYTES, stream);
    if (e != hipSuccess) fprintf(stderr, "cooperative launch failed: %s (grid %d)\n", hipGetErrorString(e), grid);
#endif
}
```

```cpp
#include <hip/hip_runtime.h>
#include <hip/hip_cooperative_groups.h>
#include <hip/hip_bf16.h>
#include <cstdio>
#include <cstdint>
namespace cg = cooperative_groups;

#ifndef MK_MULTI
#define MK_MULTI 0
#endif

namespace pg8 {
#define PG8_LAS __attribute__((address_space(3)))
typedef unsigned short bf16_t;
typedef short bf16x8 __attribute__((ext_vector_type(8)));
typedef float f32x4 __attribute__((ext_vector_type(4)));
typedef unsigned u32x4 __attribute__((ext_vector_type(4)));
constexpr int BM = 256, BK = 64, HALF = 128, HTB = HALF * BK * 2  , STAGE_BYTES = 8 * HTB, NXCD = 8, WGM = 8;

__host__ __device__ __forceinline__ int lds_byte(int r, int c) { const int st = (r >> 4) * 2 + (c >> 5), rr = r & 15, cc = c & 31, ob = rr * 64 + cc * 2; return st * 1024 + (ob ^ (((ob >> 9) & 1) << 5)); }
__host__ __device__ __forceinline__ void stage_rc(int b, int& R, int& C) { const int st = b / 1024, sb = b % 1024, swz = sb ^ (((sb >> 9) & 1) << 5); R = (st >> 1) * 16 + swz / 64; C = (st & 1) * 32 + (swz % 64) / 2; }
__host__ __device__ __forceinline__ int perm32(int rho) { const int n = rho >> 4, i = rho & 15; return 8 * (i >> 2) + 4 * n + (i & 3); }

struct Unit { int pm, pn; };
struct Gemm { const bf16_t* A; const bf16_t* Bt; int M, N, K; };

struct StaticOrder {
    int nM, nN, nwg, G, c;
    __host__ __device__ void init(int M, int N, int G_, int c_) { nM = M / BM; nN = N / BM; nwg = nM * nN; G = G_; c = c_; }
    __host__ __device__ bool next(int i, Unit& u) const {
        const long L = (long)i * G + c; if (L >= nwg) return false;
        int wgid = (int)L; { const int q = nwg / NXCD, r = nwg % NXCD, xcd = wgid % NXCD, off = wgid / NXCD; wgid = (xcd < r ? xcd * (q + 1) : r * (q + 1) + (xcd - r) * q) + off; }
        const int nig = WGM * nN, gid = wgid / nig, fm = gid * WGM, gsz = (nM - fm) < WGM ? (nM - fm) : WGM;
        u.pm = fm + ((wgid % nig) % gsz); u.pn = (wgid % nig) / gsz; return true;
    }
    __device__ __forceinline__ void a_ready(const Unit&) const {}
    __device__ __forceinline__ void done(const Unit&) const {}
};

__device__ __forceinline__ unsigned cvt_pk_bf16(float lo, float hi) { unsigned r; asm volatile("v_cvt_pk_bf16_f32 %0, %1, %2" : "=v"(r) : "v"(lo), "v"(hi)); return r; }
typedef float f32x2 __attribute__((ext_vector_type(2)));
template <class Epi, class Sched, bool ALIGN_EPI = false, bool SP2 = false>
__device__ __forceinline__ void gemm_phase(PG8_LAS unsigned char* lds, const Gemm g, const Sched& S, const Epi& E, const int wid) {
    int lane; asm volatile("v_mbcnt_lo_u32_b32 %0, -1, 0\n\tv_mbcnt_hi_u32_b32 %0, -1, %0" : "=v"(lane)); const int tid = wid * 64 + lane, wr = wid >> 2, wc = wid & 3, fr = lane & 15, fq = lane >> 4;
    const int K = g.K, nt = K / BK;
    unsigned voffA[2], voffB[2];
#pragma unroll
    for (int i = 0; i < 2; ++i) { int R, C; stage_rc(tid * 16 + i * 8192, R, C); const int Rb = Epi::PERM ? ((R & ~31) + perm32(R & 31)) : R;
        voffA[i] = (unsigned)(R * K + C) * 2u; voffB[i] = (unsigned)(Rb * K + C) * 2u; }
    const size_t kstep = (size_t)(BK * 2);
    const size_t hstep = (size_t)HALF * K * 2;
    const size_t tstep = 2 * hstep;
    const unsigned ldsw = (unsigned)wid * 1024u;
    const int aoff = lds_byte(wr * 64 + fr, fq * 8), boff = lds_byte(wc * 32 + fr, fq * 8);
#define PG8_SA(b, h) (((b) * 2 + (h)) * HTB)
#define PG8_SB(b, h) ((4 + (b) * 2 + (h)) * HTB)
#define PG8_STAGE(bufoff, gbase, voff) do { _Pragma("unroll") for (int _i = 0; _i < 2; ++_i) \
        __builtin_amdgcn_global_load_lds((const unsigned*)((const char*)(gbase) + (voff)[_i]), (PG8_LAS unsigned*)(lds + (bufoff) + ldsw + _i * 8192), 16, 0, 0); } while (0)
#define PG8_LDA(dst, b, h) do { _Pragma("unroll") for (int m = 0; m < 4; ++m) _Pragma("unroll") for (int k = 0; k < 2; ++k) dst[m][k] = *(const PG8_LAS bf16x8*)(lds + PG8_SA(b, h) + aoff + m * 2048 + k * 1024); } while (0)
#define PG8_LDB(dst, b, h) do { _Pragma("unroll") for (int n = 0; n < 2; ++n) _Pragma("unroll") for (int k = 0; k < 2; ++k) dst[n][k] = *(const PG8_LAS bf16x8*)(lds + PG8_SB(b, h) + boff + n * 2048 + k * 1024); } while (0)
#define PG8_MMA(ai, bj, At, Bt) do { __builtin_amdgcn_s_setprio(1); _Pragma("unroll") for (int m = 0; m < 4; ++m) _Pragma("unroll") for (int n = 0; n < 2; ++n) _Pragma("unroll") for (int k = 0; k < 2; ++k) \
        acc[ai][bj][m][n] = __builtin_amdgcn_mfma_f32_16x16x32_bf16(Bt[n][k], At[m][k], acc[ai][bj][m][n], 0, 0, 0); __builtin_amdgcn_s_setprio(0); } while (0)
#define PG8_WAIT_V(n) asm volatile("s_waitcnt vmcnt(" #n ")" ::: "memory")
#define PG8_WAIT_L(n) asm volatile("s_waitcnt lgkmcnt(" #n ")" ::: "memory")
#define PG8_BAR __builtin_amdgcn_s_barrier()
#define PG8_SCHED __builtin_amdgcn_sched_barrier(0)
    Unit cur, nxt; int ui = 0;
    if (!S.next(0, cur)) return;
    f32x4 acc[2][2][4][2];
#pragma unroll
    for (int a = 0; a < 2; ++a)
#pragma unroll
        for (int b = 0; b < 2; ++b)
#pragma unroll
            for (int m = 0; m < 4; ++m)
#pragma unroll
                for (int n = 0; n < 2; ++n) acc[a][b][m][n] = (f32x4){0.f, 0.f, 0.f, 0.f};
    bf16x8 At[4][2], B0[2][2], B1[2][2];
    const char* cA = (const char*)g.A + (size_t)cur.pm * tstep; const char* cB = (const char*)g.Bt + (size_t)cur.pn * tstep;
    S.a_ready(cur);
    if constexpr (SP2) {
        PG8_STAGE(PG8_SB(0, 0), cB, voffB); PG8_STAGE(PG8_SB(0, 1), cB + hstep, voffB); PG8_STAGE(PG8_SA(0, 0), cA, voffA); PG8_STAGE(PG8_SA(0, 1), cA + hstep, voffA);
        if (wr == 1) PG8_BAR;
        PG8_WAIT_V(2); PG8_BAR;
        PG8_STAGE(PG8_SB(1, 0), cB + kstep, voffB); PG8_STAGE(PG8_SA(1, 0), cA + kstep, voffA); PG8_STAGE(PG8_SB(1, 1), cB + hstep + kstep, voffB);
        PG8_WAIT_V(6); PG8_BAR;
    } else {
        PG8_STAGE(PG8_SB(0, 0), cB, voffB); PG8_STAGE(PG8_SA(0, 0), cA, voffA); PG8_STAGE(PG8_SB(0, 1), cB + hstep, voffB); PG8_STAGE(PG8_SA(0, 1), cA + hstep, voffA);
        if (wr == 1) PG8_BAR;
        PG8_WAIT_V(4); PG8_BAR;
        PG8_STAGE(PG8_SB(1, 0), cB + kstep, voffB); PG8_STAGE(PG8_SA(1, 0), cA + kstep, voffA); PG8_STAGE(PG8_SB(1, 1), cB + hstep + kstep, voffB);
        PG8_WAIT_V(6); PG8_BAR;
    }
    for (;;) {
        const bool has_next = S.next(ui + 1, nxt);
        const char* nA = has_next ? (const char*)g.A + (size_t)nxt.pm * tstep : cA; const char* nB = has_next ? (const char*)g.Bt + (size_t)nxt.pn * tstep : cB;
        for (int t = 0; t < nt; t += 2) {
            const bool last = (t == nt - 2);
            const char* a1 = cA + (size_t)(t + 1) * kstep;
            const char* a2 = last ? nA : cA + (size_t)(t + 2) * kstep; const char* b2 = last ? nB : cB + (size_t)(t + 2) * kstep;
            const char* a3 = a2 + kstep; const char* b3 = b2 + kstep;
            if (last && has_next) S.a_ready(nxt);
            if constexpr (SP2) {
            PG8_LDB(B0, 0, 0); PG8_LDB(B1, 0, 1); PG8_SCHED; PG8_LDA(At, 0, 0); PG8_STAGE(PG8_SA(1, 1), a1 + hstep, voffA);
            PG8_WAIT_V(8); PG8_WAIT_L(0); PG8_BAR; PG8_MMA(0, 0, At, B0); PG8_MMA(0, 1, At, B1); PG8_BAR; PG8_SCHED;
            PG8_LDA(At, 0, 1); PG8_STAGE(PG8_SB(0, 0), b2, voffB); PG8_STAGE(PG8_SB(0, 1), b2 + hstep, voffB); PG8_STAGE(PG8_SA(0, 0), a2, voffA);
            PG8_WAIT_V(8); PG8_WAIT_L(0); PG8_BAR; PG8_MMA(1, 0, At, B0); PG8_MMA(1, 1, At, B1); PG8_BAR; PG8_SCHED;
            PG8_LDB(B0, 1, 0); PG8_LDB(B1, 1, 1); PG8_SCHED; PG8_LDA(At, 1, 0); PG8_STAGE(PG8_SA(0, 1), a2 + hstep, voffA);
            PG8_WAIT_V(8); PG8_WAIT_L(0); PG8_BAR; PG8_MMA(0, 0, At, B0); PG8_MMA(0, 1, At, B1); PG8_BAR; PG8_SCHED;
            PG8_LDA(At, 1, 1); PG8_STAGE(PG8_SB(1, 0), b3, voffB); PG8_STAGE(PG8_SB(1, 1), b3 + hstep, voffB); PG8_STAGE(PG8_SA(1, 0), a3, voffA);
            PG8_WAIT_V(8); PG8_WAIT_L(0); PG8_BAR; PG8_MMA(1, 0, At, B0); PG8_MMA(1, 1, At, B1); PG8_BAR; PG8_SCHED;
            } else {
            PG8_LDB(B0, 0, 0); PG8_SCHED; PG8_LDA(At, 0, 0); PG8_STAGE(PG8_SA(1, 1), a1 + hstep, voffA);
            PG8_WAIT_L(8); PG8_BAR; PG8_WAIT_L(0); PG8_MMA(0, 0, At, B0); PG8_BAR; PG8_SCHED;
            PG8_LDB(B1, 0, 1); PG8_STAGE(PG8_SB(0, 0), b2, voffB);
            PG8_BAR; PG8_WAIT_L(0); PG8_MMA(0, 1, At, B1); PG8_BAR;
            PG8_LDA(At, 0, 1); PG8_STAGE(PG8_SA(0, 0), a2, voffA);
            PG8_BAR; PG8_WAIT_L(0); PG8_MMA(1, 0, At, B0); PG8_BAR; PG8_SCHED;
            PG8_STAGE(PG8_SB(0, 1), b2 + hstep, voffB);
            PG8_WAIT_V(6); PG8_BAR; PG8_MMA(1, 1, At, B1); PG8_BAR;
            PG8_LDB(B0, 1, 0); PG8_SCHED; PG8_LDA(At, 1, 0); PG8_STAGE(PG8_SA(0, 1), a2 + hstep, voffA);
            PG8_WAIT_L(8); PG8_BAR; PG8_WAIT_L(0); PG8_MMA(0, 0, At, B0); PG8_BAR; PG8_SCHED;
            PG8_LDB(B1, 1, 1); PG8_STAGE(PG8_SB(1, 0), b3, voffB);
            PG8_BAR; PG8_WAIT_L(0); PG8_MMA(0, 1, At, B1); PG8_BAR;
            PG8_LDA(At, 1, 1); PG8_STAGE(PG8_SA(1, 0), a3, voffA);
            PG8_BAR; PG8_WAIT_L(0); PG8_MMA(1, 0, At, B0); PG8_BAR; PG8_SCHED;
            PG8_STAGE(PG8_SB(1, 1), b3 + hstep, voffB);
            PG8_WAIT_V(6); PG8_BAR; PG8_MMA(1, 1, At, B1); PG8_BAR;
            }
        }
        if constexpr (ALIGN_EPI) { if (wr == 0) PG8_BAR; }
        if constexpr (!Epi::AFTER_DRAIN) { E(acc, cur, wr, wc, fr, fq); S.done(cur); }
        if (!has_next) break;
#pragma unroll
        for (int a = 0; a < 2; ++a)
#pragma unroll
            for (int b = 0; b < 2; ++b)
#pragma unroll
                for (int m = 0; m < 4; ++m)
#pragma unroll
                    for (int n = 0; n < 2; ++n) acc[a][b][m][n] = (f32x4){0.f, 0.f, 0.f, 0.f};
        cur = nxt; cA = nA; cB = nB; ++ui;
        if constexpr (ALIGN_EPI) { if (wr == 1) PG8_BAR; }
    }
    PG8_WAIT_V(0);
    if constexpr (!ALIGN_EPI) { if (wr == 0) PG8_BAR; }
    PG8_BAR;
    if constexpr (Epi::AFTER_DRAIN) { E.fused(acc, cur, wr, wc, fr, fq, lds, wid, lane); S.done(cur); }
#undef PG8_SA
#undef PG8_SB
#undef PG8_STAGE
#undef PG8_LDA
#undef PG8_LDB
#undef PG8_MMA
#undef PG8_WAIT_V
#undef PG8_WAIT_L
#undef PG8_BAR
#undef PG8_SCHED
}
}

#define LAS __attribute__((address_space(3)))
typedef unsigned short bf16;
typedef short bf16x8 __attribute__((ext_vector_type(8)));
typedef short s16x4 __attribute__((ext_vector_type(4)));
typedef float f32x4 __attribute__((ext_vector_type(4)));
typedef float f32x16 __attribute__((ext_vector_type(16)));
typedef unsigned u32x4 __attribute__((ext_vector_type(4)));
typedef unsigned u32x2 __attribute__((ext_vector_type(2)));
typedef float f32x2_t __attribute__((ext_vector_type(2)));
typedef __bf16 bf16x2_t __attribute__((ext_vector_type(2)));

constexpr int M_TOK = 12288, M_CTX = 4096, DM = 1024, NIN = 4864, DFF = 2816, NGU = 5632;
constexpr float EPS = 1e-6f, LOG2E = 1.4426950408889634f, C2 = 0.125f * 1.4426950408889634f;
constexpr size_t MiB = 1u << 20;
constexpr size_t WS_ROPE = 0, WS_QKG = 16384, WS_BAR = 32768, WS_FLAG = 49152, WS_MOD = 65536, WS_SSMF = 512 * 1024, WS_CKAK = 1 * MiB, WS_CKAV = 1 * MiB + 512 * 1024, WS_CKCK = 2 * MiB, WS_CKCV = 3 * MiB;
constexpr size_t WS_W = 4 * MiB;
constexpr size_t W_IN = WS_W, W_BRA = W_IN + 2ull * NIN * DM * 2, W_BRB = W_BRA + 2ull * DM * 512 * 2, W_BRC = W_BRB + 2ull * DM * 256 * 2, W_OUT = W_BRC + 2ull * DM * 256 * 2,
                 W_GU = W_OUT + 2ull * DM * DM * 2, W_FD = W_GU + 2ull * NGU * DM * 2, W_GLU = W_FD + 2ull * DM * DFF * 2, W_END = W_GLU + 2ull * 256 * 256 * 2;
constexpr size_t WS_H = 65 * MiB;
constexpr size_t WS_QKVU = 89 * MiB;
constexpr size_t WS_QA = WS_QKVU, WS_KA = WS_QA + 12 * MiB, WS_VA = WS_KA + 3 * MiB, WS_U = WS_VA + 3 * MiB, WS_QC = WS_U + 12 * MiB, WS_KC = WS_QC + 6 * MiB, WS_VC = WS_KC + 6 * MiB;
constexpr size_t WS_GATES = 137 * MiB;
constexpr size_t WS_OA = 209 * MiB, WS_OB = 221 * MiB, WS_OC = 227 * MiB, WS_PAR = 233 * MiB, WS_SSMF2 = 235 * MiB, WS_END = 236 * MiB;
constexpr int P_N1G = 0, P_N2G = 2048, P_FING = 4096, P_SSM0 = 5120, P_LAMR = 37888, P_LAMI = 41984, P_LSTEP = 46080, P_BRE = 46144, P_BIM = 111680, P_CRE = 177216, P_CIM = 242752, P_SSMD = 308288, P_NAB = 308800;
static_assert(W_END <= WS_H, "weights fit");
constexpr size_t O_YP = 0, O_YS = 4194304, O_GAK = 12582912, O_GAV = 13631488, O_NAK = 14680064, O_NAV = 16777216, O_SSM = 18874368;
constexpr int LDS_BYTES = 147456;

__device__ __forceinline__ unsigned cvtpk(float lo, float hi) { f32x2_t v = {lo, hi}; bf16x2_t b = __builtin_convertvector(v, bf16x2_t); return __builtin_bit_cast(unsigned, b); }
__device__ __forceinline__ float bf2f(unsigned b) { return __uint_as_float(b << 16); }
__device__ __forceinline__ float sigmoidf_(float v) { return 1.0f / (1.0f + __expf(-v)); }
template <int K> __device__ __forceinline__ float xor_shfl(float v) {
    return __uint_as_float((unsigned)__builtin_amdgcn_ds_swizzle((int)__float_as_uint(v), (K << 10) | 0x1F));
}
__device__ __forceinline__ float sum_xor32(float v) { auto rr = __builtin_amdgcn_permlane32_swap(__float_as_uint(v), __float_as_uint(v), false, false); return __uint_as_float(rr[0]) + __uint_as_float(rr[1]); }
__device__ __forceinline__ float wave_sum(float v) {
    v += xor_shfl<1>(v); v += xor_shfl<2>(v); v += xor_shfl<4>(v); v += xor_shfl<8>(v); v += xor_shfl<16>(v);
    return sum_xor32(v);
}
__device__ __forceinline__ int crow(int r, int hi) { return (r & 3) + 8 * (r >> 2) + 4 * hi; }
__device__ __forceinline__ int clampi(int v, int lo, int hi) { return v < lo ? lo : (v > hi ? hi : v); }
#define FRESH_LANE() ({ int l__; asm volatile("v_mbcnt_lo_u32_b32 %0, -1, 0\n\tv_mbcnt_hi_u32_b32 %0, -1, %0" : "=v"(l__)); l__; })
#ifndef DBG_SSM
#define DBG_SSM 1.0f
#endif
#ifndef DBG_GAK
#define DBG_GAK 1.0f
#endif
#ifndef DBG_GAV
#define DBG_GAV 1.0f
#endif
#define VM_WAIT0() asm volatile("s_waitcnt vmcnt(0)" ::: "memory")

#define XB_TMO      128
#define XB_XCNT(j)  (256  + 64 * (j))
#define XB_XSUB(j)  (1280 + 64 * (j))
#define XB_XGEN(j)  (2304 + 64 * (j))
#define XB_TOP      3328
#define XB_TOPGEN   3392
#define XCD_BAR_WORDS 3456
#define XB_SPIN_CAP (1u << 18)

__device__ __forceinline__ unsigned xb_ld(unsigned* p)              { return __hip_atomic_load(p, __ATOMIC_RELAXED, __HIP_MEMORY_SCOPE_AGENT); }
__device__ __forceinline__ unsigned xb_add(unsigned* p, unsigned v) { return __hip_atomic_fetch_add(p, v, __ATOMIC_RELAXED, __HIP_MEMORY_SCOPE_AGENT); }
__device__ __forceinline__ unsigned xb_xcc_id() { return (unsigned)__builtin_amdgcn_s_getreg((3 << 11) | 20) & 0xFu; }
#define XB_SPIN(cond, bar) do { unsigned _sp = 0; while (cond) { __builtin_amdgcn_s_sleep(1); \
    if ((++_sp & 255u) == 0u) { if (xb_ld(&(bar)[XB_TMO])) break; if (_sp > XB_SPIN_CAP) { atomicAdd(&(bar)[XB_TMO], 1u); break; } } } } while (0)

struct XcdBarrier {
    unsigned* bar; unsigned x;
    volatile LAS unsigned* st;
};

__device__ __forceinline__ XcdBarrier xcd_barrier_post(unsigned* bar, volatile LAS unsigned* st) {
    XcdBarrier b; b.bar = bar; b.x = xb_xcc_id(); b.st = st;
    if (threadIdx.x == 0) (void)xb_add(&bar[XB_XCNT(b.x)], 1u);
    return b;
}
__device__ __forceinline__ void xcd_barrier_complete(unsigned* bar, unsigned x, unsigned& nloc, unsigned& nx) {
    const unsigned G = gridDim.x * gridDim.y * gridDim.z;
    unsigned sum, cnt, mine, sp = 0u;
    for (;;) {
        sum = 0u; cnt = 0u; mine = 0u;
#pragma unroll
        for (unsigned j = 0; j < 16; ++j) { const unsigned c = xb_ld(&bar[XB_XCNT(j)]); sum += c; cnt += (c > 0u) ? 1u : 0u; mine = (j == x) ? c : mine; }
        if (sum == G) break;
        __builtin_amdgcn_s_sleep(1);
        if ((++sp & 255u) == 0u) { if (xb_ld(&bar[XB_TMO])) break; if (sp > XB_SPIN_CAP) { atomicAdd(&bar[XB_TMO], 1u); break; } }
    }
    nloc = mine > 0u ? mine : 1u; nx = cnt > 0u ? cnt : 1u;
}

__device__ __forceinline__ void xcd_barrier(const XcdBarrier& b) {
    asm volatile("s_waitcnt vmcnt(0)" ::: "memory");
    __syncthreads();
    if (threadIdx.x == 0) {
        unsigned* bar = b.bar;
        __builtin_amdgcn_s_waitcnt(0);
        unsigned nloc = b.st[0], nx = b.st[1];
        if (nloc == 0u) { xcd_barrier_complete(bar, b.x, nloc, nx); b.st[0] = nloc; b.st[1] = nx; }
        const unsigned old = xb_add(&bar[XB_XSUB(b.x)], 1u);
        const unsigned gen = old / nloc;
        if (old + 1u == (gen + 1u) * nloc) {
            __builtin_amdgcn_fence(__ATOMIC_RELEASE, "agent");
            asm volatile("s_waitcnt vmcnt(0)" ::: "memory");
            const unsigned og = xb_add(&bar[XB_TOP], 1u);
            const unsigned tg = og / nx;
            if (og + 1u == (tg + 1u) * nx) xb_add(&bar[XB_TOPGEN], 1u);
            else XB_SPIN(xb_ld(&bar[XB_TOPGEN]) == tg, bar);
            __builtin_amdgcn_fence(__ATOMIC_ACQUIRE, "agent");
            xb_add(&bar[XB_XGEN(b.x)], 1u);
            asm volatile("s_waitcnt vmcnt(0)" ::: "memory");
        } else {
            XB_SPIN(xb_ld(&bar[XB_XGEN(b.x)]) == gen, bar);
            __builtin_amdgcn_fence(__ATOMIC_ACQUIRE, "agent");
            asm volatile("s_waitcnt vmcnt(0)" ::: "memory");
        }
    }
    __syncthreads();
}
using pg8::Unit;
struct EpiIn {
    static constexpr bool PERM = false, AFTER_DRAIN = false;
    unsigned char* ws; float* out; int layer;
    __device__ __forceinline__ void operator()(const f32x4 (&acc)[2][2][4][2], const Unit& u, int wr, int wc, int fr_, int fq_) const {
        const int ln_ = FRESH_LANE(), fr = ln_ & 15, fq = ln_ >> 4;
        const int pn = u.pn; const bool ctx = u.pm < 16;
        const int rb = u.pm * 256 + wr * 64 + fr;
        if (pn >= 7) {
#pragma unroll
            for (int ai = 0; ai < 2; ++ai)
#pragma unroll
                for (int m = 0; m < 4; ++m) {
                    const int row = rb + ai * 128 + m * 16;
                    bf16* gp = (bf16*)(ws + WS_GATES) + (size_t)row * 3072 + (pn - 7) * 256 + 64 * wc + 4 * fq;
#pragma unroll
                    for (int bj = 0; bj < 2; ++bj)
#pragma unroll
                        for (int n = 0; n < 2; ++n) { const f32x4 v = acc[ai][bj][m][n]; u32x2 w; w.x = cvtpk(sigmoidf_(v[0]), sigmoidf_(v[1])); w.y = cvtpk(sigmoidf_(v[2]), sigmoidf_(v[3])); *(u32x2*)(gp + 32 * bj + 16 * n) = w; }
                }
        } else if (pn == 3) {
#pragma unroll
            for (int ai = 0; ai < 2; ++ai)
#pragma unroll
                for (int m = 0; m < 4; ++m) {
                    const int row = rb + ai * 128 + m * 16;
                    float* up = (float*)(ws + WS_U) + (size_t)row * 256 + 64 * wc + 4 * fq;
#pragma unroll
                    for (int bj = 0; bj < 2; ++bj)
#pragma unroll
                        for (int n = 0; n < 2; ++n) *(f32x4*)(up + 32 * bj + 16 * n) = acc[ai][bj][m][n];
                }
        } else if (pn >= 4) {
            bf16* base = (bf16*)(ws + (pn == 4 ? WS_QC : (pn == 5 ? WS_KC : WS_VC)));
            const float sc = pn == 4 ? C2 : 1.0f;
            float* ob = out + (pn == 5 ? O_NAK : O_NAV);
#pragma unroll
            for (int ai = 0; ai < 2; ++ai)
#pragma unroll
                for (int m = 0; m < 4; ++m) {
                    const int row = rb + ai * 128 + m * 16;
                    int b, t; size_t hrow;
                    if (ctx) { b = row >> 8; t = row & 255; hrow = (size_t)(b * 4 + wc) * 256 + t; } else { const int r2 = row - 4096; b = r2 >> 11; t = r2 & 2047; hrow = (size_t)4096 * 4 + (size_t)(b * 4 + wc) * 2048 + t; }
                    bf16* dp = base + hrow * 64 + 4 * fq;
#pragma unroll
                    for (int bj = 0; bj < 2; ++bj)
#pragma unroll
                        for (int n = 0; n < 2; ++n) { const f32x4 v = acc[ai][bj][m][n] * sc; u32x2 w; w.x = cvtpk(v[0], v[1]); w.y = cvtpk(v[2], v[3]); *(u32x2*)(dp + 32 * bj + 16 * n) = w; }
                    if (ctx && pn >= 5) { float* op = ob + ((size_t)(b * 2 + layer) * 256 + t) * 256 + wc * 64 + 4 * fq;
#pragma unroll
                        for (int bj = 0; bj < 2; ++bj)
#pragma unroll
                            for (int n = 0; n < 2; ++n) *(f32x4*)(op + 32 * bj + 16 * n) = acc[ai][bj][m][n]; }
                }
        } else {
            const bool isQ = pn < 2, isV = (pn == 2 && wc >= 2);
            const int h = isQ ? 4 * pn + wc : (wc & 1);
            const float* gsrc = (const float*)(ws + WS_QKG) + (layer * 2 + (isQ ? 0 : 1)) * 64 + 4 * fq;
            f32x4 gg[2][2];
#pragma unroll
            for (int bj = 0; bj < 2; ++bj)
#pragma unroll
                for (int n = 0; n < 2; ++n) gg[bj][n] = *(const f32x4*)(gsrc + 32 * bj + 16 * n);
            bf16* base = (bf16*)(ws + (isQ ? WS_QA : (isV ? WS_VA : WS_KA)));
            const int nh = isQ ? 8 : 2;
            float* ob = out + (isV ? O_GAV : O_GAK);
#pragma unroll
            for (int ai = 0; ai < 2; ++ai)
#pragma unroll
                for (int m = 0; m < 4; ++m) {
                    const int row = rb + ai * 128 + m * 16;
                    f32x4 v[2][2];
#pragma unroll
                    for (int bj = 0; bj < 2; ++bj)
#pragma unroll
                        for (int n = 0; n < 2; ++n) v[bj][n] = acc[ai][bj][m][n];
                    if (!isV) {
                        float ss = 0.f;
#pragma unroll
                        for (int bj = 0; bj < 2; ++bj)
#pragma unroll
                            for (int n = 0; n < 2; ++n) ss += (v[bj][n][0] * v[bj][n][0] + v[bj][n][1] * v[bj][n][1]) + (v[bj][n][2] * v[bj][n][2] + v[bj][n][3] * v[bj][n][3]);
                        ss += xor_shfl<16>(ss); ss = sum_xor32(ss);
                        const float rstd = rsqrtf(ss * (1.0f / 64.0f) + EPS);
#pragma unroll
                        for (int bj = 0; bj < 2; ++bj)
#pragma unroll
                            for (int n = 0; n < 2; ++n) v[bj][n] = v[bj][n] * rstd * gg[bj][n];
                    }
                    int b, t; size_t hrow;
                    if (ctx) { b = row >> 8; t = row & 255; hrow = (size_t)(b * nh + h) * 256 + t; }
                    else {
                        const int r2 = row - 4096; b = r2 >> 11; t = r2 & 2047; hrow = (size_t)4096 * nh + (size_t)(b * nh + h) * 2048 + t;
                        if (!isV) {
#pragma unroll
                            for (int bj = 0; bj < 2; ++bj) {
                                const int pos = bj ? (t & 63) : (t >> 6);
                                const float* tp = (const float*)(ws + WS_ROPE) + (pos * 16 + 4 * fq) * 2;
                                const f32x4 c01 = *(const f32x4*)tp, c23 = *(const f32x4*)(tp + 4);
                                const f32x4 cs = {c01[0], c01[2], c23[0], c23[2]}, sn = {c01[1], c01[3], c23[1], c23[3]};
                                const f32x4 x1 = v[bj][0], x2 = v[bj][1];
                                v[bj][0] = x1 * cs - x2 * sn; v[bj][1] = x2 * cs + x1 * sn;
                            }
                        }
                    }
                    if (ctx && !isQ) { float* op = ob + ((size_t)(b * 2 + layer) * 256 + t) * 128 + h * 64 + 4 * fq;
#pragma unroll
                        for (int bj = 0; bj < 2; ++bj)
#pragma unroll
                            for (int n = 0; n < 2; ++n) *(f32x4*)(op + 32 * bj + 16 * n) = v[bj][n] * (isV ? DBG_GAV : DBG_GAK); }
                    const float sc = isQ ? C2 : 1.0f;
                    bf16* dp = base + hrow * 64 + 4 * fq;
#pragma unroll
                    for (int bj = 0; bj < 2; ++bj)
#pragma unroll
                        for (int n = 0; n < 2; ++n) { const f32x4 x = v[bj][n] * sc; u32x2 w; w.x = cvtpk(x[0], x[1]); w.y = cvtpk(x[2], x[3]); *(u32x2*)(dp + 32 * bj + 16 * n) = w; }
                }
        }
    }
};

struct EpiRes {
    static constexpr bool PERM = false, AFTER_DRAIN = false;
    const float* xc; const float* xl; float* xo; const float* mod;
    __device__ __forceinline__ void operator()(const f32x4 (&acc)[2][2][4][2], const Unit& u, int wr, int wc, int fr_, int fq_) const {
        const int ln_ = FRESH_LANE(), fr = ln_ & 15, fq = ln_ >> 4;
        const int cv = u.pm < 16 ? 0 : 1 + ((u.pm - 16) >> 3);
        const int col0 = u.pn * 256 + wc * 32 + 4 * fq;
        f32x4 gv[2][2];
#pragma unroll
        for (int bj = 0; bj < 2; ++bj)
#pragma unroll
            for (int n = 0; n < 2; ++n) gv[bj][n] = *(const f32x4*)(mod + cv * 6144 + col0 + bj * 128 + n * 16);
#pragma unroll
        for (int ai = 0; ai < 2; ++ai)
#pragma unroll
            for (int m = 0; m < 4; ++m) {
                const int row = u.pm * 256 + ai * 128 + wr * 64 + m * 16 + fr;
                const float* xs = row < 4096 ? xc + (size_t)row * 1024 : xl + (size_t)(row - 4096) * 1024;
                float* xd = xo + (size_t)row * 1024;
#pragma unroll
                for (int bj = 0; bj < 2; ++bj)
#pragma unroll
                    for (int n = 0; n < 2; ++n) { const int c = col0 + bj * 128 + n * 16; const f32x4 xv = *(const f32x4*)(xs + c); *(f32x4*)(xd + c) = xv + gv[bj][n] * acc[ai][bj][m][n]; }
                asm volatile("" ::: "memory");
            }
    }
};

struct EpiSwiglu {
    static constexpr bool PERM = false, AFTER_DRAIN = false;
    bf16* ACT;
    __device__ __forceinline__ void operator()(const f32x4 (&acc)[2][2][4][2], const Unit& u, int wr, int wc, int fr_, int fq_) const {
        const int ln_ = FRESH_LANE(), fr = ln_ & 15, fq = ln_ >> 4;
#pragma unroll
        for (int ai = 0; ai < 2; ++ai)
#pragma unroll
            for (int m = 0; m < 4; ++m) {
                const int row = u.pm * 256 + ai * 128 + wr * 64 + m * 16 + fr;
                bf16* ap = ACT + (size_t)row * DFF + u.pn * 128 + wc * 32 + 4 * fq;
#pragma unroll
                for (int n = 0; n < 2; ++n) { const f32x4 g = acc[ai][0][m][n], up = acc[ai][1][m][n]; f32x4 r;
#pragma unroll
                    for (int i = 0; i < 4; ++i) r[i] = g[i] * sigmoidf_(g[i]) * up[i];
                    u32x2 w; w.x = cvtpk(r[0], r[1]); w.y = cvtpk(r[2], r[3]); *(u32x2*)(ap + 16 * n) = w; }
                asm volatile("" ::: "memory");
            }
    }
};

struct EpiGlu {
    static constexpr bool PERM = false, AFTER_DRAIN = false;
    bf16* OB;
    __device__ __forceinline__ void operator()(const f32x4 (&acc)[2][2][4][2], const Unit& u, int wr, int wc, int fr_, int fq_) const {
        const int ln_ = FRESH_LANE(), fr = ln_ & 15, fq = ln_ >> 4;
#pragma unroll
        for (int ai = 0; ai < 2; ++ai)
#pragma unroll
            for (int m = 0; m < 4; ++m) {
                const int row = u.pm * 256 + ai * 128 + wr * 64 + m * 16 + fr;
                bf16* p = OB + (size_t)row * 256 + wc * 32 + 4 * fq;
#pragma unroll
                for (int bj = 0; bj < 2; ++bj)
#pragma unroll
                    for (int n = 0; n < 2; ++n) { bf16* q = p + bj * 128 + n * 16; const u32x2 yv = *(const u32x2*)q; const f32x4 a = acc[ai][bj][m][n];
                        const float y0 = bf2f(yv.x & 0xffffu), y1 = bf2f(yv.x >> 16), y2 = bf2f(yv.y & 0xffffu), y3 = bf2f(yv.y >> 16);
                        u32x2 w; w.x = cvtpk(y0 * sigmoidf_(a[0]), y1 * sigmoidf_(a[1])); w.y = cvtpk(y2 * sigmoidf_(a[2]), y3 * sigmoidf_(a[3])); *(u32x2*)q = w; }
                asm volatile("" ::: "memory");
            }
    }
};

template <int MODE> struct EpiBr {
    static constexpr bool PERM = false, AFTER_DRAIN = false;
    const bf16* G; bf16* MF; bf16* MG;
    __device__ __forceinline__ void operator()(const f32x4 (&acc)[2][2][4][2], const Unit& u, int wr, int wc, int fr_, int fq_) const {
        const int ln_ = FRESH_LANE(), fr = ln_ & 15, fq = ln_ >> 4;
        const int col0 = u.pn * 256 + wc * 32 + 4 * fq;
#pragma unroll
        for (int ai = 0; ai < 2; ++ai)
#pragma unroll
            for (int m = 0; m < 4; ++m) {
                const int row = u.pm * 256 + ai * 128 + wr * 64 + m * 16 + fr;
#pragma unroll
                for (int bj = 0; bj < 2; ++bj)
#pragma unroll
                    for (int n = 0; n < 2; ++n) { const int c = col0 + bj * 128 + n * 16; const u32x2 gv = *(const u32x2*)(G + (size_t)row * 3072 + c); const f32x4 a = acc[ai][bj][m][n];
                        f32x4 r = {bf2f(gv.x & 0xffffu) * a[0], bf2f(gv.x >> 16) * a[1], bf2f(gv.y & 0xffffu) * a[2], bf2f(gv.y >> 16) * a[3]};
                        bf16* mp = MF + (size_t)row * 1024 + c;
                        if (MODE >= 1) { const u32x2 mv = *(const u32x2*)mp; r[0] += bf2f(mv.x & 0xffffu); r[1] += bf2f(mv.x >> 16); r[2] += bf2f(mv.y & 0xffffu); r[3] += bf2f(mv.y >> 16); }
                        u32x2 w; w.x = cvtpk(r[0], r[1]); w.y = cvtpk(r[2], r[3]);
                        *(u32x2*)((MODE <= 1 ? mp : MG + (size_t)row * 1024 + c)) = w; }
                asm volatile("" ::: "memory");
            }
    }
};

namespace att {
constexpr int SLOTB = 8192, LDS_K = 0, LDS_V = 16384, LDS_WS = 32768, LDS_OST = 34816, LDS_BIAS = 67584;
constexpr float THR = 8.0f;
#define SBAR() __builtin_amdgcn_sched_barrier(0)
__device__ __forceinline__ void glds16(const void* gsrc, unsigned lds_dst) { unsigned keep;
    asm volatile("s_mov_b32 %0, m0\n\ts_mov_b32 m0, %2\n\ts_nop 0\n\tglobal_load_lds_dwordx4 %1, off\n\ts_mov_b32 m0, %0" : "=&s"(keep) : "v"(gsrc), "s"(lds_dst) : "memory"); }
#define WAIT_BAR0() asm volatile("s_waitcnt vmcnt(0) lgkmcnt(0)\n\ts_barrier" ::: "memory")
typedef LAS const char* lds_cptr;
__device__ __forceinline__ void qkt(f32x16& p0, f32x16& p1, lds_cptr kb, const bf16x8* qr, const f32x16& negm) {
#pragma unroll
    for (int d0 = 0; d0 < 4; ++d0) {
        const bf16x8 b0 = *(const LAS bf16x8*)(kb + d0 * 2048);
        const bf16x8 b1 = *(const LAS bf16x8*)(kb + d0 * 2048 + 512);
        if (d0 == 0) { p0 = __builtin_amdgcn_mfma_f32_32x32x16_bf16(b0, qr[0], negm, 0, 0, 0); p1 = __builtin_amdgcn_mfma_f32_32x32x16_bf16(b1, qr[0], negm, 0, 0, 0); }
        else { p0 = __builtin_amdgcn_mfma_f32_32x32x16_bf16(b0, qr[d0], p0, 0, 0, 0); p1 = __builtin_amdgcn_mfma_f32_32x32x16_bf16(b1, qr[d0], p1, 0, 0, 0); }
    }
}
__device__ __forceinline__ float rowmax(const f32x16& p0, const f32x16& p1) {
    float a = fmaxf(fmaxf(p0[0], p0[1]), p1[0]), b = fmaxf(fmaxf(p0[2], p0[3]), p1[1]); a = fmaxf(fmaxf(a, p1[2]), p1[3]);
#pragma unroll
    for (int r = 4; r < 16; r += 4) { a = fmaxf(fmaxf(a, p0[r]), p0[r + 1]); b = fmaxf(fmaxf(b, p0[r + 2]), p0[r + 3]); a = fmaxf(fmaxf(a, p1[r]), p1[r + 1]); b = fmaxf(fmaxf(b, p1[r + 2]), p1[r + 3]); }
    const float m = fmaxf(a, b);
    auto rr = __builtin_amdgcn_permlane32_swap(__float_as_uint(m), __float_as_uint(m), false, false);
    return fmaxf(__uint_as_float(rr[0]), __uint_as_float(rr[1]));
}
__device__ __forceinline__ void pv(f32x16* o, int vb, bf16x8 pa0, bf16x8 pa1, bf16x8 pa2, bf16x8 pa3) {
#pragma unroll
    for (int d0 = 0; d0 < 2; ++d0) { s16x4 lo[4], hi[4];
#pragma unroll
        for (int ks = 0; ks < 4; ++ks) {
            asm volatile("ds_read_b64_tr_b16 %0,%1 offset:%c2" : "=&v"(lo[ks]) : "v"(vb), "i"(d0 * 4096 + ks * 1024) : "memory");
            asm volatile("ds_read_b64_tr_b16 %0,%1 offset:%c2" : "=&v"(hi[ks]) : "v"(vb), "i"(d0 * 4096 + ks * 1024 + 512) : "memory"); }
        asm volatile("s_waitcnt lgkmcnt(0)" ::: "memory"); SBAR();
#define PK(k) (bf16x8){lo[k][0], lo[k][1], lo[k][2], lo[k][3], hi[k][0], hi[k][1], hi[k][2], hi[k][3]}
        o[d0] = __builtin_amdgcn_mfma_f32_32x32x16_bf16(pa0, PK(0), o[d0], 0, 0, 0);
        o[d0] = __builtin_amdgcn_mfma_f32_32x32x16_bf16(pa1, PK(1), o[d0], 0, 0, 0);
        o[d0] = __builtin_amdgcn_mfma_f32_32x32x16_bf16(pa2, PK(2), o[d0], 0, 0, 0);
        o[d0] = __builtin_amdgcn_mfma_f32_32x32x16_bf16(pa3, PK(3), o[d0], 0, 0, 0);
#undef PK
    }
}
template <bool NA>
__device__ __forceinline__ void attn_unit(const bf16* Qw, const bf16* Kc, const bf16* Vc, const bf16* Kl, const bf16* Vl, int NT,
                                          bf16* Ow, int opitch, char* shm, int qrow, int rlo, const float* biasg, const int wid) {
    const int lane = FRESH_LANE(), tid = wid * 64 + lane, r32 = lane & 31, hi = lane >> 5;
    const unsigned lds0 = (unsigned)(uintptr_t)shm;
    const lds_cptr shm3 = (lds_cptr)shm;
    LAS float* wsf = (LAS float*)(shm3 + LDS_WS) + wid * 64;
    LAS float* bias_s = (LAS float*)(shm3 + LDS_BIAS);
    if (NA) { if (tid < 465) bias_s[tid] = biasg[tid] * LOG2E; }
    const int koff = lane * 64 + wid * 8;
    const int voff = (16 * (wid & 3) + (lane >> 2)) * 64 + (wid >> 2) * 32 + (lane & 3) * 8;
    const unsigned kdst = lds0 + LDS_K + wid * 1024, vdst = lds0 + LDS_V + wid * 1024;
#define ATT_DMA(t, slot) do { const bf16* kt_ = (t) < 4 ? Kc + (t) * 4096 : Kl + ((t) - 4) * 4096; const bf16* vt_ = (t) < 4 ? Vc + (t) * 4096 : Vl + ((t) - 4) * 4096; \
        glds16(kt_ + koff, (unsigned)__builtin_amdgcn_readfirstlane(kdst + (slot))); glds16(vt_ + voff, (unsigned)__builtin_amdgcn_readfirstlane(vdst + (slot))); } while (0)
    ATT_DMA(0, 0);
    bf16x8 qr[4];
#pragma unroll
    for (int d0 = 0; d0 < 4; ++d0) qr[d0] = *(const bf16x8*)(Qw + (size_t)r32 * 64 + d0 * 16 + hi * 8);
    float mhat = 0.f, l_reg = 0.f; f32x16 o[2]; o[0] = f32x16{}; o[1] = f32x16{}; f32x16 negm = f32x16{};
    const lds_cptr kp0 = shm3 + LDS_K + hi * 1024 + r32 * 16;
    const int vb0 = (int)(lds0 + LDS_V) + ((lane >> 4) & 1) * 32 + (lane & 3) * 8 + (4 * hi + ((lane & 15) >> 2)) * 64;
    const int qc = (wid & 1) * 32 + r32, cs = clampi(qc - 8, 0, 48), rs = clampi(qrow - 4, 0, 24);
    for (int t = 0; t < NT; ++t) {
        WAIT_BAR0();
        const int slot = (t & 1) * SLOTB;
        if (t + 1 < NT) ATT_DMA(t + 1, SLOTB - slot);
        f32x16 p0, p1;
        qkt(p0, p1, kp0 + slot, qr, negm);
        if (NA && t >= 4) {
            const int kr = rlo + t - 4;
            if (kr < rs || kr >= rs + 8) {
#pragma unroll
                for (int r = 0; r < 16; ++r) { p0[r] = -INFINITY; p1[r] = -INFINITY; }
            } else {
                const LAS float* brow = bias_s + (kr - qrow + 7) * 31;
#pragma unroll
                for (int r = 0; r < 16; ++r) {
                    const int kc = crow(r, hi);
                    const int i0 = clampi(kc - qc + 15, 0, 30), i1 = clampi(kc + 32 - qc + 15, 0, 30);
                    const float b0 = brow[i0], b1 = brow[i1];
                    p0[r] = ((unsigned)(kc - cs) < 16u) ? p0[r] + b0 : -INFINITY;
                    p1[r] = ((unsigned)(kc + 32 - cs) < 16u) ? p1[r] + b1 : -INFINITY;
                }
            }
        }
        const float rm = rowmax(p0, p1);
        if (t == 0 || __any(rm > THR)) {
            const float dl = (t == 0) ? rm : fmaxf(rm, 0.f);
            mhat += dl;
#pragma unroll
            for (int r = 0; r < 16; ++r) { p0[r] -= dl; p1[r] -= dl; negm[r] = -mhat; }
            if (t > 0) {
                const float f = __builtin_amdgcn_exp2f(-dl); l_reg *= f;
                if (hi == 0) wsf[r32] = f;
                asm volatile("s_waitcnt lgkmcnt(0)" ::: "memory");
#pragma unroll
                for (int r = 0; r < 16; ++r) { const float fr_ = wsf[crow(r, hi)]; o[0][r] *= fr_; o[1][r] *= fr_; }
                asm volatile("s_waitcnt lgkmcnt(0)" ::: "memory");
            }
        }
        float sacc = 0.f;
#pragma unroll
        for (int r = 0; r < 16; ++r) { p0[r] = __builtin_amdgcn_exp2f(p0[r]); p1[r] = __builtin_amdgcn_exp2f(p1[r]); sacc += p0[r] + p1[r]; }
        l_reg += sacc;
        u32x4 pw0, pw1, pw2, pw3;
        pw0 = (u32x4){cvtpk(p0[0], p0[1]), cvtpk(p0[2], p0[3]), cvtpk(p0[4], p0[5]), cvtpk(p0[6], p0[7])};
        pw1 = (u32x4){cvtpk(p0[8], p0[9]), cvtpk(p0[10], p0[11]), cvtpk(p0[12], p0[13]), cvtpk(p0[14], p0[15])};
        pw2 = (u32x4){cvtpk(p1[0], p1[1]), cvtpk(p1[2], p1[3]), cvtpk(p1[4], p1[5]), cvtpk(p1[6], p1[7])};
        pw3 = (u32x4){cvtpk(p1[8], p1[9]), cvtpk(p1[10], p1[11]), cvtpk(p1[12], p1[13]), cvtpk(p1[14], p1[15])};
        SBAR();
        pv(o, vb0 + slot, __builtin_bit_cast(bf16x8, pw0), __builtin_bit_cast(bf16x8, pw1), __builtin_bit_cast(bf16x8, pw2), __builtin_bit_cast(bf16x8, pw3));
    }
    { auto rr = __builtin_amdgcn_permlane32_swap(__float_as_uint(l_reg), __float_as_uint(l_reg), false, false); l_reg = __uint_as_float(rr[0]) + __uint_as_float(rr[1]); }
    if (hi == 0) wsf[32 + r32] = l_reg; asm volatile("s_waitcnt lgkmcnt(0)" ::: "memory");
    float rli[16];
#pragma unroll
    for (int r = 0; r < 16; ++r) rli[r] = __builtin_amdgcn_rcpf(wsf[32 + crow(r, hi)]);
    { LAS bf16* stg = (LAS bf16*)(shm3 + LDS_OST) + wid * 2048;
#pragma unroll
      for (int r = 0; r < 16; ++r) { const int orow = crow(r, hi);
#pragma unroll
          for (int d0 = 0; d0 < 2; ++d0) stg[orow * 64 + d0 * 32 + r32] = (bf16)(cvtpk(o[d0][r] * rli[r], 0.f) & 0xffffu); }
      asm volatile("s_waitcnt lgkmcnt(0)" ::: "memory");
#pragma unroll
      for (int i = 0; i < 4; ++i) { const int row = i * 8 + (lane >> 3), ch = lane & 7; const u32x4 v = *(const LAS u32x4*)(stg + row * 64 + ch * 8); *(u32x4*)(Ow + (size_t)row * opitch + ch * 8) = v; } }
    asm volatile("s_waitcnt vmcnt(0) lgkmcnt(0)\n\ts_barrier" ::: "memory");
#undef ATT_DMA
}
#undef SBAR
#undef WAIT_BAR0
}

struct SsmArgs { const float *lam_re, *lam_im, *log_step, *b_re, *b_im, *c_re, *c_im, *dskip;
                 const float* U; float* YF; bf16* OB; float* F; const float* h0; float* out_ssm; int layer; };
constexpr int SSM_PITCH = 132, SSM_WAVE_BYTES = 32 * SSM_PITCH * 4, LCH = 128, NLCH = 2048 / LCH;
template <int KIND, bool SECOND>
__device__ __forceinline__ void ssm_dir(const SsmArgs& A, int b, int g, int d, int k, LAS float* buf) {
    const int lane = FRESH_LANE();
    const int hi = lane >> 5, l31 = lane & 31, fr = lane & 15, fq = lane >> 4;
    const int gd = d * 16 + g;
    constexpr int CH = KIND == 0 ? 256 : LCH, NSC = CH / 32, L = KIND == 0 ? 256 : 2048;
    const int seqrow0 = KIND == 0 ? b * 256 : 4096 + b * 2048;
    const float step = expf(A.log_step[gd]);
    float ar[2], ai[2], cr[2], ci[2];
#pragma unroll
    for (int q = 0; q < 2; ++q) { const int p = l31 + 32 * q; const float lr = A.lam_re[gd * 64 + p], li = A.lam_im[gd * 64 + p];
        const float e = expf(lr * step); float s, c; sincosf(li * step, &s, &c); ar[q] = e * c; ai[q] = e * s;
        const float den = 1.0f / (lr * lr + li * li), xr = ar[q] - 1.0f; cr[q] = (xr * lr + ai[q] * li) * den; ci[q] = (ai[q] * lr - xr * li) * den; }
    float Bf[4][8];
#pragma unroll
    for (int q = 0; q < 2; ++q) { const int p = l31 + 32 * q; const float* br = A.b_re + ((size_t)gd * 64 + p) * 16; const float* bi = A.b_im + ((size_t)gd * 64 + p) * 16;
#pragma unroll
        for (int c4 = 0; c4 < 4; ++c4) { const f32x4 r = *(const f32x4*)(br + 4 * c4), im = *(const f32x4*)(bi + 4 * c4);
#pragma unroll
            for (int h2 = 0; h2 < 2; ++h2) { const float re_ = hi ? r[2 * h2 + 1] : r[2 * h2], im_ = hi ? im[2 * h2 + 1] : im[2 * h2];
                Bf[q][2 * c4 + h2] = cr[q] * re_ - ci[q] * im_; Bf[2 + q][2 * c4 + h2] = cr[q] * im_ + ci[q] * re_; } } }
    bf16x8 Cf[4];
    if (KIND != 1) {
#pragma unroll
        for (int ks = 0; ks < 4; ++ks) { const float* cp = (ks < 2 ? A.c_re : A.c_im) + ((size_t)gd * 16 + fr) * 64 + 32 * (ks & 1) + 8 * fq; const float sg = ks < 2 ? 1.0f : -1.0f;
            const f32x4 c0 = *(const f32x4*)cp * sg, c1 = *(const f32x4*)(cp + 4) * sg;
            Cf[ks] = __builtin_bit_cast(bf16x8, (u32x4){cvtpk(c0[0], c0[1]), cvtpk(c0[2], c0[3]), cvtpk(c1[0], c1[1]), cvtpk(c1[2], c1[3])}); }
    }
    const float sar = hi ? ar[1] : ar[0], sai = hi ? ai[1] : ai[0];
    float hr = 0.f, hm = 0.f;
    if (KIND == 2) {
        const size_t so = ((((size_t)(b * 2 + A.layer) * 2 + d) * 2) * 16 + g) * 64 + lane;
        hr = A.h0[so]; hm = A.h0[so + 16 * 64];
        float pr = sar, pi = sai;
#pragma unroll
        for (int i = 0; i < 7; ++i) { const float nr = pr * pr - pi * pi, ni = 2.0f * pr * pi; pr = nr; pi = ni; }
        static_assert(LCH == 128, "power");
        const float* Fp = A.F + ((((size_t)(b * 16 + g) * 2 + d) * NLCH) * 2) * 64 + lane;
        float fre[NLCH - 1], fim[NLCH - 1];
#pragma unroll
        for (int kk = 0; kk < NLCH - 1; ++kk) { fre[kk] = Fp[(size_t)kk * 128]; fim[kk] = Fp[(size_t)kk * 128 + 64]; }
#pragma unroll
        for (int kk = 0; kk < NLCH - 1; ++kk) if (kk < k) { const float nr = pr * hr - pi * hm + fre[kk], ni = pr * hm + pi * hr + fim[kk]; hr = nr; hm = ni; }
    }
    float dsk = 0.f; if (KIND != 1 && SECOND) dsk = A.dskip[g * 16 + fr];
    f32x4 un[4];
    { const int s = CH * k + l31; const int t = d ? L - 1 - s : s; const float* up = A.U + (size_t)(seqrow0 + t) * 256 + g * 16;
#pragma unroll
      for (int c4 = 0; c4 < 4; ++c4) un[c4] = *(const f32x4*)(up + 4 * c4); }
    for (int sc = 0; sc < NSC; ++sc) {
        const int s0 = CH * k + 32 * sc;
        float ua[8];
#pragma unroll
        for (int c4 = 0; c4 < 4; ++c4) { ua[2 * c4] = hi ? un[c4][1] : un[c4][0]; ua[2 * c4 + 1] = hi ? un[c4][3] : un[c4][2]; }
        if (sc + 1 < NSC) { const int s = s0 + 32 + l31; const int t = d ? L - 1 - s : s; const float* up = A.U + (size_t)(seqrow0 + t) * 256 + g * 16;
#pragma unroll
            for (int c4 = 0; c4 < 4; ++c4) un[c4] = *(const f32x4*)(up + 4 * c4); }
#pragma unroll
        for (int n = 0; n < 4; ++n) { f32x16 D = f32x16{};
#pragma unroll
            for (int kk = 0; kk < 8; ++kk) D = __builtin_amdgcn_mfma_f32_32x32x2f32(ua[kk], Bf[n][kk], D, 0, 0, 0);
#pragma unroll
            for (int r = 0; r < 16; ++r) buf[crow(r, hi) * SSM_PITCH + 32 * n + l31] = D[r]; }
        { float sre[32], sim[32];
#pragma unroll
          for (int j = 0; j < 32; ++j) { sre[j] = buf[j * SSM_PITCH + lane]; sim[j] = buf[j * SSM_PITCH + 64 + lane]; }
#pragma unroll
          for (int j = 0; j < 32; ++j) { const float nr = fmaf(sar, hr, fmaf(-sai, hm, sre[j])), ni = fmaf(sar, hm, fmaf(sai, hr, sim[j])); hr = nr; hm = ni; sre[j] = hr; sim[j] = hm; }
          if (KIND != 1) {
#pragma unroll
              for (int j = 0; j < 32; ++j) { buf[j * SSM_PITCH + lane] = sre[j]; buf[j * SSM_PITCH + 64 + lane] = sim[j]; } } }
        if (KIND != 1) {
            size_t oo[2][4]; float yv[2][4], uv[2][4];
#pragma unroll
            for (int rt = 0; rt < 2; ++rt)
#pragma unroll
                for (int r = 0; r < 4; ++r) { const int s = s0 + 16 * rt + 4 * fq + r; const int t = d ? L - 1 - s : s; oo[rt][r] = (size_t)(seqrow0 + t) * 256 + g * 16 + fr;
                    if (SECOND) { yv[rt][r] = A.YF[oo[rt][r]]; uv[rt][r] = A.U[oo[rt][r]]; } }
            f32x4 acc2[2];
#pragma unroll
            for (int rt = 0; rt < 2; ++rt) { f32x4 acc = {0.f, 0.f, 0.f, 0.f};
#pragma unroll
                for (int ks = 0; ks < 4; ++ks) { const LAS float* hp = buf + (16 * rt + fr) * SSM_PITCH + 32 * ks + 8 * fq; const f32x4 h0 = *(const LAS f32x4*)hp, h1 = *(const LAS f32x4*)(hp + 4);
                    const bf16x8 ahh = __builtin_bit_cast(bf16x8, (u32x4){cvtpk(h0[0], h0[1]), cvtpk(h0[2], h0[3]), cvtpk(h1[0], h1[1]), cvtpk(h1[2], h1[3])});
                    acc = __builtin_amdgcn_mfma_f32_16x16x32_bf16(ahh, Cf[ks], acc, 0, 0, 0); }
                acc2[rt] = acc; }
#pragma unroll
            for (int rt = 0; rt < 2; ++rt)
#pragma unroll
                for (int r = 0; r < 4; ++r) {
                    if (!SECOND) A.YF[oo[rt][r]] = acc2[rt][r];
                    else { const float v = acc2[rt][r] + yv[rt][r] + dsk * uv[rt][r]; const float q = 0.5f * v * (1.0f + tanhf(0.7978845608028654f * (v + 0.044715f * v * v * v)));
                           A.OB[oo[rt][r]] = (bf16)(cvtpk(q, 0.f) & 0xffffu); } }
        }
    }
    if (KIND == 0) { const size_t so = ((((size_t)(b * 2 + A.layer) * 2 + d) * 2) * 16 + g) * 64 + lane; A.out_ssm[so] = hr; A.out_ssm[so + 16 * 64] = hm; }
    if (KIND == 1) { const size_t fo = ((((size_t)(b * 16 + g) * 2 + d) * NLCH + k) * 2) * 64 + lane; A.F[fo] = hr; A.F[fo + 64] = hm; }
}
template <int KIND> __device__ __forceinline__ void ssm_both(const SsmArgs& A, int b, int g, int c, LAS float* buf) {
    ssm_dir<KIND, false>(A, b, g, 0, c, buf);
    asm volatile("s_waitcnt vmcnt(0)" ::: "memory");
    ssm_dir<KIND, true>(A, b, g, 1, (KIND == 0 ? 0 : NLCH - 1 - c), buf);
}

__device__ __forceinline__ void norm_mod_rows(const float* xc, const float* xl, const float* g, const float* mod, int sh_off, int sc_off, bf16* H, int gw, int NGW, int lane) {
    for (int row = gw; row < M_TOK; row += NGW) {
        const float* xr = row < 4096 ? xc + (size_t)row * 1024 : xl + (size_t)(row - 4096) * 1024;
        const int cv = row < 4096 ? 0 : 1 + ((row - 4096) >> 11);
        f32x4 v[4]; float ss = 0.f;
#pragma unroll
        for (int j = 0; j < 4; ++j) { v[j] = *(const f32x4*)(xr + 4 * (lane + 64 * j)); ss += (v[j][0] * v[j][0] + v[j][1] * v[j][1]) + (v[j][2] * v[j][2] + v[j][3] * v[j][3]); }
        const float rstd = rsqrtf(wave_sum(ss) * (1.0f / 1024.0f) + EPS);
        const float* mp = mod + cv * 6144;
#pragma unroll
        for (int j = 0; j < 4; ++j) { const int c = 4 * (lane + 64 * j); const f32x4 gg = *(const f32x4*)(g + c), sc = *(const f32x4*)(mp + sc_off + c), sh = *(const f32x4*)(mp + sh_off + c);
            const f32x4 o = v[j] * rstd * gg * (sc + 1.0f) + sh; u32x2 w; w.x = cvtpk(o[0], o[1]); w.y = cvtpk(o[2], o[3]); *(u32x2*)(H + (size_t)row * 1024 + c) = w; }
    }
}
__device__ __forceinline__ void final_norm_rows(float* x, const float* g, int gw, int NGW, int lane) {
    for (int row = gw; row < M_TOK; row += NGW) {
        float* xr = x + (size_t)row * 1024;
        f32x4 v[4]; float ss = 0.f;
#pragma unroll
        for (int j = 0; j < 4; ++j) { v[j] = *(const f32x4*)(xr + 4 * (lane + 64 * j)); ss += (v[j][0] * v[j][0] + v[j][1] * v[j][1]) + (v[j][2] * v[j][2] + v[j][3] * v[j][3]); }
        const float rstd = rsqrtf(wave_sum(ss) * (1.0f / 1024.0f) + EPS);
#ifdef DBG_SCALE_S
        const float dsc = row >= 4096 ? DBG_SCALE_S : DBG_SCALE_P;
#else
        const float dsc = 1.0f;
#endif
#pragma unroll
        for (int j = 0; j < 4; ++j) { const int c = 4 * (lane + 64 * j); *(f32x4*)(xr + c) = v[j] * (rstd * dsc) * *(const f32x4*)(g + c); }
    }
}

__device__ __forceinline__ int maprow(int mode, int n) {
    if (mode == 1) { const int lc = n & 255; return (n & ~255) + 128 * ((lc >> 5) & 1) + 32 * (lc >> 6) + (lc & 31); }
    if (mode == 2) { if (n < DFF) return 256 * (n >> 7) + (n & 127); const int n2 = n - DFF; return 256 * (n2 >> 7) + 128 + (n2 & 127); }
    return n;
}
__device__ __forceinline__ void transpose_item(const float* W, int K, int N, bf16* WT, int mode, LAS float* scr, int item, int lane) {
    const int nblk = N / 32, kb = item / nblk, nb = item % nblk, k0 = 64 * kb, n0 = 32 * nb;
#pragma unroll
    for (int i = 0; i < 32; ++i) { const int kk = 2 * i + (lane >> 5); scr[kk * 33 + (lane & 31)] = W[(size_t)(k0 + kk) * N + n0 + (lane & 31)]; }
    asm volatile("s_waitcnt lgkmcnt(0)" ::: "memory");
    const int c = lane & 7;
#pragma unroll
    for (int j = 0; j < 4; ++j) { const int n = (lane >> 3) + 8 * j; const LAS float* s = scr + (8 * c) * 33 + n;
        u32x4 o; o.x = cvtpk(s[0 * 33], s[1 * 33]); o.y = cvtpk(s[2 * 33], s[3 * 33]); o.z = cvtpk(s[4 * 33], s[5 * 33]); o.w = cvtpk(s[6 * 33], s[7 * 33]);
        *(u32x4*)(WT + (size_t)maprow(mode, n0 + n) * K + k0 + 8 * c) = o; }
    asm volatile("s_waitcnt lgkmcnt(0)" ::: "memory");
}

struct Args { const float* in[33]; float* out; unsigned char* ws; int ph_lo, ph_hi; };
constexpr int N_PHASES = 20;

__global__ void __launch_bounds__(512, 2) mega_fwd(Args args) {
    extern __shared__ __attribute__((aligned(16))) unsigned char lds[];
    LAS unsigned char* L = (LAS unsigned char*)lds;
    cg::grid_group grid = cg::this_grid();
    unsigned* barw = (unsigned*)(args.ws + WS_BAR);
    volatile LAS unsigned* bst = (volatile LAS unsigned*)((LAS unsigned char*)lds + LDS_BYTES - 64);
    if (threadIdx.x == 0) { bst[0] = 0u; bst[1] = 0u; }
    if (blockIdx.x == 0) { for (int i = threadIdx.x; i < XCD_BAR_WORDS; i += 512) barw[i] = 0u; if (threadIdx.x < 64) ((unsigned*)(args.ws + WS_FLAG))[threadIdx.x] = 0u; }
    __syncthreads();
    XcdBarrier xbar; xbar.bar = barw; xbar.x = 0; xbar.st = bst;
    const int wave0 = __builtin_amdgcn_readfirstlane(threadIdx.x >> 6);
#ifdef DBG_XSYNC
    for (int i = 0; i < DBG_XSYNC; ++i) grid.sync();
#endif
#ifdef DBG_DUP
    int dup_done = -1;
#endif
    for (int ph = args.ph_lo; ph < args.ph_hi; ++ph) {
        if (ph > args.ph_lo) { if (ph == args.ph_lo + 1) { grid.sync(); xbar = xcd_barrier_post(barw, bst); } else xcd_barrier(xbar); }
        int wave = wave0; asm volatile("" : "+s"(wave)); int G = gridDim.x; asm volatile("" : "+s"(G)); int bx = blockIdx.x; asm volatile("" : "+s"(bx));
    const int gw = bx * 8 + wave, NGW = G * 8;
    unsigned char* ws = args.ws; asm volatile("" : "+s"(ws)); float* out = args.out; asm volatile("" : "+s"(out));
    float* MOD = (float*)(ws + WS_MOD); float* ROPE = (float*)(ws + WS_ROPE);
    bf16* Hb = (bf16*)(ws + WS_H); float* YF = (float*)(ws + WS_H);
    bf16 *QA = (bf16*)(ws + WS_QA), *KA = (bf16*)(ws + WS_KA), *VA = (bf16*)(ws + WS_VA), *QC = (bf16*)(ws + WS_QC), *KC = (bf16*)(ws + WS_KC), *VC = (bf16*)(ws + WS_VC);
    float* Ub = (float*)(ws + WS_U); bf16* MF = (bf16*)(ws + WS_QKVU);
    bf16* GATES = (bf16*)(ws + WS_GATES); bf16* ACT = (bf16*)(ws + WS_GATES);
    bf16 *OA = (bf16*)(ws + WS_OA), *OB = (bf16*)(ws + WS_OB), *OC = (bf16*)(ws + WS_OC);
    bf16 *CKAK = (bf16*)(ws + WS_CKAK), *CKAV = (bf16*)(ws + WS_CKAV), *CKCK = (bf16*)(ws + WS_CKCK), *CKCV = (bf16*)(ws + WS_CKCV);
    float* SSMF = (float*)(ws + WS_SSMF2); unsigned* FLAGS = (unsigned*)(ws + WS_FLAG);

        if (ph == 0) {
#ifdef DBG_DUP_P0
            for (int rep0 = 0; rep0 < 2; ++rep0) {
#endif
            const int lane = FRESH_LANE(), tid = wave * 64 + lane;
            LAS float* S = (LAS float*)(L + 69632);
            LAS float* red = (LAS float*)(L + 90112);
            if (bx < 192) {
                for (int i = tid; i < 5 * 1024; i += 512) { const int cv = i >> 10, kx = i & 1023; const float c = cv == 0 ? args.in[8][kx] : args.in[2][(cv - 1) * 1024 + kx]; S[i] = c / (1.0f + __expf(-c)); }
                __syncthreads();
                for (int item = bx; item < 192; item += G) {
                    const int l = item / 96, col = (item % 96) * 64 + lane;
                    const float* wp = args.in[9] + (size_t)l * 1024 * 6144 + col;
                    float a0 = 0.f, a1 = 0.f, a2 = 0.f, a3 = 0.f, a4 = 0.f;
#pragma unroll 16
                    for (int kk = 0; kk < 128; ++kk) { const int kx = wave * 128 + kk; const float w = wp[(size_t)kx * 6144];
                        a0 += S[kx] * w; a1 += S[1024 + kx] * w; a2 += S[2048 + kx] * w; a3 += S[3072 + kx] * w; a4 += S[4096 + kx] * w; }
                    red[(wave * 5 + 0) * 64 + lane] = a0; red[(wave * 5 + 1) * 64 + lane] = a1; red[(wave * 5 + 2) * 64 + lane] = a2; red[(wave * 5 + 3) * 64 + lane] = a3; red[(wave * 5 + 4) * 64 + lane] = a4;
                    __syncthreads();
                    if (wave < 5) { float s = args.in[10][l * 6144 + col];
#pragma unroll
                        for (int w8 = 0; w8 < 8; ++w8) s += red[(w8 * 5 + wave) * 64 + lane];
                        MOD[(l * 5 + wave) * 6144 + col] = s; }
                    __syncthreads();
                }
            }
            if (bx == G - 2 && tid < 256) { const int ll = tid >> 7, qk = (tid >> 6) & 1, e = tid & 63; ((float*)(ws + WS_QKG))[tid] = (qk ? args.in[14] : args.in[13])[ll * 64 + e]; }
            { const int gtid = bx * 512 + tid, NTH = G * 512;
#define CPY(idx, off, n) for (int i = gtid; i < (n) / 4; i += NTH) ((f32x4*)(ws + WS_PAR) + (off) / 4)[i] = ((const f32x4*)args.in[idx])[i];
              CPY(11, P_N1G, 2048) CPY(29, P_N2G, 2048) CPY(32, P_FING, 1024) CPY(7, P_SSM0, 32768) CPY(15, P_LAMR, 4096) CPY(16, P_LAMI, 4096) CPY(17, P_LSTEP, 64)
              CPY(18, P_BRE, 65536) CPY(19, P_BIM, 65536) CPY(20, P_CRE, 65536) CPY(21, P_CIM, 65536) CPY(22, P_SSMD, 512) CPY(24, P_NAB, 3720)
#undef CPY
            }
            if (bx == G - 1) { for (int i = tid; i < 1024; i += 512) { const int pos = i >> 4, f = i & 15; const float inv = 1.0f / powf(10000.0f, (float)f / 16.0f); const float ang = (float)pos * inv; ROPE[2 * i] = cosf(ang); ROPE[2 * i + 1] = sinf(ang); } }
            for (int it = bx * 512 + tid; it < 196608; it += G * 512) {
                const float* src; bf16* dst; int e;
                if (it < 65536) { const bool isv = it >= 32768; e = (it & 32767) * 8; const int d = e & 63, t = (e >> 6) & 255, h = (e >> 14) & 1, b = (e >> 15) & 3, l = e >> 17;
                    src = (isv ? args.in[4] : args.in[3]) + ((((size_t)(b * 2 + l) * 256 + t) * 2 + h) * 64 + d); dst = (isv ? CKAV : CKAK) + e; }
                else { const int i2 = it - 65536; const bool isv = i2 >= 65536; e = (i2 & 65535) * 8; const int d = e & 63, t = (e >> 6) & 255, h = (e >> 14) & 3, b = (e >> 16) & 3, l = e >> 18;
                    src = (isv ? args.in[6] : args.in[5]) + ((((size_t)(b * 2 + l) * 256 + t) * 4 + h) * 64 + d); dst = (isv ? CKCV : CKCK) + e; }
                const f32x4 a = *(const f32x4*)src, c = *(const f32x4*)(src + 4);
                *(u32x4*)dst = (u32x4){cvtpk(a[0], a[1]), cvtpk(a[2], a[3]), cvtpk(c[0], c[1]), cvtpk(c[2], c[3])};
            }
            LAS float* scr = (LAS float*)(L + wave * 8448);
            for (int it = gw; it < 15424; it += NGW) {
                const int l = it / 7712; int r = it % 7712;
                if (r < 2432) { transpose_item(args.in[12] + (size_t)l * DM * NIN, DM, NIN, (bf16*)(ws + W_IN) + (size_t)l * NIN * DM, 1, scr, r, lane); continue; } r -= 2432;
                if (r < 256) { transpose_item(args.in[25] + (size_t)l * 512 * DM, 512, DM, (bf16*)(ws + W_BRA) + (size_t)l * DM * 512, 0, scr, r, lane); continue; } r -= 256;
                if (r < 128) { transpose_item(args.in[26] + (size_t)l * 256 * DM, 256, DM, (bf16*)(ws + W_BRB) + (size_t)l * DM * 256, 0, scr, r, lane); continue; } r -= 128;
                if (r < 128) { transpose_item(args.in[27] + (size_t)l * 256 * DM, 256, DM, (bf16*)(ws + W_BRC) + (size_t)l * DM * 256, 0, scr, r, lane); continue; } r -= 128;
                if (r < 512) { transpose_item(args.in[28] + (size_t)l * DM * DM, DM, DM, (bf16*)(ws + W_OUT) + (size_t)l * DM * DM, 0, scr, r, lane); continue; } r -= 512;
                if (r < 2816) { transpose_item(args.in[30] + (size_t)l * DM * NGU, DM, NGU, (bf16*)(ws + W_GU) + (size_t)l * NGU * DM, 2, scr, r, lane); continue; } r -= 2816;
                if (r < 1408) { transpose_item(args.in[31] + (size_t)l * DFF * DM, DFF, DM, (bf16*)(ws + W_FD) + (size_t)l * DM * DFF, 0, scr, r, lane); continue; } r -= 1408;
                transpose_item(args.in[23] + (size_t)l * 256 * 256, 256, 256, (bf16*)(ws + W_GLU) + (size_t)l * 256 * 256, 0, scr, r, lane);
            }
            __syncthreads();
#ifdef DBG_DUP_P0
            }
#endif
            continue;
        }
        const float* const PAR = (const float*)(ws + WS_PAR);
        if (ph == N_PHASES - 1) { const int lane = FRESH_LANE(); final_norm_rows(out, PAR + P_FING, gw, NGW, lane); continue; }
        const int l = (ph - 1) / 9, sp = (ph - 1) % 9;
        const float* modl = MOD + (size_t)l * 5 * 6144;
        const float* xc_in = args.in[0]; const float* xl_in = args.in[1];
        const float* xc_cur = out; const float* xl_cur = out + (size_t)4096 * 1024;
        pg8::StaticOrder S;
        switch (sp) {
        case 0: {
            const bool first = (l == 0); const int lane = FRESH_LANE();
            norm_mod_rows(first ? xc_in : xc_cur, first ? xl_in : xl_cur, PAR + P_N1G + l * 1024, modl, 0, 1024, Hb, gw, NGW, lane);
        } break;
        case 1: {
            pg8::Gemm g{Hb, (const bf16*)(ws + W_IN) + (size_t)l * NIN * DM, M_TOK, NIN, DM}; S.init(M_TOK, NIN, G, bx);
            EpiIn E{ws, out, l};

#ifndef CUT_IN
            pg8::gemm_phase<EpiIn, pg8::StaticOrder, true, true>(L, g, S, E, wave);
#endif

        } break;
        case 2: {
            SsmArgs SA{PAR + P_LAMR + l * 2048, PAR + P_LAMI + l * 2048, PAR + P_LSTEP + l * 32, PAR + P_BRE + (size_t)l * 32768, PAR + P_BIM + (size_t)l * 32768, PAR + P_CRE + (size_t)l * 32768, PAR + P_CIM + (size_t)l * 32768,
                       PAR + P_SSMD + l * 256, Ub, YF, OB, SSMF, PAR + P_SSM0, out + O_SSM, l};
            for (int item = bx; item < 864; item += G) {
                if (item < 256) {
                    const int b = item >> 6, h = (item >> 3) & 7, qb = item & 7, kvh = h >> 2;
                    const bf16* Qw = QA + ((size_t)4096 * 8 + (size_t)(b * 8 + h) * 2048 + qb * 256 + wave * 32) * 64;
                    const size_t co = ((size_t)((l * 4 + b) * 2 + kvh) * 256) * 64, lo = ((size_t)4096 * 2 + (size_t)(b * 2 + kvh) * 2048) * 64;
                    bf16* Ow = OA + ((size_t)4096 + b * 2048 + qb * 256 + wave * 32) * 512 + h * 64;
                    att::attn_unit<false>(Qw, CKAK + co, CKAV + co, KA + lo, VA + lo, 36, Ow, 512, (char*)lds, 0, 0, nullptr, wave);
                } else if (item < 384) {
                    const int i = item - 256, b = i >> 5, h = (i >> 3) & 3, qb = i & 7, r0 = 4 * qb;
                    const int rlo = clampi(r0 - 4, 0, 24), rhi = clampi(r0 - 1, 0, 24) + 7, NT = 4 + rhi - rlo + 1;
                    const bf16* Qw = QC + ((size_t)4096 * 4 + (size_t)(b * 4 + h) * 2048 + qb * 256 + wave * 32) * 64;
                    const size_t co = ((size_t)((l * 4 + b) * 4 + h) * 256) * 64, lo = ((size_t)4096 * 4 + (size_t)(b * 4 + h) * 2048 + rlo * 64) * 64;
                    bf16* Ow = OC + ((size_t)4096 + b * 2048 + qb * 256 + wave * 32) * 256 + h * 64;
                    att::attn_unit<true>(Qw, CKCK + co, CKCV + co, KC + lo, VC + lo, NT, Ow, 256, (char*)lds, r0 + (wave >> 1), rlo, PAR + P_NAB + (size_t)(l * 4 + h) * 465, wave);
                } else if (item < 416) {
                    const int wu = (item - 384) * 8 + wave;
                    ssm_both<0>(SA, wu >> 4, wu & 15, 0, (LAS float*)(L + wave * SSM_WAVE_BYTES));
                    asm volatile("s_waitcnt vmcnt(0) lgkmcnt(0)" ::: "memory"); __syncthreads();
                } else if (item < 672) {
                    const int wu = (item - 416) * 8 + wave;
                    ssm_dir<1, false>(SA, wu >> 9, (wu >> 5) & 15, (wu >> 4) & 1, wu & 15, (LAS float*)(L + wave * SSM_WAVE_BYTES));
                    asm volatile("s_waitcnt vmcnt(0) lgkmcnt(0)" ::: "memory"); __syncthreads();
                } else if (item < 800) {
                    const int i = item - 672, b = i >> 3, h = i & 7, kvh = h >> 2;
                    const bf16* Qw = QA + ((size_t)(b * 8 + h) * 256 + wave * 32) * 64;
                    const size_t co = ((size_t)(b * 2 + kvh) * 256) * 64;
                    bf16* Ow = OA + ((size_t)b * 256 + wave * 32) * 512 + h * 64;
                    att::attn_unit<false>(Qw, KA + co, VA + co, KA, VA, 4, Ow, 512, (char*)lds, 0, 0, nullptr, wave);
                } else {
                    const int i = item - 800, b = i >> 2, h = i & 3;
                    const bf16* Qw = QC + ((size_t)(b * 4 + h) * 256 + wave * 32) * 64;
                    const size_t co = ((size_t)(b * 4 + h) * 256) * 64;
                    bf16* Ow = OC + ((size_t)b * 256 + wave * 32) * 256 + h * 64;
                    att::attn_unit<false>(Qw, KC + co, VC + co, KC, VC, 4, Ow, 256, (char*)lds, 0, 0, nullptr, wave);
                }
            }
        } break;
        case 3: {
            SsmArgs SA{PAR + P_LAMR + l * 2048, PAR + P_LAMI + l * 2048, PAR + P_LSTEP + l * 32, PAR + P_BRE + (size_t)l * 32768, PAR + P_BIM + (size_t)l * 32768, PAR + P_CRE + (size_t)l * 32768, PAR + P_CIM + (size_t)l * 32768,
                       PAR + P_SSMD + l * 256, Ub, YF, OB, SSMF, PAR + P_SSM0, out + O_SSM, l};
            for (int wu = wave * G + bx; wu < 1024; wu += 8 * G) ssm_both<2>(SA, wu >> 8, (wu >> 4) & 15, wu & 15, (LAS float*)(L + wave * SSM_WAVE_BYTES));
            asm volatile("s_waitcnt vmcnt(0) lgkmcnt(0)" ::: "memory");
            __syncthreads();
        } break;
        case 4: {
            pg8::StaticOrder SG; SG.init(M_TOK, 256, G, bx); Unit ug;
            if (SG.next(0, ug)) {
                pg8::Gemm g{OB, (const bf16*)(ws + W_GLU) + (size_t)l * 256 * 256, M_TOK, 256, 256};
                EpiGlu E{OB};
                pg8::gemm_phase<EpiGlu, pg8::StaticOrder, true, true>(L, g, SG, E, wave);
                asm volatile("s_waitcnt vmcnt(0)" ::: "memory");
                __syncthreads();
                if (wave == 0) { __builtin_amdgcn_fence(__ATOMIC_RELEASE, "agent"); asm volatile("s_waitcnt vmcnt(0)" ::: "memory");
                    if (FRESH_LANE() == 0) __hip_atomic_store(FLAGS + ug.pm, (unsigned)(l + 1), __ATOMIC_RELAXED, __HIP_MEMORY_SCOPE_AGENT); }
            }
            S.init(M_TOK, DM, G, bx);
            { pg8::Gemm g{OA, (const bf16*)(ws + W_BRA) + (size_t)l * DM * 512, M_TOK, DM, 512}; EpiBr<0> E{GATES, MF, nullptr}; pg8::gemm_phase<EpiBr<0>, pg8::StaticOrder, true, true>(L, g, S, E, wave); }
            { pg8::Gemm g{OC, (const bf16*)(ws + W_BRC) + (size_t)l * DM * 256, M_TOK, DM, 256}; EpiBr<1> E{GATES + 2048, MF, nullptr}; pg8::gemm_phase<EpiBr<1>, pg8::StaticOrder, true, true>(L, g, S, E, wave); }
            { Unit ub; if (S.next(0, ub)) {
                if (wave == 0) { unsigned sp_ = 0; while (__hip_atomic_load(FLAGS + ub.pm, __ATOMIC_RELAXED, __HIP_MEMORY_SCOPE_AGENT) < (unsigned)(l + 1)) { __builtin_amdgcn_s_sleep(2); if (++sp_ > (1u << 24)) break; }
                    __builtin_amdgcn_fence(__ATOMIC_ACQUIRE, "agent"); asm volatile("s_waitcnt vmcnt(0)" ::: "memory"); }
                __syncthreads(); } }
            { pg8::Gemm g{OB, (const bf16*)(ws + W_BRB) + (size_t)l * DM * 256, M_TOK, DM, 256}; EpiBr<2> E{GATES + 1024, MF, Hb}; pg8::gemm_phase<EpiBr<2>, pg8::StaticOrder, true, true>(L, g, S, E, wave); }
        } break;
        case 5: {
            S.init(M_TOK, DM, G, bx);
            pg8::Gemm g{Hb, (const bf16*)(ws + W_OUT) + (size_t)l * DM * DM, M_TOK, DM, DM};
            EpiRes E{l == 0 ? xc_in : xc_cur, l == 0 ? xl_in : xl_cur, out, modl + 2048};
            pg8::gemm_phase<EpiRes, pg8::StaticOrder, true, true>(L, g, S, E, wave);
        } break;
        case 6: {
            const int lane = FRESH_LANE();
            norm_mod_rows(xc_cur, xl_cur, PAR + P_N2G + l * 1024, modl, 3072, 4096, Hb, gw, NGW, lane);
        } break;
        case 7: {
            pg8::Gemm g{Hb, (const bf16*)(ws + W_GU) + (size_t)l * NGU * DM, M_TOK, NGU, DM}; S.init(M_TOK, NGU, G, bx);
            EpiSwiglu E{ACT};
            pg8::gemm_phase<EpiSwiglu, pg8::StaticOrder, true, true>(L, g, S, E, wave);
        } break;
        case 8: {
            S.init(M_TOK, DM, G, bx);
            pg8::Gemm g{ACT, (const bf16*)(ws + W_FD) + (size_t)l * DM * DFF, M_TOK, DM, DFF};
            EpiRes E{xc_cur, xl_cur, out, modl + 5120};
            pg8::gemm_phase<EpiRes, pg8::StaticOrder, true, true>(L, g, S, E, wave);
        } break;
        }
#ifdef DBG_DUP
        if (sp == DBG_DUP && dup_done != ph) { dup_done = ph; --ph; }
#endif
    }
}

extern "C" void kernel_launch(void* const* d_in, const int* in_sizes, int n_in, void* d_out, int out_size, void* d_ws, size_t ws_size, hipStream_t stream) {
    static int grid = 0;
    if (grid == 0) {
        if (n_in != 33 || ws_size < WS_END) { fprintf(stderr, "kernel_launch: unexpected n_in %d / ws_size %zu\n", n_in, ws_size); grid = -1; return; }
        int dev = 0, cus = 0, per_cu = 0;
        hipGetDevice(&dev); hipDeviceGetAttribute(&cus, hipDeviceAttributeMultiprocessorCount, dev);
        if (hipFuncSetAttribute((const void*)mega_fwd, hipFuncAttributeMaxDynamicSharedMemorySize, LDS_BYTES) != hipSuccess) { fprintf(stderr, "kernel_launch: hipFuncSetAttribute failed\n"); grid = -1; return; }
        if (hipOccupancyMaxActiveBlocksPerMultiprocessor(&per_cu, (const void*)mega_fwd, 512, LDS_BYTES) != hipSuccess || per_cu < 1) { fprintf(stderr, "kernel_launch: occupancy query says %d\n", per_cu); per_cu = 1; }
        (void)hipGetLastError();
        grid = cus * 1;
        fprintf(stderr, "kernel_launch: cus %d per_cu %d grid %d ws %zu\n", cus, per_cu, grid, ws_size);
    }
    if (grid < 0) return;
    Args a{};
    for (int i = 0; i < 33; ++i) a.in[i] = (const float*)d_in[i];
    a.out = (float*)d_out; a.ws = (unsigned char*)d_ws;
#if MK_MULTI
    for (int ph = 0; ph < N_PHASES; ++ph) { a.ph_lo = ph; a.ph_hi = ph + 1; hipLaunchKernelGGL(mega_fwd, dim3(grid), dim3(512), LDS_BYTES, stream, a); }
#else
    a.ph_lo = 0; a.ph_hi = N_PHASES;
    void* kargs[] = {&a};
    hipError_t e = hipLaunchCooperativeKernel((const void*)mega_fwd, dim3(grid), dim3(512), kargs, LDS_BYTES, stream);
    if (e != hipSuccess) fprintf(stderr, "cooperative launch failed: %s (grid %d)\n", hipGetErrorString(e), grid);
#endif
}
```

```cpp
#include <hip/hip_runtime.h>
#include <hip/hip_cooperative_groups.h>
#include <hip/hip_bf16.h>
#include <cstdio>
#include <cstdint>
namespace cg = cooperative_groups;

#ifndef MK_MULTI
#define MK_MULTI 0
#endif

namespace pg8 {
#define PG8_LAS __attribute__((address_space(3)))
typedef unsigned short bf16_t;
typedef short bf16x8 __attribute__((ext_vector_type(8)));
typedef float f32x4 __attribute__((ext_vector_type(4)));
typedef unsigned u32x4 __attribute__((ext_vector_type(4)));
constexpr int BM = 256, BK = 64, HALF = 128, HTB = HALF * BK * 2  , STAGE_BYTES = 8 * HTB, NXCD = 8, WGM = 8;

__host__ __device__ __forceinline__ int lds_byte(int r, int c) { const int st = (r >> 4) * 2 + (c >> 5), rr = r & 15, cc = c & 31, ob = rr * 64 + cc * 2; return st * 1024 + (ob ^ (((ob >> 9) & 1) << 5)); }
__host__ __device__ __forceinline__ void stage_rc(int b, int& R, int& C) { const int st = b / 1024, sb = b % 1024, swz = sb ^ (((sb >> 9) & 1) << 5); R = (st >> 1) * 16 + swz / 64; C = (st & 1) * 32 + (swz % 64) / 2; }
__host__ __device__ __forceinline__ int perm32(int rho) { const int n = rho >> 4, i = rho & 15; return 8 * (i >> 2) + 4 * n + (i & 3); }

struct Unit { int pm, pn; };
struct Gemm { const bf16_t* A; const bf16_t* Bt; int M, N, K; };

struct StaticOrder {
    int nM, nN, nwg, G, c;
    __host__ __device__ void init(int M, int N, int G_, int c_) { nM = M / BM; nN = N / BM; nwg = nM * nN; G = G_; c = c_; }
    __host__ __device__ bool next(int i, Unit& u) const {
        const long L = (long)i * G + c; if (L >= nwg) return false;
        int wgid = (int)L; { const int q = nwg / NXCD, r = nwg % NXCD, xcd = wgid % NXCD, off = wgid / NXCD; wgid = (xcd < r ? xcd * (q + 1) : r * (q + 1) + (xcd - r) * q) + off; }
        const int nig = WGM * nN, gid = wgid / nig, fm = gid * WGM, gsz = (nM - fm) < WGM ? (nM - fm) : WGM;
        u.pm = fm + ((wgid % nig) % gsz); u.pn = (wgid % nig) / gsz; return true;
    }
    __device__ __forceinline__ void a_ready(const Unit&) const {}
    __device__ __forceinline__ void done(const Unit&) const {}
};

__device__ __forceinline__ unsigned cvt_pk_bf16(float lo, float hi) { unsigned r; asm volatile("v_cvt_pk_bf16_f32 %0, %1, %2" : "=v"(r) : "v"(lo), "v"(hi)); return r; }
typedef float f32x2 __attribute__((ext_vector_type(2)));
template <class Epi, class Sched, bool ALIGN_EPI = false, bool SP2 = false>
__device__ __forceinline__ void gemm_phase(PG8_LAS unsigned char* lds, const Gemm g, const Sched& S, const Epi& E, const int wid) {
    int lane; asm volatile("v_mbcnt_lo_u32_b32 %0, -1, 0\n\tv_mbcnt_hi_u32_b32 %0, -1, %0" : "=v"(lane)); const int tid = wid * 64 + lane, wr = wid >> 2, wc = wid & 3, fr = lane & 15, fq = lane >> 4;
    const int K = g.K, nt = K / BK;
    unsigned voffA[2], voffB[2];
#pragma unroll
    for (int i = 0; i < 2; ++i) { int R, C; stage_rc(tid * 16 + i * 8192, R, C); const int Rb = Epi::PERM ? ((R & ~31) + perm32(R & 31)) : R;
        voffA[i] = (unsigned)(R * K + C) * 2u; voffB[i] = (unsigned)(Rb * K + C) * 2u; }
    const size_t kstep = (size_t)(BK * 2);
    const size_t hstep = (size_t)HALF * K * 2;
    const size_t tstep = 2 * hstep;
    const unsigned ldsw = (unsigned)wid * 1024u;
    const int aoff = lds_byte(wr * 64 + fr, fq * 8), boff = lds_byte(wc * 32 + fr, fq * 8);
#define PG8_SA(b, h) (((b) * 2 + (h)) * HTB)
#define PG8_SB(b, h) ((4 + (b) * 2 + (h)) * HTB)
#define PG8_STAGE(bufoff, gbase, voff) do { _Pragma("unroll") for (int _i = 0; _i < 2; ++_i) \
        __builtin_amdgcn_global_load_lds((const unsigned*)((const char*)(gbase) + (voff)[_i]), (PG8_LAS unsigned*)(lds + (bufoff) + ldsw + _i * 8192), 16, 0, 0); } while (0)
#define PG8_LDA(dst, b, h) do { _Pragma("unroll") for (int m = 0; m < 4; ++m) _Pragma("unroll") for (int k = 0; k < 2; ++k) dst[m][k] = *(const PG8_LAS bf16x8*)(lds + PG8_SA(b, h) + aoff + m * 2048 + k * 1024); } while (0)
#define PG8_LDB(dst, b, h) do { _Pragma("unroll") for (int n = 0; n < 2; ++n) _Pragma("unroll") for (int k = 0; k < 2; ++k) dst[n][k] = *(const PG8_LAS bf16x8*)(lds + PG8_SB(b, h) + boff + n * 2048 + k * 1024); } while (0)
#define PG8_MMA(ai, bj, At, Bt) do { __builtin_amdgcn_s_setprio(1); _Pragma("unroll") for (int m = 0; m < 4; ++m) _Pragma("unroll") for (int n = 0; n < 2; ++n) _Pragma("unroll") for (int k = 0; k < 2; ++k) \
        acc[ai][bj][m][n] = __builtin_amdgcn_mfma_f32_16x16x32_bf16(Bt[n][k], At[m][k], acc[ai][bj][m][n], 0, 0, 0); __builtin_amdgcn_s_setprio(0); } while (0)
#define PG8_WAIT_V(n) asm volatile("s_waitcnt vmcnt(" #n ")" ::: "memory")
#define PG8_WAIT_L(n) asm volatile("s_waitcnt lgkmcnt(" #n ")" ::: "memory")
#define PG8_BAR __builtin_amdgcn_s_barrier()
#define PG8_SCHED __builtin_amdgcn_sched_barrier(0)
    Unit cur, nxt; int ui = 0;
    if (!S.next(0, cur)) return;
    f32x4 acc[2][2][4][2];
#pragma unroll
    for (int a = 0; a < 2; ++a)
#pragma unroll
        for (int b = 0; b < 2; ++b)
#pragma unroll
            for (int m = 0; m < 4; ++m)
#pragma unroll
                for (int n = 0; n < 2; ++n) acc[a][b][m][n] = (f32x4){0.f, 0.f, 0.f, 0.f};
    bf16x8 At[4][2], B0[2][2], B1[2][2];
    const char* cA = (const char*)g.A + (size_t)cur.pm * tstep; const char* cB = (const char*)g.Bt + (size_t)cur.pn * tstep;
    S.a_ready(cur);
    if constexpr (SP2) {
        PG8_STAGE(PG8_SB(0, 0), cB, voffB); PG8_STAGE(PG8_SB(0, 1), cB + hstep, voffB); PG8_STAGE(PG8_SA(0, 0), cA, voffA); PG8_STAGE(PG8_SA(0, 1), cA + hstep, voffA);
        if (wr == 1) PG8_BAR;
        PG8_WAIT_V(2); PG8_BAR;
        PG8_STAGE(PG8_SB(1, 0), cB + kstep, voffB); PG8_STAGE(PG8_SA(1, 0), cA + kstep, voffA); PG8_STAGE(PG8_SB(1, 1), cB + hstep + kstep, voffB);
        PG8_WAIT_V(6); PG8_BAR;
    } else {
        PG8_STAGE(PG8_SB(0, 0), cB, voffB); PG8_STAGE(PG8_SA(0, 0), cA, voffA); PG8_STAGE(PG8_SB(0, 1), cB + hstep, voffB); PG8_STAGE(PG8_SA(0, 1), cA + hstep, voffA);
        if (wr == 1) PG8_BAR;
        PG8_WAIT_V(4); PG8_BAR;
        PG8_STAGE(PG8_SB(1, 0), cB + kstep, voffB); PG8_STAGE(PG8_SA(1, 0), cA + kstep, voffA); PG8_STAGE(PG8_SB(1, 1), cB + hstep + kstep, voffB);
        PG8_WAIT_V(6); PG8_BAR;
    }
    for (;;) {
        const bool has_next = S.next(ui + 1, nxt);
        const char* nA = has_next ? (const char*)g.A + (size_t)nxt.pm * tstep : cA; const char* nB = has_next ? (const char*)g.Bt + (size_t)nxt.pn * tstep : cB;
        for (int t = 0; t < nt; t += 2) {
            const bool last = (t == nt - 2);
            const char* a1 = cA + (size_t)(t + 1) * kstep;
            const char* a2 = last ? nA : cA + (size_t)(t + 2) * kstep; const char* b2 = last ? nB : cB + (size_t)(t + 2) * kstep;
            const char* a3 = a2 + kstep; const char* b3 = b2 + kstep;
            if (last && has_next) S.a_ready(nxt);
            if constexpr (SP2) {
            PG8_LDB(B0, 0, 0); PG8_LDB(B1, 0, 1); PG8_SCHED; PG8_LDA(At, 0, 0); PG8_STAGE(PG8_SA(1, 1), a1 + hstep, voffA);
            PG8_WAIT_V(8); PG8_WAIT_L(0); PG8_BAR; PG8_MMA(0, 0, At, B0); PG8_MMA(0, 1, At, B1); PG8_BAR; PG8_SCHED;
            PG8_LDA(At, 0, 1); PG8_STAGE(PG8_SB(0, 0), b2, voffB); PG8_STAGE(PG8_SB(0, 1), b2 + hstep, voffB); PG8_STAGE(PG8_SA(0, 0), a2, voffA);
            PG8_WAIT_V(8); PG8_WAIT_L(0); PG8_BAR; PG8_MMA(1, 0, At, B0); PG8_MMA(1, 1, At, B1); PG8_BAR; PG8_SCHED;
            PG8_LDB(B0, 1, 0); PG8_LDB(B1, 1, 1); PG8_SCHED; PG8_LDA(At, 1, 0); PG8_STAGE(PG8_SA(0, 1), a2 + hstep, voffA);
            PG8_WAIT_V(8); PG8_WAIT_L(0); PG8_BAR; PG8_MMA(0, 0, At, B0); PG8_MMA(0, 1, At, B1); PG8_BAR; PG8_SCHED;
            PG8_LDA(At, 1, 1); PG8_STAGE(PG8_SB(1, 0), b3, voffB); PG8_STAGE(PG8_SB(1, 1), b3 + hstep, voffB); PG8_STAGE(PG8_SA(1, 0), a3, voffA);
            PG8_WAIT_V(8); PG8_WAIT_L(0); PG8_BAR; PG8_MMA(1, 0, At, B0); PG8_MMA(1, 1, At, B1); PG8_BAR; PG8_SCHED;
            } else {
            PG8_LDB(B0, 0, 0); PG8_SCHED; PG8_LDA(At, 0, 0); PG8_STAGE(PG8_SA(1, 1), a1 + hstep, voffA);
            PG8_WAIT_L(8); PG8_BAR; PG8_WAIT_L(0); PG8_MMA(0, 0, At, B0); PG8_BAR; PG8_SCHED;
            PG8_LDB(B1, 0, 1); PG8_STAGE(PG8_SB(0, 0), b2, voffB);
            PG8_BAR; PG8_WAIT_L(0); PG8_MMA(0, 1, At, B1); PG8_BAR;
            PG8_LDA(At, 0, 1); PG8_STAGE(PG8_SA(0, 0), a2, voffA);
            PG8_BAR; PG8_WAIT_L(0); PG8_MMA(1, 0, At, B0); PG8_BAR; PG8_SCHED;
            PG8_STAGE(PG8_SB(0, 1), b2 + hstep, voffB);
            PG8_WAIT_V(6); PG8_BAR; PG8_MMA(1, 1, At, B1); PG8_BAR;
            PG8_LDB(B0, 1, 0); PG8_SCHED; PG8_LDA(At, 1, 0); PG8_STAGE(PG8_SA(0, 1), a2 + hstep, voffA);
            PG8_WAIT_L(8); PG8_BAR; PG8_WAIT_L(0); PG8_MMA(0, 0, At, B0); PG8_BAR; PG8_SCHED;
            PG8_LDB(B1, 1, 1); PG8_STAGE(PG8_SB(1, 0), b3, voffB);
            PG8_BAR; PG8_WAIT_L(0); PG8_MMA(0, 1, At, B1); PG8_BAR;
            PG8_LDA(At, 1, 1); PG8_STAGE(PG8_SA(1, 0), a3, voffA);
            PG8_BAR; PG8_WAIT_L(0); PG8_MMA(1, 0, At, B0); PG8_BAR; PG8_SCHED;
            PG8_STAGE(PG8_SB(1, 1), b3 + hstep, voffB);
            PG8_WAIT_V(6); PG8_BAR; PG8_MMA(1, 1, At, B1); PG8_BAR;
            }
        }
        if constexpr (ALIGN_EPI) { if (wr == 0) PG8_BAR; }
        if constexpr (!Epi::AFTER_DRAIN) { E(acc, cur, wr, wc, fr, fq); S.done(cur); }
        if (!has_next) break;
#pragma unroll
        for (int a = 0; a < 2; ++a)
#pragma unroll
            for (int b = 0; b < 2; ++b)
#pragma unroll
                for (int m = 0; m < 4; ++m)
#pragma unroll
                    for (int n = 0; n < 2; ++n) acc[a][b][m][n] = (f32x4){0.f, 0.f, 0.f, 0.f};
        cur = nxt; cA = nA; cB = nB; ++ui;
        if constexpr (ALIGN_EPI) { if (wr == 1) PG8_BAR; }
    }
    PG8_WAIT_V(0);
    if constexpr (!ALIGN_EPI) { if (wr == 0) PG8_BAR; }
    PG8_BAR;
    if constexpr (Epi::AFTER_DRAIN) { E.fused(acc, cur, wr, wc, fr, fq, lds, wid, lane); S.done(cur); }
#undef PG8_SA
#undef PG8_SB
#undef PG8_STAGE
#undef PG8_LDA
#undef PG8_LDB
#undef PG8_MMA
#undef PG8_WAIT_V
#undef PG8_WAIT_L
#undef PG8_BAR
#undef PG8_SCHED
}
}

#define LAS __attribute__((address_space(3)))
typedef unsigned short bf16;
typedef short bf16x8 __attribute__((ext_vector_type(8)));
typedef short s16x4 __attribute__((ext_vector_type(4)));
typedef float f32x4 __attribute__((ext_vector_type(4)));
typedef float f32x16 __attribute__((ext_vector_type(16)));
typedef unsigned u32x4 __attribute__((ext_vector_type(4)));
typedef unsigned u32x2 __attribute__((ext_vector_type(2)));
typedef float f32x2_t __attribute__((ext_vector_type(2)));
typedef __bf16 bf16x2_t __attribute__((ext_vector_type(2)));

constexpr int M_TOK = 12288, M_CTX = 4096, DM = 1024, NIN = 4864, DFF = 2816, NGU = 5632;
constexpr float EPS = 1e-6f, LOG2E = 1.4426950408889634f, C2 = 0.125f * 1.4426950408889634f;
constexpr size_t MiB = 1u << 20;
constexpr size_t WS_ROPE = 0, WS_QKG = 16384, WS_BAR = 32768, WS_FLAG = 49152, WS_MOD = 65536, WS_SSMF = 512 * 1024, WS_CKAK = 1 * MiB, WS_CKAV = 1 * MiB + 512 * 1024, WS_CKCK = 2 * MiB, WS_CKCV = 3 * MiB;
constexpr size_t WS_W = 4 * MiB;
constexpr size_t W_IN = WS_W, W_BRA = W_IN + 2ull * NIN * DM * 2, W_BRB = W_BRA + 2ull * DM * 512 * 2, W_BRC = W_BRB + 2ull * DM * 256 * 2, W_OUT = W_BRC + 2ull * DM * 256 * 2,
                 W_GU = W_OUT + 2ull * DM * DM * 2, W_FD = W_GU + 2ull * NGU * DM * 2, W_GLU = W_FD + 2ull * DM * DFF * 2, W_END = W_GLU + 2ull * 256 * 256 * 2;
constexpr size_t WS_H = 65 * MiB;
constexpr size_t WS_QKVU = 89 * MiB;
constexpr size_t WS_QA = WS_QKVU, WS_KA = WS_QA + 12 * MiB, WS_VA = WS_KA + 3 * MiB, WS_U = WS_VA + 3 * MiB, WS_QC = WS_U + 12 * MiB, WS_KC = WS_QC + 6 * MiB, WS_VC = WS_KC + 6 * MiB;
constexpr size_t WS_GATES = 137 * MiB;
constexpr size_t WS_OA = 209 * MiB, WS_OB = 221 * MiB, WS_OC = 227 * MiB, WS_PAR = 233 * MiB, WS_SSMF2 = 235 * MiB, WS_END = 236 * MiB;
constexpr int P_N1G = 0, P_N2G = 2048, P_FING = 4096, P_SSM0 = 5120, P_LAMR = 37888, P_LAMI = 41984, P_LSTEP = 46080, P_BRE = 46144, P_BIM = 111680, P_CRE = 177216, P_CIM = 242752, P_SSMD = 308288, P_NAB = 308800;
static_assert(W_END <= WS_H, "weights fit");
constexpr size_t O_YP = 0, O_YS = 4194304, O_GAK = 12582912, O_GAV = 13631488, O_NAK = 14680064, O_NAV = 16777216, O_SSM = 18874368;
constexpr int LDS_BYTES = 147456;

__device__ __forceinline__ unsigned cvtpk(float lo, float hi) { f32x2_t v = {lo, hi}; bf16x2_t b = __builtin_convertvector(v, bf16x2_t); return __builtin_bit_cast(unsigned, b); }
__device__ __forceinline__ float bf2f(unsigned b) { return __uint_as_float(b << 16); }
__device__ __forceinline__ float sigmoidf_(float v) { return 1.0f / (1.0f + __expf(-v)); }
template <int K> __device__ __forceinline__ float xor_shfl(float v) {
    return __uint_as_float((unsigned)__builtin_amdgcn_ds_swizzle((int)__float_as_uint(v), (K << 10) | 0x1F));
}
__device__ __forceinline__ float sum_xor32(float v) { auto rr = __builtin_amdgcn_permlane32_swap(__float_as_uint(v), __float_as_uint(v), false, false); return __uint_as_float(rr[0]) + __uint_as_float(rr[1]); }
__device__ __forceinline__ float wave_sum(float v) {
    v += xor_shfl<1>(v); v += xor_shfl<2>(v); v += xor_shfl<4>(v); v += xor_shfl<8>(v); v += xor_shfl<16>(v);
    return sum_xor32(v);
}
__device__ __forceinline__ int crow(int r, int hi) { return (r & 3) + 8 * (r >> 2) + 4 * hi; }
__device__ __forceinline__ int clampi(int v, int lo, int hi) { return v < lo ? lo : (v > hi ? hi : v); }
#define FRESH_LANE() ({ int l__; asm volatile("v_mbcnt_lo_u32_b32 %0, -1, 0\n\tv_mbcnt_hi_u32_b32 %0, -1, %0" : "=v"(l__)); l__; })
#ifndef DBG_SSM
#define DBG_SSM 1.0f
#endif
#ifndef DBG_GAK
#define DBG_GAK 1.0f
#endif
#ifndef DBG_GAV
#define DBG_GAV 1.0f
#endif
#define VM_WAIT0() asm volatile("s_waitcnt vmcnt(0)" ::: "memory")

#define XB_TMO      128
#define XB_XCNT(j)  (256  + 64 * (j))
#define XB_XSUB(j)  (1280 + 64 * (j))
#define XB_XGEN(j)  (2304 + 64 * (j))
#define XB_TOP      3328
#define XB_TOPGEN   3392
#define XCD_BAR_WORDS 3456
#define XB_SPIN_CAP (1u << 18)

__device__ __forceinline__ unsigned xb_ld(unsigned* p)              { return __hip_atomic_load(p, __ATOMIC_RELAXED, __HIP_MEMORY_SCOPE_AGENT); }
__device__ __forceinline__ unsigned xb_add(unsigned* p, unsigned v) { return __hip_atomic_fetch_add(p, v, __ATOMIC_RELAXED, __HIP_MEMORY_SCOPE_AGENT); }
__device__ __forceinline__ unsigned xb_xcc_id() { return (unsigned)__builtin_amdgcn_s_getreg((3 << 11) | 20) & 0xFu; }
#define XB_SPIN(cond, bar) do { unsigned _sp = 0; while (cond) { __builtin_amdgcn_s_sleep(1); \
    if ((++_sp & 255u) == 0u) { if (xb_ld(&(bar)[XB_TMO])) break; if (_sp > XB_SPIN_CAP) { atomicAdd(&(bar)[XB_TMO], 1u); break; } } } } while (0)

struct XcdBarrier {
    unsigned* bar; unsigned x;
    volatile LAS unsigned* st;
};

__device__ __forceinline__ XcdBarrier xcd_barrier_post(unsigned* bar, volatile LAS unsigned* st) {
    XcdBarrier b; b.bar = bar; b.x = xb_xcc_id(); b.st = st;
    if (threadIdx.x == 0) (void)xb_add(&bar[XB_XCNT(b.x)], 1u);
    return b;
}
__device__ __forceinline__ void xcd_barrier_complete(unsigned* bar, unsigned x, unsigned& nloc, unsigned& nx) {
    const unsigned G = gridDim.x * gridDim.y * gridDim.z;
    unsigned sum, cnt, mine, sp = 0u;
    for (;;) {
        sum = 0u; cnt = 0u; mine = 0u;
#pragma unroll
        for (unsigned j = 0; j < 16; ++j) { const unsigned c = xb_ld(&bar[XB_XCNT(j)]); sum += c; cnt += (c > 0u) ? 1u : 0u; mine = (j == x) ? c : mine; }
        if (sum == G) break;
        __builtin_amdgcn_s_sleep(1);
        if ((++sp & 255u) == 0u) { if (xb_ld(&bar[XB_TMO])) break; if (sp > XB_SPIN_CAP) { atomicAdd(&bar[XB_TMO], 1u); break; } }
    }
    nloc = mine > 0u ? mine : 1u; nx = cnt > 0u ? cnt : 1u;
}

__device__ __forceinline__ void xcd_barrier(const XcdBarrier& b) {
    asm volatile("s_waitcnt vmcnt(0)" ::: "memory");
    __syncthreads();
    if (threadIdx.x == 0) {
        unsigned* bar = b.bar;
        __builtin_amdgcn_s_waitcnt(0);
        unsigned nloc = b.st[0], nx = b.st[1];
        if (nloc == 0u) { xcd_barrier_complete(bar, b.x, nloc, nx); b.st[0] = nloc; b.st[1] = nx; }
        const unsigned old = xb_add(&bar[XB_XSUB(b.x)], 1u);
        const unsigned gen = old / nloc;
        if (old + 1u == (gen + 1u) * nloc) {
            __builtin_amdgcn_fence(__ATOMIC_RELEASE, "agent");
            asm volatile("s_waitcnt vmcnt(0)" ::: "memory");
            const unsigned og = xb_add(&bar[XB_TOP], 1u);
            const unsigned tg = og / nx;
            if (og + 1u == (tg + 1u) * nx) xb_add(&bar[XB_TOPGEN], 1u);
            else XB_SPIN(xb_ld(&bar[XB_TOPGEN]) == tg, bar);
            __builtin_amdgcn_fence(__ATOMIC_ACQUIRE, "agent");
            xb_add(&bar[XB_XGEN(b.x)], 1u);
            asm volatile("s_waitcnt vmcnt(0)" ::: "memory");
        } else {
            XB_SPIN(xb_ld(&bar[XB_XGEN(b.x)]) == gen, bar);
            __builtin_amdgcn_fence(__ATOMIC_ACQUIRE, "agent");
            asm volatile("s_waitcnt vmcnt(0)" ::: "memory");
        }
    }
    __syncthreads();
}
using pg8::Unit;
struct EpiIn {
    static constexpr bool PERM = false, AFTER_DRAIN = false;
    unsigned char* ws; float* out; int layer;
    __device__ __forceinline__ void operator()(const f32x4 (&acc)[2][2][4][2], const Unit& u, int wr, int wc, int fr_, int fq_) const {
        const int ln_ = FRESH_LANE(), fr = ln_ & 15, fq = ln_ >> 4;
        const int pn = u.pn; const bool ctx = u.pm < 16;
        const int rb = u.pm * 256 + wr * 64 + fr;
        if (pn >= 7) {
#pragma unroll
            for (int ai = 0; ai < 2; ++ai)
#pragma unroll
                for (int m = 0; m < 4; ++m) {
                    const int row = rb + ai * 128 + m * 16;
                    bf16* gp = (bf16*)(ws + WS_GATES) + (size_t)row * 3072 + (pn - 7) * 256 + 64 * wc + 4 * fq;
#pragma unroll
                    for (int bj = 0; bj < 2; ++bj)
#pragma unroll
                        for (int n = 0; n < 2; ++n) { const f32x4 v = acc[ai][bj][m][n]; u32x2 w; w.x = cvtpk(sigmoidf_(v[0]), sigmoidf_(v[1])); w.y = cvtpk(sigmoidf_(v[2]), sigmoidf_(v[3])); *(u32x2*)(gp + 32 * bj + 16 * n) = w; }
                }
        } else if (pn == 3) {
#pragma unroll
            for (int ai = 0; ai < 2; ++ai)
#pragma unroll
                for (int m = 0; m < 4; ++m) {
                    const int row = rb + ai * 128 + m * 16;
                    float* up = (float*)(ws + WS_U) + (size_t)row * 256 + 64 * wc + 4 * fq;
#pragma unroll
                    for (int bj = 0; bj < 2; ++bj)
#pragma unroll
                        for (int n = 0; n < 2; ++n) *(f32x4*)(up + 32 * bj + 16 * n) = acc[ai][bj][m][n];
                }
        } else if (pn >= 4) {
            bf16* base = (bf16*)(ws + (pn == 4 ? WS_QC : (pn == 5 ? WS_KC : WS_VC)));
            const float sc = pn == 4 ? C2 : 1.0f;
            float* ob = out + (pn == 5 ? O_NAK : O_NAV);
#pragma unroll
            for (int ai = 0; ai < 2; ++ai)
#pragma unroll
                for (int m = 0; m < 4; ++m) {
                    const int row = rb + ai * 128 + m * 16;
                    int b, t; size_t hrow;
                    if (ctx) { b = row >> 8; t = row & 255; hrow = (size_t)(b * 4 + wc) * 256 + t; } else { const int r2 = row - 4096; b = r2 >> 11; t = r2 & 2047; hrow = (size_t)4096 * 4 + (size_t)(b * 4 + wc) * 2048 + t; }
                    bf16* dp = base + hrow * 64 + 4 * fq;
#pragma unroll
                    for (int bj = 0; bj < 2; ++bj)
#pragma unroll
                        for (int n = 0; n < 2; ++n) { const f32x4 v = acc[ai][bj][m][n] * sc; u32x2 w; w.x = cvtpk(v[0], v[1]); w.y = cvtpk(v[2], v[3]); *(u32x2*)(dp + 32 * bj + 16 * n) = w; }
                    if (ctx && pn >= 5) { float* op = ob + ((size_t)(b * 2 + layer) * 256 + t) * 256 + wc * 64 + 4 * fq;
#pragma unroll
                        for (int bj = 0; bj < 2; ++bj)
#pragma unroll
                            for (int n = 0; n < 2; ++n) *(f32x4*)(op + 32 * bj + 16 * n) = acc[ai][bj][m][n]; }
                }
        } else {
            const bool isQ = pn < 2, isV = (pn == 2 && wc >= 2);
            const int h = isQ ? 4 * pn + wc : (wc & 1);
            const float* gsrc = (const float*)(ws + WS_QKG) + (layer * 2 + (isQ ? 0 : 1)) * 64 + 4 * fq;
            f32x4 gg[2][2];
#pragma unroll
            for (int bj = 0; bj < 2; ++bj)
#pragma unroll
                for (int n = 0; n < 2; ++n) gg[bj][n] = *(const f32x4*)(gsrc + 32 * bj + 16 * n);
            bf16* base = (bf16*)(ws + (isQ ? WS_QA : (isV ? WS_VA : WS_KA)));
            const int nh = isQ ? 8 : 2;
            float* ob = out + (isV ? O_GAV : O_GAK);
#pragma unroll
            for (int ai = 0; ai < 2; ++ai)
#pragma unroll
                for (int m = 0; m < 4; ++m) {
                    const int row = rb + ai * 128 + m * 16;
                    f32x4 v[2][2];
#pragma unroll
                    for (int bj = 0; bj < 2; ++bj)
#pragma unroll
                        for (int n = 0; n < 2; ++n) v[bj][n] = acc[ai][bj][m][n];
                    if (!isV) {
                        float ss = 0.f;
#pragma unroll
                        for (int bj = 0; bj < 2; ++bj)
#pragma unroll
                            for (int n = 0; n < 2; ++n) ss += (v[bj][n][0] * v[bj][n][0] + v[bj][n][1] * v[bj][n][1]) + (v[bj][n][2] * v[bj][n][2] + v[bj][n][3] * v[bj][n][3]);
                        ss += xor_shfl<16>(ss); ss = sum_xor32(ss);
                        const float rstd = rsqrtf(ss * (1.0f / 64.0f) + EPS);
#pragma unroll
                        for (int bj = 0; bj < 2; ++bj)
#pragma unroll
                            for (int n = 0; n < 2; ++n) v[bj][n] = v[bj][n] * rstd * gg[bj][n];
                    }
                    int b, t; size_t hrow;
                    if (ctx) { b = row >> 8; t = row & 255; hrow = (size_t)(b * nh + h) * 256 + t; }
                    else {
                        const int r2 = row - 4096; b = r2 >> 11; t = r2 & 2047; hrow = (size_t)4096 * nh + (size_t)(b * nh + h) * 2048 + t;
                        if (!isV) {
#pragma unroll
                            for (int bj = 0; bj < 2; ++bj) {
                                const int pos = bj ? (t & 63) : (t >> 6);
                                const float* tp = (const float*)(ws + WS_ROPE) + (pos * 16 + 4 * fq) * 2;
                                const f32x4 c01 = *(const f32x4*)tp, c23 = *(const f32x4*)(tp + 4);
                                const f32x4 cs = {c01[0], c01[2], c23[0], c23[2]}, sn = {c01[1], c01[3], c23[1], c23[3]};
                                const f32x4 x1 = v[bj][0], x2 = v[bj][1];
                                v[bj][0] = x1 * cs - x2 * sn; v[bj][1] = x2 * cs + x1 * sn;
                            }
                        }
                    }
                    if (ctx && !isQ) { float* op = ob + ((size_t)(b * 2 + layer) * 256 + t) * 128 + h * 64 + 4 * fq;
#pragma unroll
                        for (int bj = 0; bj < 2; ++bj)
#pragma unroll
                            for (int n = 0; n < 2; ++n) *(f32x4*)(op + 32 * bj + 16 * n) = v[bj][n] * (isV ? DBG_GAV : DBG_GAK); }
                    const float sc = isQ ? C2 : 1.0f;
                    bf16* dp = base + hrow * 64 + 4 * fq;
#pragma unroll
                    for (int bj = 0; bj < 2; ++bj)
#pragma unroll
                        for (int n = 0; n < 2; ++n) { const f32x4 x = v[bj][n] * sc; u32x2 w; w.x = cvtpk(x[0], x[1]); w.y = cvtpk(x[2], x[3]); *(u32x2*)(dp + 32 * bj + 16 * n) = w; }
                }
        }
    }
};

struct EpiRes {
    static constexpr bool PERM = false, AFTER_DRAIN = false;
    const float* xc; const float* xl; float* xo; const float* mod;
    __device__ __forceinline__ void operator()(const f32x4 (&acc)[2][2][4][2], const Unit& u, int wr, int wc, int fr_, int fq_) const {
        const int ln_ = FRESH_LANE(), fr = ln_ & 15, fq = ln_ >> 4;
        const int cv = u.pm < 16 ? 0 : 1 + ((u.pm - 16) >> 3);
        const int col0 = u.pn * 256 + wc * 32 + 4 * fq;
        f32x4 gv[2][2];
#pragma unroll
        for (int bj = 0; bj < 2; ++bj)
#pragma unroll
            for (int n = 0; n < 2; ++n) gv[bj][n] = *(const f32x4*)(mod + cv * 6144 + col0 + bj * 128 + n * 16);
#pragma unroll
        for (int ai = 0; ai < 2; ++ai)
#pragma unroll
            for (int m = 0; m < 4; ++m) {
                const int row = u.pm * 256 + ai * 128 + wr * 64 + m * 16 + fr;
                const float* xs = row < 4096 ? xc + (size_t)row * 1024 : xl + (size_t)(row - 4096) * 1024;
                float* xd = xo + (size_t)row * 1024;
#pragma unroll
                for (int bj = 0; bj < 2; ++bj)
#pragma unroll
                    for (int n = 0; n < 2; ++n) { const int c = col0 + bj * 128 + n * 16; const f32x4 xv = *(const f32x4*)(xs + c); *(f32x4*)(xd + c) = xv + gv[bj][n] * acc[ai][bj][m][n]; }
                asm volatile("" ::: "memory");
            }
    }
};

struct EpiSwiglu {
    static constexpr bool PERM = false, AFTER_DRAIN = false;
    bf16* ACT;
    __device__ __forceinline__ void operator()(const f32x4 (&acc)[2][2][4][2], const Unit& u, int wr, int wc, int fr_, int fq_) const {
        const int ln_ = FRESH_LANE(), fr = ln_ & 15, fq = ln_ >> 4;
#pragma unroll
        for (int ai = 0; ai < 2; ++ai)
#pragma unroll
            for (int m = 0; m < 4; ++m) {
                const int row = u.pm * 256 + ai * 128 + wr * 64 + m * 16 + fr;
                bf16* ap = ACT + (size_t)row * DFF + u.pn * 128 + wc * 32 + 4 * fq;
#pragma unroll
                for (int n = 0; n < 2; ++n) { const f32x4 g = acc[ai][0][m][n], up = acc[ai][1][m][n]; f32x4 r;
#pragma unroll
                    for (int i = 0; i < 4; ++i) r[i] = g[i] * sigmoidf_(g[i]) * up[i];
                    u32x2 w; w.x = cvtpk(r[0], r[1]); w.y = cvtpk(r[2], r[3]); *(u32x2*)(ap + 16 * n) = w; }
                asm volatile("" ::: "memory");
            }
    }
};

struct EpiGlu {
    static constexpr bool PERM = false, AFTER_DRAIN = false;
    bf16* OB;
    __device__ __forceinline__ void operator()(const f32x4 (&acc)[2][2][4][2], const Unit& u, int wr, int wc, int fr_, int fq_) const {
        const int ln_ = FRESH_LANE(), fr = ln_ & 15, fq = ln_ >> 4;
#pragma unroll
        for (int ai = 0; ai < 2; ++ai)
#pragma unroll
            for (int m = 0; m < 4; ++m) {
                const int row = u.pm * 256 + ai * 128 + wr * 64 + m * 16 + fr;
                bf16* p = OB + (size_t)row * 256 + wc * 32 + 4 * fq;
#pragma unroll
                for (int bj = 0; bj < 2; ++bj)
#pragma unroll
                    for (int n = 0; n < 2; ++n) { bf16* q = p + bj * 128 + n * 16; const u32x2 yv = *(const u32x2*)q; const f32x4 a = acc[ai][bj][m][n];
                        const float y0 = bf2f(yv.x & 0xffffu), y1 = bf2f(yv.x >> 16), y2 = bf2f(yv.y & 0xffffu), y3 = bf2f(yv.y >> 16);
                        u32x2 w; w.x = cvtpk(y0 * sigmoidf_(a[0]), y1 * sigmoidf_(a[1])); w.y = cvtpk(y2 * sigmoidf_(a[2]), y3 * sigmoidf_(a[3])); *(u32x2*)q = w; }
                asm volatile("" ::: "memory");
            }
    }
};

template <int MODE> struct EpiBr {
    static constexpr bool PERM = false, AFTER_DRAIN = false;
    const bf16* G; bf16* MF; bf16* MG;
    __device__ __forceinline__ void operator()(const f32x4 (&acc)[2][2][4][2], const Unit& u, int wr, int wc, int fr_, int fq_) const {
        const int ln_ = FRESH_LANE(), fr = ln_ & 15, fq = ln_ >> 4;
        const int col0 = u.pn * 256 + wc * 32 + 4 * fq;
#pragma unroll
        for (int ai = 0; ai < 2; ++ai)
#pragma unroll
            for (int m = 0; m < 4; ++m) {
                const int row = u.pm * 256 + ai * 128 + wr * 64 + m * 16 + fr;
#pragma unroll
                for (int bj = 0; bj < 2; ++bj)
#pragma unroll
                    for (int n = 0; n < 2; ++n) { const int c = col0 + bj * 128 + n * 16; const u32x2 gv = *(const u32x2*)(G + (size_t)row * 3072 + c); const f32x4 a = acc[ai][bj][m][n];
                        f32x4 r = {bf2f(gv.x & 0xffffu) * a[0], bf2f(gv.x >> 16) * a[1], bf2f(gv.y & 0xffffu) * a[2], bf2f(gv.y >> 16) * a[3]};
                        bf16* mp = MF + (size_t)row * 1024 + c;
                        if (MODE >= 1) { const u32x2 mv = *(const u32x2*)mp; r[0] += bf2f(mv.x & 0xffffu); r[1] += bf2f(mv.x >> 16); r[2] += bf2f(mv.y & 0xffffu); r[3] += bf2f(mv.y >> 16); }
                        u32x2 w; w.x = cvtpk(r[0], r[1]); w.y = cvtpk(r[2], r[3]);
                        *(u32x2*)((MODE <= 1 ? mp : MG + (size_t)row * 1024 + c)) = w; }
                asm volatile("" ::: "memory");
            }
    }
};

namespace att {
constexpr int SLOTB = 8192, LDS_K = 0, LDS_V = 16384, LDS_WS = 32768, LDS_OST = 34816, LDS_BIAS = 67584;
constexpr float THR = 8.0f;
#define SBAR() __builtin_amdgcn_sched_barrier(0)
__device__ __forceinline__ void glds16(const void* gsrc, unsigned lds_dst) { unsigned keep;
    asm volatile("s_mov_b32 %0, m0\n\ts_mov_b32 m0, %2\n\ts_nop 0\n\tglobal_load_lds_dwordx4 %1, off\n\ts_mov_b32 m0, %0" : "=&s"(keep) : "v"(gsrc), "s"(lds_dst) : "memory"); }
#define WAIT_BAR0() asm volatile("s_waitcnt vmcnt(0) lgkmcnt(0)\n\ts_barrier" ::: "memory")
typedef LAS const char* lds_cptr;
__device__ __forceinline__ void qkt(f32x16& p0, f32x16& p1, lds_cptr kb, const bf16x8* qr, const f32x16& negm) {
#pragma unroll
    for (int d0 = 0; d0 < 4; ++d0) {
        const bf16x8 b0 = *(const LAS bf16x8*)(kb + d0 * 2048);
        const bf16x8 b1 = *(const LAS bf16x8*)(kb + d0 * 2048 + 512);
        if (d0 == 0) { p0 = __builtin_amdgcn_mfma_f32_32x32x16_bf16(b0, qr[0], negm, 0, 0, 0); p1 = __builtin_amdgcn_mfma_f32_32x32x16_bf16(b1, qr[0], negm, 0, 0, 0); }
        else { p0 = __builtin_amdgcn_mfma_f32_32x32x16_bf16(b0, qr[d0], p0, 0, 0, 0); p1 = __builtin_amdgcn_mfma_f32_32x32x16_bf16(b1, qr[d0], p1, 0, 0, 0); }
    }
}
__device__ __forceinline__ float rowmax(const f32x16& p0, const f32x16& p1) {
    float a = fmaxf(fmaxf(p0[0], p0[1]), p1[0]), b = fmaxf(fmaxf(p0[2], p0[3]), p1[1]); a = fmaxf(fmaxf(a, p1[2]), p1[3]);
#pragma unroll
    for (int r = 4; r < 16; r += 4) { a = fmaxf(fmaxf(a, p0[r]), p0[r + 1]); b = fmaxf(fmaxf(b, p0[r + 2]), p0[r + 3]); a = fmaxf(fmaxf(a, p1[r]), p1[r + 1]); b = fmaxf(fmaxf(b, p1[r + 2]), p1[r + 3]); }
    const float m = fmaxf(a, b);
    auto rr = __builtin_amdgcn_permlane32_swap(__float_as_uint(m), __float_as_uint(m), false, false);
    return fmaxf(__uint_as_float(rr[0]), __uint_as_float(rr[1]));
}
__device__ __forceinline__ void pv(f32x16* o, int vb, bf16x8 pa0, bf16x8 pa1, bf16x8 pa2, bf16x8 pa3) {
#pragma unroll
    for (int d0 = 0; d0 < 2; ++d0) { s16x4 lo[4], hi[4];
#pragma unroll
        for (int ks = 0; ks < 4; ++ks) {
            asm volatile("ds_read_b64_tr_b16 %0,%1 offset:%c2" : "=&v"(lo[ks]) : "v"(vb), "i"(d0 * 4096 + ks * 1024) : "memory");
            asm volatile("ds_read_b64_tr_b16 %0,%1 offset:%c2" : "=&v"(hi[ks]) : "v"(vb), "i"(d0 * 4096 + ks * 1024 + 512) : "memory"); }
        asm volatile("s_waitcnt lgkmcnt(0)" ::: "memory"); SBAR();
#define PK(k) (bf16x8){lo[k][0], lo[k][1], lo[k][2], lo[k][3], hi[k][0], hi[k][1], hi[k][2], hi[k][3]}
        o[d0] = __builtin_amdgcn_mfma_f32_32x32x16_bf16(pa0, PK(0), o[d0], 0, 0, 0);
        o[d0] = __builtin_amdgcn_mfma_f32_32x32x16_bf16(pa1, PK(1), o[d0], 0, 0, 0);
        o[d0] = __builtin_amdgcn_mfma_f32_32x32x16_bf16(pa2, PK(2), o[d0], 0, 0, 0);
        o[d0] = __builtin_amdgcn_mfma_f32_32x32x16_bf16(pa3, PK(3), o[d0], 0, 0, 0);
#undef PK
    }
}
template <bool NA>
__device__ __forceinline__ void attn_unit(const bf16* Qw, const bf16* Kc, const bf16* Vc, const bf16* Kl, const bf16* Vl, int NT,
                                          bf16* Ow, int opitch, char* shm, int qrow, int rlo, const float* biasg, const int wid) {
    const int lane = FRESH_LANE(), tid = wid * 64 + lane, r32 = lane & 31, hi = lane >> 5;
    const unsigned lds0 = (unsigned)(uintptr_t)shm;
    const lds_cptr shm3 = (lds_cptr)shm;
    LAS float* wsf = (LAS float*)(shm3 + LDS_WS) + wid * 64;
    LAS float* bias_s = (LAS float*)(shm3 + LDS_BIAS);
    if (NA) { if (tid < 465) bias_s[tid] = biasg[tid] * LOG2E; }
    const int koff = lane * 64 + wid * 8;
    const int voff = (16 * (wid & 3) + (lane >> 2)) * 64 + (wid >> 2) * 32 + (lane & 3) * 8;
    const unsigned kdst = lds0 + LDS_K + wid * 1024, vdst = lds0 + LDS_V + wid * 1024;
#define ATT_DMA(t, slot) do { const bf16* kt_ = (t) < 4 ? Kc + (t) * 4096 : Kl + ((t) - 4) * 4096; const bf16* vt_ = (t) < 4 ? Vc + (t) * 4096 : Vl + ((t) - 4) * 4096; \
        glds16(kt_ + koff, (unsigned)__builtin_amdgcn_readfirstlane(kdst + (slot))); glds16(vt_ + voff, (unsigned)__builtin_amdgcn_readfirstlane(vdst + (slot))); } while (0)
    ATT_DMA(0, 0);
    bf16x8 qr[4];
#pragma unroll
    for (int d0 = 0; d0 < 4; ++d0) qr[d0] = *(const bf16x8*)(Qw + (size_t)r32 * 64 + d0 * 16 + hi * 8);
    float mhat = 0.f, l_reg = 0.f; f32x16 o[2]; o[0] = f32x16{}; o[1] = f32x16{}; f32x16 negm = f32x16{};
    const lds_cptr kp0 = shm3 + LDS_K + hi * 1024 + r32 * 16;
    const int vb0 = (int)(lds0 + LDS_V) + ((lane >> 4) & 1) * 32 + (lane & 3) * 8 + (4 * hi + ((lane & 15) >> 2)) * 64;
    const int qc = (wid & 1) * 32 + r32, cs = clampi(qc - 8, 0, 48), rs = clampi(qrow - 4, 0, 24);
    for (int t = 0; t < NT; ++t) {
        WAIT_BAR0();
        const int slot = (t & 1) * SLOTB;
        if (t + 1 < NT) ATT_DMA(t + 1, SLOTB - slot);
        f32x16 p0, p1;
        qkt(p0, p1, kp0 + slot, qr, negm);
        if (NA && t >= 4) {
            const int kr = rlo + t - 4;
            if (kr < rs || kr >= rs + 8) {
#pragma unroll
                for (int r = 0; r < 16; ++r) { p0[r] = -INFINITY; p1[r] = -INFINITY; }
            } else {
                const LAS float* brow = bias_s + (kr - qrow + 7) * 31;
#pragma unroll
                for (int r = 0; r < 16; ++r) {
                    const int kc = crow(r, hi);
                    const int i0 = clampi(kc - qc + 15, 0, 30), i1 = clampi(kc + 32 - qc + 15, 0, 30);
                    const float b0 = brow[i0], b1 = brow[i1];
                    p0[r] = ((unsigned)(kc - cs) < 16u) ? p0[r] + b0 : -INFINITY;
                    p1[r] = ((unsigned)(kc + 32 - cs) < 16u) ? p1[r] + b1 : -INFINITY;
                }
            }
        }
        const float rm = rowmax(p0, p1);
        if (t == 0 || __any(rm > THR)) {
            const float dl = (t == 0) ? rm : fmaxf(rm, 0.f);
            mhat += dl;
#pragma unroll
            for (int r = 0; r < 16; ++r) { p0[r] -= dl; p1[r] -= dl; negm[r] = -mhat; }
            if (t > 0) {
                const float f = __builtin_amdgcn_exp2f(-dl); l_reg *= f;
                if (hi == 0) wsf[r32] = f;
                asm volatile("s_waitcnt lgkmcnt(0)" ::: "memory");
#pragma unroll
                for (int r = 0; r < 16; ++r) { const float fr_ = wsf[crow(r, hi)]; o[0][r] *= fr_; o[1][r] *= fr_; }
                asm volatile("s_waitcnt lgkmcnt(0)" ::: "memory");
            }
        }
        float sacc = 0.f;
#pragma unroll
        for (int r = 0; r < 16; ++r) { p0[r] = __builtin_amdgcn_exp2f(p0[r]); p1[r] = __builtin_amdgcn_exp2f(p1[r]); sacc += p0[r] + p1[r]; }
        l_reg += sacc;
        u32x4 pw0, pw1, pw2, pw3;
        pw0 = (u32x4){cvtpk(p0[0], p0[1]), cvtpk(p0[2], p0[3]), cvtpk(p0[4], p0[5]), cvtpk(p0[6], p0[7])};
        pw1 = (u32x4){cvtpk(p0[8], p0[9]), cvtpk(p0[10], p0[11]), cvtpk(p0[12], p0[13]), cvtpk(p0[14], p0[15])};
        pw2 = (u32x4){cvtpk(p1[0], p1[1]), cvtpk(p1[2], p1[3]), cvtpk(p1[4], p1[5]), cvtpk(p1[6], p1[7])};
        pw3 = (u32x4){cvtpk(p1[8], p1[9]), cvtpk(p1[10], p1[11]), cvtpk(p1[12], p1[13]), cvtpk(p1[14], p1[15])};
        SBAR();
        pv(o, vb0 + slot, __builtin_bit_cast(bf16x8, pw0), __builtin_bit_cast(bf16x8, pw1), __builtin_bit_cast(bf16x8, pw2), __builtin_bit_cast(bf16x8, pw3));
    }
    { auto rr = __builtin_amdgcn_permlane32_swap(__float_as_uint(l_reg), __float_as_uint(l_reg), false, false); l_reg = __uint_as_float(rr[0]) + __uint_as_float(rr[1]); }
    if (hi == 0) wsf[32 + r32] = l_reg; asm volatile("s_waitcnt lgkmcnt(0)" ::: "memory");
    float rli[16];
#pragma unroll
    for (int r = 0; r < 16; ++r) rli[r] = __builtin_amdgcn_rcpf(wsf[32 + crow(r, hi)]);
    { LAS bf16* stg = (LAS bf16*)(shm3 + LDS_OST) + wid * 2048;
#pragma unroll
      for (int r = 0; r < 16; ++r) { const int orow = crow(r, hi);
#pragma unroll
          for (int d0 = 0; d0 < 2; ++d0) stg[orow * 64 + d0 * 32 + r32] = (bf16)(cvtpk(o[d0][r] * rli[r], 0.f) & 0xffffu); }
      asm volatile("s_waitcnt lgkmcnt(0)" ::: "memory");
#pragma unroll
      for (int i = 0; i < 4; ++i) { const int row = i * 8 + (lane >> 3), ch = lane & 7; const u32x4 v = *(const LAS u32x4*)(stg + row * 64 + ch * 8); *(u32x4*)(Ow + (size_t)row * opitch + ch * 8) = v; } }
    asm volatile("s_waitcnt vmcnt(0) lgkmcnt(0)\n\ts_barrier" ::: "memory");
#undef ATT_DMA
}
#undef SBAR
#undef WAIT_BAR0
}

struct SsmArgs { const float *lam_re, *lam_im, *log_step, *b_re, *b_im, *c_re, *c_im, *dskip;
                 const float* U; float* YF; bf16* OB; float* F; const float* h0; float* out_ssm; int layer; };
constexpr int SSM_PITCH = 132, SSM_WAVE_BYTES = 32 * SSM_PITCH * 4, LCH = 128, NLCH = 2048 / LCH;
template <int KIND, bool SECOND>
__device__ __forceinline__ void ssm_dir(const SsmArgs& A, int b, int g, int d, int k, LAS float* buf) {
    const int lane = FRESH_LANE();
    const int hi = lane >> 5, l31 = lane & 31, fr = lane & 15, fq = lane >> 4;
    const int gd = d * 16 + g;
    constexpr int CH = KIND == 0 ? 256 : LCH, NSC = CH / 32, L = KIND == 0 ? 256 : 2048;
    const int seqrow0 = KIND == 0 ? b * 256 : 4096 + b * 2048;
    const float step = expf(A.log_step[gd]);
    float ar[2], ai[2], cr[2], ci[2];
#pragma unroll
    for (int q = 0; q < 2; ++q) { const int p = l31 + 32 * q; const float lr = A.lam_re[gd * 64 + p], li = A.lam_im[gd * 64 + p];
        const float e = expf(lr * step); float s, c; sincosf(li * step, &s, &c); ar[q] = e * c; ai[q] = e * s;
        const float den = 1.0f / (lr * lr + li * li), xr = ar[q] - 1.0f; cr[q] = (xr * lr + ai[q] * li) * den; ci[q] = (ai[q] * lr - xr * li) * den; }
    float Bf[4][8];
#pragma unroll
    for (int q = 0; q < 2; ++q) { const int p = l31 + 32 * q; const float* br = A.b_re + ((size_t)gd * 64 + p) * 16; const float* bi = A.b_im + ((size_t)gd * 64 + p) * 16;
#pragma unroll
        for (int c4 = 0; c4 < 4; ++c4) { const f32x4 r = *(const f32x4*)(br + 4 * c4), im = *(const f32x4*)(bi + 4 * c4);
#pragma unroll
            for (int h2 = 0; h2 < 2; ++h2) { const float re_ = hi ? r[2 * h2 + 1] : r[2 * h2], im_ = hi ? im[2 * h2 + 1] : im[2 * h2];
                Bf[q][2 * c4 + h2] = cr[q] * re_ - ci[q] * im_; Bf[2 + q][2 * c4 + h2] = cr[q] * im_ + ci[q] * re_; } } }
    bf16x8 Cf[4];
    if (KIND != 1) {
#pragma unroll
        for (int ks = 0; ks < 4; ++ks) { const float* cp = (ks < 2 ? A.c_re : A.c_im) + ((size_t)gd * 16 + fr) * 64 + 32 * (ks & 1) + 8 * fq; const float sg = ks < 2 ? 1.0f : -1.0f;
            const f32x4 c0 = *(const f32x4*)cp * sg, c1 = *(const f32x4*)(cp + 4) * sg;
            Cf[ks] = __builtin_bit_cast(bf16x8, (u32x4){cvtpk(c0[0], c0[1]), cvtpk(c0[2], c0[3]), cvtpk(c1[0], c1[1]), cvtpk(c1[2], c1[3])}); }
    }
    const float sar = hi ? ar[1] : ar[0], sai = hi ? ai[1] : ai[0];
    float hr = 0.f, hm = 0.f;
    if (KIND == 2) {
        const size_t so = ((((size_t)(b * 2 + A.layer) * 2 + d) * 2) * 16 + g) * 64 + lane;
        hr = A.h0[so]; hm = A.h0[so + 16 * 64];
        float pr = sar, pi = sai;
#pragma unroll
        for (int i = 0; i < 7; ++i) { const float nr = pr * pr - pi * pi, ni = 2.0f * pr * pi; pr = nr; pi = ni; }
        static_assert(LCH == 128, "power");
        const float* Fp = A.F + ((((size_t)(b * 16 + g) * 2 + d) * NLCH) * 2) * 64 + lane;
        float fre[NLCH - 1], fim[NLCH - 1];
#pragma unroll
        for (int kk = 0; kk < NLCH - 1; ++kk) { fre[kk] = Fp[(size_t)kk * 128]; fim[kk] = Fp[(size_t)kk * 128 + 64]; }
#pragma unroll
        for (int kk = 0; kk < NLCH - 1; ++kk) if (kk < k) { const float nr = pr * hr - pi * hm + fre[kk], ni = pr * hm + pi * hr + fim[kk]; hr = nr; hm = ni; }
    }
    float dsk = 0.f; if (KIND != 1 && SECOND) dsk = A.dskip[g * 16 + fr];
    f32x4 un[4];
    { const int s = CH * k + l31; const int t = d ? L - 1 - s : s; const float* up = A.U + (size_t)(seqrow0 + t) * 256 + g * 16;
#pragma unroll
      for (int c4 = 0; c4 < 4; ++c4) un[c4] = *(const f32x4*)(up + 4 * c4); }
    for (int sc = 0; sc < NSC; ++sc) {
        const int s0 = CH * k + 32 * sc;
        float ua[8];
#pragma unroll
        for (int c4 = 0; c4 < 4; ++c4) { ua[2 * c4] = hi ? un[c4][1] : un[c4][0]; ua[2 * c4 + 1] = hi ? un[c4][3] : un[c4][2]; }
        if (sc + 1 < NSC) { const int s = s0 + 32 + l31; const int t = d ? L - 1 - s : s; const float* up = A.U + (size_t)(seqrow0 + t) * 256 + g * 16;
#pragma unroll
            for (int c4 = 0; c4 < 4; ++c4) un[c4] = *(const f32x4*)(up + 4 * c4); }
#pragma unroll
        for (int n = 0; n < 4; ++n) { f32x16 D = f32x16{};
#pragma unroll
            for (int kk = 0; kk < 8; ++kk) D = __builtin_amdgcn_mfma_f32_32x32x2f32(ua[kk], Bf[n][kk], D, 0, 0, 0);
#pragma unroll
            for (int r = 0; r < 16; ++r) buf[crow(r, hi) * SSM_PITCH + 32 * n + l31] = D[r]; }
        { float sre[32], sim[32];
#pragma unroll
          for (int j = 0; j < 32; ++j) { sre[j] = buf[j * SSM_PITCH + lane]; sim[j] = buf[j * SSM_PITCH + 64 + lane]; }
#pragma unroll
          for (int j = 0; j < 32; ++j) { const float nr = fmaf(sar, hr, fmaf(-sai, hm, sre[j])), ni = fmaf(sar, hm, fmaf(sai, hr, sim[j])); hr = nr; hm = ni; sre[j] = hr; sim[j] = hm; }
          if (KIND != 1) {
#pragma unroll
              for (int j = 0; j < 32; ++j) { buf[j * SSM_PITCH + lane] = sre[j]; buf[j * SSM_PITCH + 64 + lane] = sim[j]; } } }
        if (KIND != 1) {
            size_t oo[2][4]; float yv[2][4], uv[2][4];
#pragma unroll
            for (int rt = 0; rt < 2; ++rt)
#pragma unroll
                for (int r = 0; r < 4; ++r) { const int s = s0 + 16 * rt + 4 * fq + r; const int t = d ? L - 1 - s : s; oo[rt][r] = (size_t)(seqrow0 + t) * 256 + g * 16 + fr;
                    if (SECOND) { yv[rt][r] = A.YF[oo[rt][r]]; uv[rt][r] = A.U[oo[rt][r]]; } }
            f32x4 acc2[2];
#pragma unroll
            for (int rt = 0; rt < 2; ++rt) { f32x4 acc = {0.f, 0.f, 0.f, 0.f};
#pragma unroll
                for (int ks = 0; ks < 4; ++ks) { const LAS float* hp = buf + (16 * rt + fr) * SSM_PITCH + 32 * ks + 8 * fq; const f32x4 h0 = *(const LAS f32x4*)hp, h1 = *(const LAS f32x4*)(hp + 4);
                    const bf16x8 ahh = __builtin_bit_cast(bf16x8, (u32x4){cvtpk(h0[0], h0[1]), cvtpk(h0[2], h0[3]), cvtpk(h1[0], h1[1]), cvtpk(h1[2], h1[3])});
                    acc = __builtin_amdgcn_mfma_f32_16x16x32_bf16(ahh, Cf[ks], acc, 0, 0, 0); }
                acc2[rt] = acc; }
#pragma unroll
            for (int rt = 0; rt < 2; ++rt)
#pragma unroll
                for (int r = 0; r < 4; ++r) {
                    if (!SECOND) A.YF[oo[rt][r]] = acc2[rt][r];
                    else { const float v = acc2[rt][r] + yv[rt][r] + dsk * uv[rt][r]; const float q = 0.5f * v * (1.0f + tanhf(0.7978845608028654f * (v + 0.044715f * v * v * v)));
                           A.OB[oo[rt][r]] = (bf16)(cvtpk(q, 0.f) & 0xffffu); } }
        }
    }
    if (KIND == 0) { const size_t so = ((((size_t)(b * 2 + A.layer) * 2 + d) * 2) * 16 + g) * 64 + lane; A.out_ssm[so] = hr; A.out_ssm[so + 16 * 64] = hm; }
    if (KIND == 1) { const size_t fo = ((((size_t)(b * 16 + g) * 2 + d) * NLCH + k) * 2) * 64 + lane; A.F[fo] = hr; A.F[fo + 64] = hm; }
}
template <int KIND> __device__ __forceinline__ void ssm_both(const SsmArgs& A, int b, int g, int c, LAS float* buf) {
    ssm_dir<KIND, false>(A, b, g, 0, c, buf);
    asm volatile("s_waitcnt vmcnt(0)" ::: "memory");
    ssm_dir<KIND, true>(A, b, g, 1, (KIND == 0 ? 0 : NLCH - 1 - c), buf);
}

__device__ __forceinline__ void norm_mod_rows(const float* xc, const float* xl, const float* g, const float* mod, int sh_off, int sc_off, bf16* H, int gw, int NGW, int lane) {
    for (int row = gw; row < M_TOK; row += NGW) {
        const float* xr = row < 4096 ? xc + (size_t)row * 1024 : xl + (size_t)(row - 4096) * 1024;
        const int cv = row < 4096 ? 0 : 1 + ((row - 4096) >> 11);
        f32x4 v[4]; float ss = 0.f;
#pragma unroll
        for (int j = 0; j < 4; ++j) { v[j] = *(const f32x4*)(xr + 4 * (lane + 64 * j)); ss += (v[j][0] * v[j][0] + v[j][1] * v[j][1]) + (v[j][2] * v[j][2] + v[j][3] * v[j][3]); }
        const float rstd = rsqrtf(wave_sum(ss) * (1.0f / 1024.0f) + EPS);
        const float* mp = mod + cv * 6144;
#pragma unroll
        for (int j = 0; j < 4; ++j) { const int c = 4 * (lane + 64 * j); const f32x4 gg = *(const f32x4*)(g + c), sc = *(const f32x4*)(mp + sc_off + c), sh = *(const f32x4*)(mp + sh_off + c);
            const f32x4 o = v[j] * rstd * gg * (sc + 1.0f) + sh; u32x2 w; w.x = cvtpk(o[0], o[1]); w.y = cvtpk(o[2], o[3]); *(u32x2*)(H + (size_t)row * 1024 + c) = w; }
    }
}
__device__ __forceinline__ void final_norm_rows(float* x, const float* g, int gw, int NGW, int lane) {
    for (int row = gw; row < M_TOK; row += NGW) {
        float* xr = x + (size_t)row * 1024;
        f32x4 v[4]; float ss = 0.f;
#pragma unroll
        for (int j = 0; j < 4; ++j) { v[j] = *(const f32x4*)(xr + 4 * (lane + 64 * j)); ss += (v[j][0] * v[j][0] + v[j][1] * v[j][1]) + (v[j][2] * v[j][2] + v[j][3] * v[j][3]); }
        const float rstd = rsqrtf(wave_sum(ss) * (1.0f / 1024.0f) + EPS);
#ifdef DBG_SCALE_S
        const float dsc = row >= 4096 ? DBG_SCALE_S : DBG_SCALE_P;
#else
        const float dsc = 1.0f;
#endif
#pragma unroll
        for (int j = 0; j < 4; ++j) { const int c = 4 * (lane + 64 * j); *(f32x4*)(xr + c) = v[j] * (rstd * dsc) * *(const f32x4*)(g + c); }
    }
}

__device__ __forceinline__ int maprow(int mode, int n) {
    if (mode == 1) { const int lc = n & 255; return (n & ~255) + 128 * ((lc >> 5) & 1) + 32 * (lc >> 6) + (lc & 31); }
    if (mode == 2) { if (n < DFF) return 256 * (n >> 7) + (n & 127); const int n2 = n - DFF; return 256 * (n2 >> 7) + 128 + (n2 & 127); }
    return n;
}
__device__ __forceinline__ void transpose_item(const float* W, int K, int N, bf16* WT, int mode, LAS float* scr, int item, int lane) {
    const int nblk = N / 32, kb = item / nblk, nb = item % nblk, k0 = 64 * kb, n0 = 32 * nb;
#pragma unroll
    for (int i = 0; i < 32; ++i) { const int kk = 2 * i + (lane >> 5); scr[kk * 33 + (lane & 31)] = W[(size_t)(k0 + kk) * N + n0 + (lane & 31)]; }
    asm volatile("s_waitcnt lgkmcnt(0)" ::: "memory");
    const int c = lane & 7;
#pragma unroll
    for (int j = 0; j < 4; ++j) { const int n = (lane >> 3) + 8 * j; const LAS float* s = scr + (8 * c) * 33 + n;
        u32x4 o; o.x = cvtpk(s[0 * 33], s[1 * 33]); o.y = cvtpk(s[2 * 33], s[3 * 33]); o.z = cvtpk(s[4 * 33], s[5 * 33]); o.w = cvtpk(s[6 * 33], s[7 * 33]);
        *(u32x4*)(WT + (size_t)maprow(mode, n0 + n) * K + k0 + 8 * c) = o; }
    asm volatile("s_waitcnt lgkmcnt(0)" ::: "memory");
}

struct Args { const float* in[33]; float* out; unsigned char* ws; int ph_lo, ph_hi; };
constexpr int N_PHASES = 20;

__global__ void __launch_bounds__(512, 2) mega_fwd(Args args) {
    extern __shared__ __attribute__((aligned(16))) unsigned char lds[];
    LAS unsigned char* L = (LAS unsigned char*)lds;
    cg::grid_group grid = cg::this_grid();
    unsigned* barw = (unsigned*)(args.ws + WS_BAR);
    volatile LAS unsigned* bst = (volatile LAS unsigned*)((LAS unsigned char*)lds + LDS_BYTES - 64);
    if (threadIdx.x == 0) { bst[0] = 0u; bst[1] = 0u; }
    if (blockIdx.x == 0) { for (int i = threadIdx.x; i < XCD_BAR_WORDS; i += 512) barw[i] = 0u; if (threadIdx.x < 64) ((unsigned*)(args.ws + WS_FLAG))[threadIdx.x] = 0u; }
    __syncthreads();
    XcdBarrier xbar; xbar.bar = barw; xbar.x = 0; xbar.st = bst;
    const int wave0 = __builtin_amdgcn_readfirstlane(threadIdx.x >> 6);
#ifdef DBG_XSYNC
    for (int i = 0; i < DBG_XSYNC; ++i) grid.sync();
#endif
#ifdef DBG_DUP
    int dup_done = -1;
#endif
    for (int ph = args.ph_lo; ph < args.ph_hi; ++ph) {
        if (ph > args.ph_lo) { if (ph == args.ph_lo + 1) { grid.sync(); xbar = xcd_barrier_post(barw, bst); } else xcd_barrier(xbar); }
        int wave = wave0; asm volatile("" : "+s"(wave)); int G = gridDim.x; asm volatile("" : "+s"(G)); int bx = blockIdx.x; asm volatile("" : "+s"(bx));
    const int gw = bx * 8 + wave, NGW = G * 8;
    unsigned char* ws = args.ws; asm volatile("" : "+s"(ws)); float* out = args.out; asm volatile("" : "+s"(out));
    float* MOD = (float*)(ws + WS_MOD); float* ROPE = (float*)(ws + WS_ROPE);
    bf16* Hb = (bf16*)(ws + WS_H); float* YF = (float*)(ws + WS_H);
    bf16 *QA = (bf16*)(ws + WS_QA), *KA = (bf16*)(ws + WS_KA), *VA = (bf16*)(ws + WS_VA), *QC = (bf16*)(ws + WS_QC), *KC = (bf16*)(ws + WS_KC), *VC = (bf16*)(ws + WS_VC);
    float* Ub = (float*)(ws + WS_U); bf16* MF = (bf16*)(ws + WS_QKVU);
    bf16* GATES = (bf16*)(ws + WS_GATES); bf16* ACT = (bf16*)(ws + WS_GATES);
    bf16 *OA = (bf16*)(ws + WS_OA), *OB = (bf16*)(ws + WS_OB), *OC = (bf16*)(ws + WS_OC);
    bf16 *CKAK = (bf16*)(ws + WS_CKAK), *CKAV = (bf16*)(ws + WS_CKAV), *CKCK = (bf16*)(ws + WS_CKCK), *CKCV = (bf16*)(ws + WS_CKCV);
    float* SSMF = (float*)(ws + WS_SSMF2); unsigned* FLAGS = (unsigned*)(ws + WS_FLAG);

        if (ph == 0) {
#ifdef DBG_DUP_P0
            for (int rep0 = 0; rep0 < 2; ++rep0) {
#endif
            const int lane = FRESH_LANE(), tid = wave * 64 + lane;
            LAS float* S = (LAS float*)(L + 69632);
            LAS float* red = (LAS float*)(L + 90112);
            if (bx < 192) {
                for (int i = tid; i < 5 * 1024; i += 512) { const int cv = i >> 10, kx = i & 1023; const float c = cv == 0 ? args.in[8][kx] : args.in[2][(cv - 1) * 1024 + kx]; S[i] = c / (1.0f + __expf(-c)); }
                __syncthreads();
                for (int item = bx; item < 192; item += G) {
                    const int l = item / 96, col = (item % 96) * 64 + lane;
                    const float* wp = args.in[9] + (size_t)l * 1024 * 6144 + col;
                    float a0 = 0.f, a1 = 0.f, a2 = 0.f, a3 = 0.f, a4 = 0.f;
#pragma unroll 16
                    for (int kk = 0; kk < 128; ++kk) { const int kx = wave * 128 + kk; const float w = wp[(size_t)kx * 6144];
                        a0 += S[kx] * w; a1 += S[1024 + kx] * w; a2 += S[2048 + kx] * w; a3 += S[3072 + kx] * w; a4 += S[4096 + kx] * w; }
                    red[(wave * 5 + 0) * 64 + lane] = a0; red[(wave * 5 + 1) * 64 + lane] = a1; red[(wave * 5 + 2) * 64 + lane] = a2; red[(wave * 5 + 3) * 64 + lane] = a3; red[(wave * 5 + 4) * 64 + lane] = a4;
                    __syncthreads();
                    if (wave < 5) { float s = args.in[10][l * 6144 + col];
#pragma unroll
                        for (int w8 = 0; w8 < 8; ++w8) s += red[(w8 * 5 + wave) * 64 + lane];
                        MOD[(l * 5 + wave) * 6144 + col] = s; }
                    __syncthreads();
                }
            }
            if (bx == G - 2 && tid < 256) { const int ll = tid >> 7, qk = (tid >> 6) & 1, e = tid & 63; ((float*)(ws + WS_QKG))[tid] = (qk ? args.in[14] : args.in[13])[ll * 64 + e]; }
            { const int gtid = bx * 512 + tid, NTH = G * 512;
#define CPY(idx, off, n) for (int i = gtid; i < (n) / 4; i += NTH) ((f32x4*)(ws + WS_PAR) + (off) / 4)[i] = ((const f32x4*)args.in[idx])[i];
              CPY(11, P_N1G, 2048) CPY(29, P_N2G, 2048) CPY(32, P_FING, 1024) CPY(7, P_SSM0, 32768) CPY(15, P_LAMR, 4096) CPY(16, P_LAMI, 4096) CPY(17, P_LSTEP, 64)
              CPY(18, P_BRE, 65536) CPY(19, P_BIM, 65536) CPY(20, P_CRE, 65536) CPY(21, P_CIM, 65536) CPY(22, P_SSMD, 512) CPY(24, P_NAB, 3720)
#undef CPY
            }
            if (bx == G - 1) { for (int i = tid; i < 1024; i += 512) { const int pos = i >> 4, f = i & 15; const float inv = 1.0f / powf(10000.0f, (float)f / 16.0f); const float ang = (float)pos * inv; ROPE[2 * i] = cosf(ang); ROPE[2 * i + 1] = sinf(ang); } }
            for (int it = bx * 512 + tid; it < 196608; it += G * 512) {
                const float* src; bf16* dst; int e;
                if (it < 65536) { const bool isv = it >= 32768; e = (it & 32767) * 8; const int d = e & 63, t = (e >> 6) & 255, h = (e >> 14) & 1, b = (e >> 15) & 3, l = e >> 17;
                    src = (isv ? args.in[4] : args.in[3]) + ((((size_t)(b * 2 + l) * 256 + t) * 2 + h) * 64 + d); dst = (isv ? CKAV : CKAK) + e; }
                else { const int i2 = it - 65536; const bool isv = i2 >= 65536; e = (i2 & 65535) * 8; const int d = e & 63, t = (e >> 6) & 255, h = (e >> 14) & 3, b = (e >> 16) & 3, l = e >> 18;
                    src = (isv ? args.in[6] : args.in[5]) + ((((size_t)(b * 2 + l) * 256 + t) * 4 + h) * 64 + d); dst = (isv ? CKCV : CKCK) + e; }
                const f32x4 a = *(const f32x4*)src, c = *(const f32x4*)(src + 4);
                *(u32x4*)dst = (u32x4){cvtpk(a[0], a[1]), cvtpk(a[2], a[3]), cvtpk(c[0], c[1]), cvtpk(c[2], c[3])};
            }
            LAS float* scr = (LAS float*)(L + wave * 8448);
            for (int it = gw; it < 15424; it += NGW) {
                const int l = it / 7712; int r = it % 7712;
                if (r < 2432) { transpose_item(args.in[12] + (size_t)l * DM * NIN, DM, NIN, (bf16*)(ws + W_IN) + (size_t)l * NIN * DM, 1, scr, r, lane); continue; } r -= 2432;
                if (r < 256) { transpose_item(args.in[25] + (size_t)l * 512 * DM, 512, DM, (bf16*)(ws + W_BRA) + (size_t)l * DM * 512, 0, scr, r, lane); continue; } r -= 256;
                if (r < 128) { transpose_item(args.in[26] + (size_t)l * 256 * DM, 256, DM, (bf16*)(ws + W_BRB) + (size_t)l * DM * 256, 0, scr, r, lane); continue; } r -= 128;
                if (r < 128) { transpose_item(args.in[27] + (size_t)l * 256 * DM, 256, DM, (bf16*)(ws + W_BRC) + (size_t)l * DM * 256, 0, scr, r, lane); continue; } r -= 128;
                if (r < 512) { transpose_item(args.in[28] + (size_t)l * DM * DM, DM, DM, (bf16*)(ws + W_OUT) + (size_t)l * DM * DM, 0, scr, r, lane); continue; } r -= 512;
                if (r < 2816) { transpose_item(args.in[30] + (size_t)l * DM * NGU, DM, NGU, (bf16*)(ws + W_GU) + (size_t)l * NGU * DM, 2, scr, r, lane); continue; } r -= 2816;
                if (r < 1408) { transpose_item(args.in[31] + (size_t)l * DFF * DM, DFF, DM, (bf16*)(ws + W_FD) + (size_t)l * DM * DFF, 0, scr, r, lane); continue; } r -= 1408;
                transpose_item(args.in[23] + (size_t)l * 256 * 256, 256, 256, (bf16*)(ws + W_GLU) + (size_t)l * 256 * 256, 0, scr, r, lane);
            }
            __syncthreads();
#ifdef DBG_DUP_P0
            }
#endif
            continue;
        }
        const float* const PAR = (const float*)(ws + WS_PAR);
        if (ph == N_PHASES - 1) { const int lane = FRESH_LANE(); final_norm_rows(out, PAR + P_FING, gw, NGW, lane); continue; }
        const int l = (ph - 1) / 9, sp = (ph - 1) % 9;
        const float* modl = MOD + (size_t)l * 5 * 6144;
        const float* xc_in = args.in[0]; const float* xl_in = args.in[1];
        const float* xc_cur = out; const float* xl_cur = out + (size_t)4096 * 1024;
        pg8::StaticOrder S;
        switch (sp) {
        case 0: {
            const bool first = (l == 0); const int lane = FRESH_LANE();
            norm_mod_rows(first ? xc_in : xc_cur, first ? xl_in : xl_cur, PAR + P_N1G + l * 1024, modl, 0, 1024, Hb, gw, NGW, lane);
        } break;
        case 1: {
            pg8::Gemm g{Hb, (const bf16*)(ws + W_IN) + (size_t)l * NIN * DM, M_TOK, NIN, DM}; S.init(M_TOK, NIN, G, bx);
            EpiIn E{ws, out, l};

#ifndef CUT_IN
            pg8::gemm_phase<EpiIn, pg8::StaticOrder, true, true>(L, g, S, E, wave);
#endif

        } break;
        case 2: {
            SsmArgs SA{PAR + P_LAMR + l * 2048, PAR + P_LAMI + l * 2048, PAR + P_LSTEP + l * 32, PAR + P_BRE + (size_t)l * 32768, PAR + P_BIM + (size_t)l * 32768, PAR + P_CRE + (size_t)l * 32768, PAR + P_CIM + (size_t)l * 32768,
                       PAR + P_SSMD + l * 256, Ub, YF, OB, SSMF, PAR + P_SSM0, out + O_SSM, l};
            volatile LAS unsigned* qslot = (volatile LAS unsigned*)((LAS unsigned char*)lds + LDS_BYTES - 32);
            for (;;) {
                __syncthreads();
                if (wave == 0 && FRESH_LANE() == 0) qslot[0] = __hip_atomic_fetch_add(FLAGS + 56 + l, 1u, __ATOMIC_RELAXED, __HIP_MEMORY_SCOPE_AGENT);
                __syncthreads();
                int item = (int)qslot[0]; item = __builtin_amdgcn_readfirstlane(item);
                if (item >= 864) break;
                if (item >= 256) { if (item < 288) item += 128; else if (item < 416) item -= 32; }
                if (item < 256) {
                    const int b = item >> 6, h = (item >> 3) & 7, qb = item & 7, kvh = h >> 2;
                    const bf16* Qw = QA + ((size_t)4096 * 8 + (size_t)(b * 8 + h) * 2048 + qb * 256 + wave * 32) * 64;
                    const size_t co = ((size_t)((l * 4 + b) * 2 + kvh) * 256) * 64, lo = ((size_t)4096 * 2 + (size_t)(b * 2 + kvh) * 2048) * 64;
                    bf16* Ow = OA + ((size_t)4096 + b * 2048 + qb * 256 + wave * 32) * 512 + h * 64;
                    att::attn_unit<false>(Qw, CKAK + co, CKAV + co, KA + lo, VA + lo, 36, Ow, 512, (char*)lds, 0, 0, nullptr, wave);
                } else if (item < 384) {
                    const int i = item - 256, b = i >> 5, h = (i >> 3) & 3, qb = i & 7, r0 = 4 * qb;
                    const int rlo = clampi(r0 - 4, 0, 24), rhi = clampi(r0 - 1, 0, 24) + 7, NT = 4 + rhi - rlo + 1;
                    const bf16* Qw = QC + ((size_t)4096 * 4 + (size_t)(b * 4 + h) * 2048 + qb * 256 + wave * 32) * 64;
                    const size_t co = ((size_t)((l * 4 + b) * 4 + h) * 256) * 64, lo = ((size_t)4096 * 4 + (size_t)(b * 4 + h) * 2048 + rlo * 64) * 64;
                    bf16* Ow = OC + ((size_t)4096 + b * 2048 + qb * 256 + wave * 32) * 256 + h * 64;
                    att::attn_unit<true>(Qw, CKCK + co, CKCV + co, KC + lo, VC + lo, NT, Ow, 256, (char*)lds, r0 + (wave >> 1), rlo, PAR + P_NAB + (size_t)(l * 4 + h) * 465, wave);
                } else if (item < 416) {
                    const int wu = (item - 384) * 8 + wave;
                    ssm_both<0>(SA, wu >> 4, wu & 15, 0, (LAS float*)(L + wave * SSM_WAVE_BYTES));
                    asm volatile("s_waitcnt vmcnt(0) lgkmcnt(0)" ::: "memory"); __syncthreads();
                } else if (item < 672) {
                    const int wu = (item - 416) * 8 + wave;
                    ssm_dir<1, false>(SA, wu >> 9, (wu >> 5) & 15, (wu >> 4) & 1, wu & 15, (LAS float*)(L + wave * SSM_WAVE_BYTES));
                    asm volatile("s_waitcnt vmcnt(0) lgkmcnt(0)" ::: "memory"); __syncthreads();
                } else if (item < 800) {
                    const int i = item - 672, b = i >> 3, h = i & 7, kvh = h >> 2;
                    const bf16* Qw = QA + ((size_t)(b * 8 + h) * 256 + wave * 32) * 64;
                    const size_t co = ((size_t)(b * 2 + kvh) * 256) * 64;
                    bf16* Ow = OA + ((size_t)b * 256 + wave * 32) * 512 + h * 64;
                    att::attn_unit<false>(Qw, KA + co, VA + co, KA, VA, 4, Ow, 512, (char*)lds, 0, 0, nullptr, wave);
                } else {
                    const int i = item - 800, b = i >> 2, h = i & 3;
                    const bf16* Qw = QC + ((size_t)(b * 4 + h) * 256 + wave * 32) * 64;
                    const size_t co = ((size_t)(b * 4 + h) * 256) * 64;
                    bf16* Ow = OC + ((size_t)b * 256 + wave * 32) * 256 + h * 64;
                    att::attn_unit<false>(Qw, KC + co, VC + co, KC, VC, 4, Ow, 256, (char*)lds, 0, 0, nullptr, wave);
                }
            }
        } break;
        case 3: {
            SsmArgs SA{PAR + P_LAMR + l * 2048, PAR + P_LAMI + l * 2048, PAR + P_LSTEP + l * 32, PAR + P_BRE + (size_t)l * 32768, PAR + P_BIM + (size_t)l * 32768, PAR + P_CRE + (size_t)l * 32768, PAR + P_CIM + (size_t)l * 32768,
                       PAR + P_SSMD + l * 256, Ub, YF, OB, SSMF, PAR + P_SSM0, out + O_SSM, l};
            for (int wu = wave * G + bx; wu < 1024; wu += 8 * G) ssm_both<2>(SA, wu >> 8, (wu >> 4) & 15, wu & 15, (LAS float*)(L + wave * SSM_WAVE_BYTES));
            asm volatile("s_waitcnt vmcnt(0) lgkmcnt(0)" ::: "memory");
            __syncthreads();
        } break;
        case 4: {
            pg8::StaticOrder SG; SG.init(M_TOK, 256, G, bx); Unit ug;
            if (SG.next(0, ug)) {
                pg8::Gemm g{OB, (const bf16*)(ws + W_GLU) + (size_t)l * 256 * 256, M_TOK, 256, 256};
                EpiGlu E{OB};
                pg8::gemm_phase<EpiGlu, pg8::StaticOrder, true, true>(L, g, SG, E, wave);
                asm volatile("s_waitcnt vmcnt(0)" ::: "memory");
                __syncthreads();
                if (wave == 0) { __builtin_amdgcn_fence(__ATOMIC_RELEASE, "agent"); asm volatile("s_waitcnt vmcnt(0)" ::: "memory");
                    if (FRESH_LANE() == 0) __hip_atomic_store(FLAGS + ug.pm, (unsigned)(l + 1), __ATOMIC_RELAXED, __HIP_MEMORY_SCOPE_AGENT); }
            }
            S.init(M_TOK, DM, G, bx);
            { pg8::Gemm g{OA, (const bf16*)(ws + W_BRA) + (size_t)l * DM * 512, M_TOK, DM, 512}; EpiBr<0> E{GATES, MF, nullptr}; pg8::gemm_phase<EpiBr<0>, pg8::StaticOrder, true, true>(L, g, S, E, wave); }
            { pg8::Gemm g{OC, (const bf16*)(ws + W_BRC) + (size_t)l * DM * 256, M_TOK, DM, 256}; EpiBr<1> E{GATES + 2048, MF, nullptr}; pg8::gemm_phase<EpiBr<1>, pg8::StaticOrder, true, true>(L, g, S, E, wave); }
            { Unit ub; if (S.next(0, ub)) {
                if (wave == 0) { unsigned sp_ = 0; while (__hip_atomic_load(FLAGS + ub.pm, __ATOMIC_RELAXED, __HIP_MEMORY_SCOPE_AGENT) < (unsigned)(l + 1)) { __builtin_amdgcn_s_sleep(2); if (++sp_ > (1u << 24)) break; }
                    __builtin_amdgcn_fence(__ATOMIC_ACQUIRE, "agent"); asm volatile("s_waitcnt vmcnt(0)" ::: "memory"); }
                __syncthreads(); } }
            { pg8::Gemm g{OB, (const bf16*)(ws + W_BRB) + (size_t)l * DM * 256, M_TOK, DM, 256}; EpiBr<2> E{GATES + 1024, MF, Hb}; pg8::gemm_phase<EpiBr<2>, pg8::StaticOrder, true, true>(L, g, S, E, wave); }
        } break;
        case 5: {
            S.init(M_TOK, DM, G, bx);
            pg8::Gemm g{Hb, (const bf16*)(ws + W_OUT) + (size_t)l * DM * DM, M_TOK, DM, DM};
            EpiRes E{l == 0 ? xc_in : xc_cur, l == 0 ? xl_in : xl_cur, out, modl + 2048};
            pg8::gemm_phase<EpiRes, pg8::StaticOrder, true, true>(L, g, S, E, wave);
        } break;
        case 6: {
            const int lane = FRESH_LANE();
            norm_mod_rows(xc_cur, xl_cur, PAR + P_N2G + l * 1024, modl, 3072, 4096, Hb, gw, NGW, lane);
        } break;
        case 7: {
            pg8::Gemm g{Hb, (const bf16*)(ws + W_GU) + (size_t)l * NGU * DM, M_TOK, NGU, DM}; S.init(M_TOK, NGU, G, bx);
            EpiSwiglu E{ACT};
            pg8::gemm_phase<EpiSwiglu, pg8::StaticOrder, true, true>(L, g, S, E, wave);
        } break;
        case 8: {
            S.init(M_TOK, DM, G, bx);
            pg8::Gemm g{ACT, (const bf16*)(ws + W_FD) + (size_t)l * DM * DFF, M_TOK, DM, DFF};
            EpiRes E{xc_cur, xl_cur, out, modl + 5120};
            pg8::gemm_phase<EpiRes, pg8::StaticOrder, true, true>(L, g, S, E, wave);
        } break;
        }
#ifdef DBG_DUP
        if (sp == DBG_DUP && dup_done != ph) { dup_done = ph; --ph; }
#endif
    }
}

extern "C" void kernel_launch(void* const* d_in, const int* in_sizes, int n_in, void* d_out, int out_size, void* d_ws, size_t ws_size, hipStream_t stream) {
    static int grid = 0;
    if (grid == 0) {
        if (n_in != 33 || ws_size < WS_END) { fprintf(stderr, "kernel_launch: unexpected n_in %d / ws_size %zu\n", n_in, ws_size); grid = -1; return; }
        int dev = 0, cus = 0, per_cu = 0;
        hipGetDevice(&dev); hipDeviceGetAttribute(&cus, hipDeviceAttributeMultiprocessorCount, dev);
        if (hipFuncSetAttribute((const void*)mega_fwd, hipFuncAttributeMaxDynamicSharedMemorySize, LDS_BYTES) != hipSuccess) { fprintf(stderr, "kernel_launch: hipFuncSetAttribute failed\n"); grid = -1; return; }
        if (hipOccupancyMaxActiveBlocksPerMultiprocessor(&per_cu, (const void*)mega_fwd, 512, LDS_BYTES) != hipSuccess || per_cu < 1) { fprintf(stderr, "kernel_launch: occupancy query says %d\n", per_cu); per_cu = 1; }
        (void)hipGetLastError();
        grid = cus * 1;
        fprintf(stderr, "kernel_launch: cus %d per_cu %d grid %d ws %zu\n", cus, per_cu, grid, ws_size);
    }
    if (grid < 0) return;
    Args a{};
    for (int i = 0; i < 33; ++i) a.in[i] = (const float*)d_in[i];
    a.out = (float*)d_out; a.ws = (unsigned char*)d_ws;
#if MK_MULTI
    for (int ph = 0; ph < N_PHASES; ++ph) { a.ph_lo = ph; a.ph_hi = ph + 1; hipLaunchKernelGGL(mega_fwd, dim3(grid), dim3(512), LDS_BYTES, stream, a); }
#else
    a.ph_lo = 0; a.ph_hi = N_PHASES;
    void* kargs[] = {&a};
    hipError_t e = hipLaunchCooperativeKernel((const void*)mega_fwd, dim3(grid), dim3(512), kargs, LDS_BYTES, stream);
    if (e != hipSuccess) fprintf(stderr, "cooperative launch failed: %s (grid %d)\n", hipGetErrorString(e), grid);
#endif
}
```

```cpp
#include <hip/hip_runtime.h>
#include <hip/hip_cooperative_groups.h>
#include <hip/hip_bf16.h>
#include <cstdio>
#include <cstdint>
namespace cg = cooperative_groups;

#ifndef MK_MULTI
#define MK_MULTI 0
#endif

namespace pg8 {
#define PG8_LAS __attribute__((address_space(3)))
typedef unsigned short bf16_t;
typedef short bf16x8 __attribute__((ext_vector_type(8)));
typedef float f32x4 __attribute__((ext_vector_type(4)));
typedef unsigned u32x4 __attribute__((ext_vector_type(4)));
constexpr int BM = 256, BK = 64, HALF = 128, HTB = HALF * BK * 2  , STAGE_BYTES = 8 * HTB, NXCD = 8, WGM = 8;

__host__ __device__ __forceinline__ int lds_byte(int r, int c) { const int st = (r >> 4) * 2 + (c >> 5), rr = r & 15, cc = c & 31, ob = rr * 64 + cc * 2; return st * 1024 + (ob ^ (((ob >> 9) & 1) << 5)); }
__host__ __device__ __forceinline__ void stage_rc(int b, int& R, int& C) { const int st = b / 1024, sb = b % 1024, swz = sb ^ (((sb >> 9) & 1) << 5); R = (st >> 1) * 16 + swz / 64; C = (st & 1) * 32 + (swz % 64) / 2; }
__host__ __device__ __forceinline__ int perm32(int rho) { const int n = rho >> 4, i = rho & 15; return 8 * (i >> 2) + 4 * n + (i & 3); }

struct Unit { int pm, pn; };
struct Gemm { const bf16_t* A; const bf16_t* Bt; int M, N, K; };

struct StaticOrder {
    int nM, nN, nwg, G, c;
    __host__ __device__ void init(int M, int N, int G_, int c_) { nM = M / BM; nN = N / BM; nwg = nM * nN; G = G_; c = c_; }
    __host__ __device__ bool next(int i, Unit& u) const {
        const long L = (long)i * G + c; if (L >= nwg) return false;
        int wgid = (int)L; { const int q = nwg / NXCD, r = nwg % NXCD, xcd = wgid % NXCD, off = wgid / NXCD; wgid = (xcd < r ? xcd * (q + 1) : r * (q + 1) + (xcd - r) * q) + off; }
        const int nig = WGM * nN, gid = wgid / nig, fm = gid * WGM, gsz = (nM - fm) < WGM ? (nM - fm) : WGM;
        u.pm = fm + ((wgid % nig) % gsz); u.pn = (wgid % nig) / gsz; return true;
    }
    __device__ __forceinline__ void a_ready(const Unit&) const {}
    __device__ __forceinline__ void done(const Unit&) const {}
};

__device__ __forceinline__ unsigned cvt_pk_bf16(float lo, float hi) { unsigned r; asm volatile("v_cvt_pk_bf16_f32 %0, %1, %2" : "=v"(r) : "v"(lo), "v"(hi)); return r; }
typedef float f32x2 __attribute__((ext_vector_type(2)));
template <class Epi, class Sched, bool ALIGN_EPI = false, bool SP2 = false>
__device__ __forceinline__ void gemm_phase(PG8_LAS unsigned char* lds, const Gemm g, const Sched& S, const Epi& E, const int wid) {
    int lane; asm volatile("v_mbcnt_lo_u32_b32 %0, -1, 0\n\tv_mbcnt_hi_u32_b32 %0, -1, %0" : "=v"(lane)); const int tid = wid * 64 + lane, wr = wid >> 2, wc = wid & 3, fr = lane & 15, fq = lane >> 4;
    const int K = g.K, nt = K / BK;
    unsigned voffA[2], voffB[2];
#pragma unroll
    for (int i = 0; i < 2; ++i) { int R, C; stage_rc(tid * 16 + i * 8192, R, C); const int Rb = Epi::PERM ? ((R & ~31) + perm32(R & 31)) : R;
        voffA[i] = (unsigned)(R * K + C) * 2u; voffB[i] = (unsigned)(Rb * K + C) * 2u; }
    const size_t kstep = (size_t)(BK * 2);
    const size_t hstep = (size_t)HALF * K * 2;
    const size_t tstep = 2 * hstep;
    const unsigned ldsw = (unsigned)wid * 1024u;
    const int aoff = lds_byte(wr * 64 + fr, fq * 8), boff = lds_byte(wc * 32 + fr, fq * 8);
#define PG8_SA(b, h) (((b) * 2 + (h)) * HTB)
#define PG8_SB(b, h) ((4 + (b) * 2 + (h)) * HTB)
#define PG8_STAGE(bufoff, gbase, voff) do { _Pragma("unroll") for (int _i = 0; _i < 2; ++_i) \
        __builtin_amdgcn_global_load_lds((const unsigned*)((const char*)(gbase) + (voff)[_i]), (PG8_LAS unsigned*)(lds + (bufoff) + ldsw + _i * 8192), 16, 0, 0); } while (0)
#define PG8_LDA(dst, b, h) do { _Pragma("unroll") for (int m = 0; m < 4; ++m) _Pragma("unroll") for (int k = 0; k < 2; ++k) dst[m][k] = *(const PG8_LAS bf16x8*)(lds + PG8_SA(b, h) + aoff + m * 2048 + k * 1024); } while (0)
#define PG8_LDB(dst, b, h) do { _Pragma("unroll") for (int n = 0; n < 2; ++n) _Pragma("unroll") for (int k = 0; k < 2; ++k) dst[n][k] = *(const PG8_LAS bf16x8*)(lds + PG8_SB(b, h) + boff + n * 2048 + k * 1024); } while (0)
#define PG8_MMA(ai, bj, At, Bt) do { __builtin_amdgcn_s_setprio(1); _Pragma("unroll") for (int m = 0; m < 4; ++m) _Pragma("unroll") for (int n = 0; n < 2; ++n) _Pragma("unroll") for (int k = 0; k < 2; ++k) \
        acc[ai][bj][m][n] = __builtin_amdgcn_mfma_f32_16x16x32_bf16(Bt[n][k], At[m][k], acc[ai][bj][m][n], 0, 0, 0); __builtin_amdgcn_s_setprio(0); } while (0)
#define PG8_WAIT_V(n) asm volatile("s_waitcnt vmcnt(" #n ")" ::: "memory")
#define PG8_WAIT_L(n) asm volatile("s_waitcnt lgkmcnt(" #n ")" ::: "memory")
#define PG8_BAR __builtin_amdgcn_s_barrier()
#define PG8_SCHED __builtin_amdgcn_sched_barrier(0)
    Unit cur, nxt; int ui = 0;
    if (!S.next(0, cur)) return;
    f32x4 acc[2][2][4][2];
#pragma unroll
    for (int a = 0; a < 2; ++a)
#pragma unroll
        for (int b = 0; b < 2; ++b)
#pragma unroll
            for (int m = 0; m < 4; ++m)
#pragma unroll
                for (int n = 0; n < 2; ++n) acc[a][b][m][n] = (f32x4){0.f, 0.f, 0.f, 0.f};
    bf16x8 At[4][2], B0[2][2], B1[2][2];
    const char* cA = (const char*)g.A + (size_t)cur.pm * tstep; const char* cB = (const char*)g.Bt + (size_t)cur.pn * tstep;
    S.a_ready(cur);
    if constexpr (SP2) {
        PG8_STAGE(PG8_SB(0, 0), cB, voffB); PG8_STAGE(PG8_SB(0, 1), cB + hstep, voffB); PG8_STAGE(PG8_SA(0, 0), cA, voffA); PG8_STAGE(PG8_SA(0, 1), cA + hstep, voffA);
        if (wr == 1) PG8_BAR;
        PG8_WAIT_V(2); PG8_BAR;
        PG8_STAGE(PG8_SB(1, 0), cB + kstep, voffB); PG8_STAGE(PG8_SA(1, 0), cA + kstep, voffA); PG8_STAGE(PG8_SB(1, 1), cB + hstep + kstep, voffB);
        PG8_WAIT_V(6); PG8_BAR;
    } else {
        PG8_STAGE(PG8_SB(0, 0), cB, voffB); PG8_STAGE(PG8_SA(0, 0), cA, voffA); PG8_STAGE(PG8_SB(0, 1), cB + hstep, voffB); PG8_STAGE(PG8_SA(0, 1), cA + hstep, voffA);
        if (wr == 1) PG8_BAR;
        PG8_WAIT_V(4); PG8_BAR;
        PG8_STAGE(PG8_SB(1, 0), cB + kstep, voffB); PG8_STAGE(PG8_SA(1, 0), cA + kstep, voffA); PG8_STAGE(PG8_SB(1, 1), cB + hstep + kstep, voffB);
        PG8_WAIT_V(6); PG8_BAR;
    }
    for (;;) {
        const bool has_next = S.next(ui + 1, nxt);
        const char* nA = has_next ? (const char*)g.A + (size_t)nxt.pm * tstep : cA; const char* nB = has_next ? (const char*)g.Bt + (size_t)nxt.pn * tstep : cB;
        for (int t = 0; t < nt; t += 2) {
            const bool last = (t == nt - 2);
            const char* a1 = cA + (size_t)(t + 1) * kstep;
            const char* a2 = last ? nA : cA + (size_t)(t + 2) * kstep; const char* b2 = last ? nB : cB + (size_t)(t + 2) * kstep;
            const char* a3 = a2 + kstep; const char* b3 = b2 + kstep;
            if (last && has_next) S.a_ready(nxt);
            if constexpr (SP2) {
            PG8_LDB(B0, 0, 0); PG8_LDB(B1, 0, 1); PG8_SCHED; PG8_LDA(At, 0, 0); PG8_STAGE(PG8_SA(1, 1), a1 + hstep, voffA);
            PG8_WAIT_V(8); PG8_WAIT_L(0); PG8_BAR; PG8_MMA(0, 0, At, B0); PG8_MMA(0, 1, At, B1); PG8_BAR; PG8_SCHED;
            PG8_LDA(At, 0, 1); PG8_STAGE(PG8_SB(0, 0), b2, voffB); PG8_STAGE(PG8_SB(0, 1), b2 + hstep, voffB); PG8_STAGE(PG8_SA(0, 0), a2, voffA);
            PG8_WAIT_V(8); PG8_WAIT_L(0); PG8_BAR; PG8_MMA(1, 0, At, B0); PG8_MMA(1, 1, At, B1); PG8_BAR; PG8_SCHED;
            PG8_LDB(B0, 1, 0); PG8_LDB(B1, 1, 1); PG8_SCHED; PG8_LDA(At, 1, 0); PG8_STAGE(PG8_SA(0, 1), a2 + hstep, voffA);
            PG8_WAIT_V(8); PG8_WAIT_L(0); PG8_BAR; PG8_MMA(0, 0, At, B0); PG8_MMA(0, 1, At, B1); PG8_BAR; PG8_SCHED;
            PG8_LDA(At, 1, 1); PG8_STAGE(PG8_SB(1, 0), b3, voffB); PG8_STAGE(PG8_SB(1, 1), b3 + hstep, voffB); PG8_STAGE(PG8_SA(1, 0), a3, voffA);
            PG8_WAIT_V(8); PG8_WAIT_L(0); PG8_BAR; PG8_MMA(1, 0, At, B0); PG8_MMA(1, 1, At, B1); PG8_BAR; PG8_SCHED;
            } else {
            PG8_LDB(B0, 0, 0); PG8_SCHED; PG8_LDA(At, 0, 0); PG8_STAGE(PG8_SA(1, 1), a1 + hstep, voffA);
            PG8_WAIT_L(8); PG8_BAR; PG8_WAIT_L(0); PG8_MMA(0, 0, At, B0); PG8_BAR; PG8_SCHED;
            PG8_LDB(B1, 0, 1); PG8_STAGE(PG8_SB(0, 0), b2, voffB);
            PG8_BAR; PG8_WAIT_L(0); PG8_MMA(0, 1, At, B1); PG8_BAR;
            PG8_LDA(At, 0, 1); PG8_STAGE(PG8_SA(0, 0), a2, voffA);
            PG8_BAR; PG8_WAIT_L(0); PG8_MMA(1, 0, At, B0); PG8_BAR; PG8_SCHED;
            PG8_STAGE(PG8_SB(0, 1), b2 + hstep, voffB);
            PG8_WAIT_V(6); PG8_BAR; PG8_MMA(1, 1, At, B1); PG8_BAR;
            PG8_LDB(B0, 1, 0); PG8_SCHED; PG8_LDA(At, 1, 0); PG8_STAGE(PG8_SA(0, 1), a2 + hstep, voffA);
            PG8_WAIT_L(8); PG8_BAR; PG8_WAIT_L(0); PG8_MMA(0, 0, At, B0); PG8_BAR; PG8_SCHED;
            PG8_LDB(B1, 1, 1); PG8_STAGE(PG8_SB(1, 0), b3, voffB);
            PG8_BAR; PG8_WAIT_L(0); PG8_MMA(0, 1, At, B1); PG8_BAR;
            PG8_LDA(At, 1, 1); PG8_STAGE(PG8_SA(1, 0), a3, voffA);
            PG8_BAR; PG8_WAIT_L(0); PG8_MMA(1, 0, At, B0); PG8_BAR; PG8_SCHED;
            PG8_STAGE(PG8_SB(1, 1), b3 + hstep, voffB);
            PG8_WAIT_V(6); PG8_BAR; PG8_MMA(1, 1, At, B1); PG8_BAR;
            }
        }
        if constexpr (ALIGN_EPI) { if (wr == 0) PG8_BAR; }
        if constexpr (!Epi::AFTER_DRAIN) { E(acc, cur, wr, wc, fr, fq); S.done(cur); }
        if (!has_next) break;
#pragma unroll
        for (int a = 0; a < 2; ++a)
#pragma unroll
            for (int b = 0; b < 2; ++b)
#pragma unroll
                for (int m = 0; m < 4; ++m)
#pragma unroll
                    for (int n = 0; n < 2; ++n) acc[a][b][m][n] = (f32x4){0.f, 0.f, 0.f, 0.f};
        cur = nxt; cA = nA; cB = nB; ++ui;
        if constexpr (ALIGN_EPI) { if (wr == 1) PG8_BAR; }
    }
    PG8_WAIT_V(0);
    if constexpr (!ALIGN_EPI) { if (wr == 0) PG8_BAR; }
    PG8_BAR;
    if constexpr (Epi::AFTER_DRAIN) { E.fused(acc, cur, wr, wc, fr, fq, lds, wid, lane); S.done(cur); }
#undef PG8_SA
#undef PG8_SB
#undef PG8_STAGE
#undef PG8_LDA
#undef PG8_LDB
#undef PG8_MMA
#undef PG8_WAIT_V
#undef PG8_WAIT_L
#undef PG8_BAR
#undef PG8_SCHED
}
}

#define LAS __attribute__((address_space(3)))
typedef unsigned short bf16;
typedef short bf16x8 __attribute__((ext_vector_type(8)));
typedef short s16x4 __attribute__((ext_vector_type(4)));
typedef float f32x4 __attribute__((ext_vector_type(4)));
typedef float f32x16 __attribute__((ext_vector_type(16)));
typedef unsigned u32x4 __attribute__((ext_vector_type(4)));
typedef unsigned u32x2 __attribute__((ext_vector_type(2)));
typedef float f32x2_t __attribute__((ext_vector_type(2)));
typedef __bf16 bf16x2_t __attribute__((ext_vector_type(2)));

constexpr int M_TOK = 12288, M_CTX = 4096, DM = 1024, NIN = 4864, DFF = 2816, NGU = 5632;
constexpr float EPS = 1e-6f, LOG2E = 1.4426950408889634f, C2 = 0.125f * 1.4426950408889634f;
constexpr size_t MiB = 1u << 20;
constexpr size_t WS_ROPE = 0, WS_QKG = 16384, WS_BAR = 32768, WS_FLAG = 49152, WS_MOD = 65536, WS_SSMF = 512 * 1024, WS_CKAK = 1 * MiB, WS_CKAV = 1 * MiB + 512 * 1024, WS_CKCK = 2 * MiB, WS_CKCV = 3 * MiB;
constexpr size_t WS_W = 4 * MiB;
constexpr size_t W_IN = WS_W, W_BRA = W_IN + 2ull * NIN * DM * 2, W_BRB = W_BRA + 2ull * DM * 512 * 2, W_BRC = W_BRB + 2ull * DM * 256 * 2, W_OUT = W_BRC + 2ull * DM * 256 * 2,
                 W_GU = W_OUT + 2ull * DM * DM * 2, W_FD = W_GU + 2ull * NGU * DM * 2, W_GLU = W_FD + 2ull * DM * DFF * 2, W_END = W_GLU + 2ull * 256 * 256 * 2;
constexpr size_t WS_H = 65 * MiB;
constexpr size_t WS_QKVU = 89 * MiB;
constexpr size_t WS_QA = WS_QKVU, WS_KA = WS_QA + 12 * MiB, WS_VA = WS_KA + 3 * MiB, WS_U = WS_VA + 3 * MiB, WS_QC = WS_U + 12 * MiB, WS_KC = WS_QC + 6 * MiB, WS_VC = WS_KC + 6 * MiB;
constexpr size_t WS_GATES = 137 * MiB;
constexpr size_t WS_OA = 209 * MiB, WS_OB = 221 * MiB, WS_OC = 227 * MiB, WS_PAR = 233 * MiB, WS_SSMF2 = 235 * MiB, WS_END = 236 * MiB;
constexpr int P_N1G = 0, P_N2G = 2048, P_FING = 4096, P_SSM0 = 5120, P_LAMR = 37888, P_LAMI = 41984, P_LSTEP = 46080, P_BRE = 46144, P_BIM = 111680, P_CRE = 177216, P_CIM = 242752, P_SSMD = 308288, P_NAB = 308800;
static_assert(W_END <= WS_H, "weights fit");
constexpr size_t O_YP = 0, O_YS = 4194304, O_GAK = 12582912, O_GAV = 13631488, O_NAK = 14680064, O_NAV = 16777216, O_SSM = 18874368;
constexpr int LDS_BYTES = 147456;

__device__ __forceinline__ unsigned cvtpk(float lo, float hi) { f32x2_t v = {lo, hi}; bf16x2_t b = __builtin_convertvector(v, bf16x2_t); return __builtin_bit_cast(unsigned, b); }
__device__ __forceinline__ float bf2f(unsigned b) { return __uint_as_float(b << 16); }
__device__ __forceinline__ float sigmoidf_(float v) { return 1.0f / (1.0f + __expf(-v)); }
template <int K> __device__ __forceinline__ float xor_shfl(float v) {
    return __uint_as_float((unsigned)__builtin_amdgcn_ds_swizzle((int)__float_as_uint(v), (K << 10) | 0x1F));
}
__device__ __forceinline__ float sum_xor32(float v) { auto rr = __builtin_amdgcn_permlane32_swap(__float_as_uint(v), __float_as_uint(v), false, false); return __uint_as_float(rr[0]) + __uint_as_float(rr[1]); }
__device__ __forceinline__ float wave_sum(float v) {
    v += xor_shfl<1>(v); v += xor_shfl<2>(v); v += xor_shfl<4>(v); v += xor_shfl<8>(v); v += xor_shfl<16>(v);
    return sum_xor32(v);
}
__device__ __forceinline__ int crow(int r, int hi) { return (r & 3) + 8 * (r >> 2) + 4 * hi; }
__device__ __forceinline__ int clampi(int v, int lo, int hi) { return v < lo ? lo : (v > hi ? hi : v); }
#define FRESH_LANE() ({ int l__; asm volatile("v_mbcnt_lo_u32_b32 %0, -1, 0\n\tv_mbcnt_hi_u32_b32 %0, -1, %0" : "=v"(l__)); l__; })
#ifndef DBG_SSM
#define DBG_SSM 1.0f
#endif
#ifndef DBG_GAK
#define DBG_GAK 1.0f
#endif
#ifndef DBG_GAV
#define DBG_GAV 1.0f
#endif
#define VM_WAIT0() asm volatile("s_waitcnt vmcnt(0)" ::: "memory")

#define XB_TMO      128
#define XB_XCNT(j)  (256  + 64 * (j))
#define XB_XSUB(j)  (1280 + 64 * (j))
#define XB_XGEN(j)  (2304 + 64 * (j))
#define XB_TOP      3328
#define XB_TOPGEN   3392
#define XCD_BAR_WORDS 3456
#define XB_SPIN_CAP (1u << 18)

__device__ __forceinline__ unsigned xb_ld(unsigned* p)              { return __hip_atomic_load(p, __ATOMIC_RELAXED, __HIP_MEMORY_SCOPE_AGENT); }
__device__ __forceinline__ unsigned xb_add(unsigned* p, unsigned v) { return __hip_atomic_fetch_add(p, v, __ATOMIC_RELAXED, __HIP_MEMORY_SCOPE_AGENT); }
__device__ __forceinline__ unsigned xb_xcc_id() { return (unsigned)__builtin_amdgcn_s_getreg((3 << 11) | 20) & 0xFu; }
#define XB_SPIN(cond, bar) do { unsigned _sp = 0; while (cond) { __builtin_amdgcn_s_sleep(1); \
    if ((++_sp & 255u) == 0u) { if (xb_ld(&(bar)[XB_TMO])) break; if (_sp > XB_SPIN_CAP) { atomicAdd(&(bar)[XB_TMO], 1u); break; } } } } while (0)

struct XcdBarrier {
    unsigned* bar; unsigned x;
    volatile LAS unsigned* st;
};

__device__ __forceinline__ XcdBarrier xcd_barrier_post(unsigned* bar, volatile LAS unsigned* st) {
    XcdBarrier b; b.bar = bar; b.x = xb_xcc_id(); b.st = st;
    if (threadIdx.x == 0) (void)xb_add(&bar[XB_XCNT(b.x)], 1u);
    return b;
}
__device__ __forceinline__ void xcd_barrier_complete(unsigned* bar, unsigned x, unsigned& nloc, unsigned& nx) {
    const unsigned G = gridDim.x * gridDim.y * gridDim.z;
    unsigned sum, cnt, mine, sp = 0u;
    for (;;) {
        sum = 0u; cnt = 0u; mine = 0u;
#pragma unroll
        for (unsigned j = 0; j < 16; ++j) { const unsigned c = xb_ld(&bar[XB_XCNT(j)]); sum += c; cnt += (c > 0u) ? 1u : 0u; mine = (j == x) ? c : mine; }
        if (sum == G) break;
        __builtin_amdgcn_s_sleep(1);
        if ((++sp & 255u) == 0u) { if (xb_ld(&bar[XB_TMO])) break; if (sp > XB_SPIN_CAP) { atomicAdd(&bar[XB_TMO], 1u); break; } }
    }
    nloc = mine > 0u ? mine : 1u; nx = cnt > 0u ? cnt : 1u;
}

__device__ __forceinline__ void xcd_barrier(const XcdBarrier& b) {
    asm volatile("s_waitcnt vmcnt(0)" ::: "memory");
    __syncthreads();
    if (threadIdx.x == 0) {
        unsigned* bar = b.bar;
        __builtin_amdgcn_s_waitcnt(0);
        unsigned nloc = b.st[0], nx = b.st[1];
        if (nloc == 0u) { xcd_barrier_complete(bar, b.x, nloc, nx); b.st[0] = nloc; b.st[1] = nx; }
        const unsigned old = xb_add(&bar[XB_XSUB(b.x)], 1u);
        const unsigned gen = old / nloc;
        if (old + 1u == (gen + 1u) * nloc) {
            __builtin_amdgcn_fence(__ATOMIC_RELEASE, "agent");
            asm volatile("s_waitcnt vmcnt(0)" ::: "memory");
            const unsigned og = xb_add(&bar[XB_TOP], 1u);
            const unsigned tg = og / nx;
            if (og + 1u == (tg + 1u) * nx) xb_add(&bar[XB_TOPGEN], 1u);
            else XB_SPIN(xb_ld(&bar[XB_TOPGEN]) == tg, bar);
            __builtin_amdgcn_fence(__ATOMIC_ACQUIRE, "agent");
            xb_add(&bar[XB_XGEN(b.x)], 1u);
            asm volatile("s_waitcnt vmcnt(0)" ::: "memory");
        } else {
            XB_SPIN(xb_ld(&bar[XB_XGEN(b.x)]) == gen, bar);
            __builtin_amdgcn_fence(__ATOMIC_ACQUIRE, "agent");
            asm volatile("s_waitcnt vmcnt(0)" ::: "memory");
        }
    }
    __syncthreads();
}
using pg8::Unit;
struct EpiIn {
    static constexpr bool PERM = false, AFTER_DRAIN = false;
    unsigned char* ws; float* out; int layer;
    __device__ __forceinline__ void operator()(const f32x4 (&acc)[2][2][4][2], const Unit& u, int wr, int wc, int fr_, int fq_) const {
        const int ln_ = FRESH_LANE(), fr = ln_ & 15, fq = ln_ >> 4;
        const int pn = u.pn; const bool ctx = u.pm < 16;
        const int rb = u.pm * 256 + wr * 64 + fr;
        if (pn >= 7) {
#pragma unroll
            for (int ai = 0; ai < 2; ++ai)
#pragma unroll
                for (int m = 0; m < 4; ++m) {
                    const int row = rb + ai * 128 + m * 16;
                    bf16* gp = (bf16*)(ws + WS_GATES) + (size_t)row * 3072 + (pn - 7) * 256 + 64 * wc + 4 * fq;
#pragma unroll
                    for (int bj = 0; bj < 2; ++bj)
#pragma unroll
                        for (int n = 0; n < 2; ++n) { const f32x4 v = acc[ai][bj][m][n]; u32x2 w; w.x = cvtpk(sigmoidf_(v[0]), sigmoidf_(v[1])); w.y = cvtpk(sigmoidf_(v[2]), sigmoidf_(v[3])); *(u32x2*)(gp + 32 * bj + 16 * n) = w; }
                }
        } else if (pn == 3) {
#pragma unroll
            for (int ai = 0; ai < 2; ++ai)
#pragma unroll
                for (int m = 0; m < 4; ++m) {
                    const int row = rb + ai * 128 + m * 16;
                    float* up = (float*)(ws + WS_U) + (size_t)row * 256 + 64 * wc + 4 * fq;
#pragma unroll
                    for (int bj = 0; bj < 2; ++bj)
#pragma unroll
                        for (int n = 0; n < 2; ++n) *(f32x4*)(up + 32 * bj + 16 * n) = acc[ai][bj][m][n];
                }
        } else if (pn >= 4) {
            bf16* base = (bf16*)(ws + (pn == 4 ? WS_QC : (pn == 5 ? WS_KC : WS_VC)));
            const float sc = pn == 4 ? C2 : 1.0f;
            float* ob = out + (pn == 5 ? O_NAK : O_NAV);
#pragma unroll
            for (int ai = 0; ai < 2; ++ai)
#pragma unroll
                for (int m = 0; m < 4; ++m) {
                    const int row = rb + ai * 128 + m * 16;
                    int b, t; size_t hrow;
                    if (ctx) { b = row >> 8; t = row & 255; hrow = (size_t)(b * 4 + wc) * 256 + t; } else { const int r2 = row - 4096; b = r2 >> 11; t = r2 & 2047; hrow = (size_t)4096 * 4 + (size_t)(b * 4 + wc) * 2048 + t; }
                    bf16* dp = base + hrow * 64 + 4 * fq;
#pragma unroll
                    for (int bj = 0; bj < 2; ++bj)
#pragma unroll
                        for (int n = 0; n < 2; ++n) { const f32x4 v = acc[ai][bj][m][n] * sc; u32x2 w; w.x = cvtpk(v[0], v[1]); w.y = cvtpk(v[2], v[3]); *(u32x2*)(dp + 32 * bj + 16 * n) = w; }
                    if (ctx && pn >= 5) { float* op = ob + ((size_t)(b * 2 + layer) * 256 + t) * 256 + wc * 64 + 4 * fq;
#pragma unroll
                        for (int bj = 0; bj < 2; ++bj)
#pragma unroll
                            for (int n = 0; n < 2; ++n) *(f32x4*)(op + 32 * bj + 16 * n) = acc[ai][bj][m][n]; }
                }
        } else {
            const bool isQ = pn < 2, isV = (pn == 2 && wc >= 2);
            const int h = isQ ? 4 * pn + wc : (wc & 1);
            const float* gsrc = (const float*)(ws + WS_QKG) + (layer * 2 + (isQ ? 0 : 1)) * 64 + 4 * fq;
            f32x4 gg[2][2];
#pragma unroll
            for (int bj = 0; bj < 2; ++bj)
#pragma unroll
                for (int n = 0; n < 2; ++n) gg[bj][n] = *(const f32x4*)(gsrc + 32 * bj + 16 * n);
            bf16* base = (bf16*)(ws + (isQ ? WS_QA : (isV ? WS_VA : WS_KA)));
            const int nh = isQ ? 8 : 2;
            float* ob = out + (isV ? O_GAV : O_GAK);
#pragma unroll
            for (int ai = 0; ai < 2; ++ai)
#pragma unroll
                for (int m = 0; m < 4; ++m) {
                    const int row = rb + ai * 128 + m * 16;
                    f32x4 v[2][2];
#pragma unroll
                    for (int bj = 0; bj < 2; ++bj)
#pragma unroll
                        for (int n = 0; n < 2; ++n) v[bj][n] = acc[ai][bj][m][n];
                    if (!isV) {
                        float ss = 0.f;
#pragma unroll
                        for (int bj = 0; bj < 2; ++bj)
#pragma unroll
                            for (int n = 0; n < 2; ++n) ss += (v[bj][n][0] * v[bj][n][0] + v[bj][n][1] * v[bj][n][1]) + (v[bj][n][2] * v[bj][n][2] + v[bj][n][3] * v[bj][n][3]);
                        ss += xor_shfl<16>(ss); ss = sum_xor32(ss);
                        const float rstd = rsqrtf(ss * (1.0f / 64.0f) + EPS);
#pragma unroll
                        for (int bj = 0; bj < 2; ++bj)
#pragma unroll
                            for (int n = 0; n < 2; ++n) v[bj][n] = v[bj][n] * rstd * gg[bj][n];
                    }
                    int b, t; size_t hrow;
                    if (ctx) { b = row >> 8; t = row & 255; hrow = (size_t)(b * nh + h) * 256 + t; }
                    else {
                        const int r2 = row - 4096; b = r2 >> 11; t = r2 & 2047; hrow = (size_t)4096 * nh + (size_t)(b * nh + h) * 2048 + t;
                        if (!isV) {
#pragma unroll
                            for (int bj = 0; bj < 2; ++bj) {
                                const int pos = bj ? (t & 63) : (t >> 6);
                                const float* tp = (const float*)(ws + WS_ROPE) + (pos * 16 + 4 * fq) * 2;
                                const f32x4 c01 = *(const f32x4*)tp, c23 = *(const f32x4*)(tp + 4);
                                const f32x4 cs = {c01[0], c01[2], c23[0], c23[2]}, sn = {c01[1], c01[3], c23[1], c23[3]};
                                const f32x4 x1 = v[bj][0], x2 = v[bj][1];
                                v[bj][0] = x1 * cs - x2 * sn; v[bj][1] = x2 * cs + x1 * sn;
                            }
                        }
                    }
                    if (ctx && !isQ) { float* op = ob + ((size_t)(b * 2 + layer) * 256 + t) * 128 + h * 64 + 4 * fq;
#pragma unroll
                        for (int bj = 0; bj < 2; ++bj)
#pragma unroll
                            for (int n = 0; n < 2; ++n) *(f32x4*)(op + 32 * bj + 16 * n) = v[bj][n] * (isV ? DBG_GAV : DBG_GAK); }
                    const float sc = isQ ? C2 : 1.0f;
                    bf16* dp = base + hrow * 64 + 4 * fq;
#pragma unroll
                    for (int bj = 0; bj < 2; ++bj)
#pragma unroll
                        for (int n = 0; n < 2; ++n) { const f32x4 x = v[bj][n] * sc; u32x2 w; w.x = cvtpk(x[0], x[1]); w.y = cvtpk(x[2], x[3]); *(u32x2*)(dp + 32 * bj + 16 * n) = w; }
                }
        }
    }
};

struct EpiRes {
    static constexpr bool PERM = false, AFTER_DRAIN = false;
    const float* xc; const float* xl; float* xo; const float* mod;
    __device__ __forceinline__ void operator()(const f32x4 (&acc)[2][2][4][2], const Unit& u, int wr, int wc, int fr_, int fq_) const {
        const int ln_ = FRESH_LANE(), fr = ln_ & 15, fq = ln_ >> 4;
        const int cv = u.pm < 16 ? 0 : 1 + ((u.pm - 16) >> 3);
        const int col0 = u.pn * 256 + wc * 32 + 4 * fq;
        f32x4 gv[2][2];
#pragma unroll
        for (int bj = 0; bj < 2; ++bj)
#pragma unroll
            for (int n = 0; n < 2; ++n) gv[bj][n] = *(const f32x4*)(mod + cv * 6144 + col0 + bj * 128 + n * 16);
#pragma unroll
        for (int ai = 0; ai < 2; ++ai)
#pragma unroll
            for (int m = 0; m < 4; ++m) {
                const int row = u.pm * 256 + ai * 128 + wr * 64 + m * 16 + fr;
                const float* xs = row < 4096 ? xc + (size_t)row * 1024 : xl + (size_t)(row - 4096) * 1024;
                float* xd = xo + (size_t)row * 1024;
#pragma unroll
                for (int bj = 0; bj < 2; ++bj)
#pragma unroll
                    for (int n = 0; n < 2; ++n) { const int c = col0 + bj * 128 + n * 16; const f32x4 xv = *(const f32x4*)(xs + c); *(f32x4*)(xd + c) = xv + gv[bj][n] * acc[ai][bj][m][n]; }
                asm volatile("" ::: "memory");
            }
    }
};

struct EpiSwiglu {
    static constexpr bool PERM = false, AFTER_DRAIN = false;
    bf16* ACT;
    __device__ __forceinline__ void operator()(const f32x4 (&acc)[2][2][4][2], const Unit& u, int wr, int wc, int fr_, int fq_) const {
        const int ln_ = FRESH_LANE(), fr = ln_ & 15, fq = ln_ >> 4;
#pragma unroll
        for (int ai = 0; ai < 2; ++ai)
#pragma unroll
            for (int m = 0; m < 4; ++m) {
                const int row = u.pm * 256 + ai * 128 + wr * 64 + m * 16 + fr;
                bf16* ap = ACT + (size_t)row * DFF + u.pn * 128 + wc * 32 + 4 * fq;
#pragma unroll
                for (int n = 0; n < 2; ++n) { const f32x4 g = acc[ai][0][m][n], up = acc[ai][1][m][n]; f32x4 r;
#pragma unroll
                    for (int i = 0; i < 4; ++i) r[i] = g[i] * sigmoidf_(g[i]) * up[i];
                    u32x2 w; w.x = cvtpk(r[0], r[1]); w.y = cvtpk(r[2], r[3]); *(u32x2*)(ap + 16 * n) = w; }
                asm volatile("" ::: "memory");
            }
    }
};

struct EpiGlu {
    static constexpr bool PERM = false, AFTER_DRAIN = false;
    bf16* OB;
    __device__ __forceinline__ void operator()(const f32x4 (&acc)[2][2][4][2], const Unit& u, int wr, int wc, int fr_, int fq_) const {
        const int ln_ = FRESH_LANE(), fr = ln_ & 15, fq = ln_ >> 4;
#pragma unroll
        for (int ai = 0; ai < 2; ++ai)
#pragma unroll
            for (int m = 0; m < 4; ++m) {
                const int row = u.pm * 256 + ai * 128 + wr * 64 + m * 16 + fr;
                bf16* p = OB + (size_t)row * 256 + wc * 32 + 4 * fq;
#pragma unroll
                for (int bj = 0; bj < 2; ++bj)
#pragma unroll
                    for (int n = 0; n < 2; ++n) { bf16* q = p + bj * 128 + n * 16; const u32x2 yv = *(const u32x2*)q; const f32x4 a = acc[ai][bj][m][n];
                        const float y0 = bf2f(yv.x & 0xffffu), y1 = bf2f(yv.x >> 16), y2 = bf2f(yv.y & 0xffffu), y3 = bf2f(yv.y >> 16);
                        u32x2 w; w.x = cvtpk(y0 * sigmoidf_(a[0]), y1 * sigmoidf_(a[1])); w.y = cvtpk(y2 * sigmoidf_(a[2]), y3 * sigmoidf_(a[3])); *(u32x2*)q = w; }
                asm volatile("" ::: "memory");
            }
    }
};

template <int MODE> struct EpiBr {
    static constexpr bool PERM = false, AFTER_DRAIN = false;
    const bf16* G; bf16* MF; bf16* MG;
    __device__ __forceinline__ void operator()(const f32x4 (&acc)[2][2][4][2], const Unit& u, int wr, int wc, int fr_, int fq_) const {
        const int ln_ = FRESH_LANE(), fr = ln_ & 15, fq = ln_ >> 4;
        const int col0 = u.pn * 256 + wc * 32 + 4 * fq;
#pragma unroll
        for (int ai = 0; ai < 2; ++ai)
#pragma unroll
            for (int m = 0; m < 4; ++m) {
                const int row = u.pm * 256 + ai * 128 + wr * 64 + m * 16 + fr;
#pragma unroll
                for (int bj = 0; bj < 2; ++bj)
#pragma unroll
                    for (int n = 0; n < 2; ++n) { const int c = col0 + bj * 128 + n * 16; const u32x2 gv = *(const u32x2*)(G + (size_t)row * 3072 + c); const f32x4 a = acc[ai][bj][m][n];
                        f32x4 r = {bf2f(gv.x & 0xffffu) * a[0], bf2f(gv.x >> 16) * a[1], bf2f(gv.y & 0xffffu) * a[2], bf2f(gv.y >> 16) * a[3]};
                        bf16* mp = MF + (size_t)row * 1024 + c;
                        if (MODE >= 1) { const u32x2 mv = *(const u32x2*)mp; r[0] += bf2f(mv.x & 0xffffu); r[1] += bf2f(mv.x >> 16); r[2] += bf2f(mv.y & 0xffffu); r[3] += bf2f(mv.y >> 16); }
                        u32x2 w; w.x = cvtpk(r[0], r[1]); w.y = cvtpk(r[2], r[3]);
                        *(u32x2*)((MODE <= 1 ? mp : MG + (size_t)row * 1024 + c)) = w; }
                asm volatile("" ::: "memory");
            }
    }
};

namespace att {
constexpr int SLOTB = 8192, LDS_K = 0, LDS_V = 24576, LDS_WS = 49152, LDS_OST = 51200, LDS_BIAS = 83968;
constexpr float THR = 8.0f;
#define SBAR() __builtin_amdgcn_sched_barrier(0)
__device__ __forceinline__ void glds16(const void* gsrc, unsigned lds_dst) { unsigned keep;
    asm volatile("s_mov_b32 %0, m0\n\ts_mov_b32 m0, %2\n\ts_nop 0\n\tglobal_load_lds_dwordx4 %1, off\n\ts_mov_b32 m0, %0" : "=&s"(keep) : "v"(gsrc), "s"(lds_dst) : "memory"); }
#define WAIT_BAR0() asm volatile("s_waitcnt vmcnt(0) lgkmcnt(0)\n\ts_barrier" ::: "memory")
#define WAIT_BAR2() asm volatile("s_waitcnt vmcnt(2) lgkmcnt(0)\n\ts_barrier" ::: "memory")
typedef LAS const char* lds_cptr;
__device__ __forceinline__ void qkt(f32x16& p0, f32x16& p1, lds_cptr kb, const bf16x8* qr, const f32x16& negm) {
#pragma unroll
    for (int d0 = 0; d0 < 4; ++d0) {
        const bf16x8 b0 = *(const LAS bf16x8*)(kb + d0 * 2048);
        const bf16x8 b1 = *(const LAS bf16x8*)(kb + d0 * 2048 + 512);
        if (d0 == 0) { p0 = __builtin_amdgcn_mfma_f32_32x32x16_bf16(b0, qr[0], negm, 0, 0, 0); p1 = __builtin_amdgcn_mfma_f32_32x32x16_bf16(b1, qr[0], negm, 0, 0, 0); }
        else { p0 = __builtin_amdgcn_mfma_f32_32x32x16_bf16(b0, qr[d0], p0, 0, 0, 0); p1 = __builtin_amdgcn_mfma_f32_32x32x16_bf16(b1, qr[d0], p1, 0, 0, 0); }
    }
}
__device__ __forceinline__ float rowmax(const f32x16& p0, const f32x16& p1) {
    float a = fmaxf(fmaxf(p0[0], p0[1]), p1[0]), b = fmaxf(fmaxf(p0[2], p0[3]), p1[1]); a = fmaxf(fmaxf(a, p1[2]), p1[3]);
#pragma unroll
    for (int r = 4; r < 16; r += 4) { a = fmaxf(fmaxf(a, p0[r]), p0[r + 1]); b = fmaxf(fmaxf(b, p0[r + 2]), p0[r + 3]); a = fmaxf(fmaxf(a, p1[r]), p1[r + 1]); b = fmaxf(fmaxf(b, p1[r + 2]), p1[r + 3]); }
    const float m = fmaxf(a, b);
    auto rr = __builtin_amdgcn_permlane32_swap(__float_as_uint(m), __float_as_uint(m), false, false);
    return fmaxf(__uint_as_float(rr[0]), __uint_as_float(rr[1]));
}
__device__ __forceinline__ void pv(f32x16* o, int vb, bf16x8 pa0, bf16x8 pa1, bf16x8 pa2, bf16x8 pa3) {
#pragma unroll
    for (int d0 = 0; d0 < 2; ++d0) { s16x4 lo[4], hi[4];
#pragma unroll
        for (int ks = 0; ks < 4; ++ks) {
            asm volatile("ds_read_b64_tr_b16 %0,%1 offset:%c2" : "=&v"(lo[ks]) : "v"(vb), "i"(d0 * 4096 + ks * 1024) : "memory");
            asm volatile("ds_read_b64_tr_b16 %0,%1 offset:%c2" : "=&v"(hi[ks]) : "v"(vb), "i"(d0 * 4096 + ks * 1024 + 512) : "memory"); }
        asm volatile("s_waitcnt lgkmcnt(0)" ::: "memory"); SBAR();
#define PK(k) (bf16x8){lo[k][0], lo[k][1], lo[k][2], lo[k][3], hi[k][0], hi[k][1], hi[k][2], hi[k][3]}
        o[d0] = __builtin_amdgcn_mfma_f32_32x32x16_bf16(pa0, PK(0), o[d0], 0, 0, 0);
        o[d0] = __builtin_amdgcn_mfma_f32_32x32x16_bf16(pa1, PK(1), o[d0], 0, 0, 0);
        o[d0] = __builtin_amdgcn_mfma_f32_32x32x16_bf16(pa2, PK(2), o[d0], 0, 0, 0);
        o[d0] = __builtin_amdgcn_mfma_f32_32x32x16_bf16(pa3, PK(3), o[d0], 0, 0, 0);
#undef PK
    }
}
template <bool NA>
__device__ __forceinline__ void attn_unit(const bf16* Qw, const bf16* Kc, const bf16* Vc, const bf16* Kl, const bf16* Vl, int NT,
                                          bf16* Ow, int opitch, char* shm, int qrow, int rlo, const float* biasg, const int wid) {
    const int lane = FRESH_LANE(), tid = wid * 64 + lane, r32 = lane & 31, hi = lane >> 5;
    const unsigned lds0 = (unsigned)(uintptr_t)shm;
    const lds_cptr shm3 = (lds_cptr)shm;
    LAS float* wsf = (LAS float*)(shm3 + LDS_WS) + wid * 64;
    LAS float* bias_s = (LAS float*)(shm3 + LDS_BIAS);
    if (NA) { if (tid < 465) bias_s[tid] = biasg[tid] * LOG2E; }
    const int koff = lane * 64 + wid * 8;
    const int voff = (16 * (wid & 3) + (lane >> 2)) * 64 + (wid >> 2) * 32 + (lane & 3) * 8;
    const unsigned kdst = lds0 + LDS_K + wid * 1024, vdst = lds0 + LDS_V + wid * 1024;
#define ATT_DMA(t, slot) do { const bf16* kt_ = (t) < 4 ? Kc + (t) * 4096 : Kl + ((t) - 4) * 4096; const bf16* vt_ = (t) < 4 ? Vc + (t) * 4096 : Vl + ((t) - 4) * 4096; \
        glds16(kt_ + koff, (unsigned)__builtin_amdgcn_readfirstlane(kdst + (slot))); glds16(vt_ + voff, (unsigned)__builtin_amdgcn_readfirstlane(vdst + (slot))); } while (0)
    ATT_DMA(0, 0); ATT_DMA(1, SLOTB);
    bf16x8 qr[4];
#pragma unroll
    for (int d0 = 0; d0 < 4; ++d0) qr[d0] = *(const bf16x8*)(Qw + (size_t)r32 * 64 + d0 * 16 + hi * 8);
    float mhat = 0.f, l_reg = 0.f; f32x16 o[2]; o[0] = f32x16{}; o[1] = f32x16{}; f32x16 negm = f32x16{};
    const lds_cptr kp0 = shm3 + LDS_K + hi * 1024 + r32 * 16;
    const int vb0 = (int)(lds0 + LDS_V) + ((lane >> 4) & 1) * 32 + (lane & 3) * 8 + (4 * hi + ((lane & 15) >> 2)) * 64;
    const int qc = (wid & 1) * 32 + r32, cs = clampi(qc - 8, 0, 48), rs = clampi(qrow - 4, 0, 24);
    int slot = 0, s_nxt = SLOTB, s_nn = 2 * SLOTB;
    for (int t = 0; t < NT; ++t) {
        if (t == 0 || t + 1 >= NT) WAIT_BAR0(); else WAIT_BAR2();
        if (t + 2 < NT) ATT_DMA(t + 2, s_nn);
        f32x16 p0, p1;
        qkt(p0, p1, kp0 + slot, qr, negm);
        if (NA && t >= 4) {
            const int kr = rlo + t - 4;
            if (kr < rs || kr >= rs + 8) {
#pragma unroll
                for (int r = 0; r < 16; ++r) { p0[r] = -INFINITY; p1[r] = -INFINITY; }
            } else {
                const LAS float* brow = bias_s + (kr - qrow + 7) * 31;
#pragma unroll
                for (int r = 0; r < 16; ++r) {
                    const int kc = crow(r, hi);
                    const int i0 = clampi(kc - qc + 15, 0, 30), i1 = clampi(kc + 32 - qc + 15, 0, 30);
                    const float b0 = brow[i0], b1 = brow[i1];
                    p0[r] = ((unsigned)(kc - cs) < 16u) ? p0[r] + b0 : -INFINITY;
                    p1[r] = ((unsigned)(kc + 32 - cs) < 16u) ? p1[r] + b1 : -INFINITY;
                }
            }
        }
        const float rm = rowmax(p0, p1);
        if (t == 0 || __any(rm > THR)) {
            const float dl = (t == 0) ? rm : fmaxf(rm, 0.f);
            mhat += dl;
#pragma unroll
            for (int r = 0; r < 16; ++r) { p0[r] -= dl; p1[r] -= dl; negm[r] = -mhat; }
            if (t > 0) {
                const float f = __builtin_amdgcn_exp2f(-dl); l_reg *= f;
                if (hi == 0) wsf[r32] = f;
                asm volatile("s_waitcnt lgkmcnt(0)" ::: "memory");
#pragma unroll
                for (int r = 0; r < 16; ++r) { const float fr_ = wsf[crow(r, hi)]; o[0][r] *= fr_; o[1][r] *= fr_; }
                asm volatile("s_waitcnt lgkmcnt(0)" ::: "memory");
            }
        }
        float sacc = 0.f;
#pragma unroll
        for (int r = 0; r < 16; ++r) { p0[r] = __builtin_amdgcn_exp2f(p0[r]); p1[r] = __builtin_amdgcn_exp2f(p1[r]); sacc += p0[r] + p1[r]; }
        l_reg += sacc;
        u32x4 pw0, pw1, pw2, pw3;
        pw0 = (u32x4){cvtpk(p0[0], p0[1]), cvtpk(p0[2], p0[3]), cvtpk(p0[4], p0[5]), cvtpk(p0[6], p0[7])};
        pw1 = (u32x4){cvtpk(p0[8], p0[9]), cvtpk(p0[10], p0[11]), cvtpk(p0[12], p0[13]), cvtpk(p0[14], p0[15])};
        pw2 = (u32x4){cvtpk(p1[0], p1[1]), cvtpk(p1[2], p1[3]), cvtpk(p1[4], p1[5]), cvtpk(p1[6], p1[7])};
        pw3 = (u32x4){cvtpk(p1[8], p1[9]), cvtpk(p1[10], p1[11]), cvtpk(p1[12], p1[13]), cvtpk(p1[14], p1[15])};
        SBAR();
        pv(o, vb0 + slot, __builtin_bit_cast(bf16x8, pw0), __builtin_bit_cast(bf16x8, pw1), __builtin_bit_cast(bf16x8, pw2), __builtin_bit_cast(bf16x8, pw3));
        { const int tmp_ = slot; slot = s_nxt; s_nxt = s_nn; s_nn = tmp_; }
    }
    { auto rr = __builtin_amdgcn_permlane32_swap(__float_as_uint(l_reg), __float_as_uint(l_reg), false, false); l_reg = __uint_as_float(rr[0]) + __uint_as_float(rr[1]); }
    if (hi == 0) wsf[32 + r32] = l_reg; asm volatile("s_waitcnt lgkmcnt(0)" ::: "memory");
    float rli[16];
#pragma unroll
    for (int r = 0; r < 16; ++r) rli[r] = __builtin_amdgcn_rcpf(wsf[32 + crow(r, hi)]);
    { LAS bf16* stg = (LAS bf16*)(shm3 + LDS_OST) + wid * 2048;
#pragma unroll
      for (int r = 0; r < 16; ++r) { const int orow = crow(r, hi);
#pragma unroll
          for (int d0 = 0; d0 < 2; ++d0) stg[orow * 64 + d0 * 32 + r32] = (bf16)(cvtpk(o[d0][r] * rli[r], 0.f) & 0xffffu); }
      asm volatile("s_waitcnt lgkmcnt(0)" ::: "memory");
#pragma unroll
      for (int i = 0; i < 4; ++i) { const int row = i * 8 + (lane >> 3), ch = lane & 7; const u32x4 v = *(const LAS u32x4*)(stg + row * 64 + ch * 8); *(u32x4*)(Ow + (size_t)row * opitch + ch * 8) = v; } }
    asm volatile("s_waitcnt vmcnt(0) lgkmcnt(0)\n\ts_barrier" ::: "memory");
#undef ATT_DMA
}
#undef SBAR
#undef WAIT_BAR0
#undef WAIT_BAR2
}

struct SsmArgs { const float *lam_re, *lam_im, *log_step, *b_re, *b_im, *c_re, *c_im, *dskip;
                 const float* U; float* YF; bf16* OB; float* F; const float* h0; float* out_ssm; int layer; };
constexpr int SSM_PITCH = 132, SSM_WAVE_BYTES = 32 * SSM_PITCH * 4, LCH = 128, NLCH = 2048 / LCH;
template <int KIND, bool SECOND>
__device__ __forceinline__ void ssm_dir(const SsmArgs& A, int b, int g, int d, int k, LAS float* buf) {
    const int lane = FRESH_LANE();
    const int hi = lane >> 5, l31 = lane & 31, fr = lane & 15, fq = lane >> 4;
    const int gd = d * 16 + g;
    constexpr int CH = KIND == 0 ? 256 : LCH, NSC = CH / 32, L = KIND == 0 ? 256 : 2048;
    const int seqrow0 = KIND == 0 ? b * 256 : 4096 + b * 2048;
    const float step = expf(A.log_step[gd]);
    float ar[2], ai[2], cr[2], ci[2];
#pragma unroll
    for (int q = 0; q < 2; ++q) { const int p = l31 + 32 * q; const float lr = A.lam_re[gd * 64 + p], li = A.lam_im[gd * 64 + p];
        const float e = expf(lr * step); float s, c; sincosf(li * step, &s, &c); ar[q] = e * c; ai[q] = e * s;
        const float den = 1.0f / (lr * lr + li * li), xr = ar[q] - 1.0f; cr[q] = (xr * lr + ai[q] * li) * den; ci[q] = (ai[q] * lr - xr * li) * den; }
    float Bf[4][8];
#pragma unroll
    for (int q = 0; q < 2; ++q) { const int p = l31 + 32 * q; const float* br = A.b_re + ((size_t)gd * 64 + p) * 16; const float* bi = A.b_im + ((size_t)gd * 64 + p) * 16;
#pragma unroll
        for (int c4 = 0; c4 < 4; ++c4) { const f32x4 r = *(const f32x4*)(br + 4 * c4), im = *(const f32x4*)(bi + 4 * c4);
#pragma unroll
            for (int h2 = 0; h2 < 2; ++h2) { const float re_ = hi ? r[2 * h2 + 1] : r[2 * h2], im_ = hi ? im[2 * h2 + 1] : im[2 * h2];
                Bf[q][2 * c4 + h2] = cr[q] * re_ - ci[q] * im_; Bf[2 + q][2 * c4 + h2] = cr[q] * im_ + ci[q] * re_; } } }
    bf16x8 Cf[4];
    if (KIND != 1) {
#pragma unroll
        for (int ks = 0; ks < 4; ++ks) { const float* cp = (ks < 2 ? A.c_re : A.c_im) + ((size_t)gd * 16 + fr) * 64 + 32 * (ks & 1) + 8 * fq; const float sg = ks < 2 ? 1.0f : -1.0f;
            const f32x4 c0 = *(const f32x4*)cp * sg, c1 = *(const f32x4*)(cp + 4) * sg;
            Cf[ks] = __builtin_bit_cast(bf16x8, (u32x4){cvtpk(c0[0], c0[1]), cvtpk(c0[2], c0[3]), cvtpk(c1[0], c1[1]), cvtpk(c1[2], c1[3])}); }
    }
    const float sar = hi ? ar[1] : ar[0], sai = hi ? ai[1] : ai[0];
    float hr = 0.f, hm = 0.f;
    if (KIND == 2) {
        const size_t so = ((((size_t)(b * 2 + A.layer) * 2 + d) * 2) * 16 + g) * 64 + lane;
        hr = A.h0[so]; hm = A.h0[so + 16 * 64];
        float pr = sar, pi = sai;
#pragma unroll
        for (int i = 0; i < 7; ++i) { const float nr = pr * pr - pi * pi, ni = 2.0f * pr * pi; pr = nr; pi = ni; }
        static_assert(LCH == 128, "power");
        const float* Fp = A.F + ((((size_t)(b * 16 + g) * 2 + d) * NLCH) * 2) * 64 + lane;
        float fre[NLCH - 1], fim[NLCH - 1];
#pragma unroll
        for (int kk = 0; kk < NLCH - 1; ++kk) { fre[kk] = Fp[(size_t)kk * 128]; fim[kk] = Fp[(size_t)kk * 128 + 64]; }
#pragma unroll
        for (int kk = 0; kk < NLCH - 1; ++kk) if (kk < k) { const float nr = pr * hr - pi * hm + fre[kk], ni = pr * hm + pi * hr + fim[kk]; hr = nr; hm = ni; }
    }
    float dsk = 0.f; if (KIND != 1 && SECOND) dsk = A.dskip[g * 16 + fr];
    f32x4 un[4];
    { const int s = CH * k + l31; const int t = d ? L - 1 - s : s; const float* up = A.U + (size_t)(seqrow0 + t) * 256 + g * 16;
#pragma unroll
      for (int c4 = 0; c4 < 4; ++c4) un[c4] = *(const f32x4*)(up + 4 * c4); }
    for (int sc = 0; sc < NSC; ++sc) {
        const int s0 = CH * k + 32 * sc;
        float ua[8];
#pragma unroll
        for (int c4 = 0; c4 < 4; ++c4) { ua[2 * c4] = hi ? un[c4][1] : un[c4][0]; ua[2 * c4 + 1] = hi ? un[c4][3] : un[c4][2]; }
        if (sc + 1 < NSC) { const int s = s0 + 32 + l31; const int t = d ? L - 1 - s : s; const float* up = A.U + (size_t)(seqrow0 + t) * 256 + g * 16;
#pragma unroll
            for (int c4 = 0; c4 < 4; ++c4) un[c4] = *(const f32x4*)(up + 4 * c4); }
#pragma unroll
        for (int n = 0; n < 4; ++n) { f32x16 D = f32x16{};
#pragma unroll
            for (int kk = 0; kk < 8; ++kk) D = __builtin_amdgcn_mfma_f32_32x32x2f32(ua[kk], Bf[n][kk], D, 0, 0, 0);
#pragma unroll
            for (int r = 0; r < 16; ++r) buf[crow(r, hi) * SSM_PITCH + 32 * n + l31] = D[r]; }
        { float sre[32], sim[32];
#pragma unroll
          for (int j = 0; j < 32; ++j) { sre[j] = buf[j * SSM_PITCH + lane]; sim[j] = buf[j * SSM_PITCH + 64 + lane]; }
#pragma unroll
          for (int j = 0; j < 32; ++j) { const float nr = fmaf(sar, hr, fmaf(-sai, hm, sre[j])), ni = fmaf(sar, hm, fmaf(sai, hr, sim[j])); hr = nr; hm = ni; sre[j] = hr; sim[j] = hm; }
          if (KIND != 1) {
#pragma unroll
              for (int j = 0; j < 32; ++j) { buf[j * SSM_PITCH + lane] = sre[j]; buf[j * SSM_PITCH + 64 + lane] = sim[j]; } } }
        if (KIND != 1) {
            size_t oo[2][4]; float yv[2][4], uv[2][4];
#pragma unroll
            for (int rt = 0; rt < 2; ++rt)
#pragma unroll
                for (int r = 0; r < 4; ++r) { const int s = s0 + 16 * rt + 4 * fq + r; const int t = d ? L - 1 - s : s; oo[rt][r] = (size_t)(seqrow0 + t) * 256 + g * 16 + fr;
                    if (SECOND) { yv[rt][r] = A.YF[oo[rt][r]]; uv[rt][r] = A.U[oo[rt][r]]; } }
            f32x4 acc2[2];
#pragma unroll
            for (int rt = 0; rt < 2; ++rt) { f32x4 acc = {0.f, 0.f, 0.f, 0.f};
#pragma unroll
                for (int ks = 0; ks < 4; ++ks) { const LAS float* hp = buf + (16 * rt + fr) * SSM_PITCH + 32 * ks + 8 * fq; const f32x4 h0 = *(const LAS f32x4*)hp, h1 = *(const LAS f32x4*)(hp + 4);
                    const bf16x8 ahh = __builtin_bit_cast(bf16x8, (u32x4){cvtpk(h0[0], h0[1]), cvtpk(h0[2], h0[3]), cvtpk(h1[0], h1[1]), cvtpk(h1[2], h1[3])});
                    acc = __builtin_amdgcn_mfma_f32_16x16x32_bf16(ahh, Cf[ks], acc, 0, 0, 0); }
                acc2[rt] = acc; }
#pragma unroll
            for (int rt = 0; rt < 2; ++rt)
#pragma unroll
                for (int r = 0; r < 4; ++r) {
                    if (!SECOND) A.YF[oo[rt][r]] = acc2[rt][r];
                    else { const float v = acc2[rt][r] + yv[rt][r] + dsk * uv[rt][r]; const float q = 0.5f * v * (1.0f + tanhf(0.7978845608028654f * (v + 0.044715f * v * v * v)));
                           A.OB[oo[rt][r]] = (bf16)(cvtpk(q, 0.f) & 0xffffu); } }
        }
    }
    if (KIND == 0) { const size_t so = ((((size_t)(b * 2 + A.layer) * 2 + d) * 2) * 16 + g) * 64 + lane; A.out_ssm[so] = hr; A.out_ssm[so + 16 * 64] = hm; }
    if (KIND == 1) { const size_t fo = ((((size_t)(b * 16 + g) * 2 + d) * NLCH + k) * 2) * 64 + lane; A.F[fo] = hr; A.F[fo + 64] = hm; }
}
template <int KIND> __device__ __forceinline__ void ssm_both(const SsmArgs& A, int b, int g, int c, LAS float* buf) {
    ssm_dir<KIND, false>(A, b, g, 0, c, buf);
    asm volatile("s_waitcnt vmcnt(0)" ::: "memory");
    ssm_dir<KIND, true>(A, b, g, 1, (KIND == 0 ? 0 : NLCH - 1 - c), buf);
}

__device__ __forceinline__ void norm_mod_rows(const float* xc, const float* xl, const float* g, const float* mod, int sh_off, int sc_off, bf16* H, int gw, int NGW, int lane) {
    for (int row0 = gw; row0 < M_TOK; row0 += 2 * NGW) {
        const int row1 = row0 + NGW; const bool has1 = row1 < M_TOK;
        const float* xr0 = row0 < 4096 ? xc + (size_t)row0 * 1024 : xl + (size_t)(row0 - 4096) * 1024;
        const float* xr1 = has1 ? (row1 < 4096 ? xc + (size_t)row1 * 1024 : xl + (size_t)(row1 - 4096) * 1024) : xr0;
        f32x4 v0[4], v1[4]; float s0 = 0.f, s1 = 0.f;
#pragma unroll
        for (int j = 0; j < 4; ++j) { v0[j] = *(const f32x4*)(xr0 + 4 * (lane + 64 * j)); v1[j] = *(const f32x4*)(xr1 + 4 * (lane + 64 * j)); }
#pragma unroll
        for (int j = 0; j < 4; ++j) { s0 += (v0[j][0] * v0[j][0] + v0[j][1] * v0[j][1]) + (v0[j][2] * v0[j][2] + v0[j][3] * v0[j][3]); s1 += (v1[j][0] * v1[j][0] + v1[j][1] * v1[j][1]) + (v1[j][2] * v1[j][2] + v1[j][3] * v1[j][3]); }
        const float rstd0 = rsqrtf(wave_sum(s0) * (1.0f / 1024.0f) + EPS), rstd1 = rsqrtf(wave_sum(s1) * (1.0f / 1024.0f) + EPS);
        const float* mp0 = mod + (row0 < 4096 ? 0 : 1 + ((row0 - 4096) >> 11)) * 6144; const float* mp1 = mod + (row1 < 4096 ? 0 : 1 + (((has1 ? row1 : row0) - 4096) >> 11)) * 6144;
#pragma unroll
        for (int j = 0; j < 4; ++j) { const int c = 4 * (lane + 64 * j); const f32x4 gg = *(const f32x4*)(g + c);
            { const f32x4 sc = *(const f32x4*)(mp0 + sc_off + c), sh = *(const f32x4*)(mp0 + sh_off + c); const f32x4 o = v0[j] * rstd0 * gg * (sc + 1.0f) + sh; u32x2 w; w.x = cvtpk(o[0], o[1]); w.y = cvtpk(o[2], o[3]); *(u32x2*)(H + (size_t)row0 * 1024 + c) = w; }
            if (has1) { const f32x4 sc = *(const f32x4*)(mp1 + sc_off + c), sh = *(const f32x4*)(mp1 + sh_off + c); const f32x4 o = v1[j] * rstd1 * gg * (sc + 1.0f) + sh; u32x2 w; w.x = cvtpk(o[0], o[1]); w.y = cvtpk(o[2], o[3]); *(u32x2*)(H + (size_t)row1 * 1024 + c) = w; } }
    }
}
__device__ __forceinline__ void final_norm_rows(float* x, const float* g, int gw, int NGW, int lane) {
    for (int row = gw; row < M_TOK; row += NGW) {
        float* xr = x + (size_t)row * 1024;
        f32x4 v[4]; float ss = 0.f;
#pragma unroll
        for (int j = 0; j < 4; ++j) { v[j] = *(const f32x4*)(xr + 4 * (lane + 64 * j)); ss += (v[j][0] * v[j][0] + v[j][1] * v[j][1]) + (v[j][2] * v[j][2] + v[j][3] * v[j][3]); }
        const float rstd = rsqrtf(wave_sum(ss) * (1.0f / 1024.0f) + EPS);
#ifdef DBG_SCALE_S
        const float dsc = row >= 4096 ? DBG_SCALE_S : DBG_SCALE_P;
#else
        const float dsc = 1.0f;
#endif
#pragma unroll
        for (int j = 0; j < 4; ++j) { const int c = 4 * (lane + 64 * j); *(f32x4*)(xr + c) = v[j] * (rstd * dsc) * *(const f32x4*)(g + c); }
    }
}

__device__ __forceinline__ int maprow(int mode, int n) {
    if (mode == 1) { const int lc = n & 255; return (n & ~255) + 128 * ((lc >> 5) & 1) + 32 * (lc >> 6) + (lc & 31); }
    if (mode == 2) { if (n < DFF) return 256 * (n >> 7) + (n & 127); const int n2 = n - DFF; return 256 * (n2 >> 7) + 128 + (n2 & 127); }
    return n;
}
__device__ __forceinline__ void transpose_item(const float* W, int K, int N, bf16* WT, int mode, LAS float* scr, int item, int lane) {
    const int nblk = N / 32, kb = item / nblk, nb = item % nblk, k0 = 64 * kb, n0 = 32 * nb;
#pragma unroll
    for (int i = 0; i < 32; ++i) { const int kk = 2 * i + (lane >> 5); scr[kk * 33 + (lane & 31)] = W[(size_t)(k0 + kk) * N + n0 + (lane & 31)]; }
    asm volatile("s_waitcnt lgkmcnt(0)" ::: "memory");
    const int c = lane & 7;
#pragma unroll
    for (int j = 0; j < 4; ++j) { const int n = (lane >> 3) + 8 * j; const LAS float* s = scr + (8 * c) * 33 + n;
        u32x4 o; o.x = cvtpk(s[0 * 33], s[1 * 33]); o.y = cvtpk(s[2 * 33], s[3 * 33]); o.z = cvtpk(s[4 * 33], s[5 * 33]); o.w = cvtpk(s[6 * 33], s[7 * 33]);
        *(u32x4*)(WT + (size_t)maprow(mode, n0 + n) * K + k0 + 8 * c) = o; }
    asm volatile("s_waitcnt lgkmcnt(0)" ::: "memory");
}

struct Args { const float* in[33]; float* out; unsigned char* ws; int ph_lo, ph_hi; };
constexpr int N_PHASES = 20;

__global__ void __launch_bounds__(512, 2) mega_fwd(Args args) {
    extern __shared__ __attribute__((aligned(16))) unsigned char lds[];
    LAS unsigned char* L = (LAS unsigned char*)lds;
    cg::grid_group grid = cg::this_grid();
    unsigned* barw = (unsigned*)(args.ws + WS_BAR);
    volatile LAS unsigned* bst = (volatile LAS unsigned*)((LAS unsigned char*)lds + LDS_BYTES - 64);
    if (threadIdx.x == 0) { bst[0] = 0u; bst[1] = 0u; }
    if (blockIdx.x == 0) { for (int i = threadIdx.x; i < XCD_BAR_WORDS; i += 512) barw[i] = 0u; if (threadIdx.x < 64) ((unsigned*)(args.ws + WS_FLAG))[threadIdx.x] = 0u; }
    __syncthreads();
    XcdBarrier xbar; xbar.bar = barw; xbar.x = 0; xbar.st = bst;
    const int wave0 = __builtin_amdgcn_readfirstlane(threadIdx.x >> 6);
#ifdef DBG_XSYNC
    for (int i = 0; i < DBG_XSYNC; ++i) grid.sync();
#endif
#ifdef DBG_DUP
    int dup_done = -1;
#endif
    for (int ph = args.ph_lo; ph < args.ph_hi; ++ph) {
        if (ph > args.ph_lo) { if (ph == args.ph_lo + 1) { grid.sync(); xbar = xcd_barrier_post(barw, bst); } else xcd_barrier(xbar); }
        int wave = wave0; asm volatile("" : "+s"(wave)); int G = gridDim.x; asm volatile("" : "+s"(G)); int bx = blockIdx.x; asm volatile("" : "+s"(bx));
    const int gw = bx * 8 + wave, NGW = G * 8;
    unsigned char* ws = args.ws; asm volatile("" : "+s"(ws)); float* out = args.out; asm volatile("" : "+s"(out));
    float* MOD = (float*)(ws + WS_MOD); float* ROPE = (float*)(ws + WS_ROPE);
    bf16* Hb = (bf16*)(ws + WS_H); float* YF = (float*)(ws + WS_H);
    bf16 *QA = (bf16*)(ws + WS_QA), *KA = (bf16*)(ws + WS_KA), *VA = (bf16*)(ws + WS_VA), *QC = (bf16*)(ws + WS_QC), *KC = (bf16*)(ws + WS_KC), *VC = (bf16*)(ws + WS_VC);
    float* Ub = (float*)(ws + WS_U); bf16* MF = (bf16*)(ws + WS_QKVU);
    bf16* GATES = (bf16*)(ws + WS_GATES); bf16* ACT = (bf16*)(ws + WS_GATES);
    bf16 *OA = (bf16*)(ws + WS_OA), *OB = (bf16*)(ws + WS_OB), *OC = (bf16*)(ws + WS_OC);
    bf16 *CKAK = (bf16*)(ws + WS_CKAK), *CKAV = (bf16*)(ws + WS_CKAV), *CKCK = (bf16*)(ws + WS_CKCK), *CKCV = (bf16*)(ws + WS_CKCV);
    float* SSMF = (float*)(ws + WS_SSMF2); unsigned* FLAGS = (unsigned*)(ws + WS_FLAG);

        if (ph == 0) {
#ifdef DBG_DUP_P0
            for (int rep0 = 0; rep0 < 2; ++rep0) {
#endif
            const int lane = FRESH_LANE(), tid = wave * 64 + lane;
            LAS float* S = (LAS float*)(L + 69632);
            LAS float* red = (LAS float*)(L + 90112);
            if (bx < 192) {
                for (int i = tid; i < 5 * 1024; i += 512) { const int cv = i >> 10, kx = i & 1023; const float c = cv == 0 ? args.in[8][kx] : args.in[2][(cv - 1) * 1024 + kx]; S[i] = c / (1.0f + __expf(-c)); }
                __syncthreads();
                for (int item = bx; item < 192; item += G) {
                    const int l = item / 96, col = (item % 96) * 64 + lane;
                    const float* wp = args.in[9] + (size_t)l * 1024 * 6144 + col;
                    float a0 = 0.f, a1 = 0.f, a2 = 0.f, a3 = 0.f, a4 = 0.f;
#pragma unroll 16
                    for (int kk = 0; kk < 128; ++kk) { const int kx = wave * 128 + kk; const float w = wp[(size_t)kx * 6144];
                        a0 += S[kx] * w; a1 += S[1024 + kx] * w; a2 += S[2048 + kx] * w; a3 += S[3072 + kx] * w; a4 += S[4096 + kx] * w; }
                    red[(wave * 5 + 0) * 64 + lane] = a0; red[(wave * 5 + 1) * 64 + lane] = a1; red[(wave * 5 + 2) * 64 + lane] = a2; red[(wave * 5 + 3) * 64 + lane] = a3; red[(wave * 5 + 4) * 64 + lane] = a4;
                    __syncthreads();
                    if (wave < 5) { float s = args.in[10][l * 6144 + col];
#pragma unroll
                        for (int w8 = 0; w8 < 8; ++w8) s += red[(w8 * 5 + wave) * 64 + lane];
                        MOD[(l * 5 + wave) * 6144 + col] = s; }
                    __syncthreads();
                }
            }
            if (bx == G - 2 && tid < 256) { const int ll = tid >> 7, qk = (tid >> 6) & 1, e = tid & 63; ((float*)(ws + WS_QKG))[tid] = (qk ? args.in[14] : args.in[13])[ll * 64 + e]; }
            { const int gtid = bx * 512 + tid, NTH = G * 512;
#define CPY(idx, off, n) for (int i = gtid; i < (n) / 4; i += NTH) ((f32x4*)(ws + WS_PAR) + (off) / 4)[i] = ((const f32x4*)args.in[idx])[i];
              CPY(11, P_N1G, 2048) CPY(29, P_N2G, 2048) CPY(32, P_FING, 1024) CPY(7, P_SSM0, 32768) CPY(15, P_LAMR, 4096) CPY(16, P_LAMI, 4096) CPY(17, P_LSTEP, 64)
              CPY(18, P_BRE, 65536) CPY(19, P_BIM, 65536) CPY(20, P_CRE, 65536) CPY(21, P_CIM, 65536) CPY(22, P_SSMD, 512) CPY(24, P_NAB, 3720)
#undef CPY
            }
            if (bx == G - 1) { for (int i = tid; i < 1024; i += 512) { const int pos = i >> 4, f = i & 15; const float inv = 1.0f / powf(10000.0f, (float)f / 16.0f); const float ang = (float)pos * inv; ROPE[2 * i] = cosf(ang); ROPE[2 * i + 1] = sinf(ang); } }
            for (int it = bx * 512 + tid; it < 196608; it += G * 512) {
                const float* src; bf16* dst; int e;
                if (it < 65536) { const bool isv = it >= 32768; e = (it & 32767) * 8; const int d = e & 63, t = (e >> 6) & 255, h = (e >> 14) & 1, b = (e >> 15) & 3, l = e >> 17;
                    src = (isv ? args.in[4] : args.in[3]) + ((((size_t)(b * 2 + l) * 256 + t) * 2 + h) * 64 + d); dst = (isv ? CKAV : CKAK) + e; }
                else { const int i2 = it - 65536; const bool isv = i2 >= 65536; e = (i2 & 65535) * 8; const int d = e & 63, t = (e >> 6) & 255, h = (e >> 14) & 3, b = (e >> 16) & 3, l = e >> 18;
                    src = (isv ? args.in[6] : args.in[5]) + ((((size_t)(b * 2 + l) * 256 + t) * 4 + h) * 64 + d); dst = (isv ? CKCV : CKCK) + e; }
                const f32x4 a = *(const f32x4*)src, c = *(const f32x4*)(src + 4);
                *(u32x4*)dst = (u32x4){cvtpk(a[0], a[1]), cvtpk(a[2], a[3]), cvtpk(c[0], c[1]), cvtpk(c[2], c[3])};
            }
            LAS float* scr = (LAS float*)(L + wave * 8448);
            for (int it = gw; it < 15424; it += NGW) {
                const int l = it / 7712; int r = it % 7712;
                if (r < 2432) { transpose_item(args.in[12] + (size_t)l * DM * NIN, DM, NIN, (bf16*)(ws + W_IN) + (size_t)l * NIN * DM, 1, scr, r, lane); continue; } r -= 2432;
                if (r < 256) { transpose_item(args.in[25] + (size_t)l * 512 * DM, 512, DM, (bf16*)(ws + W_BRA) + (size_t)l * DM * 512, 0, scr, r, lane); continue; } r -= 256;
                if (r < 128) { transpose_item(args.in[26] + (size_t)l * 256 * DM, 256, DM, (bf16*)(ws + W_BRB) + (size_t)l * DM * 256, 0, scr, r, lane); continue; } r -= 128;
                if (r < 128) { transpose_item(args.in[27] + (size_t)l * 256 * DM, 256, DM, (bf16*)(ws + W_BRC) + (size_t)l * DM * 256, 0, scr, r, lane); continue; } r -= 128;
                if (r < 512) { transpose_item(args.in[28] + (size_t)l * DM * DM, DM, DM, (bf16*)(ws + W_OUT) + (size_t)l * DM * DM, 0, scr, r, lane); continue; } r -= 512;
                if (r < 2816) { transpose_item(args.in[30] + (size_t)l * DM * NGU, DM, NGU, (bf16*)(ws + W_GU) + (size_t)l * NGU * DM, 2, scr, r, lane); continue; } r -= 2816;
                if (r < 1408) { transpose_item(args.in[31] + (size_t)l * DFF * DM, DFF, DM, (bf16*)(ws + W_FD) + (size_t)l * DM * DFF, 0, scr, r, lane); continue; } r -= 1408;
                transpose_item(args.in[23] + (size_t)l * 256 * 256, 256, 256, (bf16*)(ws + W_GLU) + (size_t)l * 256 * 256, 0, scr, r, lane);
            }
            __syncthreads();
#ifdef DBG_DUP_P0
            }
#endif
            continue;
        }
        const float* const PAR = (const float*)(ws + WS_PAR);
        if (ph == N_PHASES - 1) { const int lane = FRESH_LANE(); final_norm_rows(out, PAR + P_FING, gw, NGW, lane); continue; }
        const int l = (ph - 1) / 9, sp = (ph - 1) % 9;
        const float* modl = MOD + (size_t)l * 5 * 6144;
        const float* xc_in = args.in[0]; const float* xl_in = args.in[1];
        const float* xc_cur = out; const float* xl_cur = out + (size_t)4096 * 1024;
        pg8::StaticOrder S;
        switch (sp) {
        case 0: {
            const bool first = (l == 0); const int lane = FRESH_LANE();
            norm_mod_rows(first ? xc_in : xc_cur, first ? xl_in : xl_cur, PAR + P_N1G + l * 1024, modl, 0, 1024, Hb, gw, NGW, lane);
        } break;
        case 1: {
            pg8::Gemm g{Hb, (const bf16*)(ws + W_IN) + (size_t)l * NIN * DM, M_TOK, NIN, DM}; S.init(M_TOK, NIN, G, bx);
            EpiIn E{ws, out, l};

#ifndef CUT_IN
            pg8::gemm_phase<EpiIn, pg8::StaticOrder, true, true>(L, g, S, E, wave);
#endif

        } break;
        case 2: {
            SsmArgs SA{PAR + P_LAMR + l * 2048, PAR + P_LAMI + l * 2048, PAR + P_LSTEP + l * 32, PAR + P_BRE + (size_t)l * 32768, PAR + P_BIM + (size_t)l * 32768, PAR + P_CRE + (size_t)l * 32768, PAR + P_CIM + (size_t)l * 32768,
                       PAR + P_SSMD + l * 256, Ub, YF, OB, SSMF, PAR + P_SSM0, out + O_SSM, l};
            volatile LAS unsigned* qslot = (volatile LAS unsigned*)((LAS unsigned char*)lds + LDS_BYTES - 32);
            for (;;) {
                __syncthreads();
                if (wave == 0 && FRESH_LANE() == 0) qslot[0] = __hip_atomic_fetch_add(FLAGS + 56 + l, 1u, __ATOMIC_RELAXED, __HIP_MEMORY_SCOPE_AGENT);
                __syncthreads();
                int item = (int)qslot[0]; item = __builtin_amdgcn_readfirstlane(item);
                if (item >= 864) break;
                if (item < 32) item += 384; else if (item < 288) item -= 32; else if (item < 416) item -= 32; else if (item < 608) item += 256; else item -= 192;
                if (item < 256) {
                    const int b = item >> 6, h = (item >> 3) & 7, qb = item & 7, kvh = h >> 2;
                    const bf16* Qw = QA + ((size_t)4096 * 8 + (size_t)(b * 8 + h) * 2048 + qb * 256 + wave * 32) * 64;
                    const size_t co = ((size_t)((l * 4 + b) * 2 + kvh) * 256) * 64, lo = ((size_t)4096 * 2 + (size_t)(b * 2 + kvh) * 2048) * 64;
                    bf16* Ow = OA + ((size_t)4096 + b * 2048 + qb * 256 + wave * 32) * 512 + h * 64;
                    att::attn_unit<false>(Qw, CKAK + co, CKAV + co, KA + lo, VA + lo, 36, Ow, 512, (char*)lds, 0, 0, nullptr, wave);
                } else if (item < 384) {
                    const int i = item - 256, b = i >> 5, h = (i >> 3) & 3, qb = i & 7, r0 = 4 * qb;
                    const int rlo = clampi(r0 - 4, 0, 24), rhi = clampi(r0 - 1, 0, 24) + 7, NT = 4 + rhi - rlo + 1;
                    const bf16* Qw = QC + ((size_t)4096 * 4 + (size_t)(b * 4 + h) * 2048 + qb * 256 + wave * 32) * 64;
                    const size_t co = ((size_t)((l * 4 + b) * 4 + h) * 256) * 64, lo = ((size_t)4096 * 4 + (size_t)(b * 4 + h) * 2048 + rlo * 64) * 64;
                    bf16* Ow = OC + ((size_t)4096 + b * 2048 + qb * 256 + wave * 32) * 256 + h * 64;
                    att::attn_unit<true>(Qw, CKCK + co, CKCV + co, KC + lo, VC + lo, NT, Ow, 256, (char*)lds, r0 + (wave >> 1), rlo, PAR + P_NAB + (size_t)(l * 4 + h) * 465, wave);
                } else if (item < 416) {
                    const int wu = (item - 384) * 8 + wave;
                    ssm_both<0>(SA, wu >> 4, wu & 15, 0, (LAS float*)(L + wave * SSM_WAVE_BYTES));
                    asm volatile("s_waitcnt vmcnt(0) lgkmcnt(0)" ::: "memory"); __syncthreads();
                } else if (item < 672) {
                    const int wu = (item - 416) * 8 + wave;
                    ssm_dir<1, false>(SA, wu >> 9, (wu >> 5) & 15, (wu >> 4) & 1, wu & 15, (LAS float*)(L + wave * SSM_WAVE_BYTES));
                    asm volatile("s_waitcnt vmcnt(0) lgkmcnt(0)" ::: "memory"); __syncthreads();
                } else if (item < 800) {
                    const int i = item - 672, b = i >> 3, h = i & 7, kvh = h >> 2;
                    const bf16* Qw = QA + ((size_t)(b * 8 + h) * 256 + wave * 32) * 64;
                    const size_t co = ((size_t)(b * 2 + kvh) * 256) * 64;
                    bf16* Ow = OA + ((size_t)b * 256 + wave * 32) * 512 + h * 64;
                    att::attn_unit<false>(Qw, KA + co, VA + co, KA, VA, 4, Ow, 512, (char*)lds, 0, 0, nullptr, wave);
                } else {
                    const int i = item - 800, b = i >> 2, h = i & 3;
                    const bf16* Qw = QC + ((size_t)(b * 4 + h) * 256 + wave * 32) * 64;
                    const size_t co = ((size_t)(b * 4 + h) * 256) * 64;
                    bf16* Ow = OC + ((size_t)b * 256 + wave * 32) * 256 + h * 64;
                    att::attn_unit<false>(Qw, KC + co, VC + co, KC, VC, 4, Ow, 256, (char*)lds, 0, 0, nullptr, wave);
                }
            }
        } break;
        case 3: {
            SsmArgs SA{PAR + P_LAMR + l * 2048, PAR + P_LAMI + l * 2048, PAR + P_LSTEP + l * 32, PAR + P_BRE + (size_t)l * 32768, PAR + P_BIM + (size_t)l * 32768, PAR + P_CRE + (size_t)l * 32768, PAR + P_CIM + (size_t)l * 32768,
                       PAR + P_SSMD + l * 256, Ub, YF, OB, SSMF, PAR + P_SSM0, out + O_SSM, l};
            for (int wu = wave * G + bx; wu < 1024; wu += 8 * G) ssm_both<2>(SA, wu >> 8, (wu >> 4) & 15, wu & 15, (LAS float*)(L + wave * SSM_WAVE_BYTES));
            asm volatile("s_waitcnt vmcnt(0) lgkmcnt(0)" ::: "memory");
            __syncthreads();
        } break;
        case 4: {
            pg8::StaticOrder SG; SG.init(M_TOK, 256, G, bx); Unit ug;
            if (SG.next(0, ug)) {
                pg8::Gemm g{OB, (const bf16*)(ws + W_GLU) + (size_t)l * 256 * 256, M_TOK, 256, 256};
                EpiGlu E{OB};
                pg8::gemm_phase<EpiGlu, pg8::StaticOrder, true, true>(L, g, SG, E, wave);
                asm volatile("s_waitcnt vmcnt(0)" ::: "memory");
                __syncthreads();
                if (wave == 0) { __builtin_amdgcn_fence(__ATOMIC_RELEASE, "agent"); asm volatile("s_waitcnt vmcnt(0)" ::: "memory");
                    if (FRESH_LANE() == 0) __hip_atomic_store(FLAGS + ug.pm, (unsigned)(l + 1), __ATOMIC_RELAXED, __HIP_MEMORY_SCOPE_AGENT); }
            }
            S.init(M_TOK, DM, G, bx);
            { pg8::Gemm g{OA, (const bf16*)(ws + W_BRA) + (size_t)l * DM * 512, M_TOK, DM, 512}; EpiBr<0> E{GATES, MF, nullptr}; pg8::gemm_phase<EpiBr<0>, pg8::StaticOrder, true, true>(L, g, S, E, wave); }
            { pg8::Gemm g{OC, (const bf16*)(ws + W_BRC) + (size_t)l * DM * 256, M_TOK, DM, 256}; EpiBr<1> E{GATES + 2048, MF, nullptr}; pg8::gemm_phase<EpiBr<1>, pg8::StaticOrder, true, true>(L, g, S, E, wave); }
            { Unit ub; if (S.next(0, ub)) {
                if (wave == 0) { unsigned sp_ = 0; while (__hip_atomic_load(FLAGS + ub.pm, __ATOMIC_RELAXED, __HIP_MEMORY_SCOPE_AGENT) < (unsigned)(l + 1)) { __builtin_amdgcn_s_sleep(2); if (++sp_ > (1u << 24)) break; }
                    __builtin_amdgcn_fence(__ATOMIC_ACQUIRE, "agent"); asm volatile("s_waitcnt vmcnt(0)" ::: "memory"); }
                __syncthreads(); } }
            { pg8::Gemm g{OB, (const bf16*)(ws + W_BRB) + (size_t)l * DM * 256, M_TOK, DM, 256}; EpiBr<2> E{GATES + 1024, MF, Hb}; pg8::gemm_phase<EpiBr<2>, pg8::StaticOrder, true, true>(L, g, S, E, wave); }
        } break;
        case 5: {
            S.init(M_TOK, DM, G, bx);
            pg8::Gemm g{Hb, (const bf16*)(ws + W_OUT) + (size_t)l * DM * DM, M_TOK, DM, DM};
            EpiRes E{l == 0 ? xc_in : xc_cur, l == 0 ? xl_in : xl_cur, out, modl + 2048};
            pg8::gemm_phase<EpiRes, pg8::StaticOrder, true, true>(L, g, S, E, wave);
        } break;
        case 6: {
            const int lane = FRESH_LANE();
            norm_mod_rows(xc_cur, xl_cur, PAR + P_N2G + l * 1024, modl, 3072, 4096, Hb, gw, NGW, lane);
        } break;
        case 7: {
            pg8::Gemm g{Hb, (const bf16*)(ws + W_GU) + (size_t)l * NGU * DM, M_TOK, NGU, DM}; S.init(M_TOK, NGU, G, bx);
            EpiSwiglu E{ACT};
            pg8::gemm_phase<EpiSwiglu, pg8::StaticOrder, true, true>(L, g, S, E, wave);
        } break;
        case 8: {
            S.init(M_TOK, DM, G, bx);
            pg8::Gemm g{ACT, (const bf16*)(ws + W_FD) + (size_t)l * DM * DFF, M_TOK, DM, DFF};
            EpiRes E{xc_cur, xl_cur, out, modl + 5120};
            pg8::gemm_phase<EpiRes, pg8::StaticOrder, true, true>(L, g, S, E, wave);
        } break;
        }
#ifdef DBG_DUP
        if (sp == DBG_DUP && dup_done != ph) { dup_done = ph; --ph; }
#endif
    }
}

extern "C" void kernel_launch(void* const* d_in, const int* in_sizes, int n_in, void* d_out, int out_size, void* d_ws, size_t ws_size, hipStream_t stream) {
    static int grid = 0;
    if (grid == 0) {
        if (n_in != 33 || ws_size < WS_END) { fprintf(stderr, "kernel_launch: unexpected n_in %d / ws_size %zu\n", n_in, ws_size); grid = -1; return; }
        int dev = 0, cus = 0, per_cu = 0;
        hipGetDevice(&dev); hipDeviceGetAttribute(&cus, hipDeviceAttributeMultiprocessorCount, dev);
        if (hipFuncSetAttribute((const void*)mega_fwd, hipFuncAttributeMaxDynamicSharedMemorySize, LDS_BYTES) != hipSuccess) { fprintf(stderr, "kernel_launch: hipFuncSetAttribute failed\n"); grid = -1; return; }
        if (hipOccupancyMaxActiveBlocksPerMultiprocessor(&per_cu, (const void*)mega_fwd, 512, LDS_BYTES) != hipSuccess || per_cu < 1) { fprintf(stderr, "kernel_launch: occupancy query says %d\n", per_cu); per_cu = 1; }
        (void)hipGetLastError();
        grid = cus * 1;
        fprintf(stderr, "kernel_launch: cus %d per_cu %d grid %d ws %zu\n", cus, per_cu, grid, ws_size);
    }
    if (grid < 0) return;
    Args a{};
    for (int i = 0; i < 33; ++i) a.in[i] = (const float*)d_in[i];
    a.out = (float*)d_out; a.ws = (unsigned char*)d_ws;
#if MK_MULTI
    for (int ph = 0; ph < N_PHASES; ++ph) { a.ph_lo = ph; a.ph_hi = ph + 1; hipLaunchKernelGGL(mega_fwd, dim3(grid), dim3(512), LDS_BYTES, stream, a); }
#else
    a.ph_lo = 0; a.ph_hi = N_PHASES;
    void* kargs[] = {&a};
    hipError_t e = hipLaunchCooperativeKernel((const void*)mega_fwd, dim3(grid), dim3(512), kargs, LDS_BYTES, stream);
    if (e != hipSuccess) fprintf(stderr, "cooperative launch failed: %s (grid %d)\n", hipGetErrorString(e), grid);
#endif
}
```

```cpp
#include <hip/hip_runtime.h>
#include <hip/hip_cooperative_groups.h>
#include <hip/hip_bf16.h>
#include <cstdio>
#include <cstdint>
namespace cg = cooperative_groups;

#ifndef MK_MULTI
#define MK_MULTI 0
#endif

namespace pg8 {
#define PG8_LAS __attribute__((address_space(3)))
typedef unsigned short bf16_t;
typedef short bf16x8 __attribute__((ext_vector_type(8)));
typedef float f32x4 __attribute__((ext_vector_type(4)));
typedef unsigned u32x4 __attribute__((ext_vector_type(4)));
constexpr int BM = 256, BK = 64, HALF = 128, HTB = HALF * BK * 2  , STAGE_BYTES = 8 * HTB, NXCD = 8, WGM = 8;

__host__ __device__ __forceinline__ int lds_byte(int r, int c) { const int st = (r >> 4) * 2 + (c >> 5), rr = r & 15, cc = c & 31, ob = rr * 64 + cc * 2; return st * 1024 + (ob ^ (((ob >> 9) & 1) << 5)); }
__host__ __device__ __forceinline__ void stage_rc(int b, int& R, int& C) { const int st = b / 1024, sb = b % 1024, swz = sb ^ (((sb >> 9) & 1) << 5); R = (st >> 1) * 16 + swz / 64; C = (st & 1) * 32 + (swz % 64) / 2; }
__host__ __device__ __forceinline__ int perm32(int rho) { const int n = rho >> 4, i = rho & 15; return 8 * (i >> 2) + 4 * n + (i & 3); }

struct Unit { int pm, pn; };
struct Gemm { const bf16_t* A; const bf16_t* Bt; int M, N, K; };

struct StaticOrder {
    int nM, nN, nwg, G, c;
    __host__ __device__ void init(int M, int N, int G_, int c_) { nM = M / BM; nN = N / BM; nwg = nM * nN; G = G_; c = c_; }
    __host__ __device__ bool next(int i, Unit& u) const {
        const long L = (long)i * G + c; if (L >= nwg) return false;
        int wgid = (int)L; { const int q = nwg / NXCD, r = nwg % NXCD, xcd = wgid % NXCD, off = wgid / NXCD; wgid = (xcd < r ? xcd * (q + 1) : r * (q + 1) + (xcd - r) * q) + off; }
        const int nig = WGM * nN, gid = wgid / nig, fm = gid * WGM, gsz = (nM - fm) < WGM ? (nM - fm) : WGM;
        u.pm = fm + ((wgid % nig) % gsz); u.pn = (wgid % nig) / gsz; return true;
    }
    __device__ __forceinline__ void a_ready(const Unit&) const {}
    __device__ __forceinline__ void done(const Unit&) const {}
};

__device__ __forceinline__ unsigned cvt_pk_bf16(float lo, float hi) { unsigned r; asm volatile("v_cvt_pk_bf16_f32 %0, %1, %2" : "=v"(r) : "v"(lo), "v"(hi)); return r; }
typedef float f32x2 __attribute__((ext_vector_type(2)));
template <class Epi, class Sched, bool ALIGN_EPI = false, bool SP2 = false>
__device__ __forceinline__ void gemm_phase(PG8_LAS unsigned char* lds, const Gemm g, const Sched& S, const Epi& E, const int wid) {
    int lane; asm volatile("v_mbcnt_lo_u32_b32 %0, -1, 0\n\tv_mbcnt_hi_u32_b32 %0, -1, %0" : "=v"(lane)); const int tid = wid * 64 + lane, wr = wid >> 2, wc = wid & 3, fr = lane & 15, fq = lane >> 4;
    const int K = g.K, nt = K / BK;
    unsigned voffA[2], voffB[2];
#pragma unroll
    for (int i = 0; i < 2; ++i) { int R, C; stage_rc(tid * 16 + i * 8192, R, C); const int Rb = Epi::PERM ? ((R & ~31) + perm32(R & 31)) : R;
        voffA[i] = (unsigned)(R * K + C) * 2u; voffB[i] = (unsigned)(Rb * K + C) * 2u; }
    const size_t kstep = (size_t)(BK * 2);
    const size_t hstep = (size_t)HALF * K * 2;
    const size_t tstep = 2 * hstep;
    const unsigned ldsw = (unsigned)wid * 1024u;
    const int aoff = lds_byte(wr * 64 + fr, fq * 8), boff = lds_byte(wc * 32 + fr, fq * 8);
#define PG8_SA(b, h) (((b) * 2 + (h)) * HTB)
#define PG8_SB(b, h) ((4 + (b) * 2 + (h)) * HTB)
#define PG8_STAGE(bufoff, gbase, voff) do { _Pragma("unroll") for (int _i = 0; _i < 2; ++_i) \
        __builtin_amdgcn_global_load_lds((const unsigned*)((const char*)(gbase) + (voff)[_i]), (PG8_LAS unsigned*)(lds + (bufoff) + ldsw + _i * 8192), 16, 0, 0); } while (0)
#define PG8_LDA(dst, b, h) do { _Pragma("unroll") for (int m = 0; m < 4; ++m) _Pragma("unroll") for (int k = 0; k < 2; ++k) dst[m][k] = *(const PG8_LAS bf16x8*)(lds + PG8_SA(b, h) + aoff + m * 2048 + k * 1024); } while (0)
#define PG8_LDB(dst, b, h) do { _Pragma("unroll") for (int n = 0; n < 2; ++n) _Pragma("unroll") for (int k = 0; k < 2; ++k) dst[n][k] = *(const PG8_LAS bf16x8*)(lds + PG8_SB(b, h) + boff + n * 2048 + k * 1024); } while (0)
#define PG8_MMA(ai, bj, At, Bt) do { __builtin_amdgcn_s_setprio(1); _Pragma("unroll") for (int m = 0; m < 4; ++m) _Pragma("unroll") for (int n = 0; n < 2; ++n) _Pragma("unroll") for (int k = 0; k < 2; ++k) \
        acc[ai][bj][m][n] = __builtin_amdgcn_mfma_f32_16x16x32_bf16(Bt[n][k], At[m][k], acc[ai][bj][m][n], 0, 0, 0); __builtin_amdgcn_s_setprio(0); } while (0)
#define PG8_WAIT_V(n) asm volatile("s_waitcnt vmcnt(" #n ")" ::: "memory")
#define PG8_WAIT_L(n) asm volatile("s_waitcnt lgkmcnt(" #n ")" ::: "memory")
#define PG8_BAR __builtin_amdgcn_s_barrier()
#define PG8_SCHED __builtin_amdgcn_sched_barrier(0)
    Unit cur, nxt; int ui = 0;
    if (!S.next(0, cur)) return;
    f32x4 acc[2][2][4][2];
#pragma unroll
    for (int a = 0; a < 2; ++a)
#pragma unroll
        for (int b = 0; b < 2; ++b)
#pragma unroll
            for (int m = 0; m < 4; ++m)
#pragma unroll
                for (int n = 0; n < 2; ++n) acc[a][b][m][n] = (f32x4){0.f, 0.f, 0.f, 0.f};
    bf16x8 At[4][2], B0[2][2], B1[2][2];
    const char* cA = (const char*)g.A + (size_t)cur.pm * tstep; const char* cB = (const char*)g.Bt + (size_t)cur.pn * tstep;
    S.a_ready(cur);
    if constexpr (SP2) {
        PG8_STAGE(PG8_SB(0, 0), cB, voffB); PG8_STAGE(PG8_SB(0, 1), cB + hstep, voffB); PG8_STAGE(PG8_SA(0, 0), cA, voffA); PG8_STAGE(PG8_SA(0, 1), cA + hstep, voffA);
        if (wr == 1) PG8_BAR;
        PG8_WAIT_V(2); PG8_BAR;
        PG8_STAGE(PG8_SB(1, 0), cB + kstep, voffB); PG8_STAGE(PG8_SA(1, 0), cA + kstep, voffA); PG8_STAGE(PG8_SB(1, 1), cB + hstep + kstep, voffB);
        PG8_WAIT_V(6); PG8_BAR;
    } else {
        PG8_STAGE(PG8_SB(0, 0), cB, voffB); PG8_STAGE(PG8_SA(0, 0), cA, voffA); PG8_STAGE(PG8_SB(0, 1), cB + hstep, voffB); PG8_STAGE(PG8_SA(0, 1), cA + hstep, voffA);
        if (wr == 1) PG8_BAR;
        PG8_WAIT_V(4); PG8_BAR;
        PG8_STAGE(PG8_SB(1, 0), cB + kstep, voffB); PG8_STAGE(PG8_SA(1, 0), cA + kstep, voffA); PG8_STAGE(PG8_SB(1, 1), cB + hstep + kstep, voffB);
        PG8_WAIT_V(6); PG8_BAR;
    }
    for (;;) {
        const bool has_next = S.next(ui + 1, nxt);
        const char* nA = has_next ? (const char*)g.A + (size_t)nxt.pm * tstep : cA; const char* nB = has_next ? (const char*)g.Bt + (size_t)nxt.pn * tstep : cB;
        for (int t = 0; t < nt; t += 2) {
            const bool last = (t == nt - 2);
            const char* a1 = cA + (size_t)(t + 1) * kstep;
            const char* a2 = last ? nA : cA + (size_t)(t + 2) * kstep; const char* b2 = last ? nB : cB + (size_t)(t + 2) * kstep;
            const char* a3 = a2 + kstep; const char* b3 = b2 + kstep;
            if (last && has_next) S.a_ready(nxt);
            if constexpr (SP2) {
            PG8_LDB(B0, 0, 0); PG8_LDB(B1, 0, 1); PG8_SCHED; PG8_LDA(At, 0, 0); PG8_STAGE(PG8_SA(1, 1), a1 + hstep, voffA);
            PG8_WAIT_V(8); PG8_WAIT_L(0); PG8_BAR; PG8_MMA(0, 0, At, B0); PG8_MMA(0, 1, At, B1); PG8_BAR; PG8_SCHED;
            PG8_LDA(At, 0, 1); PG8_STAGE(PG8_SB(0, 0), b2, voffB); PG8_STAGE(PG8_SB(0, 1), b2 + hstep, voffB); PG8_STAGE(PG8_SA(0, 0), a2, voffA);
            PG8_WAIT_V(8); PG8_WAIT_L(0); PG8_BAR; PG8_MMA(1, 0, At, B0); PG8_MMA(1, 1, At, B1); PG8_BAR; PG8_SCHED;
            PG8_LDB(B0, 1, 0); PG8_LDB(B1, 1, 1); PG8_SCHED; PG8_LDA(At, 1, 0); PG8_STAGE(PG8_SA(0, 1), a2 + hstep, voffA);
            PG8_WAIT_V(8); PG8_WAIT_L(0); PG8_BAR; PG8_MMA(0, 0, At, B0); PG8_MMA(0, 1, At, B1); PG8_BAR; PG8_SCHED;
            PG8_LDA(At, 1, 1); PG8_STAGE(PG8_SB(1, 0), b3, voffB); PG8_STAGE(PG8_SB(1, 1), b3 + hstep, voffB); PG8_STAGE(PG8_SA(1, 0), a3, voffA);
            PG8_WAIT_V(8); PG8_WAIT_L(0); PG8_BAR; PG8_MMA(1, 0, At, B0); PG8_MMA(1, 1, At, B1); PG8_BAR; PG8_SCHED;
            } else {
            PG8_LDB(B0, 0, 0); PG8_SCHED; PG8_LDA(At, 0, 0); PG8_STAGE(PG8_SA(1, 1), a1 + hstep, voffA);
            PG8_WAIT_L(8); PG8_BAR; PG8_WAIT_L(0); PG8_MMA(0, 0, At, B0); PG8_BAR; PG8_SCHED;
            PG8_LDB(B1, 0, 1); PG8_STAGE(PG8_SB(0, 0), b2, voffB);
            PG8_BAR; PG8_WAIT_L(0); PG8_MMA(0, 1, At, B1); PG8_BAR;
            PG8_LDA(At, 0, 1); PG8_STAGE(PG8_SA(0, 0), a2, voffA);
            PG8_BAR; PG8_WAIT_L(0); PG8_MMA(1, 0, At, B0); PG8_BAR; PG8_SCHED;
            PG8_STAGE(PG8_SB(0, 1), b2 + hstep, voffB);
            PG8_WAIT_V(6); PG8_BAR; PG8_MMA(1, 1, At, B1); PG8_BAR;
            PG8_LDB(B0, 1, 0); PG8_SCHED; PG8_LDA(At, 1, 0); PG8_STAGE(PG8_SA(0, 1), a2 + hstep, voffA);
            PG8_WAIT_L(8); PG8_BAR; PG8_WAIT_L(0); PG8_MMA(0, 0, At, B0); PG8_BAR; PG8_SCHED;
            PG8_LDB(B1, 1, 1); PG8_STAGE(PG8_SB(1, 0), b3, voffB);
            PG8_BAR; PG8_WAIT_L(0); PG8_MMA(0, 1, At, B1); PG8_BAR;
            PG8_LDA(At, 1, 1); PG8_STAGE(PG8_SA(1, 0), a3, voffA);
            PG8_BAR; PG8_WAIT_L(0); PG8_MMA(1, 0, At, B0); PG8_BAR; PG8_SCHED;
            PG8_STAGE(PG8_SB(1, 1), b3 + hstep, voffB);
            PG8_WAIT_V(6); PG8_BAR; PG8_MMA(1, 1, At, B1); PG8_BAR;
            }
        }
        if constexpr (ALIGN_EPI) { if (wr == 0) PG8_BAR; }
        if constexpr (!Epi::AFTER_DRAIN) { E(acc, cur, wr, wc, fr, fq); S.done(cur); }
        if (!has_next) break;
#pragma unroll
        for (int a = 0; a < 2; ++a)
#pragma unroll
            for (int b = 0; b < 2; ++b)
#pragma unroll
                for (int m = 0; m < 4; ++m)
#pragma unroll
                    for (int n = 0; n < 2; ++n) acc[a][b][m][n] = (f32x4){0.f, 0.f, 0.f, 0.f};
        cur = nxt; cA = nA; cB = nB; ++ui;
        if constexpr (ALIGN_EPI) { if (wr == 1) PG8_BAR; }
    }
    PG8_WAIT_V(0);
    if constexpr (!ALIGN_EPI) { if (wr == 0) PG8_BAR; }
    PG8_BAR;
    if constexpr (Epi::AFTER_DRAIN) { E.fused(acc, cur, wr, wc, fr, fq, lds, wid, lane); S.done(cur); }
#undef PG8_SA
#undef PG8_SB
#undef PG8_STAGE
#undef PG8_LDA
#undef PG8_LDB
#undef PG8_MMA
#undef PG8_WAIT_V
#undef PG8_WAIT_L
#undef PG8_BAR
#undef PG8_SCHED
}
}

#define LAS __attribute__((address_space(3)))
typedef unsigned short bf16;
typedef short bf16x8 __attribute__((ext_vector_type(8)));
typedef short s16x4 __attribute__((ext_vector_type(4)));
typedef float f32x4 __attribute__((ext_vector_type(4)));
typedef float f32x16 __attribute__((ext_vector_type(16)));
typedef unsigned u32x4 __attribute__((ext_vector_type(4)));
typedef unsigned u32x2 __attribute__((ext_vector_type(2)));
typedef float f32x2_t __attribute__((ext_vector_type(2)));
typedef __bf16 bf16x2_t __attribute__((ext_vector_type(2)));

constexpr int M_TOK = 12288, M_CTX = 4096, DM = 1024, NIN = 4864, DFF = 2816, NGU = 5632;
constexpr float EPS = 1e-6f, LOG2E = 1.4426950408889634f, C2 = 0.125f * 1.4426950408889634f;
constexpr size_t MiB = 1u << 20;
constexpr size_t WS_ROPE = 0, WS_QKG = 16384, WS_BAR = 458752, WS_FLAG = 475136, WS_CNT = 512 * 1024, WS_TMO = 512 * 1024 + 61440, WS_XBUF = 576 * 1024, WS_MOD = 65536, WS_SSMF = 512 * 1024, WS_CKAK = 1 * MiB, WS_CKAV = 1 * MiB + 512 * 1024, WS_CKCK = 2 * MiB, WS_CKCV = 3 * MiB;
constexpr size_t WS_W = 4 * MiB;
constexpr size_t W_IN = WS_W, W_BRA = W_IN + 2ull * NIN * DM * 2, W_BRB = W_BRA + 2ull * DM * 512 * 2, W_BRC = W_BRB + 2ull * DM * 256 * 2, W_OUT = W_BRC + 2ull * DM * 256 * 2,
                 W_GU = W_OUT + 2ull * DM * DM * 2, W_FD = W_GU + 2ull * NGU * DM * 2, W_GLU = W_FD + 2ull * DM * DFF * 2, W_END = W_GLU + 2ull * 256 * 256 * 2;
constexpr size_t WS_H = 65 * MiB;
constexpr size_t WS_QKVU = 89 * MiB;
constexpr size_t WS_QA = WS_QKVU, WS_KA = WS_QA + 12 * MiB, WS_VA = WS_KA + 3 * MiB, WS_U = WS_VA + 3 * MiB, WS_QC = WS_U + 12 * MiB, WS_KC = WS_QC + 6 * MiB, WS_VC = WS_KC + 6 * MiB;
constexpr size_t WS_GATES = 137 * MiB;
constexpr size_t WS_OA = 209 * MiB, WS_OB = 221 * MiB, WS_OC = 227 * MiB, WS_PAR = 233 * MiB, WS_SSMF2 = 235 * MiB, WS_END = 236 * MiB;
constexpr int P_N1G = 0, P_N2G = 2048, P_FING = 4096, P_SSM0 = 5120, P_LAMR = 37888, P_LAMI = 41984, P_LSTEP = 46080, P_BRE = 46144, P_BIM = 111680, P_CRE = 177216, P_CIM = 242752, P_SSMD = 308288, P_NAB = 308800;
static_assert(W_END <= WS_H, "weights fit");
constexpr size_t O_YP = 0, O_YS = 4194304, O_GAK = 12582912, O_GAV = 13631488, O_NAK = 14680064, O_NAV = 16777216, O_SSM = 18874368;
constexpr int LDS_BYTES = 147456;

__device__ __forceinline__ unsigned cvtpk(float lo, float hi) { f32x2_t v = {lo, hi}; bf16x2_t b = __builtin_convertvector(v, bf16x2_t); return __builtin_bit_cast(unsigned, b); }
__device__ __forceinline__ float bf2f(unsigned b) { return __uint_as_float(b << 16); }
__device__ __forceinline__ float sigmoidf_(float v) { return __builtin_amdgcn_rcpf(1.0f + __expf(-v)); }
__device__ __forceinline__ float gelu_tanh_(float v) { const float z = 1.5957691216057308f * (v + 0.044715f * v * v * v); return v * __builtin_amdgcn_rcpf(1.0f + __expf(-z)); }
template <int K> __device__ __forceinline__ float xor_shfl(float v) {
    return __uint_as_float((unsigned)__builtin_amdgcn_ds_swizzle((int)__float_as_uint(v), (K << 10) | 0x1F));
}
__device__ __forceinline__ float sum_xor32(float v) { auto rr = __builtin_amdgcn_permlane32_swap(__float_as_uint(v), __float_as_uint(v), false, false); return __uint_as_float(rr[0]) + __uint_as_float(rr[1]); }
__device__ __forceinline__ float wave_sum(float v) {
    v += xor_shfl<1>(v); v += xor_shfl<2>(v); v += xor_shfl<4>(v); v += xor_shfl<8>(v); v += xor_shfl<16>(v);
    return sum_xor32(v);
}
__device__ __forceinline__ int crow(int r, int hi) { return (r & 3) + 8 * (r >> 2) + 4 * hi; }
__device__ __forceinline__ int clampi(int v, int lo, int hi) { return v < lo ? lo : (v > hi ? hi : v); }
#define FRESH_LANE() ({ int l__; asm volatile("v_mbcnt_lo_u32_b32 %0, -1, 0\n\tv_mbcnt_hi_u32_b32 %0, -1, %0" : "=v"(l__)); l__; })
#ifndef DBG_SSM
#define DBG_SSM 1.0f
#endif
#ifndef DBG_GAK
#define DBG_GAK 1.0f
#endif
#ifndef DBG_GAV
#define DBG_GAV 1.0f
#endif
#define VM_WAIT0() asm volatile("s_waitcnt vmcnt(0)" ::: "memory")

#define XB_TMO      128
#define XB_XCNT(j)  (256  + 64 * (j))
#define XB_XSUB(j)  (1280 + 64 * (j))
#define XB_XGEN(j)  (2304 + 64 * (j))
#define XB_TOP      3328
#define XB_TOPGEN   3392
#define XCD_BAR_WORDS 3456
#define XB_SPIN_CAP (1u << 18)

__device__ __forceinline__ unsigned xb_ld(unsigned* p)              { return __hip_atomic_load(p, __ATOMIC_RELAXED, __HIP_MEMORY_SCOPE_AGENT); }
__device__ __forceinline__ unsigned xb_add(unsigned* p, unsigned v) { return __hip_atomic_fetch_add(p, v, __ATOMIC_RELAXED, __HIP_MEMORY_SCOPE_AGENT); }
__device__ __forceinline__ unsigned xb_xcc_id() { return (unsigned)__builtin_amdgcn_s_getreg((3 << 11) | 20) & 0xFu; }
#define XB_SPIN(cond, bar) do { unsigned _sp = 0; while (cond) { __builtin_amdgcn_s_sleep(1); \
    if ((++_sp & 255u) == 0u) { if (xb_ld(&(bar)[XB_TMO])) break; if (_sp > XB_SPIN_CAP) { atomicAdd(&(bar)[XB_TMO], 1u); break; } } } } while (0)

struct XcdBarrier {
    unsigned* bar; unsigned x;
    volatile LAS unsigned* st;
};

__device__ __forceinline__ XcdBarrier xcd_barrier_post(unsigned* bar, volatile LAS unsigned* st) {
    XcdBarrier b; b.bar = bar; b.x = xb_xcc_id(); b.st = st;
    if (threadIdx.x == 0) (void)xb_add(&bar[XB_XCNT(b.x)], 1u);
    return b;
}
__device__ __forceinline__ void xcd_barrier_complete(unsigned* bar, unsigned x, unsigned& nloc, unsigned& nx) {
    const unsigned G = gridDim.x * gridDim.y * gridDim.z;
    unsigned sum, cnt, mine, sp = 0u;
    for (;;) {
        sum = 0u; cnt = 0u; mine = 0u;
#pragma unroll
        for (unsigned j = 0; j < 16; ++j) { const unsigned c = xb_ld(&bar[XB_XCNT(j)]); sum += c; cnt += (c > 0u) ? 1u : 0u; mine = (j == x) ? c : mine; }
        if (sum == G) break;
        __builtin_amdgcn_s_sleep(1);
        if ((++sp & 255u) == 0u) { if (xb_ld(&bar[XB_TMO])) break; if (sp > XB_SPIN_CAP) { atomicAdd(&bar[XB_TMO], 1u); break; } }
    }
    nloc = mine > 0u ? mine : 1u; nx = cnt > 0u ? cnt : 1u;
}

__device__ __forceinline__ void xcd_barrier(const XcdBarrier& b) {
    asm volatile("s_waitcnt vmcnt(0)" ::: "memory");
    __syncthreads();
    if (threadIdx.x == 0) {
        unsigned* bar = b.bar;
        __builtin_amdgcn_s_waitcnt(0);
        unsigned nloc = b.st[0], nx = b.st[1];
        if (nloc == 0u) { xcd_barrier_complete(bar, b.x, nloc, nx); b.st[0] = nloc; b.st[1] = nx; }
        const unsigned old = xb_add(&bar[XB_XSUB(b.x)], 1u);
        const unsigned gen = old / nloc;
        if (old + 1u == (gen + 1u) * nloc) {
            __builtin_amdgcn_fence(__ATOMIC_RELEASE, "agent");
            asm volatile("s_waitcnt vmcnt(0)" ::: "memory");
            const unsigned og = xb_add(&bar[XB_TOP], 1u);
            const unsigned tg = og / nx;
            if (og + 1u == (tg + 1u) * nx) xb_add(&bar[XB_TOPGEN], 1u);
            else XB_SPIN(xb_ld(&bar[XB_TOPGEN]) == tg, bar);
            __builtin_amdgcn_fence(__ATOMIC_ACQUIRE, "agent");
            xb_add(&bar[XB_XGEN(b.x)], 1u);
            asm volatile("s_waitcnt vmcnt(0)" ::: "memory");
        } else {
            XB_SPIN(xb_ld(&bar[XB_XGEN(b.x)]) == gen, bar);
            __builtin_amdgcn_fence(__ATOMIC_ACQUIRE, "agent");
            asm volatile("s_waitcnt vmcnt(0)" ::: "memory");
        }
    }
    __syncthreads();
}
using pg8::Unit;
struct EpiIn {
    static constexpr bool PERM = true, AFTER_DRAIN = false;
    unsigned char* ws; float* out; int layer;
    __device__ __forceinline__ void operator()(const f32x4 (&acc)[2][2][4][2], const Unit& u, int wr, int wc, int fr_, int fq_) const {
        const int ln_ = FRESH_LANE(), fr = ln_ & 15, fq = ln_ >> 4;
        const int pn = u.pn; const bool ctx = u.pm < 16;
        const int rb = u.pm * 256 + wr * 64 + fr;
        if (pn >= 7) {
#pragma unroll
            for (int ai = 0; ai < 2; ++ai)
#pragma unroll
                for (int m = 0; m < 4; ++m) {
                    const int row = rb + ai * 128 + m * 16;
                    bf16* gp = (bf16*)(ws + WS_GATES) + (size_t)row * 3072 + (pn - 7) * 256 + 64 * wc + 8 * fq;
#pragma unroll
                    for (int bj = 0; bj < 2; ++bj) { const f32x4 v0 = acc[ai][bj][m][0], v1 = acc[ai][bj][m][1];
                        *(u32x4*)(gp + 32 * bj) = (u32x4){cvtpk(sigmoidf_(v0[0]), sigmoidf_(v0[1])), cvtpk(sigmoidf_(v0[2]), sigmoidf_(v0[3])), cvtpk(sigmoidf_(v1[0]), sigmoidf_(v1[1])), cvtpk(sigmoidf_(v1[2]), sigmoidf_(v1[3]))}; }
                }
        } else if (pn == 3) {
#pragma unroll
            for (int ai = 0; ai < 2; ++ai)
#pragma unroll
                for (int m = 0; m < 4; ++m) {
                    const int row = rb + ai * 128 + m * 16;
                    float* up = (float*)(ws + WS_U) + (size_t)row * 256 + 64 * wc + 4 * fq;
#pragma unroll
                    for (int bj = 0; bj < 2; ++bj)
#pragma unroll
                        for (int n = 0; n < 2; ++n) *(f32x4*)(up + 32 * bj + 16 * n) = acc[ai][bj][m][n];
                }
        } else if (pn >= 4) {
            bf16* base = (bf16*)(ws + (pn == 4 ? WS_QC : (pn == 5 ? WS_KC : WS_VC)));
            const float sc = pn == 4 ? C2 : 1.0f;
            float* ob = out + (pn == 5 ? O_NAK : O_NAV);
            const int e0 = 32 * (fq >> 1) + 8 * (fq & 1);
#pragma unroll
            for (int ai = 0; ai < 2; ++ai)
#pragma unroll
                for (int m = 0; m < 4; ++m) {
                    const int row = rb + ai * 128 + m * 16;
                    int b, t; size_t hrow;
                    if (ctx) { b = row >> 8; t = row & 255; hrow = (size_t)(b * 4 + wc) * 256 + t; } else { const int r2 = row - 4096; b = r2 >> 11; t = r2 & 2047; hrow = (size_t)4096 * 4 + (size_t)(b * 4 + wc) * 2048 + t; }
                    bf16* dp = base + hrow * 64 + e0;
#pragma unroll
                    for (int bj = 0; bj < 2; ++bj) { const f32x4 v0 = acc[ai][bj][m][0] * sc, v1 = acc[ai][bj][m][1] * sc;
                        *(u32x4*)(dp + 16 * bj) = (u32x4){cvtpk(v0[0], v0[1]), cvtpk(v0[2], v0[3]), cvtpk(v1[0], v1[1]), cvtpk(v1[2], v1[3])}; }
                    if (ctx && pn >= 5) { float* op = ob + ((size_t)(b * 2 + layer) * 256 + t) * 256 + wc * 64 + e0;
#pragma unroll
                        for (int bj = 0; bj < 2; ++bj)
#pragma unroll
                            for (int n = 0; n < 2; ++n) *(f32x4*)(op + 16 * bj + 4 * n) = acc[ai][bj][m][n]; }
                    asm volatile("" ::: "memory");
                }
        } else {
            const bool isQ = pn < 2, isV = (pn == 2 && wc >= 2);
            const int h = isQ ? 4 * pn + wc : (wc & 1);
            const int hh = fq >> 1, e0 = 32 * hh + 8 * (fq & 1);
            const float* gsrc = (const float*)(ws + WS_QKG) + (layer * 2 + (isQ ? 0 : 1)) * 64 + e0;
            f32x4 gg[2][2];
#pragma unroll
            for (int bj = 0; bj < 2; ++bj)
#pragma unroll
                for (int n = 0; n < 2; ++n) gg[bj][n] = *(const f32x4*)(gsrc + 16 * bj + 4 * n);
            bf16* base = (bf16*)(ws + (isQ ? WS_QA : (isV ? WS_VA : WS_KA)));
            const int nh = isQ ? 8 : 2;
            float* ob = out + (isV ? O_GAV : O_GAK);
#pragma unroll
            for (int ai = 0; ai < 2; ++ai)
#pragma unroll
                for (int m = 0; m < 4; ++m) {
                    const int row = rb + ai * 128 + m * 16;
                    f32x4 v[2][2];
#pragma unroll
                    for (int bj = 0; bj < 2; ++bj)
#pragma unroll
                        for (int n = 0; n < 2; ++n) v[bj][n] = acc[ai][bj][m][n];
                    if (!isV) {
                        float ss = 0.f;
#pragma unroll
                        for (int bj = 0; bj < 2; ++bj)
#pragma unroll
                            for (int n = 0; n < 2; ++n) ss += (v[bj][n][0] * v[bj][n][0] + v[bj][n][1] * v[bj][n][1]) + (v[bj][n][2] * v[bj][n][2] + v[bj][n][3] * v[bj][n][3]);
                        ss += xor_shfl<16>(ss); ss = sum_xor32(ss);
                        const float rstd = rsqrtf(ss * (1.0f / 64.0f) + EPS);
#pragma unroll
                        for (int bj = 0; bj < 2; ++bj)
#pragma unroll
                            for (int n = 0; n < 2; ++n) v[bj][n] = v[bj][n] * rstd * gg[bj][n];
                    }
                    int b, t; size_t hrow;
                    if (ctx) { b = row >> 8; t = row & 255; hrow = (size_t)(b * nh + h) * 256 + t; }
                    else {
                        const int r2 = row - 4096; b = r2 >> 11; t = r2 & 2047; hrow = (size_t)4096 * nh + (size_t)(b * nh + h) * 2048 + t;
                        if (!isV) {
                            const int pos = hh ? (t & 63) : (t >> 6);
#pragma unroll
                            for (int n = 0; n < 2; ++n) {
                                const float* tp = (const float*)(ws + WS_ROPE) + (pos * 16 + 8 * (fq & 1) + 4 * n) * 2;
                                const f32x4 c01 = *(const f32x4*)tp, c23 = *(const f32x4*)(tp + 4);
                                const f32x4 cs = {c01[0], c01[2], c23[0], c23[2]}, sn = {c01[1], c01[3], c23[1], c23[3]};
                                const f32x4 x1 = v[0][n], x2 = v[1][n];
                                v[0][n] = x1 * cs - x2 * sn; v[1][n] = x2 * cs + x1 * sn;
                            }
                        }
                    }
                    if (ctx && !isQ) { float* op = ob + ((size_t)(b * 2 + layer) * 256 + t) * 128 + h * 64 + e0;
#pragma unroll
                        for (int bj = 0; bj < 2; ++bj)
#pragma unroll
                            for (int n = 0; n < 2; ++n) *(f32x4*)(op + 16 * bj + 4 * n) = v[bj][n]; }
                    const float sc = isQ ? C2 : 1.0f;
                    bf16* dp = base + hrow * 64 + e0;
#pragma unroll
                    for (int bj = 0; bj < 2; ++bj) { const f32x4 x0 = v[bj][0] * sc, x1 = v[bj][1] * sc;
                        *(u32x4*)(dp + 16 * bj) = (u32x4){cvtpk(x0[0], x0[1]), cvtpk(x0[2], x0[3]), cvtpk(x1[0], x1[1]), cvtpk(x1[2], x1[3])}; }
                    asm volatile("" ::: "memory");
                }
        }
    }
};

struct EpiRes {
    static constexpr bool PERM = false, AFTER_DRAIN = false;
    const float* xc; const float* xl; float* xo; const float* mod;
    __device__ __forceinline__ void operator()(const f32x4 (&acc)[2][2][4][2], const Unit& u, int wr, int wc, int fr_, int fq_) const {
        const int ln_ = FRESH_LANE(), fr = ln_ & 15, fq = ln_ >> 4;
        const int cv = u.pm < 16 ? 0 : 1 + ((u.pm - 16) >> 3);
        const int col0 = u.pn * 256 + wc * 32 + 4 * fq;
        f32x4 gv[2][2];
#pragma unroll
        for (int bj = 0; bj < 2; ++bj)
#pragma unroll
            for (int n = 0; n < 2; ++n) gv[bj][n] = *(const f32x4*)(mod + cv * 6144 + col0 + bj * 128 + n * 16);
#pragma unroll
        for (int ai = 0; ai < 2; ++ai)
#pragma unroll
            for (int m = 0; m < 4; ++m) {
                const int row = u.pm * 256 + ai * 128 + wr * 64 + m * 16 + fr;
                const float* xs = row < 4096 ? xc + (size_t)row * 1024 : xl + (size_t)(row - 4096) * 1024;
                float* xd = xo + (size_t)row * 1024;
#pragma unroll
                for (int bj = 0; bj < 2; ++bj)
#pragma unroll
                    for (int n = 0; n < 2; ++n) { const int c = col0 + bj * 128 + n * 16; const f32x4 xv = *(const f32x4*)(xs + c); *(f32x4*)(xd + c) = xv + gv[bj][n] * acc[ai][bj][m][n]; }
                asm volatile("" ::: "memory");
            }
    }
};

struct EpiSwiglu {
    static constexpr bool PERM = true, AFTER_DRAIN = false;
    bf16* ACT;
    __device__ __forceinline__ void operator()(const f32x4 (&acc)[2][2][4][2], const Unit& u, int wr, int wc, int fr_, int fq_) const {
        const int ln_ = FRESH_LANE(), fr = ln_ & 15, fq = ln_ >> 4;
#pragma unroll
        for (int ai = 0; ai < 2; ++ai)
#pragma unroll
            for (int m = 0; m < 4; ++m) {
                const int row = u.pm * 256 + ai * 128 + wr * 64 + m * 16 + fr;
                bf16* ap = ACT + (size_t)row * DFF + u.pn * 128 + wc * 32 + 8 * fq;
                unsigned w[4];
#pragma unroll
                for (int n = 0; n < 2; ++n) { const f32x4 g = acc[ai][0][m][n], up = acc[ai][1][m][n]; f32x4 r;
#pragma unroll
                    for (int i = 0; i < 4; ++i) r[i] = g[i] * sigmoidf_(g[i]) * up[i];
                    w[2 * n] = cvtpk(r[0], r[1]); w[2 * n + 1] = cvtpk(r[2], r[3]); }
                *(u32x4*)ap = (u32x4){w[0], w[1], w[2], w[3]};
                asm volatile("" ::: "memory");
            }
    }
};

struct EpiGlu {
    static constexpr bool PERM = false, AFTER_DRAIN = false;
    bf16* OB;
    __device__ __forceinline__ void operator()(const f32x4 (&acc)[2][2][4][2], const Unit& u, int wr, int wc, int fr_, int fq_) const {
        const int ln_ = FRESH_LANE(), fr = ln_ & 15, fq = ln_ >> 4;
#pragma unroll
        for (int ai = 0; ai < 2; ++ai)
#pragma unroll
            for (int m = 0; m < 4; ++m) {
                const int row = u.pm * 256 + ai * 128 + wr * 64 + m * 16 + fr;
                bf16* p = OB + (size_t)row * 256 + wc * 32 + 4 * fq;
#pragma unroll
                for (int bj = 0; bj < 2; ++bj)
#pragma unroll
                    for (int n = 0; n < 2; ++n) { bf16* q = p + bj * 128 + n * 16; const u32x2 yv = *(const u32x2*)q; const f32x4 a = acc[ai][bj][m][n];
                        const float y0 = bf2f(yv.x & 0xffffu), y1 = bf2f(yv.x >> 16), y2 = bf2f(yv.y & 0xffffu), y3 = bf2f(yv.y >> 16);
                        u32x2 w; w.x = cvtpk(y0 * sigmoidf_(a[0]), y1 * sigmoidf_(a[1])); w.y = cvtpk(y2 * sigmoidf_(a[2]), y3 * sigmoidf_(a[3])); *(u32x2*)q = w; }
                asm volatile("" ::: "memory");
            }
    }
};

template <int MODE> struct EpiBr {
    static constexpr bool PERM = true, AFTER_DRAIN = false;
    const bf16* G; bf16* MF; bf16* MG;
    __device__ __forceinline__ void operator()(const f32x4 (&acc)[2][2][4][2], const Unit& u, int wr, int wc, int fr_, int fq_) const {
        const int ln_ = FRESH_LANE(), fr = ln_ & 15, fq = ln_ >> 4;
        const int col0 = u.pn * 256 + wc * 32 + 8 * fq;
#pragma unroll
        for (int ai = 0; ai < 2; ++ai)
#pragma unroll
            for (int m = 0; m < 4; ++m) {
                const int row = u.pm * 256 + ai * 128 + wr * 64 + m * 16 + fr;
#pragma unroll
                for (int bj = 0; bj < 2; ++bj) { const int c = col0 + bj * 128; const u32x4 gv = *(const u32x4*)(G + (size_t)row * 3072 + c); const f32x4 a0 = acc[ai][bj][m][0], a1 = acc[ai][bj][m][1];
                    float r[8] = {bf2f(gv.x & 0xffffu) * a0[0], bf2f(gv.x >> 16) * a0[1], bf2f(gv.y & 0xffffu) * a0[2], bf2f(gv.y >> 16) * a0[3], bf2f(gv.z & 0xffffu) * a1[0], bf2f(gv.z >> 16) * a1[1], bf2f(gv.w & 0xffffu) * a1[2], bf2f(gv.w >> 16) * a1[3]};
                    bf16* mp = MF + (size_t)row * 1024 + c;
                    if (MODE >= 1) { const u32x4 mv = *(const u32x4*)mp; r[0] += bf2f(mv.x & 0xffffu); r[1] += bf2f(mv.x >> 16); r[2] += bf2f(mv.y & 0xffffu); r[3] += bf2f(mv.y >> 16); r[4] += bf2f(mv.z & 0xffffu); r[5] += bf2f(mv.z >> 16); r[6] += bf2f(mv.w & 0xffffu); r[7] += bf2f(mv.w >> 16); }
                    *(u32x4*)((MODE <= 1 ? mp : MG + (size_t)row * 1024 + c)) = (u32x4){cvtpk(r[0], r[1]), cvtpk(r[2], r[3]), cvtpk(r[4], r[5]), cvtpk(r[6], r[7])}; }
                asm volatile("" ::: "memory");
            }
    }
};

constexpr int BM = 256, HALF = 128;
struct PanelStats {
    unsigned* xbuf;
    unsigned* cnt;
    unsigned* tmo;
    int ntn; float eps;
    unsigned code;
    __device__ __forceinline__ bool run(const f32x4 (&v)[2][2][4][2], const Unit& u, int wr, int wc, int fr, int fq, LAS unsigned char* lds, int wid, int lane) const {
        typedef float f32x2v __attribute__((ext_vector_type(2)));
        LAS f32x2v* P = (LAS f32x2v*)lds;
        LAS f32x2v* S = (LAS f32x2v*)(lds + 8192);
        LAS unsigned* flag = (LAS unsigned*)(lds + 8192 + 2048);
#pragma unroll
        for (int ai = 0; ai < 2; ++ai)
#pragma unroll
            for (int m = 0; m < 4; ++m) {
                float s = 0.f;
#pragma unroll
                for (int bj = 0; bj < 2; ++bj)
#pragma unroll
                    for (int n = 0; n < 2; ++n) { const f32x4 x = v[ai][bj][m][n]; s += (x[0] + x[1]) + (x[2] + x[3]); }
                s += xor_shfl<16>(s); s = sum_xor32(s);
                const float mw = s * (1.0f / 64.0f); float q = 0.f;
#pragma unroll
                for (int bj = 0; bj < 2; ++bj)
#pragma unroll
                    for (int n = 0; n < 2; ++n) { const f32x4 d = v[ai][bj][m][n] - mw; q += (d[0] * d[0] + d[1] * d[1]) + (d[2] * d[2] + d[3] * d[3]); }
                q += xor_shfl<16>(q); q = sum_xor32(q);
                if (fq == 0) P[(ai * HALF + wr * 64 + m * 16 + fr) * 4 + wc] = (f32x2v){mw, q};
            }
        asm volatile("s_waitcnt lgkmcnt(0)" ::: "memory"); __builtin_amdgcn_s_barrier(); asm volatile("" ::: "memory");
#if defined(BROKEN_EXCHANGE_NO_WAIT)
#warning BROKEN CONTROL BUILD: the row-statistics exchange does not wait; results are wrong by design
        if (blockIdx.x >= 64) { const long long t0_ = clock64(); while (clock64() - t0_ < 60000) __builtin_amdgcn_s_sleep(8); }
#endif
        const int row = wid * 32 + (lane & 31);
        if (lane < 32) {
            const f32x2v a = P[row * 4 + 0], b = P[row * 4 + 1], c = P[row * 4 + 2], d = P[row * 4 + 3];
            const float mt = (a.x + b.x + c.x + d.x) * 0.25f;
            const float da = a.x - mt, db = b.x - mt, dc = c.x - mt, dd = d.x - mt;
            const float m2 = (a.y + b.y) + (c.y + d.y) + 64.0f * ((da * da + db * db) + (dc * dc + dd * dd));
            unsigned long long* slot = (unsigned long long*)xbuf + ((size_t)(u.pm * BM + row) * 4 + u.pn);
            __hip_atomic_store(slot, ((unsigned long long)__float_as_uint(m2) << 32) | __float_as_uint(mt), __ATOMIC_RELAXED, __HIP_MEMORY_SCOPE_AGENT);
        }
        asm volatile("s_waitcnt vmcnt(0)" ::: "memory");
        if (lane == 0) __hip_atomic_fetch_add(cnt + 64 * u.pm, 1u, __ATOMIC_RELAXED, __HIP_MEMORY_SCOPE_AGENT);
        if (wid == 0) {
            const unsigned want = 8u * (unsigned)ntn; unsigned sp_ = 0u;
            while ((unsigned)__builtin_amdgcn_readfirstlane(__hip_atomic_load(cnt + 64 * u.pm, __ATOMIC_RELAXED, __HIP_MEMORY_SCOPE_AGENT)) < want) { __builtin_amdgcn_s_sleep(2); if (++sp_ > (1u << 22)) break; }
            __builtin_amdgcn_fence(__ATOMIC_ACQUIRE, "agent");
        }
        asm volatile("s_waitcnt vmcnt(0) lgkmcnt(0)" ::: "memory"); __builtin_amdgcn_s_barrier(); asm volatile("" ::: "memory");
        const bool bad = false;
        if (lane < 32) {
            const unsigned long long* slot = (const unsigned long long*)xbuf + (size_t)(u.pm * BM + row) * 4; float mt[4], m2[4]; float ms = 0.f;
#pragma unroll
            for (int t = 0; t < 4; ++t) { if (t < ntn) { const unsigned long long w = __hip_atomic_load(slot + t, __ATOMIC_RELAXED, __HIP_MEMORY_SCOPE_AGENT); mt[t] = __uint_as_float((unsigned)w); m2[t] = __uint_as_float((unsigned)(w >> 32)); } else { mt[t] = 0.f; m2[t] = 0.f; } ms += mt[t]; }
            const float mean = ms / (float)ntn; float q = 0.f;
#pragma unroll
            for (int t = 0; t < 4; ++t) if (t < ntn) { const float dm = mt[t] - mean; q += m2[t] + 256.0f * dm * dm; }
            S[row] = (f32x2v){mean, 1.0f / sqrtf(q / (256.0f * (float)ntn) + mean * mean + eps)};
        }
        asm volatile("s_waitcnt lgkmcnt(0)" ::: "memory"); __builtin_amdgcn_s_barrier(); asm volatile("" ::: "memory");
        return bad;
    }
};
template <int final_> struct EpiResNorm {
    static constexpr bool PERM = true, AFTER_DRAIN = true;
    const float* xc; const float* xl; float* xo; const float* gate; const float* ng; const float* nmod; int sh_off, sc_off; bf16* H; PanelStats st;
    __device__ __forceinline__ void fused(f32x4 (&acc)[2][2][4][2], const Unit& u, int wr, int wc, int fr_, int fq_, LAS unsigned char* lds, int wid, int lane_) const {
        const int lane = FRESH_LANE(), fr = lane & 15, fq = lane >> 4;
        typedef float f32x2v __attribute__((ext_vector_type(2)));
        const LAS f32x2v* S = (const LAS f32x2v*)(lds + 8192);
        const int cv = u.pm < 16 ? 0 : 1 + ((u.pm - 16) >> 3);
        const int col0 = u.pn * 256 + wc * 32 + 8 * fq;
#pragma unroll
        for (int ai = 0; ai < 2; ++ai)
#pragma unroll
            for (int m = 0; m < 4; ++m) {
                const int row = u.pm * 256 + ai * 128 + wr * 64 + m * 16 + fr;
                const float* xs = row < 4096 ? xc + (size_t)row * 1024 : xl + (size_t)(row - 4096) * 1024;
#pragma unroll
                for (int bj = 0; bj < 2; ++bj)
#pragma unroll
                    for (int n = 0; n < 2; ++n) { const int c = col0 + bj * 128 + n * 4; const f32x4 gv = *(const f32x4*)(gate + cv * 6144 + c); const f32x4 xv = *(const f32x4*)(xs + c);
                        acc[ai][bj][m][n] = xv + gv * acc[ai][bj][m][n]; if (!final_) *(f32x4*)(xo + (size_t)row * 1024 + c) = acc[ai][bj][m][n]; }
                asm volatile("" : "+v"(acc[ai][0][m][0]), "+v"(acc[ai][0][m][1]), "+v"(acc[ai][1][m][0]), "+v"(acc[ai][1][m][1]));
                asm volatile("" ::: "memory");
            }
        (void)st.run(acc, u, wr, wc, fr, fq, lds, wid, lane);
#pragma unroll
        for (int ai = 0; ai < 2; ++ai)
#pragma unroll
            for (int m = 0; m < 4; ++m) {
                const int r = ai * 128 + wr * 64 + m * 16 + fr; const int row = u.pm * 256 + r; const float rstd = S[r].y;
#pragma unroll
                for (int bj = 0; bj < 2; ++bj) { unsigned w[4];
#pragma unroll
                    for (int n = 0; n < 2; ++n) { const int c = col0 + bj * 128 + n * 4; const f32x4 v = acc[ai][bj][m][n] * rstd * *(const f32x4*)(ng + c);
                        if (final_) *(f32x4*)(xo + (size_t)row * 1024 + c) = v;
                        else { const f32x4 sc = *(const f32x4*)(nmod + cv * 6144 + sc_off + c), sh = *(const f32x4*)(nmod + cv * 6144 + sh_off + c); const f32x4 o = v * (sc + 1.0f) + sh;
                               w[2 * n] = cvtpk(o[0], o[1]); w[2 * n + 1] = cvtpk(o[2], o[3]); } }
                    if (!final_) *(u32x4*)(H + (size_t)row * 1024 + col0 + bj * 128) = (u32x4){w[0], w[1], w[2], w[3]}; }
                asm volatile("" ::: "memory");
            }
    }
};

namespace att {
constexpr int SLOTB = 8192, LDS_K = 0, LDS_V = 24576, LDS_WS = 49152, LDS_OST = 51200, LDS_BIAS = 83968;
constexpr float THR = 8.0f;
#define SBAR() __builtin_amdgcn_sched_barrier(0)
__device__ __forceinline__ void glds16(const void* gsrc, unsigned lds_dst) { unsigned keep;
    asm volatile("s_mov_b32 %0, m0\n\ts_mov_b32 m0, %2\n\ts_nop 0\n\tglobal_load_lds_dwordx4 %1, off\n\ts_mov_b32 m0, %0" : "=&s"(keep) : "v"(gsrc), "s"(lds_dst) : "memory"); }
#define WAIT_BAR0() asm volatile("s_waitcnt vmcnt(0) lgkmcnt(0)\n\ts_barrier" ::: "memory")
#define WAIT_BAR2() asm volatile("s_waitcnt vmcnt(2) lgkmcnt(0)\n\ts_barrier" ::: "memory")
typedef LAS const char* lds_cptr;
__device__ __forceinline__ void qkt(f32x16& p0, f32x16& p1, lds_cptr kb, const bf16x8* qr, const f32x16& negm) {
#pragma unroll
    for (int d0 = 0; d0 < 4; ++d0) {
        const bf16x8 b0 = *(const LAS bf16x8*)(kb + d0 * 2048);
        const bf16x8 b1 = *(const LAS bf16x8*)(kb + d0 * 2048 + 512);
        if (d0 == 0) { p0 = __builtin_amdgcn_mfma_f32_32x32x16_bf16(b0, qr[0], negm, 0, 0, 0); p1 = __builtin_amdgcn_mfma_f32_32x32x16_bf16(b1, qr[0], negm, 0, 0, 0); }
        else { p0 = __builtin_amdgcn_mfma_f32_32x32x16_bf16(b0, qr[d0], p0, 0, 0, 0); p1 = __builtin_amdgcn_mfma_f32_32x32x16_bf16(b1, qr[d0], p1, 0, 0, 0); }
    }
}
__device__ __forceinline__ float rowmax(const f32x16& p0, const f32x16& p1) {
    float a = fmaxf(fmaxf(p0[0], p0[1]), p1[0]), b = fmaxf(fmaxf(p0[2], p0[3]), p1[1]); a = fmaxf(fmaxf(a, p1[2]), p1[3]);
#pragma unroll
    for (int r = 4; r < 16; r += 4) { a = fmaxf(fmaxf(a, p0[r]), p0[r + 1]); b = fmaxf(fmaxf(b, p0[r + 2]), p0[r + 3]); a = fmaxf(fmaxf(a, p1[r]), p1[r + 1]); b = fmaxf(fmaxf(b, p1[r + 2]), p1[r + 3]); }
    const float m = fmaxf(a, b);
    auto rr = __builtin_amdgcn_permlane32_swap(__float_as_uint(m), __float_as_uint(m), false, false);
    return fmaxf(__uint_as_float(rr[0]), __uint_as_float(rr[1]));
}
__device__ __forceinline__ void pv(f32x16* o, int vb, bf16x8 pa0, bf16x8 pa1, bf16x8 pa2, bf16x8 pa3) {
#pragma unroll
    for (int d0 = 0; d0 < 2; ++d0) { s16x4 lo[4], hi[4];
#pragma unroll
        for (int ks = 0; ks < 4; ++ks) {
            asm volatile("ds_read_b64_tr_b16 %0,%1 offset:%c2" : "=&v"(lo[ks]) : "v"(vb), "i"(d0 * 4096 + ks * 1024) : "memory");
            asm volatile("ds_read_b64_tr_b16 %0,%1 offset:%c2" : "=&v"(hi[ks]) : "v"(vb), "i"(d0 * 4096 + ks * 1024 + 512) : "memory"); }
        asm volatile("s_waitcnt lgkmcnt(0)" ::: "memory"); SBAR();
#define PK(k) (bf16x8){lo[k][0], lo[k][1], lo[k][2], lo[k][3], hi[k][0], hi[k][1], hi[k][2], hi[k][3]}
        o[d0] = __builtin_amdgcn_mfma_f32_32x32x16_bf16(pa0, PK(0), o[d0], 0, 0, 0);
        o[d0] = __builtin_amdgcn_mfma_f32_32x32x16_bf16(pa1, PK(1), o[d0], 0, 0, 0);
        o[d0] = __builtin_amdgcn_mfma_f32_32x32x16_bf16(pa2, PK(2), o[d0], 0, 0, 0);
        o[d0] = __builtin_amdgcn_mfma_f32_32x32x16_bf16(pa3, PK(3), o[d0], 0, 0, 0);
#undef PK
    }
}
template <bool NA>
__device__ __forceinline__ void attn_unit(const bf16* Qw, const bf16* Kc, const bf16* Vc, const bf16* Kl, const bf16* Vl, int NT,
                                          bf16* Ow, int opitch, char* shm, int qrow, int rlo, const float* biasg, const int wid) {
    const int lane = FRESH_LANE(), tid = wid * 64 + lane, r32 = lane & 31, hi = lane >> 5;
    const unsigned lds0 = (unsigned)(uintptr_t)shm;
    const lds_cptr shm3 = (lds_cptr)shm;
    LAS float* wsf = (LAS float*)(shm3 + LDS_WS) + wid * 64;
    LAS float* bias_s = (LAS float*)(shm3 + LDS_BIAS);
    if (NA) { if (tid < 465) bias_s[tid] = biasg[tid] * LOG2E; }
    const int koff = lane * 64 + wid * 8;
    const int voff = (16 * (wid & 3) + (lane >> 2)) * 64 + (wid >> 2) * 32 + (lane & 3) * 8;
    const unsigned kdst = lds0 + LDS_K + wid * 1024, vdst = lds0 + LDS_V + wid * 1024;
#define ATT_DMA(t, slot) do { const bf16* kt_ = (t) < 4 ? Kc + (t) * 4096 : Kl + ((t) - 4) * 4096; const bf16* vt_ = (t) < 4 ? Vc + (t) * 4096 : Vl + ((t) - 4) * 4096; \
        glds16(kt_ + koff, (unsigned)__builtin_amdgcn_readfirstlane(kdst + (slot))); glds16(vt_ + voff, (unsigned)__builtin_amdgcn_readfirstlane(vdst + (slot))); } while (0)
    ATT_DMA(0, 0); ATT_DMA(1, SLOTB);
    bf16x8 qr[4];
#pragma unroll
    for (int d0 = 0; d0 < 4; ++d0) qr[d0] = *(const bf16x8*)(Qw + (size_t)r32 * 64 + d0 * 16 + hi * 8);
    float mhat = 0.f, l_reg = 0.f; f32x16 o[2]; o[0] = f32x16{}; o[1] = f32x16{}; f32x16 negm = f32x16{};
    const lds_cptr kp0 = shm3 + LDS_K + hi * 1024 + r32 * 16;
    const int vb0 = (int)(lds0 + LDS_V) + ((lane >> 4) & 1) * 32 + (lane & 3) * 8 + (4 * hi + ((lane & 15) >> 2)) * 64;
    const int qc = (wid & 1) * 32 + r32, cs = clampi(qc - 8, 0, 48), rs = clampi(qrow - 4, 0, 24);
    int slot = 0, s_nxt = SLOTB, s_nn = 2 * SLOTB;
    for (int t = 0; t < NT; ++t) {
        if (t == 0 || t + 1 >= NT) WAIT_BAR0(); else WAIT_BAR2();
        if (t + 2 < NT) ATT_DMA(t + 2, s_nn);
        f32x16 p0, p1;
        qkt(p0, p1, kp0 + slot, qr, negm);
        if (NA && t >= 4) {
            const int kr = rlo + t - 4;
            if (kr < rs || kr >= rs + 8) {
#pragma unroll
                for (int r = 0; r < 16; ++r) { p0[r] = -INFINITY; p1[r] = -INFINITY; }
            } else {
                const LAS float* brow = bias_s + (kr - qrow + 7) * 31;
#pragma unroll
                for (int r = 0; r < 16; ++r) {
                    const int kc = crow(r, hi);
                    const int i0 = clampi(kc - qc + 15, 0, 30), i1 = clampi(kc + 32 - qc + 15, 0, 30);
                    const float b0 = brow[i0], b1 = brow[i1];
                    p0[r] = ((unsigned)(kc - cs) < 16u) ? p0[r] + b0 : -INFINITY;
                    p1[r] = ((unsigned)(kc + 32 - cs) < 16u) ? p1[r] + b1 : -INFINITY;
                }
            }
        }
        const float rm = rowmax(p0, p1);
        if (t == 0 || __any(rm > THR)) {
            const float dl = (t == 0) ? rm : fmaxf(rm, 0.f);
            mhat += dl;
#pragma unroll
            for (int r = 0; r < 16; ++r) { p0[r] -= dl; p1[r] -= dl; negm[r] = -mhat; }
            if (t > 0) {
                const float f = __builtin_amdgcn_exp2f(-dl); l_reg *= f;
                if (hi == 0) wsf[r32] = f;
                asm volatile("s_waitcnt lgkmcnt(0)" ::: "memory");
#pragma unroll
                for (int r = 0; r < 16; ++r) { const float fr_ = wsf[crow(r, hi)]; o[0][r] *= fr_; o[1][r] *= fr_; }
                asm volatile("s_waitcnt lgkmcnt(0)" ::: "memory");
            }
        }
        float sacc = 0.f;
#pragma unroll
        for (int r = 0; r < 16; ++r) { p0[r] = __builtin_amdgcn_exp2f(p0[r]); p1[r] = __builtin_amdgcn_exp2f(p1[r]); sacc += p0[r] + p1[r]; }
        l_reg += sacc;
        u32x4 pw0, pw1, pw2, pw3;
        pw0 = (u32x4){cvtpk(p0[0], p0[1]), cvtpk(p0[2], p0[3]), cvtpk(p0[4], p0[5]), cvtpk(p0[6], p0[7])};
        pw1 = (u32x4){cvtpk(p0[8], p0[9]), cvtpk(p0[10], p0[11]), cvtpk(p0[12], p0[13]), cvtpk(p0[14], p0[15])};
        pw2 = (u32x4){cvtpk(p1[0], p1[1]), cvtpk(p1[2], p1[3]), cvtpk(p1[4], p1[5]), cvtpk(p1[6], p1[7])};
        pw3 = (u32x4){cvtpk(p1[8], p1[9]), cvtpk(p1[10], p1[11]), cvtpk(p1[12], p1[13]), cvtpk(p1[14], p1[15])};
        SBAR();
        pv(o, vb0 + slot, __builtin_bit_cast(bf16x8, pw0), __builtin_bit_cast(bf16x8, pw1), __builtin_bit_cast(bf16x8, pw2), __builtin_bit_cast(bf16x8, pw3));
        { const int tmp_ = slot; slot = s_nxt; s_nxt = s_nn; s_nn = tmp_; }
    }
    { auto rr = __builtin_amdgcn_permlane32_swap(__float_as_uint(l_reg), __float_as_uint(l_reg), false, false); l_reg = __uint_as_float(rr[0]) + __uint_as_float(rr[1]); }
    if (hi == 0) wsf[32 + r32] = l_reg; asm volatile("s_waitcnt lgkmcnt(0)" ::: "memory");
    float rli[16];
#pragma unroll
    for (int r = 0; r < 16; ++r) rli[r] = __builtin_amdgcn_rcpf(wsf[32 + crow(r, hi)]);
    { LAS bf16* stg = (LAS bf16*)(shm3 + LDS_OST) + wid * 2048;
#pragma unroll
      for (int r = 0; r < 16; ++r) { const int orow = crow(r, hi);
#pragma unroll
          for (int d0 = 0; d0 < 2; ++d0) stg[orow * 64 + d0 * 32 + r32] = (bf16)(cvtpk(o[d0][r] * rli[r], 0.f) & 0xffffu); }
      asm volatile("s_waitcnt lgkmcnt(0)" ::: "memory");
#pragma unroll
      for (int i = 0; i < 4; ++i) { const int row = i * 8 + (lane >> 3), ch = lane & 7; const u32x4 v = *(const LAS u32x4*)(stg + row * 64 + ch * 8); *(u32x4*)(Ow + (size_t)row * opitch + ch * 8) = v; } }
    asm volatile("s_waitcnt vmcnt(0) lgkmcnt(0)\n\ts_barrier" ::: "memory");
#undef ATT_DMA
}
#undef SBAR
#undef WAIT_BAR0
#undef WAIT_BAR2
}

struct SsmArgs { const float *lam_re, *lam_im, *log_step, *b_re, *b_im, *c_re, *c_im, *dskip;
                 const float* U; float* YF; bf16* OB; float* F; const float* h0; float* out_ssm; int layer; };
constexpr int SSM_PITCH = 132, SSM_WAVE_BYTES = 32 * SSM_PITCH * 4, LCH = 128, NLCH = 2048 / LCH;
__device__ __forceinline__ void split8(const float* v, bf16x8& h, bf16x8& l) {
    unsigned hw[4], lw[4];
#pragma unroll
    for (int i = 0; i < 4; ++i) { const unsigned w = cvtpk(v[2 * i], v[2 * i + 1]); hw[i] = w; const float r0 = v[2 * i] - bf2f(w & 0xffffu), r1 = v[2 * i + 1] - bf2f(w >> 16); lw[i] = cvtpk(r0, r1); }
    h = __builtin_bit_cast(bf16x8, (u32x4){hw[0], hw[1], hw[2], hw[3]}); l = __builtin_bit_cast(bf16x8, (u32x4){lw[0], lw[1], lw[2], lw[3]});
}
template <int KIND, bool SECOND>
__device__ __forceinline__ void ssm_dir(const SsmArgs& A, int b, int g, int d, int k, LAS float* buf) {
    const int lane = FRESH_LANE();
    const int hi = lane >> 5, l31 = lane & 31, fr = lane & 15, fq = lane >> 4;
    const int gd = d * 16 + g;
    constexpr int CH = KIND == 0 ? 256 : LCH, NSC = CH / 32, L = KIND == 0 ? 256 : 2048;
    const int seqrow0 = KIND == 0 ? b * 256 : 4096 + b * 2048;
    const float step = expf(A.log_step[gd]);
    float ar[2], ai[2], cr[2], ci[2];
#pragma unroll
    for (int q = 0; q < 2; ++q) { const int p = l31 + 32 * q; const float lr = A.lam_re[gd * 64 + p], li = A.lam_im[gd * 64 + p];
        const float e = expf(lr * step); float s, c; sincosf(li * step, &s, &c); ar[q] = e * c; ai[q] = e * s;
        const float den = 1.0f / (lr * lr + li * li), xr = ar[q] - 1.0f; cr[q] = (xr * lr + ai[q] * li) * den; ci[q] = (ai[q] * lr - xr * li) * den; }
    float Bf[4][8];
    bf16x8 Bh[4], Bl[4];
#pragma unroll
    for (int q = 0; q < 2; ++q) { const int p = l31 + 32 * q; const float* br = A.b_re + ((size_t)gd * 64 + p) * 16; const float* bi = A.b_im + ((size_t)gd * 64 + p) * 16;
        if (KIND == 0) {
#pragma unroll
            for (int c4 = 0; c4 < 4; ++c4) { const f32x4 r = *(const f32x4*)(br + 4 * c4), im = *(const f32x4*)(bi + 4 * c4);
#pragma unroll
                for (int h2 = 0; h2 < 2; ++h2) { const float re_ = hi ? r[2 * h2 + 1] : r[2 * h2], im_ = hi ? im[2 * h2 + 1] : im[2 * h2];
                    Bf[q][2 * c4 + h2] = cr[q] * re_ - ci[q] * im_; Bf[2 + q][2 * c4 + h2] = cr[q] * im_ + ci[q] * re_; } }
        } else {
            const f32x4 r0 = *(const f32x4*)(br + 8 * hi), r1 = *(const f32x4*)(br + 8 * hi + 4), i0 = *(const f32x4*)(bi + 8 * hi), i1 = *(const f32x4*)(bi + 8 * hi + 4);
            float vr[8], vi[8];
#pragma unroll
            for (int j = 0; j < 4; ++j) { vr[j] = cr[q] * r0[j] - ci[q] * i0[j]; vi[j] = cr[q] * i0[j] + ci[q] * r0[j]; vr[4 + j] = cr[q] * r1[j] - ci[q] * i1[j]; vi[4 + j] = cr[q] * i1[j] + ci[q] * r1[j]; }
            split8(vr, Bh[q], Bl[q]); split8(vi, Bh[2 + q], Bl[2 + q]);
        }
    }
    bf16x8 Cf[4];
    if (KIND != 1) {
#pragma unroll
        for (int ks = 0; ks < 4; ++ks) { const float* cp = (ks < 2 ? A.c_re : A.c_im) + ((size_t)gd * 16 + fr) * 64 + 32 * (ks & 1) + 8 * fq; const float sg = ks < 2 ? 1.0f : -1.0f;
            const f32x4 c0 = *(const f32x4*)cp * sg, c1 = *(const f32x4*)(cp + 4) * sg;
            Cf[ks] = __builtin_bit_cast(bf16x8, (u32x4){cvtpk(c0[0], c0[1]), cvtpk(c0[2], c0[3]), cvtpk(c1[0], c1[1]), cvtpk(c1[2], c1[3])}); }
    }
    const float sar = hi ? ar[1] : ar[0], sai = hi ? ai[1] : ai[0];
    float hr = 0.f, hm = 0.f;
    if (KIND == 2) {
        const size_t so = ((((size_t)(b * 2 + A.layer) * 2 + d) * 2) * 16 + g) * 64 + lane;
        hr = A.h0[so]; hm = A.h0[so + 16 * 64];
        float pr = sar, pi = sai;
#pragma unroll
        for (int i = 0; i < 7; ++i) { const float nr = pr * pr - pi * pi, ni0 = pr * pi, ni = ni0 + ni0; pr = nr; pi = ni; }
        static_assert(LCH == 128, "power");
        const float* Fp = A.F + ((((size_t)(b * 16 + g) * 2 + d) * NLCH) * 2) * 64 + lane;
        float fre[NLCH - 1], fim[NLCH - 1];
#pragma unroll
        for (int kk = 0; kk < NLCH - 1; ++kk) { fre[kk] = Fp[(size_t)kk * 128]; fim[kk] = Fp[(size_t)kk * 128 + 64]; }
#pragma unroll
        for (int kk = 0; kk < NLCH - 1; ++kk) if (kk < k) { const float nr = pr * hr - pi * hm + fre[kk], ni = pr * hm + pi * hr + fim[kk]; hr = nr; hm = ni; }
    }
    float dsk = 0.f; if (KIND != 1 && SECOND) dsk = A.dskip[g * 16 + fr];
    f32x4 un[4];
    { const int s = CH * k + l31; const int t = d ? L - 1 - s : s; const float* up = A.U + (size_t)(seqrow0 + t) * 256 + g * 16;
#pragma unroll
      for (int c4 = 0; c4 < 4; ++c4) un[c4] = *(const f32x4*)(up + 4 * c4); }
    float yprev[2][4]; size_t oprev[2][4];
    float* const Yd = A.YF + (size_t)d * ((size_t)M_TOK * 256);
    for (int sc = 0; sc < NSC; ++sc) {
        const int s0 = CH * k + 32 * sc;
        float ua[8]; bf16x8 uah, ual;
        if (KIND == 0) {
#pragma unroll
            for (int c4 = 0; c4 < 4; ++c4) { ua[2 * c4] = hi ? un[c4][1] : un[c4][0]; ua[2 * c4 + 1] = hi ? un[c4][3] : un[c4][2]; }
        } else { const f32x4 x0 = hi ? un[2] : un[0], x1 = hi ? un[3] : un[1]; const float xv[8] = {x0[0], x0[1], x0[2], x0[3], x1[0], x1[1], x1[2], x1[3]}; split8(xv, uah, ual); }
        if (sc + 1 < NSC) { const int s = s0 + 32 + l31; const int t = d ? L - 1 - s : s; const float* up = A.U + (size_t)(seqrow0 + t) * 256 + g * 16;
#pragma unroll
            for (int c4 = 0; c4 < 4; ++c4) un[c4] = *(const f32x4*)(up + 4 * c4); }
        size_t oo[2][4]; float yv[2][4], uv[2][4];
        if (KIND != 1) {
#pragma unroll
            for (int rt = 0; rt < 2; ++rt)
#pragma unroll
                for (int r = 0; r < 4; ++r) { const int s = s0 + 16 * rt + 4 * fq + r; const int t = d ? L - 1 - s : s; oo[rt][r] = (size_t)(seqrow0 + t) * 256 + g * 16 + fr;
                    if (SECOND) { yv[rt][r] = A.YF[oo[rt][r]]; uv[rt][r] = A.U[oo[rt][r]]; } }
            if (sc > 0) {
#pragma unroll
                for (int rt = 0; rt < 2; ++rt)
#pragma unroll
                    for (int r = 0; r < 4; ++r) { if (!SECOND) Yd[oprev[rt][r]] = yprev[rt][r]; else A.OB[oprev[rt][r]] = (bf16)(cvtpk(yprev[rt][r], 0.f) & 0xffffu); }
            }
        }
#pragma unroll
        for (int n = 0; n < 4; ++n) { f32x16 D = f32x16{};
            if (KIND == 0) {
#pragma unroll
                for (int kk = 0; kk < 8; ++kk) D = __builtin_amdgcn_mfma_f32_32x32x2f32(ua[kk], Bf[n][kk], D, 0, 0, 0);
            } else { D = __builtin_amdgcn_mfma_f32_32x32x16_bf16(uah, Bh[n], D, 0, 0, 0); D = __builtin_amdgcn_mfma_f32_32x32x16_bf16(ual, Bh[n], D, 0, 0, 0); D = __builtin_amdgcn_mfma_f32_32x32x16_bf16(uah, Bl[n], D, 0, 0, 0); }
#pragma unroll
            for (int r = 0; r < 16; ++r) buf[crow(r, hi) * SSM_PITCH + 32 * n + l31] = D[r]; }
        { float sre[32], sim[32];
#pragma unroll
          for (int j = 0; j < 32; ++j) { sre[j] = buf[j * SSM_PITCH + lane]; sim[j] = buf[j * SSM_PITCH + 64 + lane]; }
#pragma unroll
          for (int j = 0; j < 32; ++j) { const float nr = fmaf(sar, hr, fmaf(-sai, hm, sre[j])), ni = fmaf(sar, hm, fmaf(sai, hr, sim[j])); hr = nr; hm = ni; sre[j] = hr; sim[j] = hm; }
          if (KIND != 1) {
#pragma unroll
              for (int j = 0; j < 32; ++j) { buf[j * SSM_PITCH + lane] = sre[j]; buf[j * SSM_PITCH + 64 + lane] = sim[j]; } } }
        if (KIND != 1) {
#pragma unroll
            for (int rt = 0; rt < 2; ++rt) { f32x4 acc = {0.f, 0.f, 0.f, 0.f};
#pragma unroll
                for (int ks = 0; ks < 4; ++ks) { const LAS float* hp = buf + (16 * rt + fr) * SSM_PITCH + 32 * ks + 8 * fq; const f32x4 h0 = *(const LAS f32x4*)hp, h1 = *(const LAS f32x4*)(hp + 4);
                    const bf16x8 ahh = __builtin_bit_cast(bf16x8, (u32x4){cvtpk(h0[0], h0[1]), cvtpk(h0[2], h0[3]), cvtpk(h1[0], h1[1]), cvtpk(h1[2], h1[3])});
                    acc = __builtin_amdgcn_mfma_f32_16x16x32_bf16(ahh, Cf[ks], acc, 0, 0, 0); }
#pragma unroll
                for (int r = 0; r < 4; ++r) { oprev[rt][r] = oo[rt][r];
                    if (!SECOND) yprev[rt][r] = acc[r]; else yprev[rt][r] = gelu_tanh_(acc[r] + yv[rt][r] + dsk * uv[rt][r]); } }
        }
    }
    if (KIND != 1) {
#pragma unroll
        for (int rt = 0; rt < 2; ++rt)
#pragma unroll
            for (int r = 0; r < 4; ++r) { if (!SECOND) Yd[oprev[rt][r]] = yprev[rt][r]; else A.OB[oprev[rt][r]] = (bf16)(cvtpk(yprev[rt][r], 0.f) & 0xffffu); }
    }
    if (KIND == 0) { const size_t so = ((((size_t)(b * 2 + A.layer) * 2 + d) * 2) * 16 + g) * 64 + lane; A.out_ssm[so] = hr; A.out_ssm[so + 16 * 64] = hm; }
    if (KIND == 1) { const size_t fo = ((((size_t)(b * 16 + g) * 2 + d) * NLCH + k) * 2) * 64 + lane; __hip_atomic_store(A.F + fo, hr, __ATOMIC_RELAXED, __HIP_MEMORY_SCOPE_AGENT); __hip_atomic_store(A.F + fo + 64, hm, __ATOMIC_RELAXED, __HIP_MEMORY_SCOPE_AGENT); }
}
template <int KIND> __device__ __forceinline__ void ssm_both(const SsmArgs& A, int b, int g, int c, LAS float* buf) {
    ssm_dir<KIND, false>(A, b, g, 0, c, buf);
    asm volatile("s_waitcnt vmcnt(0)" ::: "memory");
    ssm_dir<KIND, true>(A, b, g, 1, (KIND == 0 ? 0 : NLCH - 1 - c), buf);
}

__device__ __forceinline__ void norm_mod_rows(const float* xc, const float* xl, const float* g, const float* mod, int sh_off, int sc_off, bf16* H, int gw, int NGW, int lane) {
    for (int row0 = gw; row0 < M_TOK; row0 += 2 * NGW) {
        const int row1 = row0 + NGW; const bool has1 = row1 < M_TOK;
        const float* xr0 = row0 < 4096 ? xc + (size_t)row0 * 1024 : xl + (size_t)(row0 - 4096) * 1024;
        const float* xr1 = has1 ? (row1 < 4096 ? xc + (size_t)row1 * 1024 : xl + (size_t)(row1 - 4096) * 1024) : xr0;
        f32x4 v0[4], v1[4]; float s0 = 0.f, s1 = 0.f;
#pragma unroll
        for (int j = 0; j < 4; ++j) { v0[j] = *(const f32x4*)(xr0 + 4 * (lane + 64 * j)); v1[j] = *(const f32x4*)(xr1 + 4 * (lane + 64 * j)); }
#pragma unroll
        for (int j = 0; j < 4; ++j) { s0 += (v0[j][0] * v0[j][0] + v0[j][1] * v0[j][1]) + (v0[j][2] * v0[j][2] + v0[j][3] * v0[j][3]); s1 += (v1[j][0] * v1[j][0] + v1[j][1] * v1[j][1]) + (v1[j][2] * v1[j][2] + v1[j][3] * v1[j][3]); }
        const float rstd0 = rsqrtf(wave_sum(s0) * (1.0f / 1024.0f) + EPS), rstd1 = rsqrtf(wave_sum(s1) * (1.0f / 1024.0f) + EPS);
        const float* mp0 = mod + (row0 < 4096 ? 0 : 1 + ((row0 - 4096) >> 11)) * 6144; const float* mp1 = mod + (row1 < 4096 ? 0 : 1 + (((has1 ? row1 : row0) - 4096) >> 11)) * 6144;
#pragma unroll
        for (int j = 0; j < 4; ++j) { const int c = 4 * (lane + 64 * j); const f32x4 gg = *(const f32x4*)(g + c);
            { const f32x4 sc = *(const f32x4*)(mp0 + sc_off + c), sh = *(const f32x4*)(mp0 + sh_off + c); const f32x4 o = v0[j] * rstd0 * gg * (sc + 1.0f) + sh; u32x2 w; w.x = cvtpk(o[0], o[1]); w.y = cvtpk(o[2], o[3]); *(u32x2*)(H + (size_t)row0 * 1024 + c) = w; }
            if (has1) { const f32x4 sc = *(const f32x4*)(mp1 + sc_off + c), sh = *(const f32x4*)(mp1 + sh_off + c); const f32x4 o = v1[j] * rstd1 * gg * (sc + 1.0f) + sh; u32x2 w; w.x = cvtpk(o[0], o[1]); w.y = cvtpk(o[2], o[3]); *(u32x2*)(H + (size_t)row1 * 1024 + c) = w; } }
    }
}
__device__ __forceinline__ void final_norm_rows(float* x, const float* g, int gw, int NGW, int lane) {
    for (int row = gw; row < M_TOK; row += NGW) {
        float* xr = x + (size_t)row * 1024;
        f32x4 v[4]; float ss = 0.f;
#pragma unroll
        for (int j = 0; j < 4; ++j) { v[j] = *(const f32x4*)(xr + 4 * (lane + 64 * j)); ss += (v[j][0] * v[j][0] + v[j][1] * v[j][1]) + (v[j][2] * v[j][2] + v[j][3] * v[j][3]); }
        const float rstd = rsqrtf(wave_sum(ss) * (1.0f / 1024.0f) + EPS);
#ifdef DBG_SCALE_S
        const float dsc = row >= 4096 ? DBG_SCALE_S : DBG_SCALE_P;
#else
        const float dsc = 1.0f;
#endif
#pragma unroll
        for (int j = 0; j < 4; ++j) { const int c = 4 * (lane + 64 * j); *(f32x4*)(xr + c) = v[j] * (rstd * dsc) * *(const f32x4*)(g + c); }
    }
}

__device__ __forceinline__ int maprow(int mode, int n) {
    if (mode == 1) { const int lc = n & 255; int x = lc & 31; if (n >= 768 && n < 1024) x = 8 * ((x >> 2) & 3) + 4 * (x >> 4) + (x & 3);
        else if (n < 1792) { const int e = lc & 63; return (n & ~255) + 128 * ((e >> 4) & 1) + 32 * (lc >> 6) + 8 * (2 * (e >> 5) + ((e >> 3) & 1)) + 4 * ((e >> 2) & 1) + (e & 3); }
        return (n & ~255) + 128 * ((lc >> 5) & 1) + 32 * (lc >> 6) + x; }
    if (mode == 2) { if (n < DFF) return 256 * (n >> 7) + (n & 127); const int n2 = n - DFF; return 256 * (n2 >> 7) + 128 + (n2 & 127); }
    return n;
}
__device__ __forceinline__ void transpose_item(const float* W, int K, int N, bf16* WT, int mode, LAS float* scr, int item, int lane) {
    const int nblk = N / 32, kb = item / nblk, nb = item % nblk, k0 = 64 * kb, n0 = 32 * nb;
#pragma unroll
    for (int i = 0; i < 32; ++i) { const int kk = 2 * i + (lane >> 5); scr[kk * 33 + (lane & 31)] = W[(size_t)(k0 + kk) * N + n0 + (lane & 31)]; }
    asm volatile("s_waitcnt lgkmcnt(0)" ::: "memory");
    const int c = lane & 7;
#pragma unroll
    for (int j = 0; j < 4; ++j) { const int n = (lane >> 3) + 8 * j; const LAS float* s = scr + (8 * c) * 33 + n;
        u32x4 o; o.x = cvtpk(s[0 * 33], s[1 * 33]); o.y = cvtpk(s[2 * 33], s[3 * 33]); o.z = cvtpk(s[4 * 33], s[5 * 33]); o.w = cvtpk(s[6 * 33], s[7 * 33]);
        *(u32x4*)(WT + (size_t)maprow(mode, n0 + n) * K + k0 + 8 * c) = o; }
    asm volatile("s_waitcnt lgkmcnt(0)" ::: "memory");
}

struct Args { const float* in[33]; float* out; unsigned char* ws; int ph_lo, ph_hi; };
constexpr int N_PHASES = 13;

__global__ void __launch_bounds__(512, 2) mega_fwd(Args args) {
    extern __shared__ __attribute__((aligned(16))) unsigned char lds[];
    LAS unsigned char* L = (LAS unsigned char*)lds;
    cg::grid_group grid = cg::this_grid();
    unsigned* barw = (unsigned*)(args.ws + WS_BAR);
    volatile LAS unsigned* bst = (volatile LAS unsigned*)((LAS unsigned char*)lds + LDS_BYTES - 64);
    if (threadIdx.x == 0) { bst[0] = 0u; bst[1] = 0u; }
    __syncthreads();
    XcdBarrier xbar = xcd_barrier_post(barw, bst);
    if (args.ph_lo < 0) grid.sync();
    const int wave0 = __builtin_amdgcn_readfirstlane(threadIdx.x >> 6);
#ifdef DBG_XSYNC
    for (int i = 0; i < DBG_XSYNC; ++i) xcd_barrier(xbar);
#endif
#ifdef DBG_DUP
    int dup_done = -1;
#endif
    for (int ph = args.ph_lo; ph < args.ph_hi; ++ph) {
        if (ph > args.ph_lo) xcd_barrier(xbar);
        int wave = wave0; asm volatile("" : "+s"(wave)); int G = gridDim.x; asm volatile("" : "+s"(G)); int bx = blockIdx.x; asm volatile("" : "+s"(bx));
    const int gw = bx * 8 + wave, NGW = G * 8;
    __attribute__((address_space(1))) unsigned char* ws1_ = (__attribute__((address_space(1))) unsigned char*)args.ws; asm volatile("" : "+s"(ws1_)); unsigned char* ws = (unsigned char*)ws1_;
    __attribute__((address_space(1))) float* out1_ = (__attribute__((address_space(1))) float*)args.out; asm volatile("" : "+s"(out1_)); float* out = (float*)out1_;
    float* MOD = (float*)(ws + WS_MOD); float* ROPE = (float*)(ws + WS_ROPE);
    bf16* Hb = (bf16*)(ws + WS_H); float* YF = (float*)(ws + WS_H);
    bf16 *QA = (bf16*)(ws + WS_QA), *KA = (bf16*)(ws + WS_KA), *VA = (bf16*)(ws + WS_VA), *QC = (bf16*)(ws + WS_QC), *KC = (bf16*)(ws + WS_KC), *VC = (bf16*)(ws + WS_VC);
    float* Ub = (float*)(ws + WS_U); bf16* MF = (bf16*)(ws + WS_QKVU);
    bf16* GATES = (bf16*)(ws + WS_GATES); bf16* ACT = (bf16*)(ws + WS_GATES);
    bf16 *OA = (bf16*)(ws + WS_OA), *OB = (bf16*)(ws + WS_OB), *OC = (bf16*)(ws + WS_OC);
    bf16 *CKAK = (bf16*)(ws + WS_CKAK), *CKAV = (bf16*)(ws + WS_CKAV), *CKCK = (bf16*)(ws + WS_CKCK), *CKCV = (bf16*)(ws + WS_CKCV);
    float* SSMF = (float*)(ws + WS_SSMF2); unsigned* FLAGS = (unsigned*)(ws + WS_FLAG);

        if (ph == 0) {
#ifdef DBG_DUP_P0
            for (int rep0 = 0; rep0 < 2; ++rep0) {
#endif
            const int lane = FRESH_LANE(), tid = wave * 64 + lane;
            LAS float* S = (LAS float*)(L + 69632);
            LAS float* red = (LAS float*)(L + 90112);
            {
                for (int i = tid; i < 5 * 1024; i += 512) { const int cv = i >> 10, kx = i & 1023; const float c = cv == 0 ? args.in[8][kx] : args.in[2][(cv - 1) * 1024 + kx]; S[i] = c / (1.0f + __expf(-c)); }
                __syncthreads();
                for (int item = bx; item < 256; item += G) {
                    const int l = item >> 7, col = (item & 127) * 48 + (lane < 48 ? lane : 47);
                    const float* wp = args.in[9] + (size_t)l * 1024 * 6144 + col;
                    float a0 = 0.f, a1 = 0.f, a2 = 0.f, a3 = 0.f, a4 = 0.f;
#pragma unroll 16
                    for (int kk = 0; kk < 128; ++kk) { const int kx = wave * 128 + kk; const float w = wp[(size_t)kx * 6144];
                        a0 += S[kx] * w; a1 += S[1024 + kx] * w; a2 += S[2048 + kx] * w; a3 += S[3072 + kx] * w; a4 += S[4096 + kx] * w; }
                    red[(wave * 5 + 0) * 64 + lane] = a0; red[(wave * 5 + 1) * 64 + lane] = a1; red[(wave * 5 + 2) * 64 + lane] = a2; red[(wave * 5 + 3) * 64 + lane] = a3; red[(wave * 5 + 4) * 64 + lane] = a4;
                    __syncthreads();
                    if (wave < 5 && lane < 48) { float s = args.in[10][l * 6144 + col];
#pragma unroll
                        for (int w8 = 0; w8 < 8; ++w8) s += red[(w8 * 5 + wave) * 64 + lane];
                        MOD[(l * 5 + wave) * 6144 + col] = s; }
                    asm volatile("s_waitcnt vmcnt(0)" ::: "memory");
                    __syncthreads();
                    if (item < 43 && wave == 0) { __builtin_amdgcn_fence(__ATOMIC_RELEASE, "agent"); asm volatile("s_waitcnt vmcnt(0)" ::: "memory");
                        if (lane == 0) __hip_atomic_fetch_add(FLAGS + 60, 1u, __ATOMIC_RELAXED, __HIP_MEMORY_SCOPE_AGENT); }
                }
            }
            if (bx == G - 2 && tid < 256) { const int ll = tid >> 7, qk = (tid >> 6) & 1, e = tid & 63; ((float*)(ws + WS_QKG))[tid] = (qk ? args.in[14] : args.in[13])[ll * 64 + e]; }
            { const int gtid = bx * 512 + tid, NTH = G * 512;
#define CPY(idx, off, n) for (int i = gtid; i < (n) / 4; i += NTH) ((f32x4*)(ws + WS_PAR) + (off) / 4)[i] = ((const f32x4*)args.in[idx])[i];
              CPY(11, P_N1G, 2048) CPY(29, P_N2G, 2048) CPY(32, P_FING, 1024) CPY(7, P_SSM0, 32768) CPY(15, P_LAMR, 4096) CPY(16, P_LAMI, 4096) CPY(17, P_LSTEP, 64)
              CPY(18, P_BRE, 65536) CPY(19, P_BIM, 65536) CPY(20, P_CRE, 65536) CPY(21, P_CIM, 65536) CPY(22, P_SSMD, 512) CPY(24, P_NAB, 3720)
#undef CPY
            }
            if (bx == G - 1) { for (int i = tid; i < 1024; i += 512) { const int pos = i >> 4, f = i & 15; const float inv = 1.0f / powf(10000.0f, (float)f / 16.0f); const float ang = (float)pos * inv; ROPE[2 * i] = cosf(ang); ROPE[2 * i + 1] = sinf(ang); } }
            for (int it = bx * 512 + tid; it < 196608; it += G * 512) {
                const float* src; bf16* dst; int e;
                if (it < 65536) { const bool isv = it >= 32768; e = (it & 32767) * 8; const int d = e & 63, t = (e >> 6) & 255, h = (e >> 14) & 1, b = (e >> 15) & 3, l = e >> 17;
                    src = (isv ? args.in[4] : args.in[3]) + ((((size_t)(b * 2 + l) * 256 + t) * 2 + h) * 64 + d); dst = (isv ? CKAV : CKAK) + e; }
                else { const int i2 = it - 65536; const bool isv = i2 >= 65536; e = (i2 & 65535) * 8; const int d = e & 63, t = (e >> 6) & 255, h = (e >> 14) & 3, b = (e >> 16) & 3, l = e >> 18;
                    src = (isv ? args.in[6] : args.in[5]) + ((((size_t)(b * 2 + l) * 256 + t) * 4 + h) * 64 + d); dst = (isv ? CKCV : CKCK) + e; }
                const f32x4 a = *(const f32x4*)src, c = *(const f32x4*)(src + 4);
                *(u32x4*)dst = (u32x4){cvtpk(a[0], a[1]), cvtpk(a[2], a[3]), cvtpk(c[0], c[1]), cvtpk(c[2], c[3])};
            }
            LAS float* scr = (LAS float*)(L + wave * 8448);
            for (int it = gw; it < 7712; it += NGW) { const int l = 0; int r = it;
                if (r < 2432) { transpose_item(args.in[12] + (size_t)l * DM * NIN, DM, NIN, (bf16*)(ws + W_IN) + (size_t)l * NIN * DM, 1, scr, r, lane); continue; } r -= 2432;
                if (r < 256) { transpose_item(args.in[25] + (size_t)l * 512 * DM, 512, DM, (bf16*)(ws + W_BRA) + (size_t)l * DM * 512, 0, scr, r, lane); continue; } r -= 256;
                if (r < 128) { transpose_item(args.in[26] + (size_t)l * 256 * DM, 256, DM, (bf16*)(ws + W_BRB) + (size_t)l * DM * 256, 0, scr, r, lane); continue; } r -= 128;
                if (r < 128) { transpose_item(args.in[27] + (size_t)l * 256 * DM, 256, DM, (bf16*)(ws + W_BRC) + (size_t)l * DM * 256, 0, scr, r, lane); continue; } r -= 128;
                if (r < 512) { transpose_item(args.in[28] + (size_t)l * DM * DM, DM, DM, (bf16*)(ws + W_OUT) + (size_t)l * DM * DM, 0, scr, r, lane); continue; } r -= 512;
                if (r < 2816) { transpose_item(args.in[30] + (size_t)l * DM * NGU, DM, NGU, (bf16*)(ws + W_GU) + (size_t)l * NGU * DM, 2, scr, r, lane); continue; } r -= 2816;
                if (r < 1408) { transpose_item(args.in[31] + (size_t)l * DFF * DM, DFF, DM, (bf16*)(ws + W_FD) + (size_t)l * DM * DFF, 0, scr, r, lane); continue; } r -= 1408;
                transpose_item(args.in[23] + (size_t)l * 256 * 256, 256, 256, (bf16*)(ws + W_GLU) + (size_t)l * 256 * 256, 0, scr, r, lane);
            }
            __syncthreads();
#ifdef DBG_DUP_P0
            }
#endif
            {
                if (wave == 0) { unsigned sp_ = 0; while (__hip_atomic_load(FLAGS + 60, __ATOMIC_RELAXED, __HIP_MEMORY_SCOPE_AGENT) < 43u) { __builtin_amdgcn_s_sleep(4); if (++sp_ > (1u << 22)) break; }
                    __builtin_amdgcn_fence(__ATOMIC_ACQUIRE, "agent"); asm volatile("s_waitcnt vmcnt(0)" ::: "memory"); }
                __syncthreads();
                const int lane2 = FRESH_LANE();
                norm_mod_rows(args.in[0], args.in[1], args.in[11], MOD, 0, 1024, Hb, gw, NGW, lane2);
            }
            continue;
        }
        const float* const PAR = (const float*)(ws + WS_PAR);
        const int l = (ph - 1) / 6, sp = (ph - 1) % 6 + 1;
        unsigned* CNT = (unsigned*)(ws + WS_CNT); unsigned* TMO = (unsigned*)(ws + WS_TMO); unsigned* XBUF = (unsigned*)(ws + WS_XBUF);
        const float* modl = MOD + (size_t)l * 5 * 6144;
        const float* xc_in = args.in[0]; const float* xl_in = args.in[1];
        const float* xc_cur = out; const float* xl_cur = out + (size_t)4096 * 1024;
        pg8::StaticOrder S;
        switch (sp) {
        case 0: {
            const bool first = (l == 0); const int lane = FRESH_LANE();
            norm_mod_rows(first ? xc_in : xc_cur, first ? xl_in : xl_cur, PAR + P_N1G + l * 1024, modl, 0, 1024, Hb, gw, NGW, lane);
        } break;
        case 1: {
            pg8::Gemm g{Hb, (const bf16*)(ws + W_IN) + (size_t)l * NIN * DM, M_TOK, NIN, DM}; S.init(M_TOK, NIN, G, bx);
            EpiIn E{ws, out, l};

#ifndef CUT_IN
            pg8::gemm_phase<EpiIn, pg8::StaticOrder, true, true>(L, g, S, E, wave);
#endif

        } break;
        case 2: {
            SsmArgs SA{PAR + P_LAMR + l * 2048, PAR + P_LAMI + l * 2048, PAR + P_LSTEP + l * 32, PAR + P_BRE + (size_t)l * 32768, PAR + P_BIM + (size_t)l * 32768, PAR + P_CRE + (size_t)l * 32768, PAR + P_CIM + (size_t)l * 32768,
                       PAR + P_SSMD + l * 256, Ub, YF, OB, SSMF, PAR + P_SSM0, out + O_SSM, l};
#ifdef DBG_DUP
            const int QCTR_BASE = (dup_done == ph) ? 62 : 56;
#else
            constexpr int QCTR_BASE = 56;
#endif
            volatile LAS unsigned* qslot = (volatile LAS unsigned*)((LAS unsigned char*)lds + LDS_BYTES - 32);
            const int qx = bx & 7;
            for (;;) {
                __syncthreads();
                if (wave == 0 && FRESH_LANE() == 0) qslot[0] = __hip_atomic_fetch_add(FLAGS + 64 + (l * 2 + (QCTR_BASE == 56 ? 0 : 1)) * 8 + qx, 1u, __ATOMIC_RELAXED, __HIP_MEMORY_SCOPE_AGENT);
                __syncthreads();
                int item = (int)qslot[0]; item = __builtin_amdgcn_readfirstlane(item);
                if (item >= 140) break;
                if (item < 4) item = 384 + qx * 4 + item; else if (item < 36) item = 416 + qx * 32 + (item - 4); else if (item < 68) item = qx * 32 + (item - 36); else if (item < 84) item = 256 + qx * 16 + (item - 68);
                else if (item < 116) item = 864 + qx * 32 + (item - 84); else if (item < 132) item = 672 + qx * 16 + (item - 116); else item = 800 + qx * 8 + (item - 132);
                if (item < 256) {
                    const int b = item >> 6, h = (item >> 3) & 7, qb = item & 7, kvh = h >> 2;
                    const bf16* Qw = QA + ((size_t)4096 * 8 + (size_t)(b * 8 + h) * 2048 + qb * 256 + wave * 32) * 64;
                    const size_t co = ((size_t)((l * 4 + b) * 2 + kvh) * 256) * 64, lo = ((size_t)4096 * 2 + (size_t)(b * 2 + kvh) * 2048) * 64;
                    bf16* Ow = OA + ((size_t)4096 + b * 2048 + qb * 256 + wave * 32) * 512 + h * 64;
                    att::attn_unit<false>(Qw, CKAK + co, CKAV + co, KA + lo, VA + lo, 36, Ow, 512, (char*)lds, 0, 0, nullptr, wave);
                } else if (item < 384) {
                    const int i = item - 256, b = i >> 5, h = (i >> 3) & 3, qb = i & 7, r0 = 4 * qb;
                    const int rlo = clampi(r0 - 4, 0, 24), rhi = clampi(r0 - 1, 0, 24) + 7, NT = 4 + rhi - rlo + 1;
                    const bf16* Qw = QC + ((size_t)4096 * 4 + (size_t)(b * 4 + h) * 2048 + qb * 256 + wave * 32) * 64;
                    const size_t co = ((size_t)((l * 4 + b) * 4 + h) * 256) * 64, lo = ((size_t)4096 * 4 + (size_t)(b * 4 + h) * 2048 + rlo * 64) * 64;
                    bf16* Ow = OC + ((size_t)4096 + b * 2048 + qb * 256 + wave * 32) * 256 + h * 64;
                    att::attn_unit<true>(Qw, CKCK + co, CKCV + co, KC + lo, VC + lo, NT, Ow, 256, (char*)lds, r0 + (wave >> 1), rlo, PAR + P_NAB + (size_t)(l * 4 + h) * 465, wave);
                } else if (item < 416) {
                    const int wu = (item - 384) * 8 + wave;
                    ssm_both<0>(SA, wu >> 4, wu & 15, 0, (LAS float*)(L + wave * SSM_WAVE_BYTES));
                    asm volatile("s_waitcnt vmcnt(0) lgkmcnt(0)" ::: "memory"); __syncthreads();
                } else if (item < 672) {
                    const int wu = (item - 416) * 8 + wave;
                    ssm_dir<1, false>(SA, wu >> 9, (wu >> 5) & 15, (wu >> 4) & 1, wu & 15, (LAS float*)(L + wave * SSM_WAVE_BYTES));
                    asm volatile("s_waitcnt vmcnt(0) lgkmcnt(0)" ::: "memory"); __syncthreads();
                    if (wave == 0 && FRESH_LANE() == 0) __hip_atomic_fetch_add(FLAGS + 58 + l, 1u, __ATOMIC_RELAXED, __HIP_MEMORY_SCOPE_AGENT);
                } else if (item >= 864) {
                    if (wave == 0) { unsigned sp_ = 0; while (__hip_atomic_load(FLAGS + 58 + l, __ATOMIC_RELAXED, __HIP_MEMORY_SCOPE_AGENT) < 256u) { __builtin_amdgcn_s_sleep(4); if (++sp_ > (1u << 22)) break; }
                        __builtin_amdgcn_fence(__ATOMIC_ACQUIRE, "agent"); asm volatile("s_waitcnt vmcnt(0)" ::: "memory"); }
                    __syncthreads();
                    const int dd = wave & 1, wu = (wave >> 1) * 256 + (item - 864);
                    const int b = wu >> 8, g = (wu >> 4) & 15, c = wu & 15;
                    ssm_dir<2, false>(SA, b, g, dd, dd ? NLCH - 1 - c : c, (LAS float*)(L + wave * SSM_WAVE_BYTES));
                    asm volatile("s_waitcnt vmcnt(0) lgkmcnt(0)" ::: "memory");
                    __syncthreads();
                    { const int lane = FRESH_LANE(); const size_t o = ((size_t)4096 + b * 2048 + c * 128 + dd * 64 + lane) * 256 + g * 16;
                      const float* yf = YF + o; const float* yb = YF + (size_t)M_TOK * 256 + o; const float* uu = Ub + o; const float* dv = PAR + P_SSMD + l * 256 + g * 16;
                      unsigned w[8];
#pragma unroll
                      for (int c4 = 0; c4 < 4; ++c4) { const f32x4 y = *(const f32x4*)(yf + 4 * c4) + *(const f32x4*)(yb + 4 * c4) + *(const f32x4*)(dv + 4 * c4) * *(const f32x4*)(uu + 4 * c4); f32x4 q;
#pragma unroll
                          for (int j = 0; j < 4; ++j) { const float v = y[j]; q[j] = gelu_tanh_(v); }
                          w[2 * c4] = cvtpk(q[0], q[1]); w[2 * c4 + 1] = cvtpk(q[2], q[3]); }
                      *(u32x4*)(OB + o) = (u32x4){w[0], w[1], w[2], w[3]}; *(u32x4*)(OB + o + 8) = (u32x4){w[4], w[5], w[6], w[7]}; }
                    asm volatile("s_waitcnt vmcnt(0) lgkmcnt(0)" ::: "memory");
                    __syncthreads();
                } else if (item < 800) {
                    const int i = item - 672, b = i >> 3, h = i & 7, kvh = h >> 2;
                    const bf16* Qw = QA + ((size_t)(b * 8 + h) * 256 + wave * 32) * 64;
                    const size_t co = ((size_t)(b * 2 + kvh) * 256) * 64;
                    bf16* Ow = OA + ((size_t)b * 256 + wave * 32) * 512 + h * 64;
                    att::attn_unit<false>(Qw, KA + co, VA + co, KA, VA, 4, Ow, 512, (char*)lds, 0, 0, nullptr, wave);
                } else {
                    const int i = item - 800, b = i >> 2, h = i & 3;
                    const bf16* Qw = QC + ((size_t)(b * 4 + h) * 256 + wave * 32) * 64;
                    const size_t co = ((size_t)(b * 4 + h) * 256) * 64;
                    bf16* Ow = OC + ((size_t)b * 256 + wave * 32) * 256 + h * 64;
                    att::attn_unit<false>(Qw, KC + co, VC + co, KC, VC, 4, Ow, 256, (char*)lds, 0, 0, nullptr, wave);
                }
            }
        } break;
        case 3: {
            const int cglu = (G == 256) ? bx - 192 : bx;
            pg8::StaticOrder SG; SG.init(M_TOK, 256, G, cglu < 0 ? G : cglu); Unit ug;
            if (SG.next(0, ug)) {
                pg8::Gemm g{OB, (const bf16*)(ws + W_GLU) + (size_t)l * 256 * 256, M_TOK, 256, 256};
                EpiGlu E{OB};
                pg8::gemm_phase<EpiGlu, pg8::StaticOrder, true, true>(L, g, SG, E, wave);
                asm volatile("s_waitcnt vmcnt(0)" ::: "memory");
                __syncthreads();
                if (wave == 0) { __builtin_amdgcn_fence(__ATOMIC_RELEASE, "agent"); asm volatile("s_waitcnt vmcnt(0)" ::: "memory");
                    if (FRESH_LANE() == 0) __hip_atomic_store(FLAGS + ug.pm, (unsigned)(l + 1), __ATOMIC_RELAXED, __HIP_MEMORY_SCOPE_AGENT); }
            }
            S.init(M_TOK, DM, G, bx);
            { pg8::Gemm g{OA, (const bf16*)(ws + W_BRA) + (size_t)l * DM * 512, M_TOK, DM, 512}; EpiBr<0> E{GATES, MF, nullptr}; pg8::gemm_phase<EpiBr<0>, pg8::StaticOrder, true, true>(L, g, S, E, wave); }
            { pg8::Gemm g{OC, (const bf16*)(ws + W_BRC) + (size_t)l * DM * 256, M_TOK, DM, 256}; EpiBr<1> E{GATES + 2048, MF, nullptr}; pg8::gemm_phase<EpiBr<1>, pg8::StaticOrder, true, true>(L, g, S, E, wave); }
            { Unit ub; if (S.next(0, ub)) {
                if (wave == 0) { unsigned sp_ = 0; while (__hip_atomic_load(FLAGS + ub.pm, __ATOMIC_RELAXED, __HIP_MEMORY_SCOPE_AGENT) < (unsigned)(l + 1)) { __builtin_amdgcn_s_sleep(2); if (++sp_ > (1u << 24)) break; }
                    __builtin_amdgcn_fence(__ATOMIC_ACQUIRE, "agent"); asm volatile("s_waitcnt vmcnt(0)" ::: "memory"); }
                __syncthreads(); } }
            { pg8::Gemm g{OB, (const bf16*)(ws + W_BRB) + (size_t)l * DM * 256, M_TOK, DM, 256}; EpiBr<2> E{GATES + 1024, MF, Hb}; pg8::gemm_phase<EpiBr<2>, pg8::StaticOrder, true, true>(L, g, S, E, wave); }
        } break;
        case 4: {
            if (l == 0 && bx >= 192) {
                const int lane = FRESH_LANE(); LAS float* scr = (LAS float*)(L + wave * 8448); const int l = 1;
                for (int it = 0 + (bx - 192) * 8 + wave; it < 3856; it += (G - 192) * 8) { int r = it;
                    if (r < 2432) { transpose_item(args.in[12] + (size_t)l * DM * NIN, DM, NIN, (bf16*)(ws + W_IN) + (size_t)l * NIN * DM, 1, scr, r, lane); continue; } r -= 2432;
                    if (r < 256) { transpose_item(args.in[25] + (size_t)l * 512 * DM, 512, DM, (bf16*)(ws + W_BRA) + (size_t)l * DM * 512, 0, scr, r, lane); continue; } r -= 256;
                    if (r < 128) { transpose_item(args.in[26] + (size_t)l * 256 * DM, 256, DM, (bf16*)(ws + W_BRB) + (size_t)l * DM * 256, 0, scr, r, lane); continue; } r -= 128;
                    if (r < 128) { transpose_item(args.in[27] + (size_t)l * 256 * DM, 256, DM, (bf16*)(ws + W_BRC) + (size_t)l * DM * 256, 0, scr, r, lane); continue; } r -= 128;
                    if (r < 512) { transpose_item(args.in[28] + (size_t)l * DM * DM, DM, DM, (bf16*)(ws + W_OUT) + (size_t)l * DM * DM, 0, scr, r, lane); continue; } r -= 512;
                    if (r < 2816) { transpose_item(args.in[30] + (size_t)l * DM * NGU, DM, NGU, (bf16*)(ws + W_GU) + (size_t)l * NGU * DM, 2, scr, r, lane); continue; } r -= 2816;
                    if (r < 1408) { transpose_item(args.in[31] + (size_t)l * DFF * DM, DFF, DM, (bf16*)(ws + W_FD) + (size_t)l * DM * DFF, 0, scr, r, lane); continue; } r -= 1408;
                    transpose_item(args.in[23] + (size_t)l * 256 * 256, 256, 256, (bf16*)(ws + W_GLU) + (size_t)l * 256 * 256, 0, scr, r, lane);
            }
                asm volatile("s_waitcnt vmcnt(0) lgkmcnt(0)" ::: "memory");
            }
            S.init(M_TOK, DM, G, bx);
            pg8::Gemm g{Hb, (const bf16*)(ws + W_OUT) + (size_t)l * DM * DM, M_TOK, DM, DM};
            PanelStats st{XBUF, CNT + (l * 2 + 0) * 3072, TMO, 4, EPS, 0x700u};
            EpiResNorm<0> E{l == 0 ? xc_in : xc_cur, l == 0 ? xl_in : xl_cur, out, modl + 2048, PAR + P_N2G + l * 1024, modl, 3072, 4096, Hb, st};
            pg8::gemm_phase<EpiResNorm<0>, pg8::StaticOrder, false, true>(L, g, S, E, wave);
        } break;
        case 5: {
            pg8::Gemm g{Hb, (const bf16*)(ws + W_GU) + (size_t)l * NGU * DM, M_TOK, NGU, DM}; S.init(M_TOK, NGU, G, bx);
            EpiSwiglu E{ACT};
            pg8::gemm_phase<EpiSwiglu, pg8::StaticOrder, true, true>(L, g, S, E, wave);
        } break;
        case 6: {
            if (l == 0 && bx >= 192) {
                const int lane = FRESH_LANE(); LAS float* scr = (LAS float*)(L + wave * 8448); const int l = 1;
                for (int it = 3856 + (bx - 192) * 8 + wave; it < 7712; it += (G - 192) * 8) { int r = it;
                    if (r < 2432) { transpose_item(args.in[12] + (size_t)l * DM * NIN, DM, NIN, (bf16*)(ws + W_IN) + (size_t)l * NIN * DM, 1, scr, r, lane); continue; } r -= 2432;
                    if (r < 256) { transpose_item(args.in[25] + (size_t)l * 512 * DM, 512, DM, (bf16*)(ws + W_BRA) + (size_t)l * DM * 512, 0, scr, r, lane); continue; } r -= 256;
                    if (r < 128) { transpose_item(args.in[26] + (size_t)l * 256 * DM, 256, DM, (bf16*)(ws + W_BRB) + (size_t)l * DM * 256, 0, scr, r, lane); continue; } r -= 128;
                    if (r < 128) { transpose_item(args.in[27] + (size_t)l * 256 * DM, 256, DM, (bf16*)(ws + W_BRC) + (size_t)l * DM * 256, 0, scr, r, lane); continue; } r -= 128;
                    if (r < 512) { transpose_item(args.in[28] + (size_t)l * DM * DM, DM, DM, (bf16*)(ws + W_OUT) + (size_t)l * DM * DM, 0, scr, r, lane); continue; } r -= 512;
                    if (r < 2816) { transpose_item(args.in[30] + (size_t)l * DM * NGU, DM, NGU, (bf16*)(ws + W_GU) + (size_t)l * NGU * DM, 2, scr, r, lane); continue; } r -= 2816;
                    if (r < 1408) { transpose_item(args.in[31] + (size_t)l * DFF * DM, DFF, DM, (bf16*)(ws + W_FD) + (size_t)l * DM * DFF, 0, scr, r, lane); continue; } r -= 1408;
                    transpose_item(args.in[23] + (size_t)l * 256 * 256, 256, 256, (bf16*)(ws + W_GLU) + (size_t)l * 256 * 256, 0, scr, r, lane);
            }
                asm volatile("s_waitcnt vmcnt(0) lgkmcnt(0)" ::: "memory");
            }
            S.init(M_TOK, DM, G, bx);
            pg8::Gemm g{ACT, (const bf16*)(ws + W_FD) + (size_t)l * DM * DFF, M_TOK, DM, DFF};
            PanelStats st{XBUF, CNT + (l * 2 + 1) * 3072, TMO, 4, EPS, 0x780u};
            if (l == 0) { EpiResNorm<0> E{xc_cur, xl_cur, out, modl + 5120, PAR + P_N1G + 1024, MOD + (size_t)5 * 6144, 0, 1024, Hb, st}; pg8::gemm_phase<EpiResNorm<0>, pg8::StaticOrder, false, true>(L, g, S, E, wave); }
            else { EpiResNorm<1> E{xc_cur, xl_cur, out, modl + 5120, PAR + P_FING, MOD, 0, 1024, Hb, st}; pg8::gemm_phase<EpiResNorm<1>, pg8::StaticOrder, false, true>(L, g, S, E, wave); }
        } break;
        }
#ifdef DBG_DUP
        if (sp == DBG_DUP && dup_done != ph) { dup_done = ph; --ph; }
#endif
    }
}

extern "C" void kernel_launch(void* const* d_in, const int* in_sizes, int n_in, void* d_out, int out_size, void* d_ws, size_t ws_size, hipStream_t stream) {
    static int grid = 0;
    if (grid == 0) {
        if (n_in != 33 || ws_size < WS_END) { fprintf(stderr, "kernel_launch: unexpected n_in %d / ws_size %zu\n", n_in, ws_size); grid = -1; return; }
        int dev = 0, cus = 0, per_cu = 0;
        hipGetDevice(&dev); hipDeviceGetAttribute(&cus, hipDeviceAttributeMultiprocessorCount, dev);
        if (hipFuncSetAttribute((const void*)mega_fwd, hipFuncAttributeMaxDynamicSharedMemorySize, LDS_BYTES) != hipSuccess) { fprintf(stderr, "kernel_launch: hipFuncSetAttribute failed\n"); grid = -1; return; }
        if (hipOccupancyMaxActiveBlocksPerMultiprocessor(&per_cu, (const void*)mega_fwd, 512, LDS_BYTES) != hipSuccess || per_cu < 1) { fprintf(stderr, "kernel_launch: occupancy query says %d\n", per_cu); per_cu = 1; }
        (void)hipGetLastError();
        grid = cus * 1;
        fprintf(stderr, "kernel_launch: cus %d per_cu %d grid %d ws %zu\n", cus, per_cu, grid, ws_size);
    }
    if (grid < 0) return;
    if (hipMemsetAsync((char*)d_ws + WS_BAR, 0, 131072, stream) != hipSuccess) { fprintf(stderr, "kernel_launch: memset failed\n"); return; }
    Args a{};
    for (int i = 0; i < 33; ++i) a.in[i] = (const float*)d_in[i];
    a.out = (float*)d_out; a.ws = (unsigned char*)d_ws;
#if MK_MULTI
    for (int ph = 0; ph < N_PHASES; ++ph) { a.ph_lo = ph; a.ph_hi = ph + 1; hipLaunchKernelGGL(mega_fwd, dim3(grid), dim3(512), LDS_BYTES, stream, a); }
#else
    a.ph_lo = 0; a.ph_hi = N_PHASES;
    void* kargs[] = {&a};
    hipError_t e = hipLaunchCooperativeKernel((const void*)mega_fwd, dim3(grid), dim3(512), kargs, LDS_BYTES, stream);
    if (e != hipSuccess) fprintf(stderr, "cooperative launch failed: %s (grid %d)\n", hipGetErrorString(e), grid);
#endif
}
```

```cpp
#include <hip/hip_runtime.h>
#include <hip/hip_cooperative_groups.h>
#include <hip/hip_bf16.h>
#include <cstdio>
#include <cstdint>
namespace cg = cooperative_groups;

#ifndef MK_MULTI
#define MK_MULTI 0
#endif

namespace pg8 {
#define PG8_LAS __attribute__((address_space(3)))
typedef unsigned short bf16_t;
typedef short bf16x8 __attribute__((ext_vector_type(8)));
typedef float f32x4 __attribute__((ext_vector_type(4)));
typedef unsigned u32x4 __attribute__((ext_vector_type(4)));
constexpr int BM = 256, BK = 64, HALF = 128, HTB = HALF * BK * 2  , STAGE_BYTES = 8 * HTB, NXCD = 8, WGM = 8;

__host__ __device__ __forceinline__ int lds_byte(int r, int c) { const int st = (r >> 4) * 2 + (c >> 5), rr = r & 15, cc = c & 31, ob = rr * 64 + cc * 2; return st * 1024 + (ob ^ (((ob >> 9) & 1) << 5)); }
__host__ __device__ __forceinline__ void stage_rc(int b, int& R, int& C) { const int st = b / 1024, sb = b % 1024, swz = sb ^ (((sb >> 9) & 1) << 5); R = (st >> 1) * 16 + swz / 64; C = (st & 1) * 32 + (swz % 64) / 2; }
__host__ __device__ __forceinline__ int perm32(int rho) { const int n = rho >> 4, i = rho & 15; return 8 * (i >> 2) + 4 * n + (i & 3); }

struct Unit { int pm, pn; };
struct Gemm { const bf16_t* A; const bf16_t* Bt; int M, N, K; };

struct StaticOrder {
    int nM, nN, nwg, G, c;
    __host__ __device__ void init(int M, int N, int G_, int c_) { nM = M / BM; nN = N / BM; nwg = nM * nN; G = G_; c = c_; }
    __host__ __device__ bool next(int i, Unit& u) const {
        const long L = (long)i * G + c; if (L >= nwg) return false;
        int wgid = (int)L; { const int q = nwg / NXCD, r = nwg % NXCD, xcd = wgid % NXCD, off = wgid / NXCD; wgid = (xcd < r ? xcd * (q + 1) : r * (q + 1) + (xcd - r) * q) + off; }
        const int nig = WGM * nN, gid = wgid / nig, fm = gid * WGM, gsz = (nM - fm) < WGM ? (nM - fm) : WGM;
        u.pm = fm + ((wgid % nig) % gsz); u.pn = (wgid % nig) / gsz; return true;
    }
    __device__ __forceinline__ void a_ready(const Unit&) const {}
    __device__ __forceinline__ void done(const Unit&) const {}
};

__device__ __forceinline__ unsigned cvt_pk_bf16(float lo, float hi) { unsigned r; asm volatile("v_cvt_pk_bf16_f32 %0, %1, %2" : "=v"(r) : "v"(lo), "v"(hi)); return r; }
typedef float f32x2 __attribute__((ext_vector_type(2)));
template <class Epi, class Sched, bool ALIGN_EPI = false, bool SP2 = false>
__device__ __forceinline__ void gemm_phase(PG8_LAS unsigned char* lds, const Gemm g, const Sched& S, const Epi& E, const int wid) {
    int lane; asm volatile("v_mbcnt_lo_u32_b32 %0, -1, 0\n\tv_mbcnt_hi_u32_b32 %0, -1, %0" : "=v"(lane)); const int tid = wid * 64 + lane, wr = wid >> 2, wc = wid & 3, fr = lane & 15, fq = lane >> 4;
    const int K = g.K, nt = K / BK;
    unsigned voffA[2], voffB[2];
#pragma unroll
    for (int i = 0; i < 2; ++i) { int R, C; stage_rc(tid * 16 + i * 8192, R, C); const int Rb = Epi::PERM ? ((R & ~31) + perm32(R & 31)) : R;
        voffA[i] = (unsigned)(R * K + C) * 2u; voffB[i] = (unsigned)(Rb * K + C) * 2u; }
    const size_t kstep = (size_t)(BK * 2);
    const size_t hstep = (size_t)HALF * K * 2;
    const size_t tstep = 2 * hstep;
    const unsigned ldsw = (unsigned)wid * 1024u;
    const int aoff = lds_byte(wr * 64 + fr, fq * 8), boff = lds_byte(wc * 32 + fr, fq * 8);
#define PG8_SA(b, h) (((b) * 2 + (h)) * HTB)
#define PG8_SB(b, h) ((4 + (b) * 2 + (h)) * HTB)
#define PG8_STAGE(bufoff, gbase, voff) do { _Pragma("unroll") for (int _i = 0; _i < 2; ++_i) \
        __builtin_amdgcn_global_load_lds((const unsigned*)((const char*)(gbase) + (voff)[_i]), (PG8_LAS unsigned*)(lds + (bufoff) + ldsw + _i * 8192), 16, 0, 0); } while (0)
#define PG8_LDA(dst, b, h) do { _Pragma("unroll") for (int m = 0; m < 4; ++m) _Pragma("unroll") for (int k = 0; k < 2; ++k) dst[m][k] = *(const PG8_LAS bf16x8*)(lds + PG8_SA(b, h) + aoff + m * 2048 + k * 1024); } while (0)
#define PG8_LDB(dst, b, h) do { _Pragma("unroll") for (int n = 0; n < 2; ++n) _Pragma("unroll") for (int k = 0; k < 2; ++k) dst[n][k] = *(const PG8_LAS bf16x8*)(lds + PG8_SB(b, h) + boff + n * 2048 + k * 1024); } while (0)
#define PG8_MMA(ai, bj, At, Bt) do { __builtin_amdgcn_s_setprio(1); _Pragma("unroll") for (int m = 0; m < 4; ++m) _Pragma("unroll") for (int n = 0; n < 2; ++n) _Pragma("unroll") for (int k = 0; k < 2; ++k) \
        acc[ai][bj][m][n] = __builtin_amdgcn_mfma_f32_16x16x32_bf16(Bt[n][k], At[m][k], acc[ai][bj][m][n], 0, 0, 0); __builtin_amdgcn_s_setprio(0); } while (0)
#define PG8_WAIT_V(n) asm volatile("s_waitcnt vmcnt(" #n ")" ::: "memory")
#define PG8_WAIT_L(n) asm volatile("s_waitcnt lgkmcnt(" #n ")" ::: "memory")
#define PG8_BAR __builtin_amdgcn_s_barrier()
#define PG8_SCHED __builtin_amdgcn_sched_barrier(0)
    Unit cur, nxt; int ui = 0;
    if (!S.next(0, cur)) return;
    f32x4 acc[2][2][4][2];
#pragma unroll
    for (int a = 0; a < 2; ++a)
#pragma unroll
        for (int b = 0; b < 2; ++b)
#pragma unroll
            for (int m = 0; m < 4; ++m)
#pragma unroll
                for (int n = 0; n < 2; ++n) acc[a][b][m][n] = (f32x4){0.f, 0.f, 0.f, 0.f};
    bf16x8 At[4][2], B0[2][2], B1[2][2];
    const char* cA = (const char*)g.A + (size_t)cur.pm * tstep; const char* cB = (const char*)g.Bt + (size_t)cur.pn * tstep;
    S.a_ready(cur);
    if constexpr (SP2) {
        PG8_STAGE(PG8_SB(0, 0), cB, voffB); PG8_STAGE(PG8_SB(0, 1), cB + hstep, voffB); PG8_STAGE(PG8_SA(0, 0), cA, voffA); PG8_STAGE(PG8_SA(0, 1), cA + hstep, voffA);
        if (wr == 1) PG8_BAR;
        PG8_WAIT_V(2); PG8_BAR;
        PG8_STAGE(PG8_SB(1, 0), cB + kstep, voffB); PG8_STAGE(PG8_SA(1, 0), cA + kstep, voffA); PG8_STAGE(PG8_SB(1, 1), cB + hstep + kstep, voffB);
        PG8_WAIT_V(6); PG8_BAR;
    } else {
        PG8_STAGE(PG8_SB(0, 0), cB, voffB); PG8_STAGE(PG8_SA(0, 0), cA, voffA); PG8_STAGE(PG8_SB(0, 1), cB + hstep, voffB); PG8_STAGE(PG8_SA(0, 1), cA + hstep, voffA);
        if (wr == 1) PG8_BAR;
        PG8_WAIT_V(4); PG8_BAR;
        PG8_STAGE(PG8_SB(1, 0), cB + kstep, voffB); PG8_STAGE(PG8_SA(1, 0), cA + kstep, voffA); PG8_STAGE(PG8_SB(1, 1), cB + hstep + kstep, voffB);
        PG8_WAIT_V(6); PG8_BAR;
    }
    for (;;) {
        const bool has_next = S.next(ui + 1, nxt);
        const char* nA = has_next ? (const char*)g.A + (size_t)nxt.pm * tstep : cA; const char* nB = has_next ? (const char*)g.Bt + (size_t)nxt.pn * tstep : cB;
        for (int t = 0; t < nt; t += 2) {
            const bool last = (t == nt - 2);
            const char* a1 = cA + (size_t)(t + 1) * kstep;
            const char* a2 = last ? nA : cA + (size_t)(t + 2) * kstep; const char* b2 = last ? nB : cB + (size_t)(t + 2) * kstep;
            const char* a3 = a2 + kstep; const char* b3 = b2 + kstep;
            if (last && has_next) S.a_ready(nxt);
            if constexpr (SP2) {
            PG8_LDB(B0, 0, 0); PG8_LDB(B1, 0, 1); PG8_SCHED; PG8_LDA(At, 0, 0); PG8_STAGE(PG8_SA(1, 1), a1 + hstep, voffA);
            PG8_WAIT_V(8); PG8_WAIT_L(0); PG8_BAR; PG8_MMA(0, 0, At, B0); PG8_MMA(0, 1, At, B1); PG8_BAR; PG8_SCHED;
            PG8_LDA(At, 0, 1); PG8_STAGE(PG8_SB(0, 0), b2, voffB); PG8_STAGE(PG8_SB(0, 1), b2 + hstep, voffB); PG8_STAGE(PG8_SA(0, 0), a2, voffA);
            PG8_WAIT_V(8); PG8_WAIT_L(0); PG8_BAR; PG8_MMA(1, 0, At, B0); PG8_MMA(1, 1, At, B1); PG8_BAR; PG8_SCHED;
            PG8_LDB(B0, 1, 0); PG8_LDB(B1, 1, 1); PG8_SCHED; PG8_LDA(At, 1, 0); PG8_STAGE(PG8_SA(0, 1), a2 + hstep, voffA);
            PG8_WAIT_V(8); PG8_WAIT_L(0); PG8_BAR; PG8_MMA(0, 0, At, B0); PG8_MMA(0, 1, At, B1); PG8_BAR; PG8_SCHED;
            PG8_LDA(At, 1, 1); PG8_STAGE(PG8_SB(1, 0), b3, voffB); PG8_STAGE(PG8_SB(1, 1), b3 + hstep, voffB); PG8_STAGE(PG8_SA(1, 0), a3, voffA);
            PG8_WAIT_V(8); PG8_WAIT_L(0); PG8_BAR; PG8_MMA(1, 0, At, B0); PG8_MMA(1, 1, At, B1); PG8_BAR; PG8_SCHED;
            } else {
            PG8_LDB(B0, 0, 0); PG8_SCHED; PG8_LDA(At, 0, 0); PG8_STAGE(PG8_SA(1, 1), a1 + hstep, voffA);
            PG8_WAIT_L(8); PG8_BAR; PG8_WAIT_L(0); PG8_MMA(0, 0, At, B0); PG8_BAR; PG8_SCHED;
            PG8_LDB(B1, 0, 1); PG8_STAGE(PG8_SB(0, 0), b2, voffB);
            PG8_BAR; PG8_WAIT_L(0); PG8_MMA(0, 1, At, B1); PG8_BAR;
            PG8_LDA(At, 0, 1); PG8_STAGE(PG8_SA(0, 0), a2, voffA);
            PG8_BAR; PG8_WAIT_L(0); PG8_MMA(1, 0, At, B0); PG8_BAR; PG8_SCHED;
            PG8_STAGE(PG8_SB(0, 1), b2 + hstep, voffB);
            PG8_WAIT_V(6); PG8_BAR; PG8_MMA(1, 1, At, B1); PG8_BAR;
            PG8_LDB(B0, 1, 0); PG8_SCHED; PG8_LDA(At, 1, 0); PG8_STAGE(PG8_SA(0, 1), a2 + hstep, voffA);
            PG8_WAIT_L(8); PG8_BAR; PG8_WAIT_L(0); PG8_MMA(0, 0, At, B0); PG8_BAR; PG8_SCHED;
            PG8_LDB(B1, 1, 1); PG8_STAGE(PG8_SB(1, 0), b3, voffB);
            PG8_BAR; PG8_WAIT_L(0); PG8_MMA(0, 1, At, B1); PG8_BAR;
            PG8_LDA(At, 1, 1); PG8_STAGE(PG8_SA(1, 0), a3, voffA);
            PG8_BAR; PG8_WAIT_L(0); PG8_MMA(1, 0, At, B0); PG8_BAR; PG8_SCHED;
            PG8_STAGE(PG8_SB(1, 1), b3 + hstep, voffB);
            PG8_WAIT_V(6); PG8_BAR; PG8_MMA(1, 1, At, B1); PG8_BAR;
            }
        }
        if constexpr (ALIGN_EPI) { if (wr == 0) PG8_BAR; }
        if constexpr (!Epi::AFTER_DRAIN) { E(acc, cur, wr, wc, fr, fq); S.done(cur); }
        if (!has_next) break;
#pragma unroll
        for (int a = 0; a < 2; ++a)
#pragma unroll
            for (int b = 0; b < 2; ++b)
#pragma unroll
                for (int m = 0; m < 4; ++m)
#pragma unroll
                    for (int n = 0; n < 2; ++n) acc[a][b][m][n] = (f32x4){0.f, 0.f, 0.f, 0.f};
        cur = nxt; cA = nA; cB = nB; ++ui;
        if constexpr (ALIGN_EPI) { if (wr == 1) PG8_BAR; }
    }
    PG8_WAIT_V(0);
    if constexpr (!ALIGN_EPI) { if (wr == 0) PG8_BAR; }
    PG8_BAR;
    if constexpr (Epi::AFTER_DRAIN) { E.fused(acc, cur, wr, wc, fr, fq, lds, wid, lane); S.done(cur); }
#undef PG8_SA
#undef PG8_SB
#undef PG8_STAGE
#undef PG8_LDA
#undef PG8_LDB
#undef PG8_MMA
#undef PG8_WAIT_V
#undef PG8_WAIT_L
#undef PG8_BAR
#undef PG8_SCHED
}
}

#define LAS __attribute__((address_space(3)))
typedef unsigned short bf16;
typedef short bf16x8 __attribute__((ext_vector_type(8)));
typedef short s16x4 __attribute__((ext_vector_type(4)));
typedef float f32x4 __attribute__((ext_vector_type(4)));
typedef float f32x16 __attribute__((ext_vector_type(16)));
typedef unsigned u32x4 __attribute__((ext_vector_type(4)));
typedef unsigned u32x2 __attribute__((ext_vector_type(2)));
typedef float f32x2_t __attribute__((ext_vector_type(2)));
typedef __bf16 bf16x2_t __attribute__((ext_vector_type(2)));

constexpr int M_TOK = 12288, M_CTX = 4096, DM = 1024, NIN = 4864, DFF = 2816, NGU = 5632;
constexpr float EPS = 1e-6f, LOG2E = 1.4426950408889634f, C2 = 0.125f * 1.4426950408889634f;
constexpr size_t MiB = 1u << 20;
constexpr size_t WS_ROPE = 0, WS_QKG = 16384, WS_BAR = 458752, WS_FLAG = 475136, WS_CNT = 512 * 1024, WS_TMO = 512 * 1024 + 61440, WS_XBUF = 576 * 1024, WS_MOD = 65536, WS_SSMF = 512 * 1024, WS_CKAK = 1 * MiB, WS_CKAV = 1 * MiB + 512 * 1024, WS_CKCK = 2 * MiB, WS_CKCV = 3 * MiB;
constexpr size_t WS_W = 4 * MiB;
constexpr size_t W_IN = WS_W, W_BRA = W_IN + 2ull * NIN * DM * 2, W_BRB = W_BRA + 2ull * DM * 512 * 2, W_BRC = W_BRB + 2ull * DM * 256 * 2, W_OUT = W_BRC + 2ull * DM * 256 * 2,
                 W_GU = W_OUT + 2ull * DM * DM * 2, W_FD = W_GU + 2ull * NGU * DM * 2, W_GLU = W_FD + 2ull * DM * DFF * 2, W_END = W_GLU + 2ull * 256 * 256 * 2;
constexpr size_t WS_H = 65 * MiB;
constexpr size_t WS_QKVU = 89 * MiB;
constexpr size_t WS_QA = WS_QKVU, WS_KA = WS_QA + 12 * MiB, WS_VA = WS_KA + 3 * MiB, WS_U = WS_VA + 3 * MiB, WS_QC = WS_U + 12 * MiB, WS_KC = WS_QC + 6 * MiB, WS_VC = WS_KC + 6 * MiB;
constexpr size_t WS_GATES = 137 * MiB;
constexpr size_t WS_OA = 209 * MiB, WS_OB = 221 * MiB, WS_OC = 227 * MiB, WS_PAR = 233 * MiB, WS_SSMF2 = 235 * MiB, WS_END = 236 * MiB;
constexpr int P_N1G = 0, P_N2G = 2048, P_FING = 4096, P_SSM0 = 5120, P_LAMR = 37888, P_LAMI = 41984, P_LSTEP = 46080, P_BRE = 46144, P_BIM = 111680, P_CRE = 177216, P_CIM = 242752, P_SSMD = 308288, P_NAB = 308800;
static_assert(W_END <= WS_H, "weights fit");
constexpr size_t O_YP = 0, O_YS = 4194304, O_GAK = 12582912, O_GAV = 13631488, O_NAK = 14680064, O_NAV = 16777216, O_SSM = 18874368;
constexpr int LDS_BYTES = 147456;

__device__ __forceinline__ unsigned cvtpk(float lo, float hi) { f32x2_t v = {lo, hi}; bf16x2_t b = __builtin_convertvector(v, bf16x2_t); return __builtin_bit_cast(unsigned, b); }
__device__ __forceinline__ float bf2f(unsigned b) { return __uint_as_float(b << 16); }
__device__ __forceinline__ float sigmoidf_(float v) { return __builtin_amdgcn_rcpf(1.0f + __expf(-v)); }
__device__ __forceinline__ float gelu_tanh_(float v) { const float z = 1.5957691216057308f * (v + 0.044715f * v * v * v); return v * __builtin_amdgcn_rcpf(1.0f + __expf(-z)); }
template <int K> __device__ __forceinline__ float xor_shfl(float v) {
    return __uint_as_float((unsigned)__builtin_amdgcn_ds_swizzle((int)__float_as_uint(v), (K << 10) | 0x1F));
}
__device__ __forceinline__ float sum_xor32(float v) { auto rr = __builtin_amdgcn_permlane32_swap(__float_as_uint(v), __float_as_uint(v), false, false); return __uint_as_float(rr[0]) + __uint_as_float(rr[1]); }
__device__ __forceinline__ float wave_sum(float v) {
    v += xor_shfl<1>(v); v += xor_shfl<2>(v); v += xor_shfl<4>(v); v += xor_shfl<8>(v); v += xor_shfl<16>(v);
    return sum_xor32(v);
}
__device__ __forceinline__ int crow(int r, int hi) { return (r & 3) + 8 * (r >> 2) + 4 * hi; }
__device__ __forceinline__ int clampi(int v, int lo, int hi) { return v < lo ? lo : (v > hi ? hi : v); }
#define FRESH_LANE() ({ int l__; asm volatile("v_mbcnt_lo_u32_b32 %0, -1, 0\n\tv_mbcnt_hi_u32_b32 %0, -1, %0" : "=v"(l__)); l__; })
#ifndef DBG_SSM
#define DBG_SSM 1.0f
#endif
#ifndef DBG_GAK
#define DBG_GAK 1.0f
#endif
#ifndef DBG_GAV
#define DBG_GAV 1.0f
#endif
#define VM_WAIT0() asm volatile("s_waitcnt vmcnt(0)" ::: "memory")

#define XB_TMO      128
#define XB_XCNT(j)  (256  + 64 * (j))
#define XB_XSUB(j)  (1280 + 64 * (j))
#define XB_XGEN(j)  (2304 + 64 * (j))
#define XB_TOP      3328
#define XB_TOPGEN   3392
#define XCD_BAR_WORDS 3456
#define XB_SPIN_CAP (1u << 18)

__device__ __forceinline__ unsigned xb_ld(unsigned* p)              { return __hip_atomic_load(p, __ATOMIC_RELAXED, __HIP_MEMORY_SCOPE_AGENT); }
__device__ __forceinline__ unsigned xb_add(unsigned* p, unsigned v) { return __hip_atomic_fetch_add(p, v, __ATOMIC_RELAXED, __HIP_MEMORY_SCOPE_AGENT); }
__device__ __forceinline__ unsigned xb_xcc_id() { return (unsigned)__builtin_amdgcn_s_getreg((3 << 11) | 20) & 0xFu; }
#define XB_SPIN(cond, bar) do { unsigned _sp = 0; while (cond) { __builtin_amdgcn_s_sleep(1); \
    if ((++_sp & 255u) == 0u) { if (xb_ld(&(bar)[XB_TMO])) break; if (_sp > XB_SPIN_CAP) { atomicAdd(&(bar)[XB_TMO], 1u); break; } } } } while (0)

struct XcdBarrier {
    unsigned* bar; unsigned x;
    volatile LAS unsigned* st;
};

__device__ __forceinline__ XcdBarrier xcd_barrier_post(unsigned* bar, volatile LAS unsigned* st) {
    XcdBarrier b; b.bar = bar; b.x = xb_xcc_id(); b.st = st;
    if (threadIdx.x == 0) (void)xb_add(&bar[XB_XCNT(b.x)], 1u);
    return b;
}
__device__ __forceinline__ void xcd_barrier_complete(unsigned* bar, unsigned x, unsigned& nloc, unsigned& nx) {
    const unsigned G = gridDim.x * gridDim.y * gridDim.z;
    unsigned sum, cnt, mine, sp = 0u;
    for (;;) {
        sum = 0u; cnt = 0u; mine = 0u;
#pragma unroll
        for (unsigned j = 0; j < 16; ++j) { const unsigned c = xb_ld(&bar[XB_XCNT(j)]); sum += c; cnt += (c > 0u) ? 1u : 0u; mine = (j == x) ? c : mine; }
        if (sum == G) break;
        __builtin_amdgcn_s_sleep(1);
        if ((++sp & 255u) == 0u) { if (xb_ld(&bar[XB_TMO])) break; if (sp > XB_SPIN_CAP) { atomicAdd(&bar[XB_TMO], 1u); break; } }
    }
    nloc = mine > 0u ? mine : 1u; nx = cnt > 0u ? cnt : 1u;
}

__device__ __forceinline__ void xcd_barrier(const XcdBarrier& b) {
    asm volatile("s_waitcnt vmcnt(0)" ::: "memory");
    __syncthreads();
    if (threadIdx.x == 0) {
        unsigned* bar = b.bar;
        __builtin_amdgcn_s_waitcnt(0);
        unsigned nloc = b.st[0], nx = b.st[1];
        if (nloc == 0u) { xcd_barrier_complete(bar, b.x, nloc, nx); b.st[0] = nloc; b.st[1] = nx; }
        const unsigned old = xb_add(&bar[XB_XSUB(b.x)], 1u);
        const unsigned gen = old / nloc;
        if (old + 1u == (gen + 1u) * nloc) {
            __builtin_amdgcn_fence(__ATOMIC_RELEASE, "agent");
            asm volatile("s_waitcnt vmcnt(0)" ::: "memory");
            const unsigned og = xb_add(&bar[XB_TOP], 1u);
            const unsigned tg = og / nx;
            if (og + 1u == (tg + 1u) * nx) xb_add(&bar[XB_TOPGEN], 1u);
            else XB_SPIN(xb_ld(&bar[XB_TOPGEN]) == tg, bar);
            __builtin_amdgcn_fence(__ATOMIC_ACQUIRE, "agent");
            xb_add(&bar[XB_XGEN(b.x)], 1u);
            asm volatile("s_waitcnt vmcnt(0)" ::: "memory");
        } else {
            XB_SPIN(xb_ld(&bar[XB_XGEN(b.x)]) == gen, bar);
            __builtin_amdgcn_fence(__ATOMIC_ACQUIRE, "agent");
            asm volatile("s_waitcnt vmcnt(0)" ::: "memory");
        }
    }
    __syncthreads();
}
using pg8::Unit;
struct EpiIn {
    static constexpr bool PERM = true, AFTER_DRAIN = false;
    unsigned char* ws; float* out; int layer;
    __device__ __forceinline__ void operator()(const f32x4 (&acc)[2][2][4][2], const Unit& u, int wr, int wc, int fr_, int fq_) const {
        const int ln_ = FRESH_LANE(), fr = ln_ & 15, fq = ln_ >> 4;
        const int pn = u.pn; const bool ctx = u.pm < 16;
        const int rb = u.pm * 256 + wr * 64 + fr;
        if (pn >= 7) {
#pragma unroll
            for (int ai = 0; ai < 2; ++ai)
#pragma unroll
                for (int m = 0; m < 4; ++m) {
                    const int row = rb + ai * 128 + m * 16;
                    bf16* gp = (bf16*)(ws + WS_GATES) + (size_t)row * 3072 + (pn - 7) * 256 + 64 * wc + 8 * fq;
#pragma unroll
                    for (int bj = 0; bj < 2; ++bj) { const f32x4 v0 = acc[ai][bj][m][0], v1 = acc[ai][bj][m][1];
                        *(u32x4*)(gp + 32 * bj) = (u32x4){cvtpk(sigmoidf_(v0[0]), sigmoidf_(v0[1])), cvtpk(sigmoidf_(v0[2]), sigmoidf_(v0[3])), cvtpk(sigmoidf_(v1[0]), sigmoidf_(v1[1])), cvtpk(sigmoidf_(v1[2]), sigmoidf_(v1[3]))}; }
                }
        } else if (pn == 3) {
#pragma unroll
            for (int ai = 0; ai < 2; ++ai)
#pragma unroll
                for (int m = 0; m < 4; ++m) {
                    const int row = rb + ai * 128 + m * 16;
                    float* up = (float*)(ws + WS_U) + (size_t)row * 256 + 64 * wc + 4 * fq;
#pragma unroll
                    for (int bj = 0; bj < 2; ++bj)
#pragma unroll
                        for (int n = 0; n < 2; ++n) *(f32x4*)(up + 32 * bj + 16 * n) = acc[ai][bj][m][n];
                }
        } else if (pn >= 4) {
            bf16* base = (bf16*)(ws + (pn == 4 ? WS_QC : (pn == 5 ? WS_KC : WS_VC)));
            const float sc = pn == 4 ? C2 : 1.0f;
            float* ob = out + (pn == 5 ? O_NAK : O_NAV);
            const int e0 = 32 * (fq >> 1) + 8 * (fq & 1);
#pragma unroll
            for (int ai = 0; ai < 2; ++ai)
#pragma unroll
                for (int m = 0; m < 4; ++m) {
                    const int row = rb + ai * 128 + m * 16;
                    int b, t; size_t hrow;
                    if (ctx) { b = row >> 8; t = row & 255; hrow = (size_t)(b * 4 + wc) * 256 + t; } else { const int r2 = row - 4096; b = r2 >> 11; t = r2 & 2047; hrow = (size_t)4096 * 4 + (size_t)(b * 4 + wc) * 2048 + t; }
                    bf16* dp = base + hrow * 64 + e0;
#pragma unroll
                    for (int bj = 0; bj < 2; ++bj) { const f32x4 v0 = acc[ai][bj][m][0] * sc, v1 = acc[ai][bj][m][1] * sc;
                        *(u32x4*)(dp + 16 * bj) = (u32x4){cvtpk(v0[0], v0[1]), cvtpk(v0[2], v0[3]), cvtpk(v1[0], v1[1]), cvtpk(v1[2], v1[3])}; }
                    if (ctx && pn >= 5) { float* op = ob + ((size_t)(b * 2 + layer) * 256 + t) * 256 + wc * 64 + e0;
#pragma unroll
                        for (int bj = 0; bj < 2; ++bj)
#pragma unroll
                            for (int n = 0; n < 2; ++n) *(f32x4*)(op + 16 * bj + 4 * n) = acc[ai][bj][m][n]; }
                    asm volatile("" ::: "memory");
                }
        } else {
            const bool isQ = pn < 2, isV = (pn == 2 && wc >= 2);
            const int h = isQ ? 4 * pn + wc : (wc & 1);
            const int hh = fq >> 1, e0 = 32 * hh + 8 * (fq & 1);
            const float* gsrc = (const float*)(ws + WS_QKG) + (layer * 2 + (isQ ? 0 : 1)) * 64 + e0;
            f32x4 gg[2][2];
#pragma unroll
            for (int bj = 0; bj < 2; ++bj)
#pragma unroll
                for (int n = 0; n < 2; ++n) gg[bj][n] = *(const f32x4*)(gsrc + 16 * bj + 4 * n);
            bf16* base = (bf16*)(ws + (isQ ? WS_QA : (isV ? WS_VA : WS_KA)));
            const int nh = isQ ? 8 : 2;
            float* ob = out + (isV ? O_GAV : O_GAK);
#pragma unroll
            for (int ai = 0; ai < 2; ++ai)
#pragma unroll
                for (int m = 0; m < 4; ++m) {
                    const int row = rb + ai * 128 + m * 16;
                    f32x4 v[2][2];
#pragma unroll
                    for (int bj = 0; bj < 2; ++bj)
#pragma unroll
                        for (int n = 0; n < 2; ++n) v[bj][n] = acc[ai][bj][m][n];
                    if (!isV) {
                        float ss = 0.f;
#pragma unroll
                        for (int bj = 0; bj < 2; ++bj)
#pragma unroll
                            for (int n = 0; n < 2; ++n) ss += (v[bj][n][0] * v[bj][n][0] + v[bj][n][1] * v[bj][n][1]) + (v[bj][n][2] * v[bj][n][2] + v[bj][n][3] * v[bj][n][3]);
                        ss += xor_shfl<16>(ss); ss = sum_xor32(ss);
                        const float rstd = rsqrtf(ss * (1.0f / 64.0f) + EPS);
#pragma unroll
                        for (int bj = 0; bj < 2; ++bj)
#pragma unroll
                            for (int n = 0; n < 2; ++n) v[bj][n] = v[bj][n] * rstd * gg[bj][n];
                    }
                    int b, t; size_t hrow;
                    if (ctx) { b = row >> 8; t = row & 255; hrow = (size_t)(b * nh + h) * 256 + t; }
                    else {
                        const int r2 = row - 4096; b = r2 >> 11; t = r2 & 2047; hrow = (size_t)4096 * nh + (size_t)(b * nh + h) * 2048 + t;
                        if (!isV) {
                            const int pos = hh ? (t & 63) : (t >> 6);
#pragma unroll
                            for (int n = 0; n < 2; ++n) {
                                const float* tp = (const float*)(ws + WS_ROPE) + (pos * 16 + 8 * (fq & 1) + 4 * n) * 2;
                                const f32x4 c01 = *(const f32x4*)tp, c23 = *(const f32x4*)(tp + 4);
                                const f32x4 cs = {c01[0], c01[2], c23[0], c23[2]}, sn = {c01[1], c01[3], c23[1], c23[3]};
                                const f32x4 x1 = v[0][n], x2 = v[1][n];
                                v[0][n] = x1 * cs - x2 * sn; v[1][n] = x2 * cs + x1 * sn;
                            }
                        }
                    }
                    if (ctx && !isQ) { float* op = ob + ((size_t)(b * 2 + layer) * 256 + t) * 128 + h * 64 + e0;
#pragma unroll
                        for (int bj = 0; bj < 2; ++bj)
#pragma unroll
                            for (int n = 0; n < 2; ++n) *(f32x4*)(op + 16 * bj + 4 * n) = v[bj][n]; }
                    const float sc = isQ ? C2 : 1.0f;
                    bf16* dp = base + hrow * 64 + e0;
#pragma unroll
                    for (int bj = 0; bj < 2; ++bj) { const f32x4 x0 = v[bj][0] * sc, x1 = v[bj][1] * sc;
                        *(u32x4*)(dp + 16 * bj) = (u32x4){cvtpk(x0[0], x0[1]), cvtpk(x0[2], x0[3]), cvtpk(x1[0], x1[1]), cvtpk(x1[2], x1[3])}; }
                    asm volatile("" ::: "memory");
                }
        }
    }
};

struct EpiRes {
    static constexpr bool PERM = false, AFTER_DRAIN = false;
    const float* xc; const float* xl; float* xo; const float* mod;
    __device__ __forceinline__ void operator()(const f32x4 (&acc)[2][2][4][2], const Unit& u, int wr, int wc, int fr_, int fq_) const {
        const int ln_ = FRESH_LANE(), fr = ln_ & 15, fq = ln_ >> 4;
        const int cv = u.pm < 16 ? 0 : 1 + ((u.pm - 16) >> 3);
        const int col0 = u.pn * 256 + wc * 32 + 4 * fq;
        f32x4 gv[2][2];
#pragma unroll
        for (int bj = 0; bj < 2; ++bj)
#pragma unroll
            for (int n = 0; n < 2; ++n) gv[bj][n] = *(const f32x4*)(mod + cv * 6144 + col0 + bj * 128 + n * 16);
#pragma unroll
        for (int ai = 0; ai < 2; ++ai)
#pragma unroll
            for (int m = 0; m < 4; ++m) {
                const int row = u.pm * 256 + ai * 128 + wr * 64 + m * 16 + fr;
                const float* xs = row < 4096 ? xc + (size_t)row * 1024 : xl + (size_t)(row - 4096) * 1024;
                float* xd = xo + (size_t)row * 1024;
#pragma unroll
                for (int bj = 0; bj < 2; ++bj)
#pragma unroll
                    for (int n = 0; n < 2; ++n) { const int c = col0 + bj * 128 + n * 16; const f32x4 xv = *(const f32x4*)(xs + c); *(f32x4*)(xd + c) = xv + gv[bj][n] * acc[ai][bj][m][n]; }
                asm volatile("" ::: "memory");
            }
    }
};

struct EpiSwiglu {
    static constexpr bool PERM = true, AFTER_DRAIN = false;
    bf16* ACT;
    __device__ __forceinline__ void operator()(const f32x4 (&acc)[2][2][4][2], const Unit& u, int wr, int wc, int fr_, int fq_) const {
        const int ln_ = FRESH_LANE(), fr = ln_ & 15, fq = ln_ >> 4;
#pragma unroll
        for (int ai = 0; ai < 2; ++ai)
#pragma unroll
            for (int m = 0; m < 4; ++m) {
                const int row = u.pm * 256 + ai * 128 + wr * 64 + m * 16 + fr;
                bf16* ap = ACT + (size_t)row * DFF + u.pn * 128 + wc * 32 + 8 * fq;
                unsigned w[4];
#pragma unroll
                for (int n = 0; n < 2; ++n) { const f32x4 g = acc[ai][0][m][n], up = acc[ai][1][m][n]; f32x4 r;
#pragma unroll
                    for (int i = 0; i < 4; ++i) r[i] = g[i] * sigmoidf_(g[i]) * up[i];
                    w[2 * n] = cvtpk(r[0], r[1]); w[2 * n + 1] = cvtpk(r[2], r[3]); }
                *(u32x4*)ap = (u32x4){w[0], w[1], w[2], w[3]};
                asm volatile("" ::: "memory");
            }
    }
};

struct EpiGlu {
    static constexpr bool PERM = false, AFTER_DRAIN = false;
    bf16* OB;
    __device__ __forceinline__ void operator()(const f32x4 (&acc)[2][2][4][2], const Unit& u, int wr, int wc, int fr_, int fq_) const {
        const int ln_ = FRESH_LANE(), fr = ln_ & 15, fq = ln_ >> 4;
#pragma unroll
        for (int ai = 0; ai < 2; ++ai)
#pragma unroll
            for (int m = 0; m < 4; ++m) {
                const int row = u.pm * 256 + ai * 128 + wr * 64 + m * 16 + fr;
                bf16* p = OB + (size_t)row * 256 + wc * 32 + 4 * fq;
#pragma unroll
                for (int bj = 0; bj < 2; ++bj)
#pragma unroll
                    for (int n = 0; n < 2; ++n) { bf16* q = p + bj * 128 + n * 16; const u32x2 yv = *(const u32x2*)q; const f32x4 a = acc[ai][bj][m][n];
                        const float y0 = bf2f(yv.x & 0xffffu), y1 = bf2f(yv.x >> 16), y2 = bf2f(yv.y & 0xffffu), y3 = bf2f(yv.y >> 16);
                        u32x2 w; w.x = cvtpk(y0 * sigmoidf_(a[0]), y1 * sigmoidf_(a[1])); w.y = cvtpk(y2 * sigmoidf_(a[2]), y3 * sigmoidf_(a[3])); *(u32x2*)q = w; }
                asm volatile("" ::: "memory");
            }
    }
};

template <int MODE> struct EpiBr {
    static constexpr bool PERM = true, AFTER_DRAIN = false;
    const bf16* G; bf16* MF; bf16* MG;
    __device__ __forceinline__ void operator()(const f32x4 (&acc)[2][2][4][2], const Unit& u, int wr, int wc, int fr_, int fq_) const {
        const int ln_ = FRESH_LANE(), fr = ln_ & 15, fq = ln_ >> 4;
        const int col0 = u.pn * 256 + wc * 32 + 8 * fq;
#pragma unroll
        for (int ai = 0; ai < 2; ++ai)
#pragma unroll
            for (int m = 0; m < 4; ++m) {
                const int row = u.pm * 256 + ai * 128 + wr * 64 + m * 16 + fr;
#pragma unroll
                for (int bj = 0; bj < 2; ++bj) { const int c = col0 + bj * 128; const u32x4 gv = *(const u32x4*)(G + (size_t)row * 3072 + c); const f32x4 a0 = acc[ai][bj][m][0], a1 = acc[ai][bj][m][1];
                    float r[8] = {bf2f(gv.x & 0xffffu) * a0[0], bf2f(gv.x >> 16) * a0[1], bf2f(gv.y & 0xffffu) * a0[2], bf2f(gv.y >> 16) * a0[3], bf2f(gv.z & 0xffffu) * a1[0], bf2f(gv.z >> 16) * a1[1], bf2f(gv.w & 0xffffu) * a1[2], bf2f(gv.w >> 16) * a1[3]};
                    bf16* mp = MF + (size_t)row * 1024 + c;
                    if (MODE >= 1) { const u32x4 mv = *(const u32x4*)mp; r[0] += bf2f(mv.x & 0xffffu); r[1] += bf2f(mv.x >> 16); r[2] += bf2f(mv.y & 0xffffu); r[3] += bf2f(mv.y >> 16); r[4] += bf2f(mv.z & 0xffffu); r[5] += bf2f(mv.z >> 16); r[6] += bf2f(mv.w & 0xffffu); r[7] += bf2f(mv.w >> 16); }
                    *(u32x4*)((MODE <= 1 ? mp : MG + (size_t)row * 1024 + c)) = (u32x4){cvtpk(r[0], r[1]), cvtpk(r[2], r[3]), cvtpk(r[4], r[5]), cvtpk(r[6], r[7])}; }
                asm volatile("" ::: "memory");
            }
    }
};

constexpr int BM = 256, HALF = 128;
struct PanelStats {
    unsigned* xbuf;
    unsigned* cnt;
    unsigned* tmo;
    int ntn; float eps;
    unsigned code;
    __device__ __forceinline__ bool run(const f32x4 (&v)[2][2][4][2], const Unit& u, int wr, int wc, int fr, int fq, LAS unsigned char* lds, int wid, int lane) const {
        typedef float f32x2v __attribute__((ext_vector_type(2)));
        LAS f32x2v* P = (LAS f32x2v*)lds;
        LAS f32x2v* S = (LAS f32x2v*)(lds + 8192);
        LAS unsigned* flag = (LAS unsigned*)(lds + 8192 + 2048);
#pragma unroll
        for (int ai = 0; ai < 2; ++ai)
#pragma unroll
            for (int m = 0; m < 4; ++m) {
                float s = 0.f;
#pragma unroll
                for (int bj = 0; bj < 2; ++bj)
#pragma unroll
                    for (int n = 0; n < 2; ++n) { const f32x4 x = v[ai][bj][m][n]; s += (x[0] + x[1]) + (x[2] + x[3]); }
                s += xor_shfl<16>(s); s = sum_xor32(s);
                const float mw = s * (1.0f / 64.0f); float q = 0.f;
#pragma unroll
                for (int bj = 0; bj < 2; ++bj)
#pragma unroll
                    for (int n = 0; n < 2; ++n) { const f32x4 d = v[ai][bj][m][n] - mw; q += (d[0] * d[0] + d[1] * d[1]) + (d[2] * d[2] + d[3] * d[3]); }
                q += xor_shfl<16>(q); q = sum_xor32(q);
                if (fq == 0) P[(ai * HALF + wr * 64 + m * 16 + fr) * 4 + wc] = (f32x2v){mw, q};
            }
        asm volatile("s_waitcnt lgkmcnt(0)" ::: "memory"); __builtin_amdgcn_s_barrier(); asm volatile("" ::: "memory");
#if defined(BROKEN_EXCHANGE_NO_WAIT)
#warning BROKEN CONTROL BUILD: the row-statistics exchange does not wait; results are wrong by design
        if (blockIdx.x >= 64) { const long long t0_ = clock64(); while (clock64() - t0_ < 60000) __builtin_amdgcn_s_sleep(8); }
#endif
        const int row = wid * 32 + (lane & 31);
        if (lane < 32) {
            const f32x2v a = P[row * 4 + 0], b = P[row * 4 + 1], c = P[row * 4 + 2], d = P[row * 4 + 3];
            const float mt = (a.x + b.x + c.x + d.x) * 0.25f;
            const float da = a.x - mt, db = b.x - mt, dc = c.x - mt, dd = d.x - mt;
            const float m2 = (a.y + b.y) + (c.y + d.y) + 64.0f * ((da * da + db * db) + (dc * dc + dd * dd));
            unsigned long long* slot = (unsigned long long*)xbuf + ((size_t)(u.pm * BM + row) * 4 + u.pn);
            __hip_atomic_store(slot, ((unsigned long long)__float_as_uint(m2) << 32) | __float_as_uint(mt), __ATOMIC_RELAXED, __HIP_MEMORY_SCOPE_AGENT);
        }
        asm volatile("s_waitcnt vmcnt(0)" ::: "memory");
        if (lane == 0) __hip_atomic_fetch_add(cnt + 64 * u.pm, 1u, __ATOMIC_RELAXED, __HIP_MEMORY_SCOPE_AGENT);
        if (wid == 0) {
            const unsigned want = 8u * (unsigned)ntn; unsigned sp_ = 0u;
            while ((unsigned)__builtin_amdgcn_readfirstlane(__hip_atomic_load(cnt + 64 * u.pm, __ATOMIC_RELAXED, __HIP_MEMORY_SCOPE_AGENT)) < want) { __builtin_amdgcn_s_sleep(2); if (++sp_ > (1u << 22)) break; }
            __builtin_amdgcn_fence(__ATOMIC_ACQUIRE, "agent");
        }
        asm volatile("s_waitcnt vmcnt(0) lgkmcnt(0)" ::: "memory"); __builtin_amdgcn_s_barrier(); asm volatile("" ::: "memory");
        const bool bad = false;
        if (lane < 32) {
            const unsigned long long* slot = (const unsigned long long*)xbuf + (size_t)(u.pm * BM + row) * 4; float mt[4], m2[4]; float ms = 0.f;
#pragma unroll
            for (int t = 0; t < 4; ++t) { if (t < ntn) { const unsigned long long w = __hip_atomic_load(slot + t, __ATOMIC_RELAXED, __HIP_MEMORY_SCOPE_AGENT); mt[t] = __uint_as_float((unsigned)w); m2[t] = __uint_as_float((unsigned)(w >> 32)); } else { mt[t] = 0.f; m2[t] = 0.f; } ms += mt[t]; }
            const float mean = ms / (float)ntn; float q = 0.f;
#pragma unroll
            for (int t = 0; t < 4; ++t) if (t < ntn) { const float dm = mt[t] - mean; q += m2[t] + 256.0f * dm * dm; }
            S[row] = (f32x2v){mean, 1.0f / sqrtf(q / (256.0f * (float)ntn) + mean * mean + eps)};
        }
        asm volatile("s_waitcnt lgkmcnt(0)" ::: "memory"); __builtin_amdgcn_s_barrier(); asm volatile("" ::: "memory");
        return bad;
    }
};
template <int final_> struct EpiResNorm {
    static constexpr bool PERM = true, AFTER_DRAIN = true;
    const float* xc; const float* xl; float* xo; const float* gate; const float* ng; const float* nmod; int sh_off, sc_off; bf16* H; PanelStats st;
    __device__ __forceinline__ void fused(f32x4 (&acc)[2][2][4][2], const Unit& u, int wr, int wc, int fr_, int fq_, LAS unsigned char* lds, int wid, int lane_) const {
        const int lane = FRESH_LANE(), fr = lane & 15, fq = lane >> 4;
        typedef float f32x2v __attribute__((ext_vector_type(2)));
        const LAS f32x2v* S = (const LAS f32x2v*)(lds + 8192);
        const int cv = u.pm < 16 ? 0 : 1 + ((u.pm - 16) >> 3);
        const int col0 = u.pn * 256 + wc * 32 + 8 * fq;
#pragma unroll
        for (int ai = 0; ai < 2; ++ai)
#pragma unroll
            for (int m = 0; m < 4; ++m) {
                const int row = u.pm * 256 + ai * 128 + wr * 64 + m * 16 + fr;
                const float* xs = row < 4096 ? xc + (size_t)row * 1024 : xl + (size_t)(row - 4096) * 1024;
#pragma unroll
                for (int bj = 0; bj < 2; ++bj)
#pragma unroll
                    for (int n = 0; n < 2; ++n) { const int c = col0 + bj * 128 + n * 4; const f32x4 gv = *(const f32x4*)(gate + cv * 6144 + c); const f32x4 xv = *(const f32x4*)(xs + c);
                        acc[ai][bj][m][n] = xv + gv * acc[ai][bj][m][n]; if (!final_) *(f32x4*)(xo + (size_t)row * 1024 + c) = acc[ai][bj][m][n]; }
                asm volatile("" : "+v"(acc[ai][0][m][0]), "+v"(acc[ai][0][m][1]), "+v"(acc[ai][1][m][0]), "+v"(acc[ai][1][m][1]));
                asm volatile("" ::: "memory");
            }
        (void)st.run(acc, u, wr, wc, fr, fq, lds, wid, lane);
#pragma unroll
        for (int ai = 0; ai < 2; ++ai)
#pragma unroll
            for (int m = 0; m < 4; ++m) {
                const int r = ai * 128 + wr * 64 + m * 16 + fr; const int row = u.pm * 256 + r; const float rstd = S[r].y;
#pragma unroll
                for (int bj = 0; bj < 2; ++bj) { unsigned w[4];
#pragma unroll
                    for (int n = 0; n < 2; ++n) { const int c = col0 + bj * 128 + n * 4; const f32x4 v = acc[ai][bj][m][n] * rstd * *(const f32x4*)(ng + c);
                        if (final_) *(f32x4*)(xo + (size_t)row * 1024 + c) = v;
                        else { const f32x4 sc = *(const f32x4*)(nmod + cv * 6144 + sc_off + c), sh = *(const f32x4*)(nmod + cv * 6144 + sh_off + c); const f32x4 o = v * (sc + 1.0f) + sh;
                               w[2 * n] = cvtpk(o[0], o[1]); w[2 * n + 1] = cvtpk(o[2], o[3]); } }
                    if (!final_) *(u32x4*)(H + (size_t)row * 1024 + col0 + bj * 128) = (u32x4){w[0], w[1], w[2], w[3]}; }
                asm volatile("" ::: "memory");
            }
    }
};

namespace att {
constexpr int SLOTB = 8192, LDS_K = 0, LDS_V = 24576, LDS_WS = 49152, LDS_OST = 51200, LDS_BIAS = 83968;
constexpr float THR = 8.0f;
#define SBAR() __builtin_amdgcn_sched_barrier(0)
__device__ __forceinline__ void glds16(const void* gsrc, unsigned lds_dst) { unsigned keep;
    asm volatile("s_mov_b32 %0, m0\n\ts_mov_b32 m0, %2\n\ts_nop 0\n\tglobal_load_lds_dwordx4 %1, off\n\ts_mov_b32 m0, %0" : "=&s"(keep) : "v"(gsrc), "s"(lds_dst) : "memory"); }
#define WAIT_BAR0() asm volatile("s_waitcnt vmcnt(0) lgkmcnt(0)\n\ts_barrier" ::: "memory")
#define WAIT_BAR2() asm volatile("s_waitcnt vmcnt(2) lgkmcnt(0)\n\ts_barrier" ::: "memory")
typedef LAS const char* lds_cptr;
__device__ __forceinline__ void qkt(f32x16& p0, f32x16& p1, lds_cptr kb, const bf16x8* qr, const f32x16& negm) {
#pragma unroll
    for (int d0 = 0; d0 < 4; ++d0) {
        const bf16x8 b0 = *(const LAS bf16x8*)(kb + d0 * 2048);
        const bf16x8 b1 = *(const LAS bf16x8*)(kb + d0 * 2048 + 512);
        if (d0 == 0) { p0 = __builtin_amdgcn_mfma_f32_32x32x16_bf16(b0, qr[0], negm, 0, 0, 0); p1 = __builtin_amdgcn_mfma_f32_32x32x16_bf16(b1, qr[0], negm, 0, 0, 0); }
        else { p0 = __builtin_amdgcn_mfma_f32_32x32x16_bf16(b0, qr[d0], p0, 0, 0, 0); p1 = __builtin_amdgcn_mfma_f32_32x32x16_bf16(b1, qr[d0], p1, 0, 0, 0); }
    }
}
__device__ __forceinline__ float rowmax(const f32x16& p0, const f32x16& p1) {
    float a = fmaxf(fmaxf(p0[0], p0[1]), p1[0]), b = fmaxf(fmaxf(p0[2], p0[3]), p1[1]); a = fmaxf(fmaxf(a, p1[2]), p1[3]);
#pragma unroll
    for (int r = 4; r < 16; r += 4) { a = fmaxf(fmaxf(a, p0[r]), p0[r + 1]); b = fmaxf(fmaxf(b, p0[r + 2]), p0[r + 3]); a = fmaxf(fmaxf(a, p1[r]), p1[r + 1]); b = fmaxf(fmaxf(b, p1[r + 2]), p1[r + 3]); }
    const float m = fmaxf(a, b);
    auto rr = __builtin_amdgcn_permlane32_swap(__float_as_uint(m), __float_as_uint(m), false, false);
    return fmaxf(__uint_as_float(rr[0]), __uint_as_float(rr[1]));
}
__device__ __forceinline__ void pv(f32x16* o, int vb, bf16x8 pa0, bf16x8 pa1, bf16x8 pa2, bf16x8 pa3) {
#pragma unroll
    for (int d0 = 0; d0 < 2; ++d0) { s16x4 lo[4], hi[4];
#pragma unroll
        for (int ks = 0; ks < 4; ++ks) {
            asm volatile("ds_read_b64_tr_b16 %0,%1 offset:%c2" : "=&v"(lo[ks]) : "v"(vb), "i"(d0 * 4096 + ks * 1024) : "memory");
            asm volatile("ds_read_b64_tr_b16 %0,%1 offset:%c2" : "=&v"(hi[ks]) : "v"(vb), "i"(d0 * 4096 + ks * 1024 + 512) : "memory"); }
        asm volatile("s_waitcnt lgkmcnt(0)" ::: "memory"); SBAR();
#define PK(k) (bf16x8){lo[k][0], lo[k][1], lo[k][2], lo[k][3], hi[k][0], hi[k][1], hi[k][2], hi[k][3]}
        o[d0] = __builtin_amdgcn_mfma_f32_32x32x16_bf16(pa0, PK(0), o[d0], 0, 0, 0);
        o[d0] = __builtin_amdgcn_mfma_f32_32x32x16_bf16(pa1, PK(1), o[d0], 0, 0, 0);
        o[d0] = __builtin_amdgcn_mfma_f32_32x32x16_bf16(pa2, PK(2), o[d0], 0, 0, 0);
        o[d0] = __builtin_amdgcn_mfma_f32_32x32x16_bf16(pa3, PK(3), o[d0], 0, 0, 0);
#undef PK
    }
}
template <bool NA>
__device__ __forceinline__ void attn_unit(const bf16* Qw, const bf16* Kc, const bf16* Vc, const bf16* Kl, const bf16* Vl, int NT,
                                          bf16* Ow, int opitch, char* shm, int qrow, int rlo, const float* biasg, const int wid) {
    const int lane = FRESH_LANE(), tid = wid * 64 + lane, r32 = lane & 31, hi = lane >> 5;
    const unsigned lds0 = (unsigned)(uintptr_t)shm;
    const lds_cptr shm3 = (lds_cptr)shm;
    LAS float* wsf = (LAS float*)(shm3 + LDS_WS) + wid * 64;
    LAS float* bias_s = (LAS float*)(shm3 + LDS_BIAS);
    if (NA) { if (tid < 465) bias_s[tid] = biasg[tid] * LOG2E; }
    const int koff = lane * 64 + wid * 8;
    const int voff = (16 * (wid & 3) + (lane >> 2)) * 64 + (wid >> 2) * 32 + (lane & 3) * 8;
    const unsigned kdst = lds0 + LDS_K + wid * 1024, vdst = lds0 + LDS_V + wid * 1024;
#define ATT_DMA(t, slot) do { const bf16* kt_ = (t) < 4 ? Kc + (t) * 4096 : Kl + ((t) - 4) * 4096; const bf16* vt_ = (t) < 4 ? Vc + (t) * 4096 : Vl + ((t) - 4) * 4096; \
        glds16(kt_ + koff, (unsigned)__builtin_amdgcn_readfirstlane(kdst + (slot))); glds16(vt_ + voff, (unsigned)__builtin_amdgcn_readfirstlane(vdst + (slot))); } while (0)
    ATT_DMA(0, 0); ATT_DMA(1, SLOTB);
    bf16x8 qr[4];
#pragma unroll
    for (int d0 = 0; d0 < 4; ++d0) qr[d0] = *(const bf16x8*)(Qw + (size_t)r32 * 64 + d0 * 16 + hi * 8);
    float mhat = 0.f, l_reg = 0.f; f32x16 o[2]; o[0] = f32x16{}; o[1] = f32x16{}; f32x16 negm = f32x16{};
    const lds_cptr kp0 = shm3 + LDS_K + hi * 1024 + r32 * 16;
    const int vb0 = (int)(lds0 + LDS_V) + ((lane >> 4) & 1) * 32 + (lane & 3) * 8 + (4 * hi + ((lane & 15) >> 2)) * 64;
    const int qc = (wid & 1) * 32 + r32, cs = clampi(qc - 8, 0, 48), rs = clampi(qrow - 4, 0, 24);
    int slot = 0, s_nxt = SLOTB, s_nn = 2 * SLOTB;
    for (int t = 0; t < NT; ++t) {
        if (t == 0 || t + 1 >= NT) WAIT_BAR0(); else WAIT_BAR2();
        if (t + 2 < NT) ATT_DMA(t + 2, s_nn);
        f32x16 p0, p1;
        qkt(p0, p1, kp0 + slot, qr, negm);
        if (NA && t >= 4) {
            const int kr = rlo + t - 4;
            if (kr < rs || kr >= rs + 8) {
#pragma unroll
                for (int r = 0; r < 16; ++r) { p0[r] = -INFINITY; p1[r] = -INFINITY; }
            } else {
                const LAS float* brow = bias_s + (kr - qrow + 7) * 31;
#pragma unroll
                for (int r = 0; r < 16; ++r) {
                    const int kc = crow(r, hi);
                    const int i0 = clampi(kc - qc + 15, 0, 30), i1 = clampi(kc + 32 - qc + 15, 0, 30);
                    const float b0 = brow[i0], b1 = brow[i1];
                    p0[r] = ((unsigned)(kc - cs) < 16u) ? p0[r] + b0 : -INFINITY;
                    p1[r] = ((unsigned)(kc + 32 - cs) < 16u) ? p1[r] + b1 : -INFINITY;
                }
            }
        }
        const float rm = rowmax(p0, p1);
        if (t == 0 || __any(rm > THR)) {
            const float dl = (t == 0) ? rm : fmaxf(rm, 0.f);
            mhat += dl;
#pragma unroll
            for (int r = 0; r < 16; ++r) { p0[r] -= dl; p1[r] -= dl; negm[r] = -mhat; }
            if (t > 0) {
                const float f = __builtin_amdgcn_exp2f(-dl); l_reg *= f;
                if (hi == 0) wsf[r32] = f;
                asm volatile("s_waitcnt lgkmcnt(0)" ::: "memory");
#pragma unroll
                for (int r = 0; r < 16; ++r) { const float fr_ = wsf[crow(r, hi)]; o[0][r] *= fr_; o[1][r] *= fr_; }
                asm volatile("s_waitcnt lgkmcnt(0)" ::: "memory");
            }
        }
        float sacc = 0.f;
#pragma unroll
        for (int r = 0; r < 16; ++r) { p0[r] = __builtin_amdgcn_exp2f(p0[r]); p1[r] = __builtin_amdgcn_exp2f(p1[r]); sacc += p0[r] + p1[r]; }
        l_reg += sacc;
        u32x4 pw0, pw1, pw2, pw3;
        pw0 = (u32x4){cvtpk(p0[0], p0[1]), cvtpk(p0[2], p0[3]), cvtpk(p0[4], p0[5]), cvtpk(p0[6], p0[7])};
        pw1 = (u32x4){cvtpk(p0[8], p0[9]), cvtpk(p0[10], p0[11]), cvtpk(p0[12], p0[13]), cvtpk(p0[14], p0[15])};
        pw2 = (u32x4){cvtpk(p1[0], p1[1]), cvtpk(p1[2], p1[3]), cvtpk(p1[4], p1[5]), cvtpk(p1[6], p1[7])};
        pw3 = (u32x4){cvtpk(p1[8], p1[9]), cvtpk(p1[10], p1[11]), cvtpk(p1[12], p1[13]), cvtpk(p1[14], p1[15])};
        SBAR();
        pv(o, vb0 + slot, __builtin_bit_cast(bf16x8, pw0), __builtin_bit_cast(bf16x8, pw1), __builtin_bit_cast(bf16x8, pw2), __builtin_bit_cast(bf16x8, pw3));
        { const int tmp_ = slot; slot = s_nxt; s_nxt = s_nn; s_nn = tmp_; }
    }
    { auto rr = __builtin_amdgcn_permlane32_swap(__float_as_uint(l_reg), __float_as_uint(l_reg), false, false); l_reg = __uint_as_float(rr[0]) + __uint_as_float(rr[1]); }
    if (hi == 0) wsf[32 + r32] = l_reg; asm volatile("s_waitcnt lgkmcnt(0)" ::: "memory");
    float rli[16];
#pragma unroll
    for (int r = 0; r < 16; ++r) rli[r] = __builtin_amdgcn_rcpf(wsf[32 + crow(r, hi)]);
    { LAS bf16* stg = (LAS bf16*)(shm3 + LDS_OST) + wid * 2048;
#pragma unroll
      for (int r = 0; r < 16; ++r) { const int orow = crow(r, hi);
#pragma unroll
          for (int d0 = 0; d0 < 2; ++d0) stg[orow * 64 + d0 * 32 + r32] = (bf16)(cvtpk(o[d0][r] * rli[r], 0.f) & 0xffffu); }
      asm volatile("s_waitcnt lgkmcnt(0)" ::: "memory");
#pragma unroll
      for (int i = 0; i < 4; ++i) { const int row = i * 8 + (lane >> 3), ch = lane & 7; const u32x4 v = *(const LAS u32x4*)(stg + row * 64 + ch * 8); *(u32x4*)(Ow + (size_t)row * opitch + ch * 8) = v; } }
    asm volatile("s_waitcnt vmcnt(0) lgkmcnt(0)\n\ts_barrier" ::: "memory");
#undef ATT_DMA
}
#undef SBAR
#undef WAIT_BAR0
#undef WAIT_BAR2
}

struct SsmArgs { const float *lam_re, *lam_im, *log_step, *b_re, *b_im, *c_re, *c_im, *dskip;
                 const float* U; float* YF; bf16* OB; float* F; const float* h0; float* out_ssm; int layer; };
constexpr int SSM_PITCH = 132, SSM_WAVE_BYTES = 32 * SSM_PITCH * 4, LCH = 128, NLCH = 2048 / LCH;
__device__ __forceinline__ void split8(const float* v, bf16x8& h, bf16x8& l) {
    unsigned hw[4], lw[4];
#pragma unroll
    for (int i = 0; i < 4; ++i) { const unsigned w = cvtpk(v[2 * i], v[2 * i + 1]); hw[i] = w; const float r0 = v[2 * i] - bf2f(w & 0xffffu), r1 = v[2 * i + 1] - bf2f(w >> 16); lw[i] = cvtpk(r0, r1); }
    h = __builtin_bit_cast(bf16x8, (u32x4){hw[0], hw[1], hw[2], hw[3]}); l = __builtin_bit_cast(bf16x8, (u32x4){lw[0], lw[1], lw[2], lw[3]});
}
template <int KIND, bool SECOND>
__device__ __forceinline__ void ssm_dir(const SsmArgs& A, int b, int g, int d, int k, LAS float* buf) {
    const int lane = FRESH_LANE();
    const int hi = lane >> 5, l31 = lane & 31, fr = lane & 15, fq = lane >> 4;
    const int gd = d * 16 + g;
    constexpr int CH = KIND == 0 ? 256 : LCH, NSC = CH / 32, L = KIND == 0 ? 256 : 2048;
    const int seqrow0 = KIND == 0 ? b * 256 : 4096 + b * 2048;
    const float step = expf(A.log_step[gd]);
    float ar[2], ai[2], cr[2], ci[2];
#pragma unroll
    for (int q = 0; q < 2; ++q) { const int p = l31 + 32 * q; const float lr = A.lam_re[gd * 64 + p], li = A.lam_im[gd * 64 + p];
        const float e = expf(lr * step); float s, c; sincosf(li * step, &s, &c); ar[q] = e * c; ai[q] = e * s;
        const float den = 1.0f / (lr * lr + li * li), xr = ar[q] - 1.0f; cr[q] = (xr * lr + ai[q] * li) * den; ci[q] = (ai[q] * lr - xr * li) * den; }
    float Bf[4][8];
    bf16x8 Bh[4], Bl[4];
#pragma unroll
    for (int q = 0; q < 2; ++q) { const int p = l31 + 32 * q; const float* br = A.b_re + ((size_t)gd * 64 + p) * 16; const float* bi = A.b_im + ((size_t)gd * 64 + p) * 16;
        if (KIND == 0) {
#pragma unroll
            for (int c4 = 0; c4 < 4; ++c4) { const f32x4 r = *(const f32x4*)(br + 4 * c4), im = *(const f32x4*)(bi + 4 * c4);
#pragma unroll
                for (int h2 = 0; h2 < 2; ++h2) { const float re_ = hi ? r[2 * h2 + 1] : r[2 * h2], im_ = hi ? im[2 * h2 + 1] : im[2 * h2];
                    Bf[q][2 * c4 + h2] = cr[q] * re_ - ci[q] * im_; Bf[2 + q][2 * c4 + h2] = cr[q] * im_ + ci[q] * re_; } }
        } else {
            const f32x4 r0 = *(const f32x4*)(br + 8 * hi), r1 = *(const f32x4*)(br + 8 * hi + 4), i0 = *(const f32x4*)(bi + 8 * hi), i1 = *(const f32x4*)(bi + 8 * hi + 4);
            float vr[8], vi[8];
#pragma unroll
            for (int j = 0; j < 4; ++j) { vr[j] = cr[q] * r0[j] - ci[q] * i0[j]; vi[j] = cr[q] * i0[j] + ci[q] * r0[j]; vr[4 + j] = cr[q] * r1[j] - ci[q] * i1[j]; vi[4 + j] = cr[q] * i1[j] + ci[q] * r1[j]; }
            split8(vr, Bh[q], Bl[q]); split8(vi, Bh[2 + q], Bl[2 + q]);
        }
    }
    bf16x8 Cf[4];
    if (KIND != 1) {
#pragma unroll
        for (int ks = 0; ks < 4; ++ks) { const float* cp = (ks < 2 ? A.c_re : A.c_im) + ((size_t)gd * 16 + fr) * 64 + 32 * (ks & 1) + 8 * fq; const float sg = ks < 2 ? 1.0f : -1.0f;
            const f32x4 c0 = *(const f32x4*)cp * sg, c1 = *(const f32x4*)(cp + 4) * sg;
            Cf[ks] = __builtin_bit_cast(bf16x8, (u32x4){cvtpk(c0[0], c0[1]), cvtpk(c0[2], c0[3]), cvtpk(c1[0], c1[1]), cvtpk(c1[2], c1[3])}); }
    }
    const float sar = hi ? ar[1] : ar[0], sai = hi ? ai[1] : ai[0];
    float hr = 0.f, hm = 0.f;
    if (KIND == 2) {
        const size_t so = ((((size_t)(b * 2 + A.layer) * 2 + d) * 2) * 16 + g) * 64 + lane;
        hr = A.h0[so]; hm = A.h0[so + 16 * 64];
        float pr = sar, pi = sai;
#pragma unroll
        for (int i = 0; i < 7; ++i) { const float nr = pr * pr - pi * pi, ni0 = pr * pi, ni = ni0 + ni0; pr = nr; pi = ni; }
        static_assert(LCH == 128, "power");
        const float* Fp = A.F + ((((size_t)(b * 16 + g) * 2 + d) * NLCH) * 2) * 64 + lane;
        float fre[NLCH - 1], fim[NLCH - 1];
#pragma unroll
        for (int kk = 0; kk < NLCH - 1; ++kk) { fre[kk] = Fp[(size_t)kk * 128]; fim[kk] = Fp[(size_t)kk * 128 + 64]; }
#pragma unroll
        for (int kk = 0; kk < NLCH - 1; ++kk) if (kk < k) { const float nr = pr * hr - pi * hm + fre[kk], ni = pr * hm + pi * hr + fim[kk]; hr = nr; hm = ni; }
    }
    float dsk = 0.f; if (KIND != 1 && SECOND) dsk = A.dskip[g * 16 + fr];
    f32x4 un[4];
    { const int s = CH * k + l31; const int t = d ? L - 1 - s : s; const float* up = A.U + (size_t)(seqrow0 + t) * 256 + g * 16;
#pragma unroll
      for (int c4 = 0; c4 < 4; ++c4) un[c4] = *(const f32x4*)(up + 4 * c4); }
    float yprev[2][4]; size_t oprev[2][4];
    float* const Yd = A.YF + (size_t)d * ((size_t)M_TOK * 256);
    for (int sc = 0; sc < NSC; ++sc) {
        const int s0 = CH * k + 32 * sc;
        float ua[8]; bf16x8 uah, ual;
        if (KIND == 0) {
#pragma unroll
            for (int c4 = 0; c4 < 4; ++c4) { ua[2 * c4] = hi ? un[c4][1] : un[c4][0]; ua[2 * c4 + 1] = hi ? un[c4][3] : un[c4][2]; }
        } else { const f32x4 x0 = hi ? un[2] : un[0], x1 = hi ? un[3] : un[1]; const float xv[8] = {x0[0], x0[1], x0[2], x0[3], x1[0], x1[1], x1[2], x1[3]}; split8(xv, uah, ual); }
        if (sc + 1 < NSC) { const int s = s0 + 32 + l31; const int t = d ? L - 1 - s : s; const float* up = A.U + (size_t)(seqrow0 + t) * 256 + g * 16;
#pragma unroll
            for (int c4 = 0; c4 < 4; ++c4) un[c4] = *(const f32x4*)(up + 4 * c4); }
        size_t oo[2][4]; float yv[2][4], uv[2][4];
        if (KIND != 1) {
#pragma unroll
            for (int rt = 0; rt < 2; ++rt)
#pragma unroll
                for (int r = 0; r < 4; ++r) { const int s = s0 + 16 * rt + 4 * fq + r; const int t = d ? L - 1 - s : s; oo[rt][r] = (size_t)(seqrow0 + t) * 256 + g * 16 + fr;
                    if (SECOND) { yv[rt][r] = A.YF[oo[rt][r]]; uv[rt][r] = A.U[oo[rt][r]]; } }
            if (sc > 0) {
#pragma unroll
                for (int rt = 0; rt < 2; ++rt)
#pragma unroll
                    for (int r = 0; r < 4; ++r) { if (!SECOND) Yd[oprev[rt][r]] = yprev[rt][r]; else A.OB[oprev[rt][r]] = (bf16)(cvtpk(yprev[rt][r], 0.f) & 0xffffu); }
            }
        }
#pragma unroll
        for (int n = 0; n < 4; ++n) { f32x16 D = f32x16{};
            if (KIND == 0) {
#pragma unroll
                for (int kk = 0; kk < 8; ++kk) D = __builtin_amdgcn_mfma_f32_32x32x2f32(ua[kk], Bf[n][kk], D, 0, 0, 0);
            } else { D = __builtin_amdgcn_mfma_f32_32x32x16_bf16(uah, Bh[n], D, 0, 0, 0); D = __builtin_amdgcn_mfma_f32_32x32x16_bf16(ual, Bh[n], D, 0, 0, 0); D = __builtin_amdgcn_mfma_f32_32x32x16_bf16(uah, Bl[n], D, 0, 0, 0); }
#pragma unroll
            for (int r = 0; r < 16; ++r) buf[crow(r, hi) * SSM_PITCH + 32 * n + l31] = D[r]; }
        { float sre[32], sim[32];
#pragma unroll
          for (int j = 0; j < 32; ++j) { sre[j] = buf[j * SSM_PITCH + lane]; sim[j] = buf[j * SSM_PITCH + 64 + lane]; }
#pragma unroll
          for (int j = 0; j < 32; ++j) { const float nr = fmaf(sar, hr, fmaf(-sai, hm, sre[j])), ni = fmaf(sar, hm, fmaf(sai, hr, sim[j])); hr = nr; hm = ni; sre[j] = hr; sim[j] = hm; }
          if (KIND != 1) {
#pragma unroll
              for (int j = 0; j < 32; ++j) { buf[j * SSM_PITCH + lane] = sre[j]; buf[j * SSM_PITCH + 64 + lane] = sim[j]; } } }
        if (KIND != 1) {
#pragma unroll
            for (int rt = 0; rt < 2; ++rt) { f32x4 acc = {0.f, 0.f, 0.f, 0.f};
#pragma unroll
                for (int ks = 0; ks < 4; ++ks) { const LAS float* hp = buf + (16 * rt + fr) * SSM_PITCH + 32 * ks + 8 * fq; const f32x4 h0 = *(const LAS f32x4*)hp, h1 = *(const LAS f32x4*)(hp + 4);
                    const bf16x8 ahh = __builtin_bit_cast(bf16x8, (u32x4){cvtpk(h0[0], h0[1]), cvtpk(h0[2], h0[3]), cvtpk(h1[0], h1[1]), cvtpk(h1[2], h1[3])});
                    acc = __builtin_amdgcn_mfma_f32_16x16x32_bf16(ahh, Cf[ks], acc, 0, 0, 0); }
#pragma unroll
                for (int r = 0; r < 4; ++r) { oprev[rt][r] = oo[rt][r];
                    if (!SECOND) yprev[rt][r] = acc[r]; else yprev[rt][r] = gelu_tanh_(acc[r] + yv[rt][r] + dsk * uv[rt][r]); } }
        }
    }
    if (KIND != 1) {
#pragma unroll
        for (int rt = 0; rt < 2; ++rt)
#pragma unroll
            for (int r = 0; r < 4; ++r) { if (!SECOND) Yd[oprev[rt][r]] = yprev[rt][r]; else A.OB[oprev[rt][r]] = (bf16)(cvtpk(yprev[rt][r], 0.f) & 0xffffu); }
    }
    if (KIND == 0) { const size_t so = ((((size_t)(b * 2 + A.layer) * 2 + d) * 2) * 16 + g) * 64 + lane; A.out_ssm[so] = hr; A.out_ssm[so + 16 * 64] = hm; }
    if (KIND == 1) { const size_t fo = ((((size_t)(b * 16 + g) * 2 + d) * NLCH + k) * 2) * 64 + lane; __hip_atomic_store(A.F + fo, hr, __ATOMIC_RELAXED, __HIP_MEMORY_SCOPE_AGENT); __hip_atomic_store(A.F + fo + 64, hm, __ATOMIC_RELAXED, __HIP_MEMORY_SCOPE_AGENT); }
}
template <int KIND> __device__ __forceinline__ void ssm_both(const SsmArgs& A, int b, int g, int c, LAS float* buf) {
    ssm_dir<KIND, false>(A, b, g, 0, c, buf);
    asm volatile("s_waitcnt vmcnt(0)" ::: "memory");
    ssm_dir<KIND, true>(A, b, g, 1, (KIND == 0 ? 0 : NLCH - 1 - c), buf);
}

__device__ __forceinline__ void norm_mod_rows(const float* xc, const float* xl, const float* g, const float* mod, int sh_off, int sc_off, bf16* H, int gw, int NGW, int lane) {
    for (int row0 = gw; row0 < M_TOK; row0 += 2 * NGW) {
        const int row1 = row0 + NGW; const bool has1 = row1 < M_TOK;
        const float* xr0 = row0 < 4096 ? xc + (size_t)row0 * 1024 : xl + (size_t)(row0 - 4096) * 1024;
        const float* xr1 = has1 ? (row1 < 4096 ? xc + (size_t)row1 * 1024 : xl + (size_t)(row1 - 4096) * 1024) : xr0;
        f32x4 v0[4], v1[4]; float s0 = 0.f, s1 = 0.f;
#pragma unroll
        for (int j = 0; j < 4; ++j) { v0[j] = *(const f32x4*)(xr0 + 4 * (lane + 64 * j)); v1[j] = *(const f32x4*)(xr1 + 4 * (lane + 64 * j)); }
#pragma unroll
        for (int j = 0; j < 4; ++j) { s0 += (v0[j][0] * v0[j][0] + v0[j][1] * v0[j][1]) + (v0[j][2] * v0[j][2] + v0[j][3] * v0[j][3]); s1 += (v1[j][0] * v1[j][0] + v1[j][1] * v1[j][1]) + (v1[j][2] * v1[j][2] + v1[j][3] * v1[j][3]); }
        const float rstd0 = rsqrtf(wave_sum(s0) * (1.0f / 1024.0f) + EPS), rstd1 = rsqrtf(wave_sum(s1) * (1.0f / 1024.0f) + EPS);
        const float* mp0 = mod + (row0 < 4096 ? 0 : 1 + ((row0 - 4096) >> 11)) * 6144; const float* mp1 = mod + (row1 < 4096 ? 0 : 1 + (((has1 ? row1 : row0) - 4096) >> 11)) * 6144;
#pragma unroll
        for (int j = 0; j < 4; ++j) { const int c = 4 * (lane + 64 * j); const f32x4 gg = *(const f32x4*)(g + c);
            { const f32x4 sc = *(const f32x4*)(mp0 + sc_off + c), sh = *(const f32x4*)(mp0 + sh_off + c); const f32x4 o = v0[j] * rstd0 * gg * (sc + 1.0f) + sh; u32x2 w; w.x = cvtpk(o[0], o[1]); w.y = cvtpk(o[2], o[3]); *(u32x2*)(H + (size_t)row0 * 1024 + c) = w; }
            if (has1) { const f32x4 sc = *(const f32x4*)(mp1 + sc_off + c), sh = *(const f32x4*)(mp1 + sh_off + c); const f32x4 o = v1[j] * rstd1 * gg * (sc + 1.0f) + sh; u32x2 w; w.x = cvtpk(o[0], o[1]); w.y = cvtpk(o[2], o[3]); *(u32x2*)(H + (size_t)row1 * 1024 + c) = w; } }
    }
}
__device__ __forceinline__ void final_norm_rows(float* x, const float* g, int gw, int NGW, int lane) {
    for (int row = gw; row < M_TOK; row += NGW) {
        float* xr = x + (size_t)row * 1024;
        f32x4 v[4]; float ss = 0.f;
#pragma unroll
        for (int j = 0; j < 4; ++j) { v[j] = *(const f32x4*)(xr + 4 * (lane + 64 * j)); ss += (v[j][0] * v[j][0] + v[j][1] * v[j][1]) + (v[j][2] * v[j][2] + v[j][3] * v[j][3]); }
        const float rstd = rsqrtf(wave_sum(ss) * (1.0f / 1024.0f) + EPS);
#ifdef DBG_SCALE_S
        const float dsc = row >= 4096 ? DBG_SCALE_S : DBG_SCALE_P;
#else
        const float dsc = 1.0f;
#endif
#pragma unroll
        for (int j = 0; j < 4; ++j) { const int c = 4 * (lane + 64 * j); *(f32x4*)(xr + c) = v[j] * (rstd * dsc) * *(const f32x4*)(g + c); }
    }
}

__device__ __forceinline__ int maprow(int mode, int n) {
    if (mode == 1) { const int lc = n & 255; int x = lc & 31; if (n >= 768 && n < 1024) x = 8 * ((x >> 2) & 3) + 4 * (x >> 4) + (x & 3);
        else if (n < 1792) { const int e = lc & 63; return (n & ~255) + 128 * ((e >> 4) & 1) + 32 * (lc >> 6) + 8 * (2 * (e >> 5) + ((e >> 3) & 1)) + 4 * ((e >> 2) & 1) + (e & 3); }
        return (n & ~255) + 128 * ((lc >> 5) & 1) + 32 * (lc >> 6) + x; }
    if (mode == 2) { if (n < DFF) return 256 * (n >> 7) + (n & 127); const int n2 = n - DFF; return 256 * (n2 >> 7) + 128 + (n2 & 127); }
    return n;
}
__device__ __forceinline__ void transpose_item(const float* W, int K, int N, bf16* WT, int mode, LAS float* scr, int item, int lane) {
    const int nblk = N / 32, kb = item / nblk, nb = item % nblk, k0 = 64 * kb, n0 = 32 * nb;
#pragma unroll
    for (int i = 0; i < 32; ++i) { const int kk = 2 * i + (lane >> 5); scr[kk * 33 + (lane & 31)] = W[(size_t)(k0 + kk) * N + n0 + (lane & 31)]; }
    asm volatile("s_waitcnt lgkmcnt(0)" ::: "memory");
    const int c = lane & 7;
#pragma unroll
    for (int j = 0; j < 4; ++j) { const int n = (lane >> 3) + 8 * j; const LAS float* s = scr + (8 * c) * 33 + n;
        u32x4 o; o.x = cvtpk(s[0 * 33], s[1 * 33]); o.y = cvtpk(s[2 * 33], s[3 * 33]); o.z = cvtpk(s[4 * 33], s[5 * 33]); o.w = cvtpk(s[6 * 33], s[7 * 33]);
        *(u32x4*)(WT + (size_t)maprow(mode, n0 + n) * K + k0 + 8 * c) = o; }
    asm volatile("s_waitcnt lgkmcnt(0)" ::: "memory");
}

struct Args { const float* in[33]; float* out; unsigned char* ws; int ph_lo, ph_hi; };
constexpr int N_PHASES = 13;

__global__ void __launch_bounds__(512, 2) mega_fwd(Args args) {
    extern __shared__ __attribute__((aligned(16))) unsigned char lds[];
    LAS unsigned char* L = (LAS unsigned char*)lds;
    cg::grid_group grid = cg::this_grid();
    unsigned* barw = (unsigned*)(args.ws + WS_BAR);
    volatile LAS unsigned* bst = (volatile LAS unsigned*)((LAS unsigned char*)lds + LDS_BYTES - 64);
    if (threadIdx.x == 0) { bst[0] = 0u; bst[1] = 0u; }
    __syncthreads();
    XcdBarrier xbar = xcd_barrier_post(barw, bst);
    if (args.ph_lo < 0) grid.sync();
    const int wave0 = __builtin_amdgcn_readfirstlane(threadIdx.x >> 6);
#ifdef DBG_XSYNC
    for (int i = 0; i < DBG_XSYNC; ++i) xcd_barrier(xbar);
#endif
#ifdef DBG_DUP
    int dup_done = -1;
#endif
    for (int ph = args.ph_lo; ph < args.ph_hi; ++ph) {
        if (ph > args.ph_lo) xcd_barrier(xbar);
        int wave = wave0; asm volatile("" : "+s"(wave)); int G = gridDim.x; asm volatile("" : "+s"(G)); int bx = blockIdx.x; asm volatile("" : "+s"(bx));
    const int gw = bx * 8 + wave, NGW = G * 8;
    __attribute__((address_space(1))) unsigned char* ws1_ = (__attribute__((address_space(1))) unsigned char*)args.ws; asm volatile("" : "+s"(ws1_)); unsigned char* ws = (unsigned char*)ws1_;
    __attribute__((address_space(1))) float* out1_ = (__attribute__((address_space(1))) float*)args.out; asm volatile("" : "+s"(out1_)); float* out = (float*)out1_;
    float* MOD = (float*)(ws + WS_MOD); float* ROPE = (float*)(ws + WS_ROPE);
    bf16* Hb = (bf16*)(ws + WS_H); float* YF = (float*)(ws + WS_H);
    bf16 *QA = (bf16*)(ws + WS_QA), *KA = (bf16*)(ws + WS_KA), *VA = (bf16*)(ws + WS_VA), *QC = (bf16*)(ws + WS_QC), *KC = (bf16*)(ws + WS_KC), *VC = (bf16*)(ws + WS_VC);
    float* Ub = (float*)(ws + WS_U); bf16* MF = (bf16*)(ws + WS_QKVU);
    bf16* GATES = (bf16*)(ws + WS_GATES); bf16* ACT = (bf16*)(ws + WS_GATES);
    bf16 *OA = (bf16*)(ws + WS_OA), *OB = (bf16*)(ws + WS_OB), *OC = (bf16*)(ws + WS_OC);
    bf16 *CKAK = (bf16*)(ws + WS_CKAK), *CKAV = (bf16*)(ws + WS_CKAV), *CKCK = (bf16*)(ws + WS_CKCK), *CKCV = (bf16*)(ws + WS_CKCV);
    float* SSMF = (float*)(ws + WS_SSMF2); unsigned* FLAGS = (unsigned*)(ws + WS_FLAG);

        if (ph == 0) {
#ifdef DBG_DUP_P0
            for (int rep0 = 0; rep0 < 2; ++rep0) {
#endif
            const int lane = FRESH_LANE(), tid = wave * 64 + lane;
            LAS float* S = (LAS float*)(L + 69632);
            LAS float* red = (LAS float*)(L + 90112);
            if (bx < 192) {
                for (int i = tid; i < 5 * 1024; i += 512) { const int cv = i >> 10, kx = i & 1023; const float c = cv == 0 ? args.in[8][kx] : args.in[2][(cv - 1) * 1024 + kx]; S[i] = c / (1.0f + __expf(-c)); }
                __syncthreads();
                for (int item = bx; item < 192; item += G) {
                    const int l = item / 96, col = (item % 96) * 64 + lane;
                    const float* wp = args.in[9] + (size_t)l * 1024 * 6144 + col;
                    float a0 = 0.f, a1 = 0.f, a2 = 0.f, a3 = 0.f, a4 = 0.f;
#pragma unroll 16
                    for (int kk = 0; kk < 128; ++kk) { const int kx = wave * 128 + kk; const float w = wp[(size_t)kx * 6144];
                        a0 += S[kx] * w; a1 += S[1024 + kx] * w; a2 += S[2048 + kx] * w; a3 += S[3072 + kx] * w; a4 += S[4096 + kx] * w; }
                    red[(wave * 5 + 0) * 64 + lane] = a0; red[(wave * 5 + 1) * 64 + lane] = a1; red[(wave * 5 + 2) * 64 + lane] = a2; red[(wave * 5 + 3) * 64 + lane] = a3; red[(wave * 5 + 4) * 64 + lane] = a4;
                    __syncthreads();
                    if (wave < 5) { float s = args.in[10][l * 6144 + col];
#pragma unroll
                        for (int w8 = 0; w8 < 8; ++w8) s += red[(w8 * 5 + wave) * 64 + lane];
                        MOD[(l * 5 + wave) * 6144 + col] = s; }
                    asm volatile("s_waitcnt vmcnt(0)" ::: "memory");
                    __syncthreads();
                    if (item < 32 && wave == 0) { __builtin_amdgcn_fence(__ATOMIC_RELEASE, "agent"); asm volatile("s_waitcnt vmcnt(0)" ::: "memory");
                        if (lane == 0) __hip_atomic_fetch_add(FLAGS + 60, 1u, __ATOMIC_RELAXED, __HIP_MEMORY_SCOPE_AGENT); }
                }
            }
            if (bx == G - 2 && tid < 256) { const int ll = tid >> 7, qk = (tid >> 6) & 1, e = tid & 63; ((float*)(ws + WS_QKG))[tid] = (qk ? args.in[14] : args.in[13])[ll * 64 + e]; }
            { const int gtid = bx * 512 + tid, NTH = G * 512;
#define CPY(idx, off, n) for (int i = gtid; i < (n) / 4; i += NTH) ((f32x4*)(ws + WS_PAR) + (off) / 4)[i] = ((const f32x4*)args.in[idx])[i];
              CPY(11, P_N1G, 2048) CPY(29, P_N2G, 2048) CPY(32, P_FING, 1024) CPY(7, P_SSM0, 32768) CPY(15, P_LAMR, 4096) CPY(16, P_LAMI, 4096) CPY(17, P_LSTEP, 64)
              CPY(18, P_BRE, 65536) CPY(19, P_BIM, 65536) CPY(20, P_CRE, 65536) CPY(21, P_CIM, 65536) CPY(22, P_SSMD, 512) CPY(24, P_NAB, 3720)
#undef CPY
            }
            if (bx == G - 1) { for (int i = tid; i < 1024; i += 512) { const int pos = i >> 4, f = i & 15; const float inv = 1.0f / powf(10000.0f, (float)f / 16.0f); const float ang = (float)pos * inv; ROPE[2 * i] = cosf(ang); ROPE[2 * i + 1] = sinf(ang); } }
            for (int it = bx * 512 + tid; it < 196608; it += G * 512) {
                const float* src; bf16* dst; int e;
                if (it < 65536) { const bool isv = it >= 32768; e = (it & 32767) * 8; const int d = e & 63, t = (e >> 6) & 255, h = (e >> 14) & 1, b = (e >> 15) & 3, l = e >> 17;
                    src = (isv ? args.in[4] : args.in[3]) + ((((size_t)(b * 2 + l) * 256 + t) * 2 + h) * 64 + d); dst = (isv ? CKAV : CKAK) + e; }
                else { const int i2 = it - 65536; const bool isv = i2 >= 65536; e = (i2 & 65535) * 8; const int d = e & 63, t = (e >> 6) & 255, h = (e >> 14) & 3, b = (e >> 16) & 3, l = e >> 18;
                    src = (isv ? args.in[6] : args.in[5]) + ((((size_t)(b * 2 + l) * 256 + t) * 4 + h) * 64 + d); dst = (isv ? CKCV : CKCK) + e; }
                const f32x4 a = *(const f32x4*)src, c = *(const f32x4*)(src + 4);
                *(u32x4*)dst = (u32x4){cvtpk(a[0], a[1]), cvtpk(a[2], a[3]), cvtpk(c[0], c[1]), cvtpk(c[2], c[3])};
            }
            LAS float* scr = (LAS float*)(L + wave * 8448);
            for (int it = gw; it < 7712; it += NGW) { const int l = 0; int r = it;
                if (r < 2432) { transpose_item(args.in[12] + (size_t)l * DM * NIN, DM, NIN, (bf16*)(ws + W_IN) + (size_t)l * NIN * DM, 1, scr, r, lane); continue; } r -= 2432;
                if (r < 256) { transpose_item(args.in[25] + (size_t)l * 512 * DM, 512, DM, (bf16*)(ws + W_BRA) + (size_t)l * DM * 512, 0, scr, r, lane); continue; } r -= 256;
                if (r < 128) { transpose_item(args.in[26] + (size_t)l * 256 * DM, 256, DM, (bf16*)(ws + W_BRB) + (size_t)l * DM * 256, 0, scr, r, lane); continue; } r -= 128;
                if (r < 128) { transpose_item(args.in[27] + (size_t)l * 256 * DM, 256, DM, (bf16*)(ws + W_BRC) + (size_t)l * DM * 256, 0, scr, r, lane); continue; } r -= 128;
                if (r < 512) { transpose_item(args.in[28] + (size_t)l * DM * DM, DM, DM, (bf16*)(ws + W_OUT) + (size_t)l * DM * DM, 0, scr, r, lane); continue; } r -= 512;
                if (r < 2816) { transpose_item(args.in[30] + (size_t)l * DM * NGU, DM, NGU, (bf16*)(ws + W_GU) + (size_t)l * NGU * DM, 2, scr, r, lane); continue; } r -= 2816;
                if (r < 1408) { transpose_item(args.in[31] + (size_t)l * DFF * DM, DFF, DM, (bf16*)(ws + W_FD) + (size_t)l * DM * DFF, 0, scr, r, lane); continue; } r -= 1408;
                transpose_item(args.in[23] + (size_t)l * 256 * 256, 256, 256, (bf16*)(ws + W_GLU) + (size_t)l * 256 * 256, 0, scr, r, lane);
            }
            __syncthreads();
#ifdef DBG_DUP_P0
            }
#endif
            {
                if (wave == 0) { unsigned sp_ = 0; while (__hip_atomic_load(FLAGS + 60, __ATOMIC_RELAXED, __HIP_MEMORY_SCOPE_AGENT) < 32u) { __builtin_amdgcn_s_sleep(4); if (++sp_ > (1u << 22)) break; }
                    __builtin_amdgcn_fence(__ATOMIC_ACQUIRE, "agent"); asm volatile("s_waitcnt vmcnt(0)" ::: "memory"); }
                __syncthreads();
                const int lane2 = FRESH_LANE();
                norm_mod_rows(args.in[0], args.in[1], args.in[11], MOD, 0, 1024, Hb, gw, NGW, lane2);
            }
            continue;
        }
        const float* const PAR = (const float*)(ws + WS_PAR);
        const int l = (ph - 1) / 6, sp = (ph - 1) % 6 + 1;
        unsigned* CNT = (unsigned*)(ws + WS_CNT); unsigned* TMO = (unsigned*)(ws + WS_TMO); unsigned* XBUF = (unsigned*)(ws + WS_XBUF);
        const float* modl = MOD + (size_t)l * 5 * 6144;
        const float* xc_in = args.in[0]; const float* xl_in = args.in[1];
        const float* xc_cur = out; const float* xl_cur = out + (size_t)4096 * 1024;
        pg8::StaticOrder S;
        switch (sp) {
        case 0: {
            const bool first = (l == 0); const int lane = FRESH_LANE();
            norm_mod_rows(first ? xc_in : xc_cur, first ? xl_in : xl_cur, PAR + P_N1G + l * 1024, modl, 0, 1024, Hb, gw, NGW, lane);
        } break;
        case 1: {
            pg8::Gemm g{Hb, (const bf16*)(ws + W_IN) + (size_t)l * NIN * DM, M_TOK, NIN, DM}; S.init(M_TOK, NIN, G, bx);
            EpiIn E{ws, out, l};

#ifndef CUT_IN
            pg8::gemm_phase<EpiIn, pg8::StaticOrder, true, true>(L, g, S, E, wave);
#endif

        } break;
        case 2: {
            SsmArgs SA{PAR + P_LAMR + l * 2048, PAR + P_LAMI + l * 2048, PAR + P_LSTEP + l * 32, PAR + P_BRE + (size_t)l * 32768, PAR + P_BIM + (size_t)l * 32768, PAR + P_CRE + (size_t)l * 32768, PAR + P_CIM + (size_t)l * 32768,
                       PAR + P_SSMD + l * 256, Ub, YF, OB, SSMF, PAR + P_SSM0, out + O_SSM, l};
#ifdef DBG_DUP
            const int QCTR_BASE = (dup_done == ph) ? 62 : 56;
#else
            constexpr int QCTR_BASE = 56;
#endif
            volatile LAS unsigned* qslot = (volatile LAS unsigned*)((LAS unsigned char*)lds + LDS_BYTES - 32);
            const int qx = bx & 7;
            for (;;) {
                __syncthreads();
                if (wave == 0 && FRESH_LANE() == 0) qslot[0] = __hip_atomic_fetch_add(FLAGS + 64 + (l * 2 + (QCTR_BASE == 56 ? 0 : 1)) * 8 + qx, 1u, __ATOMIC_RELAXED, __HIP_MEMORY_SCOPE_AGENT);
                __syncthreads();
                int item = (int)qslot[0]; item = __builtin_amdgcn_readfirstlane(item);
                if (item >= 140) break;
                if (item < 4) item = 384 + qx * 4 + item; else if (item < 36) item = 416 + qx * 32 + (item - 4); else if (item < 68) item = qx * 32 + (item - 36); else if (item < 84) item = 256 + qx * 16 + (item - 68);
                else if (item < 116) item = 864 + qx * 32 + (item - 84); else if (item < 132) item = 672 + qx * 16 + (item - 116); else item = 800 + qx * 8 + (item - 132);
                if (item < 256) {
                    const int b = item >> 6, h = (item >> 3) & 7, qb = item & 7, kvh = h >> 2;
                    const bf16* Qw = QA + ((size_t)4096 * 8 + (size_t)(b * 8 + h) * 2048 + qb * 256 + wave * 32) * 64;
                    const size_t co = ((size_t)((l * 4 + b) * 2 + kvh) * 256) * 64, lo = ((size_t)4096 * 2 + (size_t)(b * 2 + kvh) * 2048) * 64;
                    bf16* Ow = OA + ((size_t)4096 + b * 2048 + qb * 256 + wave * 32) * 512 + h * 64;
                    att::attn_unit<false>(Qw, CKAK + co, CKAV + co, KA + lo, VA + lo, 36, Ow, 512, (char*)lds, 0, 0, nullptr, wave);
                } else if (item < 384) {
                    const int i = item - 256, b = i >> 5, h = (i >> 3) & 3, qb = i & 7, r0 = 4 * qb;
                    const int rlo = clampi(r0 - 4, 0, 24), rhi = clampi(r0 - 1, 0, 24) + 7, NT = 4 + rhi - rlo + 1;
                    const bf16* Qw = QC + ((size_t)4096 * 4 + (size_t)(b * 4 + h) * 2048 + qb * 256 + wave * 32) * 64;
                    const size_t co = ((size_t)((l * 4 + b) * 4 + h) * 256) * 64, lo = ((size_t)4096 * 4 + (size_t)(b * 4 + h) * 2048 + rlo * 64) * 64;
                    bf16* Ow = OC + ((size_t)4096 + b * 2048 + qb * 256 + wave * 32) * 256 + h * 64;
                    att::attn_unit<true>(Qw, CKCK + co, CKCV + co, KC + lo, VC + lo, NT, Ow, 256, (char*)lds, r0 + (wave >> 1), rlo, PAR + P_NAB + (size_t)(l * 4 + h) * 465, wave);
                } else if (item < 416) {
                    const int wu = (item - 384) * 8 + wave;
                    ssm_both<0>(SA, wu >> 4, wu & 15, 0, (LAS float*)(L + wave * SSM_WAVE_BYTES));
                    asm volatile("s_waitcnt vmcnt(0) lgkmcnt(0)" ::: "memory"); __syncthreads();
                } else if (item < 672) {
                    const int wu = (item - 416) * 8 + wave;
                    ssm_dir<1, false>(SA, wu >> 9, (wu >> 5) & 15, (wu >> 4) & 1, wu & 15, (LAS float*)(L + wave * SSM_WAVE_BYTES));
                    asm volatile("s_waitcnt vmcnt(0) lgkmcnt(0)" ::: "memory"); __syncthreads();
                    if (wave == 0 && FRESH_LANE() == 0) __hip_atomic_fetch_add(FLAGS + 58 + l, 1u, __ATOMIC_RELAXED, __HIP_MEMORY_SCOPE_AGENT);
                } else if (item >= 864) {
                    if (wave == 0) { unsigned sp_ = 0; while (__hip_atomic_load(FLAGS + 58 + l, __ATOMIC_RELAXED, __HIP_MEMORY_SCOPE_AGENT) < 256u) { __builtin_amdgcn_s_sleep(4); if (++sp_ > (1u << 22)) break; }
                        __builtin_amdgcn_fence(__ATOMIC_ACQUIRE, "agent"); asm volatile("s_waitcnt vmcnt(0)" ::: "memory"); }
                    __syncthreads();
                    const int dd = wave & 1, wu = (wave >> 1) * 256 + (item - 864);
                    const int b = wu >> 8, g = (wu >> 4) & 15, c = wu & 15;
                    ssm_dir<2, false>(SA, b, g, dd, dd ? NLCH - 1 - c : c, (LAS float*)(L + wave * SSM_WAVE_BYTES));
                    asm volatile("s_waitcnt vmcnt(0) lgkmcnt(0)" ::: "memory");
                    __syncthreads();
                    { const int lane = FRESH_LANE(); const size_t o = ((size_t)4096 + b * 2048 + c * 128 + dd * 64 + lane) * 256 + g * 16;
                      const float* yf = YF + o; const float* yb = YF + (size_t)M_TOK * 256 + o; const float* uu = Ub + o; const float* dv = PAR + P_SSMD + l * 256 + g * 16;
                      unsigned w[8];
#pragma unroll
                      for (int c4 = 0; c4 < 4; ++c4) { const f32x4 y = *(const f32x4*)(yf + 4 * c4) + *(const f32x4*)(yb + 4 * c4) + *(const f32x4*)(dv + 4 * c4) * *(const f32x4*)(uu + 4 * c4); f32x4 q;
#pragma unroll
                          for (int j = 0; j < 4; ++j) { const float v = y[j]; q[j] = gelu_tanh_(v); }
                          w[2 * c4] = cvtpk(q[0], q[1]); w[2 * c4 + 1] = cvtpk(q[2], q[3]); }
                      *(u32x4*)(OB + o) = (u32x4){w[0], w[1], w[2], w[3]}; *(u32x4*)(OB + o + 8) = (u32x4){w[4], w[5], w[6], w[7]}; }
                    asm volatile("s_waitcnt vmcnt(0) lgkmcnt(0)" ::: "memory");
                    __syncthreads();
                } else if (item < 800) {
                    const int i = item - 672, b = i >> 3, h = i & 7, kvh = h >> 2;
                    const bf16* Qw = QA + ((size_t)(b * 8 + h) * 256 + wave * 32) * 64;
                    const size_t co = ((size_t)(b * 2 + kvh) * 256) * 64;
                    bf16* Ow = OA + ((size_t)b * 256 + wave * 32) * 512 + h * 64;
                    att::attn_unit<false>(Qw, KA + co, VA + co, KA, VA, 4, Ow, 512, (char*)lds, 0, 0, nullptr, wave);
                } else {
                    const int i = item - 800, b = i >> 2, h = i & 3;
                    const bf16* Qw = QC + ((size_t)(b * 4 + h) * 256 + wave * 32) * 64;
                    const size_t co = ((size_t)(b * 4 + h) * 256) * 64;
                    bf16* Ow = OC + ((size_t)b * 256 + wave * 32) * 256 + h * 64;
                    att::attn_unit<false>(Qw, KC + co, VC + co, KC, VC, 4, Ow, 256, (char*)lds, 0, 0, nullptr, wave);
                }
            }
        } break;
        case 3: {
            const int cglu = (G == 256) ? bx - 192 : bx;
            pg8::StaticOrder SG; SG.init(M_TOK, 256, G, cglu < 0 ? G : cglu); Unit ug;
            if (SG.next(0, ug)) {
                pg8::Gemm g{OB, (const bf16*)(ws + W_GLU) + (size_t)l * 256 * 256, M_TOK, 256, 256};
                EpiGlu E{OB};
                pg8::gemm_phase<EpiGlu, pg8::StaticOrder, true, true>(L, g, SG, E, wave);
                asm volatile("s_waitcnt vmcnt(0)" ::: "memory");
                __syncthreads();
                if (wave == 0) { __builtin_amdgcn_fence(__ATOMIC_RELEASE, "agent"); asm volatile("s_waitcnt vmcnt(0)" ::: "memory");
                    if (FRESH_LANE() == 0) __hip_atomic_store(FLAGS + ug.pm, (unsigned)(l + 1), __ATOMIC_RELAXED, __HIP_MEMORY_SCOPE_AGENT); }
            }
            if (l == 0 && bx >= 192) {
                __syncthreads();
                const int lane = FRESH_LANE(); LAS float* scr = (LAS float*)(L + wave * 8448); const int l = 1;
                for (int it = 0 + (bx - 192) * 8 + wave; it < 2000; it += (G - 192) * 8) { int r = it;
                    if (r < 2432) { transpose_item(args.in[12] + (size_t)l * DM * NIN, DM, NIN, (bf16*)(ws + W_IN) + (size_t)l * NIN * DM, 1, scr, r, lane); continue; } r -= 2432;
                    if (r < 256) { transpose_item(args.in[25] + (size_t)l * 512 * DM, 512, DM, (bf16*)(ws + W_BRA) + (size_t)l * DM * 512, 0, scr, r, lane); continue; } r -= 256;
                    if (r < 128) { transpose_item(args.in[26] + (size_t)l * 256 * DM, 256, DM, (bf16*)(ws + W_BRB) + (size_t)l * DM * 256, 0, scr, r, lane); continue; } r -= 128;
                    if (r < 128) { transpose_item(args.in[27] + (size_t)l * 256 * DM, 256, DM, (bf16*)(ws + W_BRC) + (size_t)l * DM * 256, 0, scr, r, lane); continue; } r -= 128;
                    if (r < 512) { transpose_item(args.in[28] + (size_t)l * DM * DM, DM, DM, (bf16*)(ws + W_OUT) + (size_t)l * DM * DM, 0, scr, r, lane); continue; } r -= 512;
                    if (r < 2816) { transpose_item(args.in[30] + (size_t)l * DM * NGU, DM, NGU, (bf16*)(ws + W_GU) + (size_t)l * NGU * DM, 2, scr, r, lane); continue; } r -= 2816;
                    if (r < 1408) { transpose_item(args.in[31] + (size_t)l * DFF * DM, DFF, DM, (bf16*)(ws + W_FD) + (size_t)l * DM * DFF, 0, scr, r, lane); continue; } r -= 1408;
                    transpose_item(args.in[23] + (size_t)l * 256 * 256, 256, 256, (bf16*)(ws + W_GLU) + (size_t)l * 256 * 256, 0, scr, r, lane);
            }
                asm volatile("s_waitcnt vmcnt(0) lgkmcnt(0)" ::: "memory");
            }
            S.init(M_TOK, DM, G, bx);
            { pg8::Gemm g{OA, (const bf16*)(ws + W_BRA) + (size_t)l * DM * 512, M_TOK, DM, 512}; EpiBr<0> E{GATES, MF, nullptr}; pg8::gemm_phase<EpiBr<0>, pg8::StaticOrder, true, true>(L, g, S, E, wave); }
            { pg8::Gemm g{OC, (const bf16*)(ws + W_BRC) + (size_t)l * DM * 256, M_TOK, DM, 256}; EpiBr<1> E{GATES + 2048, MF, nullptr}; pg8::gemm_phase<EpiBr<1>, pg8::StaticOrder, true, true>(L, g, S, E, wave); }
            { Unit ub; if (S.next(0, ub)) {
                if (wave == 0) { unsigned sp_ = 0; while (__hip_atomic_load(FLAGS + ub.pm, __ATOMIC_RELAXED, __HIP_MEMORY_SCOPE_AGENT) < (unsigned)(l + 1)) { __builtin_amdgcn_s_sleep(2); if (++sp_ > (1u << 24)) break; }
                    __builtin_amdgcn_fence(__ATOMIC_ACQUIRE, "agent"); asm volatile("s_waitcnt vmcnt(0)" ::: "memory"); }
                __syncthreads(); } }
            { pg8::Gemm g{OB, (const bf16*)(ws + W_BRB) + (size_t)l * DM * 256, M_TOK, DM, 256}; EpiBr<2> E{GATES + 1024, MF, Hb}; pg8::gemm_phase<EpiBr<2>, pg8::StaticOrder, true, true>(L, g, S, E, wave); }
        } break;
        case 4: {
            if (l == 0 && bx >= 192) {
                const int lane = FRESH_LANE(); LAS float* scr = (LAS float*)(L + wave * 8448); const int l = 1;
                for (int it = 2000 + (bx - 192) * 8 + wave; it < 3900; it += (G - 192) * 8) { int r = it;
                    if (r < 2432) { transpose_item(args.in[12] + (size_t)l * DM * NIN, DM, NIN, (bf16*)(ws + W_IN) + (size_t)l * NIN * DM, 1, scr, r, lane); continue; } r -= 2432;
                    if (r < 256) { transpose_item(args.in[25] + (size_t)l * 512 * DM, 512, DM, (bf16*)(ws + W_BRA) + (size_t)l * DM * 512, 0, scr, r, lane); continue; } r -= 256;
                    if (r < 128) { transpose_item(args.in[26] + (size_t)l * 256 * DM, 256, DM, (bf16*)(ws + W_BRB) + (size_t)l * DM * 256, 0, scr, r, lane); continue; } r -= 128;
                    if (r < 128) { transpose_item(args.in[27] + (size_t)l * 256 * DM, 256, DM, (bf16*)(ws + W_BRC) + (size_t)l * DM * 256, 0, scr, r, lane); continue; } r -= 128;
                    if (r < 512) { transpose_item(args.in[28] + (size_t)l * DM * DM, DM, DM, (bf16*)(ws + W_OUT) + (size_t)l * DM * DM, 0, scr, r, lane); continue; } r -= 512;
                    if (r < 2816) { transpose_item(args.in[30] + (size_t)l * DM * NGU, DM, NGU, (bf16*)(ws + W_GU) + (size_t)l * NGU * DM, 2, scr, r, lane); continue; } r -= 2816;
                    if (r < 1408) { transpose_item(args.in[31] + (size_t)l * DFF * DM, DFF, DM, (bf16*)(ws + W_FD) + (size_t)l * DM * DFF, 0, scr, r, lane); continue; } r -= 1408;
                    transpose_item(args.in[23] + (size_t)l * 256 * 256, 256, 256, (bf16*)(ws + W_GLU) + (size_t)l * 256 * 256, 0, scr, r, lane);
            }
                asm volatile("s_waitcnt vmcnt(0) lgkmcnt(0)" ::: "memory");
            }
            S.init(M_TOK, DM, G, bx);
            pg8::Gemm g{Hb, (const bf16*)(ws + W_OUT) + (size_t)l * DM * DM, M_TOK, DM, DM};
            PanelStats st{XBUF, CNT + (l * 2 + 0) * 3072, TMO, 4, EPS, 0x700u};
            EpiResNorm<0> E{l == 0 ? xc_in : xc_cur, l == 0 ? xl_in : xl_cur, out, modl + 2048, PAR + P_N2G + l * 1024, modl, 3072, 4096, Hb, st};
            pg8::gemm_phase<EpiResNorm<0>, pg8::StaticOrder, false, true>(L, g, S, E, wave);
        } break;
        case 5: {
            pg8::Gemm g{Hb, (const bf16*)(ws + W_GU) + (size_t)l * NGU * DM, M_TOK, NGU, DM}; S.init(M_TOK, NGU, G, bx);
            EpiSwiglu E{ACT};
            pg8::gemm_phase<EpiSwiglu, pg8::StaticOrder, true, true>(L, g, S, E, wave);
        } break;
        case 6: {
            if (l == 0 && bx >= 192) {
                const int lane = FRESH_LANE(); LAS float* scr = (LAS float*)(L + wave * 8448); const int l = 1;
                for (int it = 3900 + (bx - 192) * 8 + wave; it < 7712; it += (G - 192) * 8) { int r = it;
                    if (r < 2432) { transpose_item(args.in[12] + (size_t)l * DM * NIN, DM, NIN, (bf16*)(ws + W_IN) + (size_t)l * NIN * DM, 1, scr, r, lane); continue; } r -= 2432;
                    if (r < 256) { transpose_item(args.in[25] + (size_t)l * 512 * DM, 512, DM, (bf16*)(ws + W_BRA) + (size_t)l * DM * 512, 0, scr, r, lane); continue; } r -= 256;
                    if (r < 128) { transpose_item(args.in[26] + (size_t)l * 256 * DM, 256, DM, (bf16*)(ws + W_BRB) + (size_t)l * DM * 256, 0, scr, r, lane); continue; } r -= 128;
                    if (r < 128) { transpose_item(args.in[27] + (size_t)l * 256 * DM, 256, DM, (bf16*)(ws + W_BRC) + (size_t)l * DM * 256, 0, scr, r, lane); continue; } r -= 128;
                    if (r < 512) { transpose_item(args.in[28] + (size_t)l * DM * DM, DM, DM, (bf16*)(ws + W_OUT) + (size_t)l * DM * DM, 0, scr, r, lane); continue; } r -= 512;
                    if (r < 2816) { transpose_item(args.in[30] + (size_t)l * DM * NGU, DM, NGU, (bf16*)(ws + W_GU) + (size_t)l * NGU * DM, 2, scr, r, lane); continue; } r -= 2816;
                    if (r < 1408) { transpose_item(args.in[31] + (size_t)l * DFF * DM, DFF, DM, (bf16*)(ws + W_FD) + (size_t)l * DM * DFF, 0, scr, r, lane); continue; } r -= 1408;
                    transpose_item(args.in[23] + (size_t)l * 256 * 256, 256, 256, (bf16*)(ws + W_GLU) + (size_t)l * 256 * 256, 0, scr, r, lane);
            }
                asm volatile("s_waitcnt vmcnt(0) lgkmcnt(0)" ::: "memory");
            }
            S.init(M_TOK, DM, G, bx);
            pg8::Gemm g{ACT, (const bf16*)(ws + W_FD) + (size_t)l * DM * DFF, M_TOK, DM, DFF};
            PanelStats st{XBUF, CNT + (l * 2 + 1) * 3072, TMO, 4, EPS, 0x780u};
            if (l == 0) { EpiResNorm<0> E{xc_cur, xl_cur, out, modl + 5120, PAR + P_N1G + 1024, MOD + (size_t)5 * 6144, 0, 1024, Hb, st}; pg8::gemm_phase<EpiResNorm<0>, pg8::StaticOrder, false, true>(L, g, S, E, wave); }
            else { EpiResNorm<1> E{xc_cur, xl_cur, out, modl + 5120, PAR + P_FING, MOD, 0, 1024, Hb, st}; pg8::gemm_phase<EpiResNorm<1>, pg8::StaticOrder, false, true>(L, g, S, E, wave); }
        } break;
        }
#ifdef DBG_DUP
        if (sp == DBG_DUP && dup_done != ph) { dup_done = ph; --ph; }
#endif
    }
}

extern "C" void kernel_launch(void* const* d_in, const int* in_sizes, int n_in, void* d_out, int out_size, void* d_ws, size_t ws_size, hipStream_t stream) {
    static int grid = 0;
    if (grid == 0) {
        if (n_in != 33 || ws_size < WS_END) { fprintf(stderr, "kernel_launch: unexpected n_in %d / ws_size %zu\n", n_in, ws_size); grid = -1; return; }
        int dev = 0, cus = 0, per_cu = 0;
        hipGetDevice(&dev); hipDeviceGetAttribute(&cus, hipDeviceAttributeMultiprocessorCount, dev);
        if (hipFuncSetAttribute((const void*)mega_fwd, hipFuncAttributeMaxDynamicSharedMemorySize, LDS_BYTES) != hipSuccess) { fprintf(stderr, "kernel_launch: hipFuncSetAttribute failed\n"); grid = -1; return; }
        if (hipOccupancyMaxActiveBlocksPerMultiprocessor(&per_cu, (const void*)mega_fwd, 512, LDS_BYTES) != hipSuccess || per_cu < 1) { fprintf(stderr, "kernel_launch: occupancy query says %d\n", per_cu); per_cu = 1; }
        (void)hipGetLastError();
        grid = cus * 1;
        fprintf(stderr, "kernel_launch: cus %d per_cu %d grid %d ws %zu\n", cus, per_cu, grid, ws_size);
    }
    if (grid < 0) return;
    if (hipMemsetAsync((char*)d_ws + WS_BAR, 0, 131072, stream) != hipSuccess) { fprintf(stderr, "kernel_launch: memset failed\n"); return; }
    Args a{};
    for (int i = 0; i < 33; ++i) a.in[i] = (const float*)d_in[i];
    a.out = (float*)d_out; a.ws = (unsigned char*)d_ws;
#if MK_MULTI
    for (int ph = 0; ph < N_PHASES; ++ph) { a.ph_lo = ph; a.ph_hi = ph + 1; hipLaunchKernelGGL(mega_fwd, dim3(grid), dim3(512), LDS_BYTES, stream, a); }
#else
    a.ph_lo = 0; a.ph_hi = N_PHASES;
    void* kargs[] = {&a};
    hipError_t e = hipLaunchCooperativeKernel((const void*)mega_fwd, dim3(grid), dim3(512), kargs, LDS_BYTES, stream);
    if (e != hipSuccess) fprintf(stderr, "cooperative launch failed: %s (grid %d)\n", hipGetErrorString(e), grid);
#endif
}
```

```cpp
#include <hip/hip_runtime.h>
#include <hip/hip_cooperative_groups.h>
#include <hip/hip_bf16.h>
#include <cstdio>
#include <cstdint>
namespace cg = cooperative_groups;

#ifndef MK_MULTI
#define MK_MULTI 0
#endif

namespace pg8 {
#define PG8_LAS __attribute__((address_space(3)))
typedef unsigned short bf16_t;
typedef short bf16x8 __attribute__((ext_vector_type(8)));
typedef float f32x4 __attribute__((ext_vector_type(4)));
typedef unsigned u32x4 __attribute__((ext_vector_type(4)));
constexpr int BM = 256, BK = 64, HALF = 128, HTB = HALF * BK * 2  , STAGE_BYTES = 8 * HTB, NXCD = 8, WGM = 8;

__host__ __device__ __forceinline__ int lds_byte(int r, int c) { const int st = (r >> 4) * 2 + (c >> 5), rr = r & 15, cc = c & 31, ob = rr * 64 + cc * 2; return st * 1024 + (ob ^ (((ob >> 9) & 1) << 5)); }
__host__ __device__ __forceinline__ void stage_rc(int b, int& R, int& C) { const int st = b / 1024, sb = b % 1024, swz = sb ^ (((sb >> 9) & 1) << 5); R = (st >> 1) * 16 + swz / 64; C = (st & 1) * 32 + (swz % 64) / 2; }
__host__ __device__ __forceinline__ int perm32(int rho) { const int n = rho >> 4, i = rho & 15; return 8 * (i >> 2) + 4 * n + (i & 3); }

struct Unit { int pm, pn; };
struct Gemm { const bf16_t* A; const bf16_t* Bt; int M, N, K; };

struct StaticOrder {
    int nM, nN, nwg, G, c;
    __host__ __device__ void init(int M, int N, int G_, int c_) { nM = M / BM; nN = N / BM; nwg = nM * nN; G = G_; c = c_; }
    __host__ __device__ bool next(int i, Unit& u) const {
        const long L = (long)i * G + c; if (L >= nwg) return false;
        int wgid = (int)L; { const int q = nwg / NXCD, r = nwg % NXCD, xcd = wgid % NXCD, off = wgid / NXCD; wgid = (xcd < r ? xcd * (q + 1) : r * (q + 1) + (xcd - r) * q) + off; }
        const int nig = WGM * nN, gid = wgid / nig, fm = gid * WGM, gsz = (nM - fm) < WGM ? (nM - fm) : WGM;
        u.pm = fm + ((wgid % nig) % gsz); u.pn = (wgid % nig) / gsz; return true;
    }
    __device__ __forceinline__ void a_ready(const Unit&) const {}
    __device__ __forceinline__ void done(const Unit&) const {}
};

__device__ __forceinline__ unsigned cvt_pk_bf16(float lo, float hi) { unsigned r; asm volatile("v_cvt_pk_bf16_f32 %0, %1, %2" : "=v"(r) : "v"(lo), "v"(hi)); return r; }
typedef float f32x2 __attribute__((ext_vector_type(2)));
template <class Epi, class Sched, bool ALIGN_EPI = false, bool SP2 = false>
__device__ __forceinline__ void gemm_phase(PG8_LAS unsigned char* lds, const Gemm g, const Sched& S, const Epi& E, const int wid) {
    int lane; asm volatile("v_mbcnt_lo_u32_b32 %0, -1, 0\n\tv_mbcnt_hi_u32_b32 %0, -1, %0" : "=v"(lane)); const int tid = wid * 64 + lane, wr = wid >> 2, wc = wid & 3, fr = lane & 15, fq = lane >> 4;
    const int K = g.K, nt = K / BK;
    unsigned voffA[2], voffB[2];
#pragma unroll
    for (int i = 0; i < 2; ++i) { int R, C; stage_rc(tid * 16 + i * 8192, R, C); const int Rb = Epi::PERM ? ((R & ~31) + perm32(R & 31)) : R;
        voffA[i] = (unsigned)(R * K + C) * 2u; voffB[i] = (unsigned)(Rb * K + C) * 2u; }
    const size_t kstep = (size_t)(BK * 2);
    const size_t hstep = (size_t)HALF * K * 2;
    const size_t tstep = 2 * hstep;
    const unsigned ldsw = (unsigned)wid * 1024u;
    const int aoff = lds_byte(wr * 64 + fr, fq * 8), boff = lds_byte(wc * 32 + fr, fq * 8);
#define PG8_SA(b, h) (((b) * 2 + (h)) * HTB)
#define PG8_SB(b, h) ((4 + (b) * 2 + (h)) * HTB)
#define PG8_STAGE(bufoff, gbase, voff) do { _Pragma("unroll") for (int _i = 0; _i < 2; ++_i) \
        __builtin_amdgcn_global_load_lds((const unsigned*)((const char*)(gbase) + (voff)[_i]), (PG8_LAS unsigned*)(lds + (bufoff) + ldsw + _i * 8192), 16, 0, 0); } while (0)
#define PG8_LDA(dst, b, h) do { _Pragma("unroll") for (int m = 0; m < 4; ++m) _Pragma("unroll") for (int k = 0; k < 2; ++k) dst[m][k] = *(const PG8_LAS bf16x8*)(lds + PG8_SA(b, h) + aoff + m * 2048 + k * 1024); } while (0)
#define PG8_LDB(dst, b, h) do { _Pragma("unroll") for (int n = 0; n < 2; ++n) _Pragma("unroll") for (int k = 0; k < 2; ++k) dst[n][k] = *(const PG8_LAS bf16x8*)(lds + PG8_SB(b, h) + boff + n * 2048 + k * 1024); } while (0)
#define PG8_MMA(ai, bj, At, Bt) do { __builtin_amdgcn_s_setprio(1); _Pragma("unroll") for (int m = 0; m < 4; ++m) _Pragma("unroll") for (int n = 0; n < 2; ++n) _Pragma("unroll") for (int k = 0; k < 2; ++k) \
        acc[ai][bj][m][n] = __builtin_amdgcn_mfma_f32_16x16x32_bf16(Bt[n][k], At[m][k], acc[ai][bj][m][n], 0, 0, 0); __builtin_amdgcn_s_setprio(0); } while (0)
#define PG8_WAIT_V(n) asm volatile("s_waitcnt vmcnt(" #n ")" ::: "memory")
#define PG8_WAIT_L(n) asm volatile("s_waitcnt lgkmcnt(" #n ")" ::: "memory")
#define PG8_BAR __builtin_amdgcn_s_barrier()
#define PG8_SCHED __builtin_amdgcn_sched_barrier(0)
    Unit cur, nxt; int ui = 0;
    if (!S.next(0, cur)) return;
    f32x4 acc[2][2][4][2];
#pragma unroll
    for (int a = 0; a < 2; ++a)
#pragma unroll
        for (int b = 0; b < 2; ++b)
#pragma unroll
            for (int m = 0; m < 4; ++m)
#pragma unroll
                for (int n = 0; n < 2; ++n) acc[a][b][m][n] = (f32x4){0.f, 0.f, 0.f, 0.f};
    bf16x8 At[4][2], B0[2][2], B1[2][2];
    const char* cA = (const char*)g.A + (size_t)cur.pm * tstep; const char* cB = (const char*)g.Bt + (size_t)cur.pn * tstep;
    S.a_ready(cur);
    if constexpr (SP2) {
        PG8_STAGE(PG8_SB(0, 0), cB, voffB); PG8_STAGE(PG8_SB(0, 1), cB + hstep, voffB); PG8_STAGE(PG8_SA(0, 0), cA, voffA); PG8_STAGE(PG8_SA(0, 1), cA + hstep, voffA);
        if (wr == 1) PG8_BAR;
        PG8_WAIT_V(2); PG8_BAR;
        PG8_STAGE(PG8_SB(1, 0), cB + kstep, voffB); PG8_STAGE(PG8_SA(1, 0), cA + kstep, voffA); PG8_STAGE(PG8_SB(1, 1), cB + hstep + kstep, voffB);
        PG8_WAIT_V(6); PG8_BAR;
    } else {
        PG8_STAGE(PG8_SB(0, 0), cB, voffB); PG8_STAGE(PG8_SA(0, 0), cA, voffA); PG8_STAGE(PG8_SB(0, 1), cB + hstep, voffB); PG8_STAGE(PG8_SA(0, 1), cA + hstep, voffA);
        if (wr == 1) PG8_BAR;
        PG8_WAIT_V(4); PG8_BAR;
        PG8_STAGE(PG8_SB(1, 0), cB + kstep, voffB); PG8_STAGE(PG8_SA(1, 0), cA + kstep, voffA); PG8_STAGE(PG8_SB(1, 1), cB + hstep + kstep, voffB);
        PG8_WAIT_V(6); PG8_BAR;
    }
    for (;;) {
        const bool has_next = S.next(ui + 1, nxt);
        const char* nA = has_next ? (const char*)g.A + (size_t)nxt.pm * tstep : cA; const char* nB = has_next ? (const char*)g.Bt + (size_t)nxt.pn * tstep : cB;
        for (int t = 0; t < nt; t += 2) {
            const bool last = (t == nt - 2);
            const char* a1 = cA + (size_t)(t + 1) * kstep;
            const char* a2 = last ? nA : cA + (size_t)(t + 2) * kstep; const char* b2 = last ? nB : cB + (size_t)(t + 2) * kstep;
            const char* a3 = a2 + kstep; const char* b3 = b2 + kstep;
            if (last && has_next) S.a_ready(nxt);
            if constexpr (SP2) {
            PG8_LDB(B0, 0, 0); PG8_LDB(B1, 0, 1); PG8_SCHED; PG8_LDA(At, 0, 0); PG8_STAGE(PG8_SA(1, 1), a1 + hstep, voffA);
            PG8_WAIT_V(8); PG8_WAIT_L(0); PG8_BAR; PG8_MMA(0, 0, At, B0); PG8_MMA(0, 1, At, B1); PG8_BAR; PG8_SCHED;
            PG8_LDA(At, 0, 1); PG8_STAGE(PG8_SB(0, 0), b2, voffB); PG8_STAGE(PG8_SB(0, 1), b2 + hstep, voffB); PG8_STAGE(PG8_SA(0, 0), a2, voffA);
            PG8_WAIT_V(8); PG8_WAIT_L(0); PG8_BAR; PG8_MMA(1, 0, At, B0); PG8_MMA(1, 1, At, B1); PG8_BAR; PG8_SCHED;
            PG8_LDB(B0, 1, 0); PG8_LDB(B1, 1, 1); PG8_SCHED; PG8_LDA(At, 1, 0); PG8_STAGE(PG8_SA(0, 1), a2 + hstep, voffA);
            PG8_WAIT_V(8); PG8_WAIT_L(0); PG8_BAR; PG8_MMA(0, 0, At, B0); PG8_MMA(0, 1, At, B1); PG8_BAR; PG8_SCHED;
            PG8_LDA(At, 1, 1); PG8_STAGE(PG8_SB(1, 0), b3, voffB); PG8_STAGE(PG8_SB(1, 1), b3 + hstep, voffB); PG8_STAGE(PG8_SA(1, 0), a3, voffA);
            PG8_WAIT_V(8); PG8_WAIT_L(0); PG8_BAR; PG8_MMA(1, 0, At, B0); PG8_MMA(1, 1, At, B1); PG8_BAR; PG8_SCHED;
            } else {
            PG8_LDB(B0, 0, 0); PG8_SCHED; PG8_LDA(At, 0, 0); PG8_STAGE(PG8_SA(1, 1), a1 + hstep, voffA);
            PG8_WAIT_L(8); PG8_BAR; PG8_WAIT_L(0); PG8_MMA(0, 0, At, B0); PG8_BAR; PG8_SCHED;
            PG8_LDB(B1, 0, 1); PG8_STAGE(PG8_SB(0, 0), b2, voffB);
            PG8_BAR; PG8_WAIT_L(0); PG8_MMA(0, 1, At, B1); PG8_BAR;
            PG8_LDA(At, 0, 1); PG8_STAGE(PG8_SA(0, 0), a2, voffA);
            PG8_BAR; PG8_WAIT_L(0); PG8_MMA(1, 0, At, B0); PG8_BAR; PG8_SCHED;
            PG8_STAGE(PG8_SB(0, 1), b2 + hstep, voffB);
            PG8_WAIT_V(6); PG8_BAR; PG8_MMA(1, 1, At, B1); PG8_BAR;
            PG8_LDB(B0, 1, 0); PG8_SCHED; PG8_LDA(At, 1, 0); PG8_STAGE(PG8_SA(0, 1), a2 + hstep, voffA);
            PG8_WAIT_L(8); PG8_BAR; PG8_WAIT_L(0); PG8_MMA(0, 0, At, B0); PG8_BAR; PG8_SCHED;
            PG8_LDB(B1, 1, 1); PG8_STAGE(PG8_SB(1, 0), b3, voffB);
            PG8_BAR; PG8_WAIT_L(0); PG8_MMA(0, 1, At, B1); PG8_BAR;
            PG8_LDA(At, 1, 1); PG8_STAGE(PG8_SA(1, 0), a3, voffA);
            PG8_BAR; PG8_WAIT_L(0); PG8_MMA(1, 0, At, B0); PG8_BAR; PG8_SCHED;
            PG8_STAGE(PG8_SB(1, 1), b3 + hstep, voffB);
            PG8_WAIT_V(6); PG8_BAR; PG8_MMA(1, 1, At, B1); PG8_BAR;
            }
        }
        if constexpr (ALIGN_EPI) { if (wr == 0) PG8_BAR; }
        if constexpr (!Epi::AFTER_DRAIN) { E(acc, cur, wr, wc, fr, fq); S.done(cur); }
        if (!has_next) break;
#pragma unroll
        for (int a = 0; a < 2; ++a)
#pragma unroll
            for (int b = 0; b < 2; ++b)
#pragma unroll
                for (int m = 0; m < 4; ++m)
#pragma unroll
                    for (int n = 0; n < 2; ++n) acc[a][b][m][n] = (f32x4){0.f, 0.f, 0.f, 0.f};
        cur = nxt; cA = nA; cB = nB; ++ui;
        if constexpr (ALIGN_EPI) { if (wr == 1) PG8_BAR; }
    }
    PG8_WAIT_V(0);
    if constexpr (!ALIGN_EPI) { if (wr == 0) PG8_BAR; }
    PG8_BAR;
    if constexpr (Epi::AFTER_DRAIN) { E.fused(acc, cur, wr, wc, fr, fq, lds, wid, lane); S.done(cur); }
#undef PG8_SA
#undef PG8_SB
#undef PG8_STAGE
#undef PG8_LDA
#undef PG8_LDB
#undef PG8_MMA
#undef PG8_WAIT_V
#undef PG8_WAIT_L
#undef PG8_BAR
#undef PG8_SCHED
}
}

#define LAS __attribute__((address_space(3)))
typedef unsigned short bf16;
typedef short bf16x8 __attribute__((ext_vector_type(8)));
typedef short s16x4 __attribute__((ext_vector_type(4)));
typedef float f32x4 __attribute__((ext_vector_type(4)));
typedef float f32x16 __attribute__((ext_vector_type(16)));
typedef unsigned u32x4 __attribute__((ext_vector_type(4)));
typedef unsigned u32x2 __attribute__((ext_vector_type(2)));
typedef float f32x2_t __attribute__((ext_vector_type(2)));
typedef __bf16 bf16x2_t __attribute__((ext_vector_type(2)));

constexpr int M_TOK = 12288, M_CTX = 4096, DM = 1024, NIN = 4864, DFF = 2816, NGU = 5632;
constexpr float EPS = 1e-6f, LOG2E = 1.4426950408889634f, C2 = 0.125f * 1.4426950408889634f;
constexpr size_t MiB = 1u << 20;
constexpr size_t WS_ROPE = 0, WS_QKG = 16384, WS_BAR = 458752, WS_FLAG = 475136, WS_CNT = 512 * 1024, WS_TMO = 512 * 1024 + 61440, WS_XBUF = 576 * 1024, WS_MOD = 65536, WS_SSMF = 512 * 1024, WS_CKAK = 1 * MiB, WS_CKAV = 1 * MiB + 512 * 1024, WS_CKCK = 2 * MiB, WS_CKCV = 3 * MiB;
constexpr size_t WS_W = 4 * MiB;
constexpr size_t W_IN = WS_W, W_BRA = W_IN + 2ull * NIN * DM * 2, W_BRB = W_BRA + 2ull * DM * 512 * 2, W_BRC = W_BRB + 2ull * DM * 256 * 2, W_OUT = W_BRC + 2ull * DM * 256 * 2,
                 W_GU = W_OUT + 2ull * DM * DM * 2, W_FD = W_GU + 2ull * NGU * DM * 2, W_GLU = W_FD + 2ull * DM * DFF * 2, W_END = W_GLU + 2ull * 256 * 256 * 2;
constexpr size_t WS_H = 65 * MiB;
constexpr size_t WS_QKVU = 89 * MiB;
constexpr size_t WS_QA = WS_QKVU, WS_KA = WS_QA + 12 * MiB, WS_VA = WS_KA + 3 * MiB, WS_U = WS_VA + 3 * MiB, WS_QC = WS_U + 12 * MiB, WS_KC = WS_QC + 6 * MiB, WS_VC = WS_KC + 6 * MiB;
constexpr size_t WS_GATES = 137 * MiB;
constexpr size_t WS_OA = 209 * MiB, WS_OB = 221 * MiB, WS_OC = 227 * MiB, WS_PAR = 233 * MiB, WS_SSMF2 = 235 * MiB, WS_END = 236 * MiB;
constexpr int P_N1G = 0, P_N2G = 2048, P_FING = 4096, P_SSM0 = 5120, P_LAMR = 37888, P_LAMI = 41984, P_LSTEP = 46080, P_BRE = 46144, P_BIM = 111680, P_CRE = 177216, P_CIM = 242752, P_SSMD = 308288, P_NAB = 308800;
static_assert(W_END <= WS_H, "weights fit");
constexpr size_t O_YP = 0, O_YS = 4194304, O_GAK = 12582912, O_GAV = 13631488, O_NAK = 14680064, O_NAV = 16777216, O_SSM = 18874368;
constexpr int LDS_BYTES = 147456;

__device__ __forceinline__ unsigned cvtpk(float lo, float hi) { f32x2_t v = {lo, hi}; bf16x2_t b = __builtin_convertvector(v, bf16x2_t); return __builtin_bit_cast(unsigned, b); }
__device__ __forceinline__ float bf2f(unsigned b) { return __uint_as_float(b << 16); }
__device__ __forceinline__ float sigmoidf_(float v) { return __builtin_amdgcn_rcpf(1.0f + __expf(-v)); }
__device__ __forceinline__ float gelu_tanh_(float v) { const float z = 1.5957691216057308f * (v + 0.044715f * v * v * v); return v * __builtin_amdgcn_rcpf(1.0f + __expf(-z)); }
template <int K> __device__ __forceinline__ float xor_shfl(float v) {
    return __uint_as_float((unsigned)__builtin_amdgcn_ds_swizzle((int)__float_as_uint(v), (K << 10) | 0x1F));
}
__device__ __forceinline__ float sum_xor32(float v) { auto rr = __builtin_amdgcn_permlane32_swap(__float_as_uint(v), __float_as_uint(v), false, false); return __uint_as_float(rr[0]) + __uint_as_float(rr[1]); }
__device__ __forceinline__ float wave_sum(float v) {
    v += xor_shfl<1>(v); v += xor_shfl<2>(v); v += xor_shfl<4>(v); v += xor_shfl<8>(v); v += xor_shfl<16>(v);
    return sum_xor32(v);
}
__device__ __forceinline__ int crow(int r, int hi) { return (r & 3) + 8 * (r >> 2) + 4 * hi; }
__device__ __forceinline__ int clampi(int v, int lo, int hi) { return v < lo ? lo : (v > hi ? hi : v); }
#define FRESH_LANE() ({ int l__; asm volatile("v_mbcnt_lo_u32_b32 %0, -1, 0\n\tv_mbcnt_hi_u32_b32 %0, -1, %0" : "=v"(l__)); l__; })
#ifndef DBG_SSM
#define DBG_SSM 1.0f
#endif
#ifndef DBG_GAK
#define DBG_GAK 1.0f
#endif
#ifndef DBG_GAV
#define DBG_GAV 1.0f
#endif
#define VM_WAIT0() asm volatile("s_waitcnt vmcnt(0)" ::: "memory")

#define XB_TMO      128
#define XB_XCNT(j)  (256  + 64 * (j))
#define XB_XSUB(j)  (1280 + 64 * (j))
#define XB_XGEN(j)  (2304 + 64 * (j))
#define XB_TOP      3328
#define XB_TOPGEN   3392
#define XCD_BAR_WORDS 3456
#define XB_SPIN_CAP (1u << 18)

__device__ __forceinline__ unsigned xb_ld(unsigned* p)              { return __hip_atomic_load(p, __ATOMIC_RELAXED, __HIP_MEMORY_SCOPE_AGENT); }
__device__ __forceinline__ unsigned xb_add(unsigned* p, unsigned v) { return __hip_atomic_fetch_add(p, v, __ATOMIC_RELAXED, __HIP_MEMORY_SCOPE_AGENT); }
__device__ __forceinline__ unsigned xb_xcc_id() { return (unsigned)__builtin_amdgcn_s_getreg((3 << 11) | 20) & 0xFu; }
#define XB_SPIN(cond, bar) do { unsigned _sp = 0; while (cond) { __builtin_amdgcn_s_sleep(1); \
    if ((++_sp & 255u) == 0u) { if (xb_ld(&(bar)[XB_TMO])) break; if (_sp > XB_SPIN_CAP) { atomicAdd(&(bar)[XB_TMO], 1u); break; } } } } while (0)

struct XcdBarrier {
    unsigned* bar; unsigned x;
    volatile LAS unsigned* st;
};

__device__ __forceinline__ XcdBarrier xcd_barrier_post(unsigned* bar, volatile LAS unsigned* st) {
    XcdBarrier b; b.bar = bar; b.x = xb_xcc_id(); b.st = st;
    if (threadIdx.x == 0) (void)xb_add(&bar[XB_XCNT(b.x)], 1u);
    return b;
}
__device__ __forceinline__ void xcd_barrier_complete(unsigned* bar, unsigned x, unsigned& nloc, unsigned& nx) {
    const unsigned G = gridDim.x * gridDim.y * gridDim.z;
    unsigned sum, cnt, mine, sp = 0u;
    for (;;) {
        sum = 0u; cnt = 0u; mine = 0u;
#pragma unroll
        for (unsigned j = 0; j < 16; ++j) { const unsigned c = xb_ld(&bar[XB_XCNT(j)]); sum += c; cnt += (c > 0u) ? 1u : 0u; mine = (j == x) ? c : mine; }
        if (sum == G) break;
        __builtin_amdgcn_s_sleep(1);
        if ((++sp & 255u) == 0u) { if (xb_ld(&bar[XB_TMO])) break; if (sp > XB_SPIN_CAP) { atomicAdd(&bar[XB_TMO], 1u); break; } }
    }
    nloc = mine > 0u ? mine : 1u; nx = cnt > 0u ? cnt : 1u;
}

__device__ __forceinline__ void xcd_barrier(const XcdBarrier& b) {
    asm volatile("s_waitcnt vmcnt(0)" ::: "memory");
    __syncthreads();
    if (threadIdx.x == 0) {
        unsigned* bar = b.bar;
        __builtin_amdgcn_s_waitcnt(0);
        unsigned nloc = b.st[0], nx = b.st[1];
        if (nloc == 0u) { xcd_barrier_complete(bar, b.x, nloc, nx); b.st[0] = nloc; b.st[1] = nx; }
        const unsigned old = xb_add(&bar[XB_XSUB(b.x)], 1u);
        const unsigned gen = old / nloc;
        if (old + 1u == (gen + 1u) * nloc) {
            __builtin_amdgcn_fence(__ATOMIC_RELEASE, "agent");
            asm volatile("s_waitcnt vmcnt(0)" ::: "memory");
            const unsigned og = xb_add(&bar[XB_TOP], 1u);
            const unsigned tg = og / nx;
            if (og + 1u == (tg + 1u) * nx) xb_add(&bar[XB_TOPGEN], 1u);
            else XB_SPIN(xb_ld(&bar[XB_TOPGEN]) == tg, bar);
            __builtin_amdgcn_fence(__ATOMIC_ACQUIRE, "agent");
            xb_add(&bar[XB_XGEN(b.x)], 1u);
            asm volatile("s_waitcnt vmcnt(0)" ::: "memory");
        } else {
            XB_SPIN(xb_ld(&bar[XB_XGEN(b.x)]) == gen, bar);
            __builtin_amdgcn_fence(__ATOMIC_ACQUIRE, "agent");
            asm volatile("s_waitcnt vmcnt(0)" ::: "memory");
        }
    }
    __syncthreads();
}
using pg8::Unit;
struct EpiIn {
    static constexpr bool PERM = true, AFTER_DRAIN = false;
    unsigned char* ws; float* out; int layer;
    __device__ __forceinline__ void operator()(const f32x4 (&acc)[2][2][4][2], const Unit& u, int wr, int wc, int fr_, int fq_) const {
        const int ln_ = FRESH_LANE(), fr = ln_ & 15, fq = ln_ >> 4;
        const int pn = u.pn; const bool ctx = u.pm < 16;
        const int rb = u.pm * 256 + wr * 64 + fr;
        if (pn >= 7) {
#pragma unroll
            for (int ai = 0; ai < 2; ++ai)
#pragma unroll
                for (int m = 0; m < 4; ++m) {
                    const int row = rb + ai * 128 + m * 16;
                    bf16* gp = (bf16*)(ws + WS_GATES) + (size_t)row * 3072 + (pn - 7) * 256 + 64 * wc + 8 * fq;
#pragma unroll
                    for (int bj = 0; bj < 2; ++bj) { const f32x4 v0 = acc[ai][bj][m][0], v1 = acc[ai][bj][m][1];
                        *(u32x4*)(gp + 32 * bj) = (u32x4){cvtpk(sigmoidf_(v0[0]), sigmoidf_(v0[1])), cvtpk(sigmoidf_(v0[2]), sigmoidf_(v0[3])), cvtpk(sigmoidf_(v1[0]), sigmoidf_(v1[1])), cvtpk(sigmoidf_(v1[2]), sigmoidf_(v1[3]))}; }
                }
        } else if (pn == 3) {
#pragma unroll
            for (int ai = 0; ai < 2; ++ai)
#pragma unroll
                for (int m = 0; m < 4; ++m) {
                    const int row = rb + ai * 128 + m * 16;
                    float* up = (float*)(ws + WS_U) + (size_t)row * 256 + 64 * wc + 4 * fq;
#pragma unroll
                    for (int bj = 0; bj < 2; ++bj)
#pragma unroll
                        for (int n = 0; n < 2; ++n) *(f32x4*)(up + 32 * bj + 16 * n) = acc[ai][bj][m][n];
                }
        } else if (pn >= 4) {
            bf16* base = (bf16*)(ws + (pn == 4 ? WS_QC : (pn == 5 ? WS_KC : WS_VC)));
            const float sc = pn == 4 ? C2 : 1.0f;
            float* ob = out + (pn == 5 ? O_NAK : O_NAV);
            const int e0 = 32 * (fq >> 1) + 8 * (fq & 1);
#pragma unroll
            for (int ai = 0; ai < 2; ++ai)
#pragma unroll
                for (int m = 0; m < 4; ++m) {
                    const int row = rb + ai * 128 + m * 16;
                    int b, t; size_t hrow;
                    if (ctx) { b = row >> 8; t = row & 255; hrow = (size_t)(b * 4 + wc) * 256 + t; } else { const int r2 = row - 4096; b = r2 >> 11; t = r2 & 2047; hrow = (size_t)4096 * 4 + (size_t)(b * 4 + wc) * 2048 + t; }
                    bf16* dp = base + hrow * 64 + e0;
#pragma unroll
                    for (int bj = 0; bj < 2; ++bj) { const f32x4 v0 = acc[ai][bj][m][0] * sc, v1 = acc[ai][bj][m][1] * sc;
                        *(u32x4*)(dp + 16 * bj) = (u32x4){cvtpk(v0[0], v0[1]), cvtpk(v0[2], v0[3]), cvtpk(v1[0], v1[1]), cvtpk(v1[2], v1[3])}; }
                    if (ctx && pn >= 5) { float* op = ob + ((size_t)(b * 2 + layer) * 256 + t) * 256 + wc * 64 + e0;
#pragma unroll
                        for (int bj = 0; bj < 2; ++bj)
#pragma unroll
                            for (int n = 0; n < 2; ++n) *(f32x4*)(op + 16 * bj + 4 * n) = acc[ai][bj][m][n]; }
                    asm volatile("" ::: "memory");
                }
        } else {
            const bool isQ = pn < 2, isV = (pn == 2 && wc >= 2);
            const int h = isQ ? 4 * pn + wc : (wc & 1);
            const int hh = fq >> 1, e0 = 32 * hh + 8 * (fq & 1);
            const float* gsrc = (const float*)(ws + WS_QKG) + (layer * 2 + (isQ ? 0 : 1)) * 64 + e0;
            f32x4 gg[2][2];
#pragma unroll
            for (int bj = 0; bj < 2; ++bj)
#pragma unroll
                for (int n = 0; n < 2; ++n) gg[bj][n] = *(const f32x4*)(gsrc + 16 * bj + 4 * n);
            bf16* base = (bf16*)(ws + (isQ ? WS_QA : (isV ? WS_VA : WS_KA)));
            const int nh = isQ ? 8 : 2;
            float* ob = out + (isV ? O_GAV : O_GAK);
#pragma unroll
            for (int ai = 0; ai < 2; ++ai)
#pragma unroll
                for (int m = 0; m < 4; ++m) {
                    const int row = rb + ai * 128 + m * 16;
                    f32x4 v[2][2];
#pragma unroll
                    for (int bj = 0; bj < 2; ++bj)
#pragma unroll
                        for (int n = 0; n < 2; ++n) v[bj][n] = acc[ai][bj][m][n];
                    if (!isV) {
                        float ss = 0.f;
#pragma unroll
                        for (int bj = 0; bj < 2; ++bj)
#pragma unroll
                            for (int n = 0; n < 2; ++n) ss += (v[bj][n][0] * v[bj][n][0] + v[bj][n][1] * v[bj][n][1]) + (v[bj][n][2] * v[bj][n][2] + v[bj][n][3] * v[bj][n][3]);
                        ss += xor_shfl<16>(ss); ss = sum_xor32(ss);
                        const float rstd = rsqrtf(ss * (1.0f / 64.0f) + EPS);
#pragma unroll
                        for (int bj = 0; bj < 2; ++bj)
#pragma unroll
                            for (int n = 0; n < 2; ++n) v[bj][n] = v[bj][n] * rstd * gg[bj][n];
                    }
                    int b, t; size_t hrow;
                    if (ctx) { b = row >> 8; t = row & 255; hrow = (size_t)(b * nh + h) * 256 + t; }
                    else {
                        const int r2 = row - 4096; b = r2 >> 11; t = r2 & 2047; hrow = (size_t)4096 * nh + (size_t)(b * nh + h) * 2048 + t;
                        if (!isV) {
                            const int pos = hh ? (t & 63) : (t >> 6);
#pragma unroll
                            for (int n = 0; n < 2; ++n) {
                                const float* tp = (const float*)(ws + WS_ROPE) + (pos * 16 + 8 * (fq & 1) + 4 * n) * 2;
                                const f32x4 c01 = *(const f32x4*)tp, c23 = *(const f32x4*)(tp + 4);
                                const f32x4 cs = {c01[0], c01[2], c23[0], c23[2]}, sn = {c01[1], c01[3], c23[1], c23[3]};
                                const f32x4 x1 = v[0][n], x2 = v[1][n];
                                v[0][n] = x1 * cs - x2 * sn; v[1][n] = x2 * cs + x1 * sn;
                            }
                        }
                    }
                    if (ctx && !isQ) { float* op = ob + ((size_t)(b * 2 + layer) * 256 + t) * 128 + h * 64 + e0;
#pragma unroll
                        for (int bj = 0; bj < 2; ++bj)
#pragma unroll
                            for (int n = 0; n < 2; ++n) *(f32x4*)(op + 16 * bj + 4 * n) = v[bj][n]; }
                    const float sc = isQ ? C2 : 1.0f;
                    bf16* dp = base + hrow * 64 + e0;
#pragma unroll
                    for (int bj = 0; bj < 2; ++bj) { const f32x4 x0 = v[bj][0] * sc, x1 = v[bj][1] * sc;
                        *(u32x4*)(dp + 16 * bj) = (u32x4){cvtpk(x0[0], x0[1]), cvtpk(x0[2], x0[3]), cvtpk(x1[0], x1[1]), cvtpk(x1[2], x1[3])}; }
                    asm volatile("" ::: "memory");
                }
        }
    }
};

struct EpiRes {
    static constexpr bool PERM = false, AFTER_DRAIN = false;
    const float* xc; const float* xl; float* xo; const float* mod;
    __device__ __forceinline__ void operator()(const f32x4 (&acc)[2][2][4][2], const Unit& u, int wr, int wc, int fr_, int fq_) const {
        const int ln_ = FRESH_LANE(), fr = ln_ & 15, fq = ln_ >> 4;
        const int cv = u.pm < 16 ? 0 : 1 + ((u.pm - 16) >> 3);
        const int col0 = u.pn * 256 + wc * 32 + 4 * fq;
        f32x4 gv[2][2];
#pragma unroll
        for (int bj = 0; bj < 2; ++bj)
#pragma unroll
            for (int n = 0; n < 2; ++n) gv[bj][n] = *(const f32x4*)(mod + cv * 6144 + col0 + bj * 128 + n * 16);
#pragma unroll
        for (int ai = 0; ai < 2; ++ai)
#pragma unroll
            for (int m = 0; m < 4; ++m) {
                const int row = u.pm * 256 + ai * 128 + wr * 64 + m * 16 + fr;
                const float* xs = row < 4096 ? xc + (size_t)row * 1024 : xl + (size_t)(row - 4096) * 1024;
                float* xd = xo + (size_t)row * 1024;
#pragma unroll
                for (int bj = 0; bj < 2; ++bj)
#pragma unroll
                    for (int n = 0; n < 2; ++n) { const int c = col0 + bj * 128 + n * 16; const f32x4 xv = *(const f32x4*)(xs + c); *(f32x4*)(xd + c) = xv + gv[bj][n] * acc[ai][bj][m][n]; }
                asm volatile("" ::: "memory");
            }
    }
};

struct EpiSwiglu {
    static constexpr bool PERM = true, AFTER_DRAIN = false;
    bf16* ACT;
    __device__ __forceinline__ void operator()(const f32x4 (&acc)[2][2][4][2], const Unit& u, int wr, int wc, int fr_, int fq_) const {
        const int ln_ = FRESH_LANE(), fr = ln_ & 15, fq = ln_ >> 4;
#pragma unroll
        for (int ai = 0; ai < 2; ++ai)
#pragma unroll
            for (int m = 0; m < 4; ++m) {
                const int row = u.pm * 256 + ai * 128 + wr * 64 + m * 16 + fr;
                bf16* ap = ACT + (size_t)row * DFF + u.pn * 128 + wc * 32 + 8 * fq;
                unsigned w[4];
#pragma unroll
                for (int n = 0; n < 2; ++n) { const f32x4 g = acc[ai][0][m][n], up = acc[ai][1][m][n]; f32x4 r;
#pragma unroll
                    for (int i = 0; i < 4; ++i) r[i] = g[i] * sigmoidf_(g[i]) * up[i];
                    w[2 * n] = cvtpk(r[0], r[1]); w[2 * n + 1] = cvtpk(r[2], r[3]); }
                *(u32x4*)ap = (u32x4){w[0], w[1], w[2], w[3]};
                asm volatile("" ::: "memory");
            }
    }
};

struct EpiGlu {
    static constexpr bool PERM = false, AFTER_DRAIN = false;
    bf16* OB;
    __device__ __forceinline__ void operator()(const f32x4 (&acc)[2][2][4][2], const Unit& u, int wr, int wc, int fr_, int fq_) const {
        const int ln_ = FRESH_LANE(), fr = ln_ & 15, fq = ln_ >> 4;
#pragma unroll
        for (int ai = 0; ai < 2; ++ai)
#pragma unroll
            for (int m = 0; m < 4; ++m) {
                const int row = u.pm * 256 + ai * 128 + wr * 64 + m * 16 + fr;
                bf16* p = OB + (size_t)row * 256 + wc * 32 + 4 * fq;
#pragma unroll
                for (int bj = 0; bj < 2; ++bj)
#pragma unroll
                    for (int n = 0; n < 2; ++n) { bf16* q = p + bj * 128 + n * 16; const u32x2 yv = *(const u32x2*)q; const f32x4 a = acc[ai][bj][m][n];
                        const float y0 = bf2f(yv.x & 0xffffu), y1 = bf2f(yv.x >> 16), y2 = bf2f(yv.y & 0xffffu), y3 = bf2f(yv.y >> 16);
                        u32x2 w; w.x = cvtpk(y0 * sigmoidf_(a[0]), y1 * sigmoidf_(a[1])); w.y = cvtpk(y2 * sigmoidf_(a[2]), y3 * sigmoidf_(a[3])); *(u32x2*)q = w; }
                asm volatile("" ::: "memory");
            }
    }
};

template <int MODE> struct EpiBr {
    static constexpr bool PERM = true, AFTER_DRAIN = false;
    const bf16* G; bf16* MF; bf16* MG;
    __device__ __forceinline__ void operator()(const f32x4 (&acc)[2][2][4][2], const Unit& u, int wr, int wc, int fr_, int fq_) const {
        const int ln_ = FRESH_LANE(), fr = ln_ & 15, fq = ln_ >> 4;
        const int col0 = u.pn * 256 + wc * 32 + 8 * fq;
#pragma unroll
        for (int ai = 0; ai < 2; ++ai)
#pragma unroll
            for (int m = 0; m < 4; ++m) {
                const int row = u.pm * 256 + ai * 128 + wr * 64 + m * 16 + fr;
#pragma unroll
                for (int bj = 0; bj < 2; ++bj) { const int c = col0 + bj * 128; const u32x4 gv = *(const u32x4*)(G + (size_t)row * 3072 + c); const f32x4 a0 = acc[ai][bj][m][0], a1 = acc[ai][bj][m][1];
                    float r[8] = {bf2f(gv.x & 0xffffu) * a0[0], bf2f(gv.x >> 16) * a0[1], bf2f(gv.y & 0xffffu) * a0[2], bf2f(gv.y >> 16) * a0[3], bf2f(gv.z & 0xffffu) * a1[0], bf2f(gv.z >> 16) * a1[1], bf2f(gv.w & 0xffffu) * a1[2], bf2f(gv.w >> 16) * a1[3]};
                    bf16* mp = MF + (size_t)row * 1024 + c;
                    if (MODE >= 1) { const u32x4 mv = *(const u32x4*)mp; r[0] += bf2f(mv.x & 0xffffu); r[1] += bf2f(mv.x >> 16); r[2] += bf2f(mv.y & 0xffffu); r[3] += bf2f(mv.y >> 16); r[4] += bf2f(mv.z & 0xffffu); r[5] += bf2f(mv.z >> 16); r[6] += bf2f(mv.w & 0xffffu); r[7] += bf2f(mv.w >> 16); }
                    *(u32x4*)((MODE <= 1 ? mp : MG + (size_t)row * 1024 + c)) = (u32x4){cvtpk(r[0], r[1]), cvtpk(r[2], r[3]), cvtpk(r[4], r[5]), cvtpk(r[6], r[7])}; }
                asm volatile("" ::: "memory");
            }
    }
};

constexpr int BM = 256, HALF = 128;
struct PanelStats {
    unsigned* xbuf;
    unsigned* cnt;
    unsigned* tmo;
    int ntn; float eps;
    unsigned code;
    __device__ __forceinline__ bool run(const f32x4 (&v)[2][2][4][2], const Unit& u, int wr, int wc, int fr, int fq, LAS unsigned char* lds, int wid, int lane) const {
        typedef float f32x2v __attribute__((ext_vector_type(2)));
        LAS f32x2v* P = (LAS f32x2v*)lds;
        LAS f32x2v* S = (LAS f32x2v*)(lds + 8192);
        LAS unsigned* flag = (LAS unsigned*)(lds + 8192 + 2048);
#pragma unroll
        for (int ai = 0; ai < 2; ++ai)
#pragma unroll
            for (int m = 0; m < 4; ++m) {
                float s = 0.f;
#pragma unroll
                for (int bj = 0; bj < 2; ++bj)
#pragma unroll
                    for (int n = 0; n < 2; ++n) { const f32x4 x = v[ai][bj][m][n]; s += (x[0] + x[1]) + (x[2] + x[3]); }
                s += xor_shfl<16>(s); s = sum_xor32(s);
                const float mw = s * (1.0f / 64.0f); float q = 0.f;
#pragma unroll
                for (int bj = 0; bj < 2; ++bj)
#pragma unroll
                    for (int n = 0; n < 2; ++n) { const f32x4 d = v[ai][bj][m][n] - mw; q += (d[0] * d[0] + d[1] * d[1]) + (d[2] * d[2] + d[3] * d[3]); }
                q += xor_shfl<16>(q); q = sum_xor32(q);
                if (fq == 0) P[(ai * HALF + wr * 64 + m * 16 + fr) * 4 + wc] = (f32x2v){mw, q};
            }
        asm volatile("s_waitcnt lgkmcnt(0)" ::: "memory"); __builtin_amdgcn_s_barrier(); asm volatile("" ::: "memory");
#if defined(BROKEN_EXCHANGE_NO_WAIT)
#warning BROKEN CONTROL BUILD: the row-statistics exchange does not wait; results are wrong by design
        if (blockIdx.x >= 64) { const long long t0_ = clock64(); while (clock64() - t0_ < 60000) __builtin_amdgcn_s_sleep(8); }
#endif
        const int row = wid * 32 + (lane & 31);
        if (lane < 32) {
            const f32x2v a = P[row * 4 + 0], b = P[row * 4 + 1], c = P[row * 4 + 2], d = P[row * 4 + 3];
            const float mt = (a.x + b.x + c.x + d.x) * 0.25f;
            const float da = a.x - mt, db = b.x - mt, dc = c.x - mt, dd = d.x - mt;
            const float m2 = (a.y + b.y) + (c.y + d.y) + 64.0f * ((da * da + db * db) + (dc * dc + dd * dd));
            unsigned long long* slot = (unsigned long long*)xbuf + ((size_t)(u.pm * BM + row) * 4 + u.pn);
            __hip_atomic_store(slot, ((unsigned long long)__float_as_uint(m2) << 32) | __float_as_uint(mt), __ATOMIC_RELAXED, __HIP_MEMORY_SCOPE_AGENT);
        }
        asm volatile("s_waitcnt vmcnt(0)" ::: "memory");
        if (lane == 0) __hip_atomic_fetch_add(cnt + 64 * u.pm, 1u, __ATOMIC_RELAXED, __HIP_MEMORY_SCOPE_AGENT);
        if (wid == 0) {
            const unsigned want = 8u * (unsigned)ntn; unsigned sp_ = 0u;
            while ((unsigned)__builtin_amdgcn_readfirstlane(__hip_atomic_load(cnt + 64 * u.pm, __ATOMIC_RELAXED, __HIP_MEMORY_SCOPE_AGENT)) < want) { __builtin_amdgcn_s_sleep(2); if (++sp_ > (1u << 22)) break; }
            __builtin_amdgcn_fence(__ATOMIC_ACQUIRE, "agent");
        }
        asm volatile("s_waitcnt vmcnt(0) lgkmcnt(0)" ::: "memory"); __builtin_amdgcn_s_barrier(); asm volatile("" ::: "memory");
        const bool bad = false;
        if (lane < 32) {
            const unsigned long long* slot = (const unsigned long long*)xbuf + (size_t)(u.pm * BM + row) * 4; float mt[4], m2[4]; float ms = 0.f;
#pragma unroll
            for (int t = 0; t < 4; ++t) { if (t < ntn) { const unsigned long long w = __hip_atomic_load(slot + t, __ATOMIC_RELAXED, __HIP_MEMORY_SCOPE_AGENT); mt[t] = __uint_as_float((unsigned)w); m2[t] = __uint_as_float((unsigned)(w >> 32)); } else { mt[t] = 0.f; m2[t] = 0.f; } ms += mt[t]; }
            const float mean = ms / (float)ntn; float q = 0.f;
#pragma unroll
            for (int t = 0; t < 4; ++t) if (t < ntn) { const float dm = mt[t] - mean; q += m2[t] + 256.0f * dm * dm; }
            S[row] = (f32x2v){mean, 1.0f / sqrtf(q / (256.0f * (float)ntn) + mean * mean + eps)};
        }
        asm volatile("s_waitcnt lgkmcnt(0)" ::: "memory"); __builtin_amdgcn_s_barrier(); asm volatile("" ::: "memory");
        return bad;
    }
};
template <int final_> struct EpiResNorm {
    static constexpr bool PERM = true, AFTER_DRAIN = true;
    const float* xc; const float* xl; float* xo; const float* gate; const float* ng; const float* nmod; int sh_off, sc_off; bf16* H; PanelStats st;
    __device__ __forceinline__ void fused(f32x4 (&acc)[2][2][4][2], const Unit& u, int wr, int wc, int fr_, int fq_, LAS unsigned char* lds, int wid, int lane_) const {
        const int lane = FRESH_LANE(), fr = lane & 15, fq = lane >> 4;
        typedef float f32x2v __attribute__((ext_vector_type(2)));
        const LAS f32x2v* S = (const LAS f32x2v*)(lds + 8192);
        const int cv = u.pm < 16 ? 0 : 1 + ((u.pm - 16) >> 3);
        const int col0 = u.pn * 256 + wc * 32 + 8 * fq;
#pragma unroll
        for (int ai = 0; ai < 2; ++ai)
#pragma unroll
            for (int m = 0; m < 4; ++m) {
                const int row = u.pm * 256 + ai * 128 + wr * 64 + m * 16 + fr;
                const float* xs = row < 4096 ? xc + (size_t)row * 1024 : xl + (size_t)(row - 4096) * 1024;
#pragma unroll
                for (int bj = 0; bj < 2; ++bj)
#pragma unroll
                    for (int n = 0; n < 2; ++n) { const int c = col0 + bj * 128 + n * 4; const f32x4 gv = *(const f32x4*)(gate + cv * 6144 + c); const f32x4 xv = *(const f32x4*)(xs + c);
                        acc[ai][bj][m][n] = xv + gv * acc[ai][bj][m][n]; if (!final_) *(f32x4*)(xo + (size_t)row * 1024 + c) = acc[ai][bj][m][n]; }
                asm volatile("" : "+v"(acc[ai][0][m][0]), "+v"(acc[ai][0][m][1]), "+v"(acc[ai][1][m][0]), "+v"(acc[ai][1][m][1]));
                asm volatile("" ::: "memory");
            }
        (void)st.run(acc, u, wr, wc, fr, fq, lds, wid, lane);
#pragma unroll
        for (int ai = 0; ai < 2; ++ai)
#pragma unroll
            for (int m = 0; m < 4; ++m) {
                const int r = ai * 128 + wr * 64 + m * 16 + fr; const int row = u.pm * 256 + r; const float rstd = S[r].y;
#pragma unroll
                for (int bj = 0; bj < 2; ++bj) { unsigned w[4];
#pragma unroll
                    for (int n = 0; n < 2; ++n) { const int c = col0 + bj * 128 + n * 4; const f32x4 v = acc[ai][bj][m][n] * rstd * *(const f32x4*)(ng + c);
                        if (final_) *(f32x4*)(xo + (size_t)row * 1024 + c) = v;
                        else { const f32x4 sc = *(const f32x4*)(nmod + cv * 6144 + sc_off + c), sh = *(const f32x4*)(nmod + cv * 6144 + sh_off + c); const f32x4 o = v * (sc + 1.0f) + sh;
                               w[2 * n] = cvtpk(o[0], o[1]); w[2 * n + 1] = cvtpk(o[2], o[3]); } }
                    if (!final_) *(u32x4*)(H + (size_t)row * 1024 + col0 + bj * 128) = (u32x4){w[0], w[1], w[2], w[3]}; }
                asm volatile("" ::: "memory");
            }
    }
};

namespace att {
constexpr int SLOTB = 8192, LDS_K = 0, LDS_V = 24576, LDS_WS = 49152, LDS_OST = 51200, LDS_BIAS = 83968;
constexpr float THR = 8.0f;
#define SBAR() __builtin_amdgcn_sched_barrier(0)
__device__ __forceinline__ void glds16(const void* gsrc, unsigned lds_dst) { unsigned keep;
    asm volatile("s_mov_b32 %0, m0\n\ts_mov_b32 m0, %2\n\ts_nop 0\n\tglobal_load_lds_dwordx4 %1, off\n\ts_mov_b32 m0, %0" : "=&s"(keep) : "v"(gsrc), "s"(lds_dst) : "memory"); }
#define WAIT_BAR0() asm volatile("s_waitcnt vmcnt(0) lgkmcnt(0)\n\ts_barrier" ::: "memory")
#define WAIT_BAR2() asm volatile("s_waitcnt vmcnt(2) lgkmcnt(0)\n\ts_barrier" ::: "memory")
typedef LAS const char* lds_cptr;
__device__ __forceinline__ void qkt(f32x16& p0, f32x16& p1, lds_cptr kb, const bf16x8* qr, const f32x16& negm) {
#pragma unroll
    for (int d0 = 0; d0 < 4; ++d0) {
        const bf16x8 b0 = *(const LAS bf16x8*)(kb + d0 * 2048);
        const bf16x8 b1 = *(const LAS bf16x8*)(kb + d0 * 2048 + 512);
        if (d0 == 0) { p0 = __builtin_amdgcn_mfma_f32_32x32x16_bf16(b0, qr[0], negm, 0, 0, 0); p1 = __builtin_amdgcn_mfma_f32_32x32x16_bf16(b1, qr[0], negm, 0, 0, 0); }
        else { p0 = __builtin_amdgcn_mfma_f32_32x32x16_bf16(b0, qr[d0], p0, 0, 0, 0); p1 = __builtin_amdgcn_mfma_f32_32x32x16_bf16(b1, qr[d0], p1, 0, 0, 0); }
    }
}
__device__ __forceinline__ float rowmax(const f32x16& p0, const f32x16& p1) {
    float a = fmaxf(fmaxf(p0[0], p0[1]), p1[0]), b = fmaxf(fmaxf(p0[2], p0[3]), p1[1]); a = fmaxf(fmaxf(a, p1[2]), p1[3]);
#pragma unroll
    for (int r = 4; r < 16; r += 4) { a = fmaxf(fmaxf(a, p0[r]), p0[r + 1]); b = fmaxf(fmaxf(b, p0[r + 2]), p0[r + 3]); a = fmaxf(fmaxf(a, p1[r]), p1[r + 1]); b = fmaxf(fmaxf(b, p1[r + 2]), p1[r + 3]); }
    const float m = fmaxf(a, b);
    auto rr = __builtin_amdgcn_permlane32_swap(__float_as_uint(m), __float_as_uint(m), false, false);
    return fmaxf(__uint_as_float(rr[0]), __uint_as_float(rr[1]));
}
__device__ __forceinline__ void pv(f32x16* o, int vb, bf16x8 pa0, bf16x8 pa1, bf16x8 pa2, bf16x8 pa3) {
#pragma unroll
    for (int d0 = 0; d0 < 2; ++d0) { s16x4 lo[4], hi[4];
#pragma unroll
        for (int ks = 0; ks < 4; ++ks) {
            asm volatile("ds_read_b64_tr_b16 %0,%1 offset:%c2" : "=&v"(lo[ks]) : "v"(vb), "i"(d0 * 4096 + ks * 1024) : "memory");
            asm volatile("ds_read_b64_tr_b16 %0,%1 offset:%c2" : "=&v"(hi[ks]) : "v"(vb), "i"(d0 * 4096 + ks * 1024 + 512) : "memory"); }
        asm volatile("s_waitcnt lgkmcnt(0)" ::: "memory"); SBAR();
#define PK(k) (bf16x8){lo[k][0], lo[k][1], lo[k][2], lo[k][3], hi[k][0], hi[k][1], hi[k][2], hi[k][3]}
        o[d0] = __builtin_amdgcn_mfma_f32_32x32x16_bf16(pa0, PK(0), o[d0], 0, 0, 0);
        o[d0] = __builtin_amdgcn_mfma_f32_32x32x16_bf16(pa1, PK(1), o[d0], 0, 0, 0);
        o[d0] = __builtin_amdgcn_mfma_f32_32x32x16_bf16(pa2, PK(2), o[d0], 0, 0, 0);
        o[d0] = __builtin_amdgcn_mfma_f32_32x32x16_bf16(pa3, PK(3), o[d0], 0, 0, 0);
#undef PK
    }
}
template <bool NA>
__device__ __forceinline__ void attn_unit(const bf16* Qw, const bf16* Kc, const bf16* Vc, const bf16* Kl, const bf16* Vl, int NT,
                                          bf16* Ow, int opitch, char* shm, int qrow, int rlo, const float* biasg, const int wid) {
    const int lane = FRESH_LANE(), tid = wid * 64 + lane, r32 = lane & 31, hi = lane >> 5;
    const unsigned lds0 = (unsigned)(uintptr_t)shm;
    const lds_cptr shm3 = (lds_cptr)shm;
    LAS float* wsf = (LAS float*)(shm3 + LDS_WS) + wid * 64;
    LAS float* bias_s = (LAS float*)(shm3 + LDS_BIAS);
    if (NA) { if (tid < 465) bias_s[tid] = biasg[tid] * LOG2E; }
    const int koff = lane * 64 + wid * 8;
    const int voff = (16 * (wid & 3) + (lane >> 2)) * 64 + (wid >> 2) * 32 + (lane & 3) * 8;
    const unsigned kdst = lds0 + LDS_K + wid * 1024, vdst = lds0 + LDS_V + wid * 1024;
#define ATT_DMA(t, slot) do { const bf16* kt_ = (t) < 4 ? Kc + (t) * 4096 : Kl + ((t) - 4) * 4096; const bf16* vt_ = (t) < 4 ? Vc + (t) * 4096 : Vl + ((t) - 4) * 4096; \
        glds16(kt_ + koff, (unsigned)__builtin_amdgcn_readfirstlane(kdst + (slot))); glds16(vt_ + voff, (unsigned)__builtin_amdgcn_readfirstlane(vdst + (slot))); } while (0)
    ATT_DMA(0, 0); ATT_DMA(1, SLOTB);
    bf16x8 qr[4];
#pragma unroll
    for (int d0 = 0; d0 < 4; ++d0) qr[d0] = *(const bf16x8*)(Qw + (size_t)r32 * 64 + d0 * 16 + hi * 8);
    float mhat = 0.f, l_reg = 0.f; f32x16 o[2]; o[0] = f32x16{}; o[1] = f32x16{}; f32x16 negm = f32x16{};
    const lds_cptr kp0 = shm3 + LDS_K + hi * 1024 + r32 * 16;
    const int vb0 = (int)(lds0 + LDS_V) + ((lane >> 4) & 1) * 32 + (lane & 3) * 8 + (4 * hi + ((lane & 15) >> 2)) * 64;
    const int qc = (wid & 1) * 32 + r32, cs = clampi(qc - 8, 0, 48), rs = clampi(qrow - 4, 0, 24);
    int slot = 0, s_nxt = SLOTB, s_nn = 2 * SLOTB;
    for (int t = 0; t < NT; ++t) {
        if (t == 0 || t + 1 >= NT) WAIT_BAR0(); else WAIT_BAR2();
        if (t + 2 < NT) ATT_DMA(t + 2, s_nn);
        f32x16 p0, p1;
        qkt(p0, p1, kp0 + slot, qr, negm);
        if (NA && t >= 4) {
            const int kr = rlo + t - 4;
            if (kr < rs || kr >= rs + 8) {
#pragma unroll
                for (int r = 0; r < 16; ++r) { p0[r] = -INFINITY; p1[r] = -INFINITY; }
            } else {
                const LAS float* brow = bias_s + (kr - qrow + 7) * 31;
#pragma unroll
                for (int r = 0; r < 16; ++r) {
                    const int kc = crow(r, hi);
                    const int i0 = clampi(kc - qc + 15, 0, 30), i1 = clampi(kc + 32 - qc + 15, 0, 30);
                    const float b0 = brow[i0], b1 = brow[i1];
                    p0[r] = ((unsigned)(kc - cs) < 16u) ? p0[r] + b0 : -INFINITY;
                    p1[r] = ((unsigned)(kc + 32 - cs) < 16u) ? p1[r] + b1 : -INFINITY;
                }
            }
        }
        const float rm = rowmax(p0, p1);
        if (t == 0 || __any(rm > THR)) {
            const float dl = (t == 0) ? rm : fmaxf(rm, 0.f);
            mhat += dl;
#pragma unroll
            for (int r = 0; r < 16; ++r) { p0[r] -= dl; p1[r] -= dl; negm[r] = -mhat; }
            if (t > 0) {
                const float f = __builtin_amdgcn_exp2f(-dl); l_reg *= f;
                if (hi == 0) wsf[r32] = f;
                asm volatile("s_waitcnt lgkmcnt(0)" ::: "memory");
#pragma unroll
                for (int r = 0; r < 16; ++r) { const float fr_ = wsf[crow(r, hi)]; o[0][r] *= fr_; o[1][r] *= fr_; }
                asm volatile("s_waitcnt lgkmcnt(0)" ::: "memory");
            }
        }
        float sacc = 0.f;
#pragma unroll
        for (int r = 0; r < 16; ++r) { p0[r] = __builtin_amdgcn_exp2f(p0[r]); p1[r] = __builtin_amdgcn_exp2f(p1[r]); sacc += p0[r] + p1[r]; }
        l_reg += sacc;
        u32x4 pw0, pw1, pw2, pw3;
        pw0 = (u32x4){cvtpk(p0[0], p0[1]), cvtpk(p0[2], p0[3]), cvtpk(p0[4], p0[5]), cvtpk(p0[6], p0[7])};
        pw1 = (u32x4){cvtpk(p0[8], p0[9]), cvtpk(p0[10], p0[11]), cvtpk(p0[12], p0[13]), cvtpk(p0[14], p0[15])};
        pw2 = (u32x4){cvtpk(p1[0], p1[1]), cvtpk(p1[2], p1[3]), cvtpk(p1[4], p1[5]), cvtpk(p1[6], p1[7])};
        pw3 = (u32x4){cvtpk(p1[8], p1[9]), cvtpk(p1[10], p1[11]), cvtpk(p1[12], p1[13]), cvtpk(p1[14], p1[15])};
        SBAR();
        pv(o, vb0 + slot, __builtin_bit_cast(bf16x8, pw0), __builtin_bit_cast(bf16x8, pw1), __builtin_bit_cast(bf16x8, pw2), __builtin_bit_cast(bf16x8, pw3));
        { const int tmp_ = slot; slot = s_nxt; s_nxt = s_nn; s_nn = tmp_; }
    }
    { auto rr = __builtin_amdgcn_permlane32_swap(__float_as_uint(l_reg), __float_as_uint(l_reg), false, false); l_reg = __uint_as_float(rr[0]) + __uint_as_float(rr[1]); }
    if (hi == 0) wsf[32 + r32] = l_reg; asm volatile("s_waitcnt lgkmcnt(0)" ::: "memory");
    float rli[16];
#pragma unroll
    for (int r = 0; r < 16; ++r) rli[r] = __builtin_amdgcn_rcpf(wsf[32 + crow(r, hi)]);
    { LAS bf16* stg = (LAS bf16*)(shm3 + LDS_OST) + wid * 2048;
#pragma unroll
      for (int r = 0; r < 16; ++r) { const int orow = crow(r, hi);
#pragma unroll
          for (int d0 = 0; d0 < 2; ++d0) stg[orow * 64 + d0 * 32 + r32] = (bf16)(cvtpk(o[d0][r] * rli[r], 0.f) & 0xffffu); }
      asm volatile("s_waitcnt lgkmcnt(0)" ::: "memory");
#pragma unroll
      for (int i = 0; i < 4; ++i) { const int row = i * 8 + (lane >> 3), ch = lane & 7; const u32x4 v = *(const LAS u32x4*)(stg + row * 64 + ch * 8); *(u32x4*)(Ow + (size_t)row * opitch + ch * 8) = v; } }
    asm volatile("s_waitcnt vmcnt(0) lgkmcnt(0)\n\ts_barrier" ::: "memory");
#undef ATT_DMA
}
#undef SBAR
#undef WAIT_BAR0
#undef WAIT_BAR2
}

struct SsmArgs { const float *lam_re, *lam_im, *log_step, *b_re, *b_im, *c_re, *c_im, *dskip;
                 const float* U; float* YF; bf16* OB; float* F; const float* h0; float* out_ssm; int layer; };
constexpr int SSM_PITCH = 132, SSM_WAVE_BYTES = 32 * SSM_PITCH * 4, LCH = 128, NLCH = 2048 / LCH;
__device__ __forceinline__ void split8(const float* v, bf16x8& h, bf16x8& l) {
    unsigned hw[4], lw[4];
#pragma unroll
    for (int i = 0; i < 4; ++i) { const unsigned w = cvtpk(v[2 * i], v[2 * i + 1]); hw[i] = w; const float r0 = v[2 * i] - bf2f(w & 0xffffu), r1 = v[2 * i + 1] - bf2f(w >> 16); lw[i] = cvtpk(r0, r1); }
    h = __builtin_bit_cast(bf16x8, (u32x4){hw[0], hw[1], hw[2], hw[3]}); l = __builtin_bit_cast(bf16x8, (u32x4){lw[0], lw[1], lw[2], lw[3]});
}
template <int KIND, bool SECOND>
__device__ __forceinline__ void ssm_dir(const SsmArgs& A, int b, int g, int d, int k, LAS float* buf) {
    const int lane = FRESH_LANE();
    const int hi = lane >> 5, l31 = lane & 31, fr = lane & 15, fq = lane >> 4;
    const int gd = d * 16 + g;
    constexpr int CH = KIND == 0 ? 256 : LCH, NSC = CH / 32, L = KIND == 0 ? 256 : 2048;
    const int seqrow0 = KIND == 0 ? b * 256 : 4096 + b * 2048;
    const float step = expf(A.log_step[gd]);
    float ar[2], ai[2], cr[2], ci[2];
#pragma unroll
    for (int q = 0; q < 2; ++q) { const int p = l31 + 32 * q; const float lr = A.lam_re[gd * 64 + p], li = A.lam_im[gd * 64 + p];
        const float e = expf(lr * step); float s, c; sincosf(li * step, &s, &c); ar[q] = e * c; ai[q] = e * s;
        const float den = 1.0f / (lr * lr + li * li), xr = ar[q] - 1.0f; cr[q] = (xr * lr + ai[q] * li) * den; ci[q] = (ai[q] * lr - xr * li) * den; }
    float Bf[4][8];
    bf16x8 Bh[4], Bl[4];
#pragma unroll
    for (int q = 0; q < 2; ++q) { const int p = l31 + 32 * q; const float* br = A.b_re + ((size_t)gd * 64 + p) * 16; const float* bi = A.b_im + ((size_t)gd * 64 + p) * 16;
        if (KIND == 0) {
#pragma unroll
            for (int c4 = 0; c4 < 4; ++c4) { const f32x4 r = *(const f32x4*)(br + 4 * c4), im = *(const f32x4*)(bi + 4 * c4);
#pragma unroll
                for (int h2 = 0; h2 < 2; ++h2) { const float re_ = hi ? r[2 * h2 + 1] : r[2 * h2], im_ = hi ? im[2 * h2 + 1] : im[2 * h2];
                    Bf[q][2 * c4 + h2] = cr[q] * re_ - ci[q] * im_; Bf[2 + q][2 * c4 + h2] = cr[q] * im_ + ci[q] * re_; } }
        } else {
            const f32x4 r0 = *(const f32x4*)(br + 8 * hi), r1 = *(const f32x4*)(br + 8 * hi + 4), i0 = *(const f32x4*)(bi + 8 * hi), i1 = *(const f32x4*)(bi + 8 * hi + 4);
            float vr[8], vi[8];
#pragma unroll
            for (int j = 0; j < 4; ++j) { vr[j] = cr[q] * r0[j] - ci[q] * i0[j]; vi[j] = cr[q] * i0[j] + ci[q] * r0[j]; vr[4 + j] = cr[q] * r1[j] - ci[q] * i1[j]; vi[4 + j] = cr[q] * i1[j] + ci[q] * r1[j]; }
            split8(vr, Bh[q], Bl[q]); split8(vi, Bh[2 + q], Bl[2 + q]);
        }
    }
    bf16x8 Cf[4];
    if (KIND != 1) {
#pragma unroll
        for (int ks = 0; ks < 4; ++ks) { const float* cp = (ks < 2 ? A.c_re : A.c_im) + ((size_t)gd * 16 + fr) * 64 + 32 * (ks & 1) + 8 * fq; const float sg = ks < 2 ? 1.0f : -1.0f;
            const f32x4 c0 = *(const f32x4*)cp * sg, c1 = *(const f32x4*)(cp + 4) * sg;
            Cf[ks] = __builtin_bit_cast(bf16x8, (u32x4){cvtpk(c0[0], c0[1]), cvtpk(c0[2], c0[3]), cvtpk(c1[0], c1[1]), cvtpk(c1[2], c1[3])}); }
    }
    const float sar = hi ? ar[1] : ar[0], sai = hi ? ai[1] : ai[0];
    float hr = 0.f, hm = 0.f;
    if (KIND == 2) {
        const size_t so = ((((size_t)(b * 2 + A.layer) * 2 + d) * 2) * 16 + g) * 64 + lane;
        hr = A.h0[so]; hm = A.h0[so + 16 * 64];
        float pr = sar, pi = sai;
#pragma unroll
        for (int i = 0; i < 7; ++i) { const float nr = pr * pr - pi * pi, ni0 = pr * pi, ni = ni0 + ni0; pr = nr; pi = ni; }
        static_assert(LCH == 128, "power");
        const float* Fp = A.F + ((((size_t)(b * 16 + g) * 2 + d) * NLCH) * 2) * 64 + lane;
        float fre[NLCH - 1], fim[NLCH - 1];
#pragma unroll
        for (int kk = 0; kk < NLCH - 1; ++kk) { fre[kk] = Fp[(size_t)kk * 128]; fim[kk] = Fp[(size_t)kk * 128 + 64]; }
#pragma unroll
        for (int kk = 0; kk < NLCH - 1; ++kk) if (kk < k) { const float nr = pr * hr - pi * hm + fre[kk], ni = pr * hm + pi * hr + fim[kk]; hr = nr; hm = ni; }
    }
    float dsk = 0.f; if (KIND != 1 && SECOND) dsk = A.dskip[g * 16 + fr];
    f32x4 un[4];
    { const int s = CH * k + l31; const int t = d ? L - 1 - s : s; const float* up = A.U + (size_t)(seqrow0 + t) * 256 + g * 16;
#pragma unroll
      for (int c4 = 0; c4 < 4; ++c4) un[c4] = *(const f32x4*)(up + 4 * c4); }
    float yprev[2][4]; size_t oprev[2][4];
    float* const Yd = A.YF + (size_t)d * ((size_t)M_TOK * 256);
    for (int sc = 0; sc < NSC; ++sc) {
        const int s0 = CH * k + 32 * sc;
        float ua[8]; bf16x8 uah, ual;
        if (KIND == 0) {
#pragma unroll
            for (int c4 = 0; c4 < 4; ++c4) { ua[2 * c4] = hi ? un[c4][1] : un[c4][0]; ua[2 * c4 + 1] = hi ? un[c4][3] : un[c4][2]; }
        } else { const f32x4 x0 = hi ? un[2] : un[0], x1 = hi ? un[3] : un[1]; const float xv[8] = {x0[0], x0[1], x0[2], x0[3], x1[0], x1[1], x1[2], x1[3]}; split8(xv, uah, ual); }
        if (sc + 1 < NSC) { const int s = s0 + 32 + l31; const int t = d ? L - 1 - s : s; const float* up = A.U + (size_t)(seqrow0 + t) * 256 + g * 16;
#pragma unroll
            for (int c4 = 0; c4 < 4; ++c4) un[c4] = *(const f32x4*)(up + 4 * c4); }
        size_t oo[2][4]; float yv[2][4], uv[2][4];
        if (KIND != 1) {
#pragma unroll
            for (int rt = 0; rt < 2; ++rt)
#pragma unroll
                for (int r = 0; r < 4; ++r) { const int s = s0 + 16 * rt + 4 * fq + r; const int t = d ? L - 1 - s : s; oo[rt][r] = (size_t)(seqrow0 + t) * 256 + g * 16 + fr;
                    if (SECOND) { yv[rt][r] = A.YF[oo[rt][r]]; uv[rt][r] = A.U[oo[rt][r]]; } }
            if (sc > 0) {
#pragma unroll
                for (int rt = 0; rt < 2; ++rt)
#pragma unroll
                    for (int r = 0; r < 4; ++r) { if (!SECOND) Yd[oprev[rt][r]] = yprev[rt][r]; else A.OB[oprev[rt][r]] = (bf16)(cvtpk(yprev[rt][r], 0.f) & 0xffffu); }
            }
        }
#pragma unroll
        for (int n = 0; n < 4; ++n) { f32x16 D = f32x16{};
            if (KIND == 0) {
#pragma unroll
                for (int kk = 0; kk < 8; ++kk) D = __builtin_amdgcn_mfma_f32_32x32x2f32(ua[kk], Bf[n][kk], D, 0, 0, 0);
            } else { D = __builtin_amdgcn_mfma_f32_32x32x16_bf16(uah, Bh[n], D, 0, 0, 0); D = __builtin_amdgcn_mfma_f32_32x32x16_bf16(ual, Bh[n], D, 0, 0, 0); D = __builtin_amdgcn_mfma_f32_32x32x16_bf16(uah, Bl[n], D, 0, 0, 0); }
#pragma unroll
            for (int r = 0; r < 16; ++r) buf[crow(r, hi) * SSM_PITCH + 32 * n + l31] = D[r]; }
        { float sre[32], sim[32];
#pragma unroll
          for (int j = 0; j < 32; ++j) { sre[j] = buf[j * SSM_PITCH + lane]; sim[j] = buf[j * SSM_PITCH + 64 + lane]; }
#pragma unroll
          for (int j = 0; j < 32; ++j) { const float nr = fmaf(sar, hr, fmaf(-sai, hm, sre[j])), ni = fmaf(sar, hm, fmaf(sai, hr, sim[j])); hr = nr; hm = ni; sre[j] = hr; sim[j] = hm; }
          if (KIND != 1) {
#pragma unroll
              for (int j = 0; j < 32; ++j) { buf[j * SSM_PITCH + lane] = sre[j]; buf[j * SSM_PITCH + 64 + lane] = sim[j]; } } }
        if (KIND != 1) {
#pragma unroll
            for (int rt = 0; rt < 2; ++rt) { f32x4 acc = {0.f, 0.f, 0.f, 0.f};
#pragma unroll
                for (int ks = 0; ks < 4; ++ks) { const LAS float* hp = buf + (16 * rt + fr) * SSM_PITCH + 32 * ks + 8 * fq; const f32x4 h0 = *(const LAS f32x4*)hp, h1 = *(const LAS f32x4*)(hp + 4);
                    const bf16x8 ahh = __builtin_bit_cast(bf16x8, (u32x4){cvtpk(h0[0], h0[1]), cvtpk(h0[2], h0[3]), cvtpk(h1[0], h1[1]), cvtpk(h1[2], h1[3])});
                    acc = __builtin_amdgcn_mfma_f32_16x16x32_bf16(ahh, Cf[ks], acc, 0, 0, 0); }
#pragma unroll
                for (int r = 0; r < 4; ++r) { oprev[rt][r] = oo[rt][r];
                    if (!SECOND) yprev[rt][r] = acc[r]; else yprev[rt][r] = gelu_tanh_(acc[r] + yv[rt][r] + dsk * uv[rt][r]); } }
        }
    }
    if (KIND != 1) {
#pragma unroll
        for (int rt = 0; rt < 2; ++rt)
#pragma unroll
            for (int r = 0; r < 4; ++r) { if (!SECOND) Yd[oprev[rt][r]] = yprev[rt][r]; else A.OB[oprev[rt][r]] = (bf16)(cvtpk(yprev[rt][r], 0.f) & 0xffffu); }
    }
    if (KIND == 0) { const size_t so = ((((size_t)(b * 2 + A.layer) * 2 + d) * 2) * 16 + g) * 64 + lane; A.out_ssm[so] = hr; A.out_ssm[so + 16 * 64] = hm; }
    if (KIND == 1) { const size_t fo = ((((size_t)(b * 16 + g) * 2 + d) * NLCH + k) * 2) * 64 + lane; __hip_atomic_store(A.F + fo, hr, __ATOMIC_RELAXED, __HIP_MEMORY_SCOPE_AGENT); __hip_atomic_store(A.F + fo + 64, hm, __ATOMIC_RELAXED, __HIP_MEMORY_SCOPE_AGENT); }
}
template <int KIND> __device__ __forceinline__ void ssm_both(const SsmArgs& A, int b, int g, int c, LAS float* buf) {
    ssm_dir<KIND, false>(A, b, g, 0, c, buf);
    asm volatile("s_waitcnt vmcnt(0)" ::: "memory");
    ssm_dir<KIND, true>(A, b, g, 1, (KIND == 0 ? 0 : NLCH - 1 - c), buf);
}

__device__ __forceinline__ void norm_mod_rows(const float* xc, const float* xl, const float* g, const float* mod, int sh_off, int sc_off, bf16* H, int gw, int NGW, int lane) {
    for (int row0 = gw; row0 < M_TOK; row0 += 2 * NGW) {
        const int row1 = row0 + NGW; const bool has1 = row1 < M_TOK;
        const float* xr0 = row0 < 4096 ? xc + (size_t)row0 * 1024 : xl + (size_t)(row0 - 4096) * 1024;
        const float* xr1 = has1 ? (row1 < 4096 ? xc + (size_t)row1 * 1024 : xl + (size_t)(row1 - 4096) * 1024) : xr0;
        f32x4 v0[4], v1[4]; float s0 = 0.f, s1 = 0.f;
#pragma unroll
        for (int j = 0; j < 4; ++j) { v0[j] = *(const f32x4*)(xr0 + 4 * (lane + 64 * j)); v1[j] = *(const f32x4*)(xr1 + 4 * (lane + 64 * j)); }
#pragma unroll
        for (int j = 0; j < 4; ++j) { s0 += (v0[j][0] * v0[j][0] + v0[j][1] * v0[j][1]) + (v0[j][2] * v0[j][2] + v0[j][3] * v0[j][3]); s1 += (v1[j][0] * v1[j][0] + v1[j][1] * v1[j][1]) + (v1[j][2] * v1[j][2] + v1[j][3] * v1[j][3]); }
        const float rstd0 = rsqrtf(wave_sum(s0) * (1.0f / 1024.0f) + EPS), rstd1 = rsqrtf(wave_sum(s1) * (1.0f / 1024.0f) + EPS);
        const float* mp0 = mod + (row0 < 4096 ? 0 : 1 + ((row0 - 4096) >> 11)) * 6144; const float* mp1 = mod + (row1 < 4096 ? 0 : 1 + (((has1 ? row1 : row0) - 4096) >> 11)) * 6144;
#pragma unroll
        for (int j = 0; j < 4; ++j) { const int c = 4 * (lane + 64 * j); const f32x4 gg = *(const f32x4*)(g + c);
            { const f32x4 sc = *(const f32x4*)(mp0 + sc_off + c), sh = *(const f32x4*)(mp0 + sh_off + c); const f32x4 o = v0[j] * rstd0 * gg * (sc + 1.0f) + sh; u32x2 w; w.x = cvtpk(o[0], o[1]); w.y = cvtpk(o[2], o[3]); *(u32x2*)(H + (size_t)row0 * 1024 + c) = w; }
            if (has1) { const f32x4 sc = *(const f32x4*)(mp1 + sc_off + c), sh = *(const f32x4*)(mp1 + sh_off + c); const f32x4 o = v1[j] * rstd1 * gg * (sc + 1.0f) + sh; u32x2 w; w.x = cvtpk(o[0], o[1]); w.y = cvtpk(o[2], o[3]); *(u32x2*)(H + (size_t)row1 * 1024 + c) = w; } }
    }
}
__device__ __forceinline__ void final_norm_rows(float* x, const float* g, int gw, int NGW, int lane) {
    for (int row = gw; row < M_TOK; row += NGW) {
        float* xr = x + (size_t)row * 1024;
        f32x4 v[4]; float ss = 0.f;
#pragma unroll
        for (int j = 0; j < 4; ++j) { v[j] = *(const f32x4*)(xr + 4 * (lane + 64 * j)); ss += (v[j][0] * v[j][0] + v[j][1] * v[j][1]) + (v[j][2] * v[j][2] + v[j][3] * v[j][3]); }
        const float rstd = rsqrtf(wave_sum(ss) * (1.0f / 1024.0f) + EPS);
#ifdef DBG_SCALE_S
        const float dsc = row >= 4096 ? DBG_SCALE_S : DBG_SCALE_P;
#else
        const float dsc = 1.0f;
#endif
#pragma unroll
        for (int j = 0; j < 4; ++j) { const int c = 4 * (lane + 64 * j); *(f32x4*)(xr + c) = v[j] * (rstd * dsc) * *(const f32x4*)(g + c); }
    }
}

__device__ __forceinline__ int maprow(int mode, int n) {
    if (mode == 1) { const int lc = n & 255; int x = lc & 31; if (n >= 768 && n < 1024) x = 8 * ((x >> 2) & 3) + 4 * (x >> 4) + (x & 3);
        else if (n < 1792) { const int e = lc & 63; return (n & ~255) + 128 * ((e >> 4) & 1) + 32 * (lc >> 6) + 8 * (2 * (e >> 5) + ((e >> 3) & 1)) + 4 * ((e >> 2) & 1) + (e & 3); }
        return (n & ~255) + 128 * ((lc >> 5) & 1) + 32 * (lc >> 6) + x; }
    if (mode == 2) { if (n < DFF) return 256 * (n >> 7) + (n & 127); const int n2 = n - DFF; return 256 * (n2 >> 7) + 128 + (n2 & 127); }
    return n;
}
__device__ __forceinline__ void transpose_item(const float* W, int K, int N, bf16* WT, int mode, LAS float* scr, int item, int lane) {
    const int nblk = N / 32, kb = item / nblk, nb = item % nblk, k0 = 64 * kb, n0 = 32 * nb;
#pragma unroll
    for (int i = 0; i < 32; ++i) { const int kk = 2 * i + (lane >> 5); scr[kk * 33 + (lane & 31)] = W[(size_t)(k0 + kk) * N + n0 + (lane & 31)]; }
    asm volatile("s_waitcnt lgkmcnt(0)" ::: "memory");
    const int c = lane & 7;
#pragma unroll
    for (int j = 0; j < 4; ++j) { const int n = (lane >> 3) + 8 * j; const LAS float* s = scr + (8 * c) * 33 + n;
        u32x4 o; o.x = cvtpk(s[0 * 33], s[1 * 33]); o.y = cvtpk(s[2 * 33], s[3 * 33]); o.z = cvtpk(s[4 * 33], s[5 * 33]); o.w = cvtpk(s[6 * 33], s[7 * 33]);
        *(u32x4*)(WT + (size_t)maprow(mode, n0 + n) * K + k0 + 8 * c) = o; }
    asm volatile("s_waitcnt lgkmcnt(0)" ::: "memory");
}

struct Args { const float* in[33]; float* out; unsigned char* ws; int ph_lo, ph_hi; };
constexpr int N_PHASES = 13;

__global__ void __launch_bounds__(512, 2) mega_fwd(Args args) {
    extern __shared__ __attribute__((aligned(16))) unsigned char lds[];
    LAS unsigned char* L = (LAS unsigned char*)lds;
    cg::grid_group grid = cg::this_grid();
    unsigned* barw = (unsigned*)(args.ws + WS_BAR);
    volatile LAS unsigned* bst = (volatile LAS unsigned*)((LAS unsigned char*)lds + LDS_BYTES - 64);
    if (threadIdx.x == 0) { bst[0] = 0u; bst[1] = 0u; }
    __syncthreads();
    XcdBarrier xbar = xcd_barrier_post(barw, bst);
    if (args.ph_lo < 0) grid.sync();
    const int wave0 = __builtin_amdgcn_readfirstlane(threadIdx.x >> 6);
#ifdef DBG_XSYNC
    for (int i = 0; i < DBG_XSYNC; ++i) xcd_barrier(xbar);
#endif
#ifdef DBG_DUP
    int dup_done = -1;
#endif
    for (int ph = args.ph_lo; ph < args.ph_hi; ++ph) {
        if (ph > args.ph_lo) xcd_barrier(xbar);
        int wave = wave0; asm volatile("" : "+s"(wave)); int G = gridDim.x; asm volatile("" : "+s"(G)); int bx = blockIdx.x; asm volatile("" : "+s"(bx));
    const int gw = bx * 8 + wave, NGW = G * 8;
    __attribute__((address_space(1))) unsigned char* ws1_ = (__attribute__((address_space(1))) unsigned char*)args.ws; asm volatile("" : "+s"(ws1_)); unsigned char* ws = (unsigned char*)ws1_;
    __attribute__((address_space(1))) float* out1_ = (__attribute__((address_space(1))) float*)args.out; asm volatile("" : "+s"(out1_)); float* out = (float*)out1_;
    float* MOD = (float*)(ws + WS_MOD); float* ROPE = (float*)(ws + WS_ROPE);
    bf16* Hb = (bf16*)(ws + WS_H); float* YF = (float*)(ws + WS_H);
    bf16 *QA = (bf16*)(ws + WS_QA), *KA = (bf16*)(ws + WS_KA), *VA = (bf16*)(ws + WS_VA), *QC = (bf16*)(ws + WS_QC), *KC = (bf16*)(ws + WS_KC), *VC = (bf16*)(ws + WS_VC);
    float* Ub = (float*)(ws + WS_U); bf16* MF = (bf16*)(ws + WS_QKVU);
    bf16* GATES = (bf16*)(ws + WS_GATES); bf16* ACT = (bf16*)(ws + WS_GATES);
    bf16 *OA = (bf16*)(ws + WS_OA), *OB = (bf16*)(ws + WS_OB), *OC = (bf16*)(ws + WS_OC);
    bf16 *CKAK = (bf16*)(ws + WS_CKAK), *CKAV = (bf16*)(ws + WS_CKAV), *CKCK = (bf16*)(ws + WS_CKCK), *CKCV = (bf16*)(ws + WS_CKCV);
    float* SSMF = (float*)(ws + WS_SSMF2); unsigned* FLAGS = (unsigned*)(ws + WS_FLAG);

        if (ph == 0) {
#ifdef DBG_DUP_P0
            for (int rep0 = 0; rep0 < 2; ++rep0) {
#endif
            const int lane = FRESH_LANE(), tid = wave * 64 + lane;
            LAS float* S = (LAS float*)(L + 69632);
            LAS float* red = (LAS float*)(L + 90112);
            if (bx < 192) {
                for (int i = tid; i < 5 * 1024; i += 512) { const int cv = i >> 10, kx = i & 1023; const float c = cv == 0 ? args.in[8][kx] : args.in[2][(cv - 1) * 1024 + kx]; S[i] = c / (1.0f + __expf(-c)); }
                __syncthreads();
                for (int item = bx; item < 192; item += G) {
                    const int l = item / 96, col = (item % 96) * 64 + lane;
                    const float* wp = args.in[9] + (size_t)l * 1024 * 6144 + col;
                    float a0 = 0.f, a1 = 0.f, a2 = 0.f, a3 = 0.f, a4 = 0.f;
#pragma unroll 16
                    for (int kk = 0; kk < 128; ++kk) { const int kx = wave * 128 + kk; const float w = wp[(size_t)kx * 6144];
                        a0 += S[kx] * w; a1 += S[1024 + kx] * w; a2 += S[2048 + kx] * w; a3 += S[3072 + kx] * w; a4 += S[4096 + kx] * w; }
                    red[(wave * 5 + 0) * 64 + lane] = a0; red[(wave * 5 + 1) * 64 + lane] = a1; red[(wave * 5 + 2) * 64 + lane] = a2; red[(wave * 5 + 3) * 64 + lane] = a3; red[(wave * 5 + 4) * 64 + lane] = a4;
                    __syncthreads();
                    if (wave < 5) { float s = args.in[10][l * 6144 + col];
#pragma unroll
                        for (int w8 = 0; w8 < 8; ++w8) s += red[(w8 * 5 + wave) * 64 + lane];
                        MOD[(l * 5 + wave) * 6144 + col] = s; }
                    asm volatile("s_waitcnt vmcnt(0)" ::: "memory");
                    __syncthreads();
                    if (item < 32 && wave == 0) { __builtin_amdgcn_fence(__ATOMIC_RELEASE, "agent"); asm volatile("s_waitcnt vmcnt(0)" ::: "memory");
                        if (lane == 0) __hip_atomic_fetch_add(FLAGS + 60, 1u, __ATOMIC_RELAXED, __HIP_MEMORY_SCOPE_AGENT); }
                }
            }
            if (bx == G - 2 && tid < 256) { const int ll = tid >> 7, qk = (tid >> 6) & 1, e = tid & 63; ((float*)(ws + WS_QKG))[tid] = (qk ? args.in[14] : args.in[13])[ll * 64 + e]; }
            { const int gtid = bx * 512 + tid, NTH = G * 512;
#define CPY(idx, off, n) for (int i = gtid; i < (n) / 4; i += NTH) ((f32x4*)(ws + WS_PAR) + (off) / 4)[i] = ((const f32x4*)args.in[idx])[i];
              CPY(11, P_N1G, 2048) CPY(29, P_N2G, 2048) CPY(32, P_FING, 1024) CPY(7, P_SSM0, 32768) CPY(15, P_LAMR, 4096) CPY(16, P_LAMI, 4096) CPY(17, P_LSTEP, 64)
              CPY(18, P_BRE, 65536) CPY(19, P_BIM, 65536) CPY(20, P_CRE, 65536) CPY(21, P_CIM, 65536) CPY(22, P_SSMD, 512) CPY(24, P_NAB, 3720)
#undef CPY
            }
            if (bx == G - 1) { for (int i = tid; i < 1024; i += 512) { const int pos = i >> 4, f = i & 15; const float inv = 1.0f / powf(10000.0f, (float)f / 16.0f); const float ang = (float)pos * inv; ROPE[2 * i] = cosf(ang); ROPE[2 * i + 1] = sinf(ang); } }
            for (int it = bx * 512 + tid; it < 196608; it += G * 512) {
                const float* src; bf16* dst; int e;
                if (it < 65536) { const bool isv = it >= 32768; e = (it & 32767) * 8; const int d = e & 63, t = (e >> 6) & 255, h = (e >> 14) & 1, b = (e >> 15) & 3, l = e >> 17;
                    src = (isv ? args.in[4] : args.in[3]) + ((((size_t)(b * 2 + l) * 256 + t) * 2 + h) * 64 + d); dst = (isv ? CKAV : CKAK) + e; }
                else { const int i2 = it - 65536; const bool isv = i2 >= 65536; e = (i2 & 65535) * 8; const int d = e & 63, t = (e >> 6) & 255, h = (e >> 14) & 3, b = (e >> 16) & 3, l = e >> 18;
                    src = (isv ? args.in[6] : args.in[5]) + ((((size_t)(b * 2 + l) * 256 + t) * 4 + h) * 64 + d); dst = (isv ? CKCV : CKCK) + e; }
                const f32x4 a = *(const f32x4*)src, c = *(const f32x4*)(src + 4);
                *(u32x4*)dst = (u32x4){cvtpk(a[0], a[1]), cvtpk(a[2], a[3]), cvtpk(c[0], c[1]), cvtpk(c[2], c[3])};
            }
            LAS float* scr = (LAS float*)(L + wave * 8448);
            for (int it = gw; it < 6304; it += NGW) { const int l = 0; int r = it < 6272 ? it : it + 1408;
                if (r < 2432) { transpose_item(args.in[12] + (size_t)l * DM * NIN, DM, NIN, (bf16*)(ws + W_IN) + (size_t)l * NIN * DM, 1, scr, r, lane); continue; } r -= 2432;
                if (r < 256) { transpose_item(args.in[25] + (size_t)l * 512 * DM, 512, DM, (bf16*)(ws + W_BRA) + (size_t)l * DM * 512, 0, scr, r, lane); continue; } r -= 256;
                if (r < 128) { transpose_item(args.in[26] + (size_t)l * 256 * DM, 256, DM, (bf16*)(ws + W_BRB) + (size_t)l * DM * 256, 0, scr, r, lane); continue; } r -= 128;
                if (r < 128) { transpose_item(args.in[27] + (size_t)l * 256 * DM, 256, DM, (bf16*)(ws + W_BRC) + (size_t)l * DM * 256, 0, scr, r, lane); continue; } r -= 128;
                if (r < 512) { transpose_item(args.in[28] + (size_t)l * DM * DM, DM, DM, (bf16*)(ws + W_OUT) + (size_t)l * DM * DM, 0, scr, r, lane); continue; } r -= 512;
                if (r < 2816) { transpose_item(args.in[30] + (size_t)l * DM * NGU, DM, NGU, (bf16*)(ws + W_GU) + (size_t)l * NGU * DM, 2, scr, r, lane); continue; } r -= 2816;
                if (r < 1408) { transpose_item(args.in[31] + (size_t)l * DFF * DM, DFF, DM, (bf16*)(ws + W_FD) + (size_t)l * DM * DFF, 0, scr, r, lane); continue; } r -= 1408;
                transpose_item(args.in[23] + (size_t)l * 256 * 256, 256, 256, (bf16*)(ws + W_GLU) + (size_t)l * 256 * 256, 0, scr, r, lane);
            }
            __syncthreads();
#ifdef DBG_DUP_P0
            }
#endif
            {
                if (wave == 0) { unsigned sp_ = 0; while (__hip_atomic_load(FLAGS + 60, __ATOMIC_RELAXED, __HIP_MEMORY_SCOPE_AGENT) < 32u) { __builtin_amdgcn_s_sleep(4); if (++sp_ > (1u << 22)) break; }
                    __builtin_amdgcn_fence(__ATOMIC_ACQUIRE, "agent"); asm volatile("s_waitcnt vmcnt(0)" ::: "memory"); }
                __syncthreads();
                const int lane2 = FRESH_LANE();
                norm_mod_rows(args.in[0], args.in[1], args.in[11], MOD, 0, 1024, Hb, gw, NGW, lane2);
            }
            continue;
        }
        const float* const PAR = (const float*)(ws + WS_PAR);
        const int l = (ph - 1) / 6, sp = (ph - 1) % 6 + 1;
        unsigned* CNT = (unsigned*)(ws + WS_CNT); unsigned* TMO = (unsigned*)(ws + WS_TMO); unsigned* XBUF = (unsigned*)(ws + WS_XBUF);
        const float* modl = MOD + (size_t)l * 5 * 6144;
        const float* xc_in = args.in[0]; const float* xl_in = args.in[1];
        const float* xc_cur = out; const float* xl_cur = out + (size_t)4096 * 1024;
        pg8::StaticOrder S;
        switch (sp) {
        case 0: {
            const bool first = (l == 0); const int lane = FRESH_LANE();
            norm_mod_rows(first ? xc_in : xc_cur, first ? xl_in : xl_cur, PAR + P_N1G + l * 1024, modl, 0, 1024, Hb, gw, NGW, lane);
        } break;
        case 1: {
            pg8::Gemm g{Hb, (const bf16*)(ws + W_IN) + (size_t)l * NIN * DM, M_TOK, NIN, DM}; S.init(M_TOK, NIN, G, bx);
            EpiIn E{ws, out, l};

#ifndef CUT_IN
            pg8::gemm_phase<EpiIn, pg8::StaticOrder, true, true>(L, g, S, E, wave);
#endif

        } break;
        case 2: {
            SsmArgs SA{PAR + P_LAMR + l * 2048, PAR + P_LAMI + l * 2048, PAR + P_LSTEP + l * 32, PAR + P_BRE + (size_t)l * 32768, PAR + P_BIM + (size_t)l * 32768, PAR + P_CRE + (size_t)l * 32768, PAR + P_CIM + (size_t)l * 32768,
                       PAR + P_SSMD + l * 256, Ub, YF, OB, SSMF, PAR + P_SSM0, out + O_SSM, l};
#ifdef DBG_DUP
            const int QCTR_BASE = (dup_done == ph) ? 62 : 56;
#else
            constexpr int QCTR_BASE = 56;
#endif
            volatile LAS unsigned* qslot = (volatile LAS unsigned*)((LAS unsigned char*)lds + LDS_BYTES - 32);
            const int qx = bx & 7;
            for (;;) {
                __syncthreads();
                if (wave == 0 && FRESH_LANE() == 0) qslot[0] = __hip_atomic_fetch_add(FLAGS + 64 + (l * 2 + (QCTR_BASE == 56 ? 0 : 1)) * 8 + qx, 1u, __ATOMIC_RELAXED, __HIP_MEMORY_SCOPE_AGENT);
                __syncthreads();
                int item = (int)qslot[0]; item = __builtin_amdgcn_readfirstlane(item);
                if (item >= 140) break;
                if (item < 4) item = 384 + qx * 4 + item; else if (item < 36) item = 416 + qx * 32 + (item - 4); else if (item < 68) item = qx * 32 + (item - 36); else if (item < 84) item = 256 + qx * 16 + (item - 68);
                else if (item < 116) item = 864 + qx * 32 + (item - 84); else if (item < 132) item = 672 + qx * 16 + (item - 116); else item = 800 + qx * 8 + (item - 132);
                if (item < 256) {
                    const int b = item >> 6, h = (item >> 3) & 7, qb = item & 7, kvh = h >> 2;
                    const bf16* Qw = QA + ((size_t)4096 * 8 + (size_t)(b * 8 + h) * 2048 + qb * 256 + wave * 32) * 64;
                    const size_t co = ((size_t)((l * 4 + b) * 2 + kvh) * 256) * 64, lo = ((size_t)4096 * 2 + (size_t)(b * 2 + kvh) * 2048) * 64;
                    bf16* Ow = OA + ((size_t)4096 + b * 2048 + qb * 256 + wave * 32) * 512 + h * 64;
                    att::attn_unit<false>(Qw, CKAK + co, CKAV + co, KA + lo, VA + lo, 36, Ow, 512, (char*)lds, 0, 0, nullptr, wave);
                } else if (item < 384) {
                    const int i = item - 256, b = i >> 5, h = (i >> 3) & 3, qb = i & 7, r0 = 4 * qb;
                    const int rlo = clampi(r0 - 4, 0, 24), rhi = clampi(r0 - 1, 0, 24) + 7, NT = 4 + rhi - rlo + 1;
                    const bf16* Qw = QC + ((size_t)4096 * 4 + (size_t)(b * 4 + h) * 2048 + qb * 256 + wave * 32) * 64;
                    const size_t co = ((size_t)((l * 4 + b) * 4 + h) * 256) * 64, lo = ((size_t)4096 * 4 + (size_t)(b * 4 + h) * 2048 + rlo * 64) * 64;
                    bf16* Ow = OC + ((size_t)4096 + b * 2048 + qb * 256 + wave * 32) * 256 + h * 64;
                    att::attn_unit<true>(Qw, CKCK + co, CKCV + co, KC + lo, VC + lo, NT, Ow, 256, (char*)lds, r0 + (wave >> 1), rlo, PAR + P_NAB + (size_t)(l * 4 + h) * 465, wave);
                } else if (item < 416) {
                    const int wu = (item - 384) * 8 + wave;
                    ssm_both<0>(SA, wu >> 4, wu & 15, 0, (LAS float*)(L + wave * SSM_WAVE_BYTES));
                    asm volatile("s_waitcnt vmcnt(0) lgkmcnt(0)" ::: "memory"); __syncthreads();
                } else if (item < 672) {
                    const int wu = (item - 416) * 8 + wave;
                    ssm_dir<1, false>(SA, wu >> 9, (wu >> 5) & 15, (wu >> 4) & 1, wu & 15, (LAS float*)(L + wave * SSM_WAVE_BYTES));
                    asm volatile("s_waitcnt vmcnt(0) lgkmcnt(0)" ::: "memory"); __syncthreads();
                    if (wave == 0 && FRESH_LANE() == 0) __hip_atomic_fetch_add(FLAGS + 58 + l, 1u, __ATOMIC_RELAXED, __HIP_MEMORY_SCOPE_AGENT);
                } else if (item >= 864) {
                    if (wave == 0) { unsigned sp_ = 0; while (__hip_atomic_load(FLAGS + 58 + l, __ATOMIC_RELAXED, __HIP_MEMORY_SCOPE_AGENT) < 256u) { __builtin_amdgcn_s_sleep(4); if (++sp_ > (1u << 22)) break; }
                        __builtin_amdgcn_fence(__ATOMIC_ACQUIRE, "agent"); asm volatile("s_waitcnt vmcnt(0)" ::: "memory"); }
                    __syncthreads();
                    const int dd = wave & 1, wu = (wave >> 1) * 256 + (item - 864);
                    const int b = wu >> 8, g = (wu >> 4) & 15, c = wu & 15;
                    ssm_dir<2, false>(SA, b, g, dd, dd ? NLCH - 1 - c : c, (LAS float*)(L + wave * SSM_WAVE_BYTES));
                    asm volatile("s_waitcnt vmcnt(0) lgkmcnt(0)" ::: "memory");
                    __syncthreads();
                    { const int lane = FRESH_LANE(); const size_t o = ((size_t)4096 + b * 2048 + c * 128 + dd * 64 + lane) * 256 + g * 16;
                      const float* yf = YF + o; const float* yb = YF + (size_t)M_TOK * 256 + o; const float* uu = Ub + o; const float* dv = PAR + P_SSMD + l * 256 + g * 16;
                      unsigned w[8];
#pragma unroll
                      for (int c4 = 0; c4 < 4; ++c4) { const f32x4 y = *(const f32x4*)(yf + 4 * c4) + *(const f32x4*)(yb + 4 * c4) + *(const f32x4*)(dv + 4 * c4) * *(const f32x4*)(uu + 4 * c4); f32x4 q;
#pragma unroll
                          for (int j = 0; j < 4; ++j) { const float v = y[j]; q[j] = gelu_tanh_(v); }
                          w[2 * c4] = cvtpk(q[0], q[1]); w[2 * c4 + 1] = cvtpk(q[2], q[3]); }
                      *(u32x4*)(OB + o) = (u32x4){w[0], w[1], w[2], w[3]}; *(u32x4*)(OB + o + 8) = (u32x4){w[4], w[5], w[6], w[7]}; }
                    asm volatile("s_waitcnt vmcnt(0) lgkmcnt(0)" ::: "memory");
                    __syncthreads();
                } else if (item < 800) {
                    const int i = item - 672, b = i >> 3, h = i & 7, kvh = h >> 2;
                    const bf16* Qw = QA + ((size_t)(b * 8 + h) * 256 + wave * 32) * 64;
                    const size_t co = ((size_t)(b * 2 + kvh) * 256) * 64;
                    bf16* Ow = OA + ((size_t)b * 256 + wave * 32) * 512 + h * 64;
                    att::attn_unit<false>(Qw, KA + co, VA + co, KA, VA, 4, Ow, 512, (char*)lds, 0, 0, nullptr, wave);
                } else {
                    const int i = item - 800, b = i >> 2, h = i & 3;
                    const bf16* Qw = QC + ((size_t)(b * 4 + h) * 256 + wave * 32) * 64;
                    const size_t co = ((size_t)(b * 4 + h) * 256) * 64;
                    bf16* Ow = OC + ((size_t)b * 256 + wave * 32) * 256 + h * 64;
                    att::attn_unit<false>(Qw, KC + co, VC + co, KC, VC, 4, Ow, 256, (char*)lds, 0, 0, nullptr, wave);
                }
            }
        } break;
        case 3: {
            const int cglu = (G == 256) ? bx - 192 : bx;
            pg8::StaticOrder SG; SG.init(M_TOK, 256, G, cglu < 0 ? G : cglu); Unit ug;
            if (SG.next(0, ug)) {
                pg8::Gemm g{OB, (const bf16*)(ws + W_GLU) + (size_t)l * 256 * 256, M_TOK, 256, 256};
                EpiGlu E{OB};
                pg8::gemm_phase<EpiGlu, pg8::StaticOrder, true, true>(L, g, SG, E, wave);
                asm volatile("s_waitcnt vmcnt(0)" ::: "memory");
                __syncthreads();
                if (wave == 0) { __builtin_amdgcn_fence(__ATOMIC_RELEASE, "agent"); asm volatile("s_waitcnt vmcnt(0)" ::: "memory");
                    if (FRESH_LANE() == 0) __hip_atomic_store(FLAGS + ug.pm, (unsigned)(l + 1), __ATOMIC_RELAXED, __HIP_MEMORY_SCOPE_AGENT); }
            }
            if (l == 0 && bx >= 192) {
                __syncthreads();
                const int lane = FRESH_LANE(); LAS float* scr = (LAS float*)(L + wave * 8448); const int l = 1;
                for (int it = 0 + (bx - 192) * 8 + wave; it < 2000; it += (G - 192) * 8) { int r = it;
                    if (r < 2432) { transpose_item(args.in[12] + (size_t)l * DM * NIN, DM, NIN, (bf16*)(ws + W_IN) + (size_t)l * NIN * DM, 1, scr, r, lane); continue; } r -= 2432;
                    if (r < 256) { transpose_item(args.in[25] + (size_t)l * 512 * DM, 512, DM, (bf16*)(ws + W_BRA) + (size_t)l * DM * 512, 0, scr, r, lane); continue; } r -= 256;
                    if (r < 128) { transpose_item(args.in[26] + (size_t)l * 256 * DM, 256, DM, (bf16*)(ws + W_BRB) + (size_t)l * DM * 256, 0, scr, r, lane); continue; } r -= 128;
                    if (r < 128) { transpose_item(args.in[27] + (size_t)l * 256 * DM, 256, DM, (bf16*)(ws + W_BRC) + (size_t)l * DM * 256, 0, scr, r, lane); continue; } r -= 128;
                    if (r < 512) { transpose_item(args.in[28] + (size_t)l * DM * DM, DM, DM, (bf16*)(ws + W_OUT) + (size_t)l * DM * DM, 0, scr, r, lane); continue; } r -= 512;
                    if (r < 2816) { transpose_item(args.in[30] + (size_t)l * DM * NGU, DM, NGU, (bf16*)(ws + W_GU) + (size_t)l * NGU * DM, 2, scr, r, lane); continue; } r -= 2816;
                    if (r < 1408) { transpose_item(args.in[31] + (size_t)l * DFF * DM, DFF, DM, (bf16*)(ws + W_FD) + (size_t)l * DM * DFF, 0, scr, r, lane); continue; } r -= 1408;
                    transpose_item(args.in[23] + (size_t)l * 256 * 256, 256, 256, (bf16*)(ws + W_GLU) + (size_t)l * 256 * 256, 0, scr, r, lane);
            }
                asm volatile("s_waitcnt vmcnt(0) lgkmcnt(0)" ::: "memory");
            }
            S.init(M_TOK, DM, G, bx);
            { pg8::Gemm g{OA, (const bf16*)(ws + W_BRA) + (size_t)l * DM * 512, M_TOK, DM, 512}; EpiBr<0> E{GATES, MF, nullptr}; pg8::gemm_phase<EpiBr<0>, pg8::StaticOrder, true, true>(L, g, S, E, wave); }
            { pg8::Gemm g{OC, (const bf16*)(ws + W_BRC) + (size_t)l * DM * 256, M_TOK, DM, 256}; EpiBr<1> E{GATES + 2048, MF, nullptr}; pg8::gemm_phase<EpiBr<1>, pg8::StaticOrder, true, true>(L, g, S, E, wave); }
            { Unit ub; if (S.next(0, ub)) {
                if (wave == 0) { unsigned sp_ = 0; while (__hip_atomic_load(FLAGS + ub.pm, __ATOMIC_RELAXED, __HIP_MEMORY_SCOPE_AGENT) < (unsigned)(l + 1)) { __builtin_amdgcn_s_sleep(2); if (++sp_ > (1u << 24)) break; }
                    __builtin_amdgcn_fence(__ATOMIC_ACQUIRE, "agent"); asm volatile("s_waitcnt vmcnt(0)" ::: "memory"); }
                __syncthreads(); } }
            { pg8::Gemm g{OB, (const bf16*)(ws + W_BRB) + (size_t)l * DM * 256, M_TOK, DM, 256}; EpiBr<2> E{GATES + 1024, MF, Hb}; pg8::gemm_phase<EpiBr<2>, pg8::StaticOrder, true, true>(L, g, S, E, wave); }
        } break;
        case 4: {
            if (l == 0 && bx >= 192) {
                const int lane = FRESH_LANE(); LAS float* scr = (LAS float*)(L + wave * 8448); const int l = 1;
                for (int it = 2000 + (bx - 192) * 8 + wave; it < 3900; it += (G - 192) * 8) { int r = it;
                    if (r < 2432) { transpose_item(args.in[12] + (size_t)l * DM * NIN, DM, NIN, (bf16*)(ws + W_IN) + (size_t)l * NIN * DM, 1, scr, r, lane); continue; } r -= 2432;
                    if (r < 256) { transpose_item(args.in[25] + (size_t)l * 512 * DM, 512, DM, (bf16*)(ws + W_BRA) + (size_t)l * DM * 512, 0, scr, r, lane); continue; } r -= 256;
                    if (r < 128) { transpose_item(args.in[26] + (size_t)l * 256 * DM, 256, DM, (bf16*)(ws + W_BRB) + (size_t)l * DM * 256, 0, scr, r, lane); continue; } r -= 128;
                    if (r < 128) { transpose_item(args.in[27] + (size_t)l * 256 * DM, 256, DM, (bf16*)(ws + W_BRC) + (size_t)l * DM * 256, 0, scr, r, lane); continue; } r -= 128;
                    if (r < 512) { transpose_item(args.in[28] + (size_t)l * DM * DM, DM, DM, (bf16*)(ws + W_OUT) + (size_t)l * DM * DM, 0, scr, r, lane); continue; } r -= 512;
                    if (r < 2816) { transpose_item(args.in[30] + (size_t)l * DM * NGU, DM, NGU, (bf16*)(ws + W_GU) + (size_t)l * NGU * DM, 2, scr, r, lane); continue; } r -= 2816;
                    if (r < 1408) { transpose_item(args.in[31] + (size_t)l * DFF * DM, DFF, DM, (bf16*)(ws + W_FD) + (size_t)l * DM * DFF, 0, scr, r, lane); continue; } r -= 1408;
                    transpose_item(args.in[23] + (size_t)l * 256 * 256, 256, 256, (bf16*)(ws + W_GLU) + (size_t)l * 256 * 256, 0, scr, r, lane);
            }
                asm volatile("s_waitcnt vmcnt(0) lgkmcnt(0)" ::: "memory");
            }
            S.init(M_TOK, DM, G, bx);
            pg8::Gemm g{Hb, (const bf16*)(ws + W_OUT) + (size_t)l * DM * DM, M_TOK, DM, DM};
            PanelStats st{XBUF, CNT + (l * 2 + 0) * 3072, TMO, 4, EPS, 0x700u};
            EpiResNorm<0> E{l == 0 ? xc_in : xc_cur, l == 0 ? xl_in : xl_cur, out, modl + 2048, PAR + P_N2G + l * 1024, modl, 3072, 4096, Hb, st};
            pg8::gemm_phase<EpiResNorm<0>, pg8::StaticOrder, false, true>(L, g, S, E, wave);
        } break;
        case 5: {
            pg8::Gemm g{Hb, (const bf16*)(ws + W_GU) + (size_t)l * NGU * DM, M_TOK, NGU, DM}; S.init(M_TOK, NGU, G, bx);
            EpiSwiglu E{ACT};
            pg8::gemm_phase<EpiSwiglu, pg8::StaticOrder, true, true>(L, g, S, E, wave);
            if (l == 0 && bx >= 32 && G == 256) {
                __syncthreads();
                const int lane = FRESH_LANE(); LAS float* scr = (LAS float*)(L + wave * 8448); const int l = 0;
                for (int it = 6272 + (bx - 32) * 8 + wave; it < 7680; it += (G - 32) * 8) { int r = it;
                    if (r < 2432) { transpose_item(args.in[12] + (size_t)l * DM * NIN, DM, NIN, (bf16*)(ws + W_IN) + (size_t)l * NIN * DM, 1, scr, r, lane); continue; } r -= 2432;
                    if (r < 256) { transpose_item(args.in[25] + (size_t)l * 512 * DM, 512, DM, (bf16*)(ws + W_BRA) + (size_t)l * DM * 512, 0, scr, r, lane); continue; } r -= 256;
                    if (r < 128) { transpose_item(args.in[26] + (size_t)l * 256 * DM, 256, DM, (bf16*)(ws + W_BRB) + (size_t)l * DM * 256, 0, scr, r, lane); continue; } r -= 128;
                    if (r < 128) { transpose_item(args.in[27] + (size_t)l * 256 * DM, 256, DM, (bf16*)(ws + W_BRC) + (size_t)l * DM * 256, 0, scr, r, lane); continue; } r -= 128;
                    if (r < 512) { transpose_item(args.in[28] + (size_t)l * DM * DM, DM, DM, (bf16*)(ws + W_OUT) + (size_t)l * DM * DM, 0, scr, r, lane); continue; } r -= 512;
                    if (r < 2816) { transpose_item(args.in[30] + (size_t)l * DM * NGU, DM, NGU, (bf16*)(ws + W_GU) + (size_t)l * NGU * DM, 2, scr, r, lane); continue; } r -= 2816;
                    if (r < 1408) { transpose_item(args.in[31] + (size_t)l * DFF * DM, DFF, DM, (bf16*)(ws + W_FD) + (size_t)l * DM * DFF, 0, scr, r, lane); continue; } r -= 1408;
                    transpose_item(args.in[23] + (size_t)l * 256 * 256, 256, 256, (bf16*)(ws + W_GLU) + (size_t)l * 256 * 256, 0, scr, r, lane);
            }
                asm volatile("s_waitcnt vmcnt(0) lgkmcnt(0)" ::: "memory");
            }
        } break;
        case 6: {
            if (l == 0 && bx >= 192) {
                const int lane = FRESH_LANE(); LAS float* scr = (LAS float*)(L + wave * 8448); const int l = 1;
                for (int it = 3900 + (bx - 192) * 8 + wave; it < 7712; it += (G - 192) * 8) { int r = it;
                    if (r < 2432) { transpose_item(args.in[12] + (size_t)l * DM * NIN, DM, NIN, (bf16*)(ws + W_IN) + (size_t)l * NIN * DM, 1, scr, r, lane); continue; } r -= 2432;
                    if (r < 256) { transpose_item(args.in[25] + (size_t)l * 512 * DM, 512, DM, (bf16*)(ws + W_BRA) + (size_t)l * DM * 512, 0, scr, r, lane); continue; } r -= 256;
                    if (r < 128) { transpose_item(args.in[26] + (size_t)l * 256 * DM, 256, DM, (bf16*)(ws + W_BRB) + (size_t)l * DM * 256, 0, scr, r, lane); continue; } r -= 128;
                    if (r < 128) { transpose_item(args.in[27] + (size_t)l * 256 * DM, 256, DM, (bf16*)(ws + W_BRC) + (size_t)l * DM * 256, 0, scr, r, lane); continue; } r -= 128;
                    if (r < 512) { transpose_item(args.in[28] + (size_t)l * DM * DM, DM, DM, (bf16*)(ws + W_OUT) + (size_t)l * DM * DM, 0, scr, r, lane); continue; } r -= 512;
                    if (r < 2816) { transpose_item(args.in[30] + (size_t)l * DM * NGU, DM, NGU, (bf16*)(ws + W_GU) + (size_t)l * NGU * DM, 2, scr, r, lane); continue; } r -= 2816;
                    if (r < 1408) { transpose_item(args.in[31] + (size_t)l * DFF * DM, DFF, DM, (bf16*)(ws + W_FD) + (size_t)l * DM * DFF, 0, scr, r, lane); continue; } r -= 1408;
                    transpose_item(args.in[23] + (size_t)l * 256 * 256, 256, 256, (bf16*)(ws + W_GLU) + (size_t)l * 256 * 256, 0, scr, r, lane);
            }
                asm volatile("s_waitcnt vmcnt(0) lgkmcnt(0)" ::: "memory");
            }
            S.init(M_TOK, DM, G, bx);
            pg8::Gemm g{ACT, (const bf16*)(ws + W_FD) + (size_t)l * DM * DFF, M_TOK, DM, DFF};
            PanelStats st{XBUF, CNT + (l * 2 + 1) * 3072, TMO, 4, EPS, 0x780u};
            if (l == 0) { EpiResNorm<0> E{xc_cur, xl_cur, out, modl + 5120, PAR + P_N1G + 1024, MOD + (size_t)5 * 6144, 0, 1024, Hb, st}; pg8::gemm_phase<EpiResNorm<0>, pg8::StaticOrder, false, true>(L, g, S, E, wave); }
            else { EpiResNorm<1> E{xc_cur, xl_cur, out, modl + 5120, PAR + P_FING, MOD, 0, 1024, Hb, st}; pg8::gemm_phase<EpiResNorm<1>, pg8::StaticOrder, false, true>(L, g, S, E, wave); }
        } break;
        }
#ifdef DBG_DUP
        if (sp == DBG_DUP && dup_done != ph) { dup_done = ph; --ph; }
#endif
    }
}

extern "C" void kernel_launch(void* const* d_in, const int* in_sizes, int n_in, void* d_out, int out_size, void* d_ws, size_t ws_size, hipStream_t stream) {
    static int grid = 0;
    if (grid == 0) {
        if (n_in != 33 || ws_size < WS_END) { fprintf(stderr, "kernel_launch: unexpected n_in %d / ws_size %zu\n", n_in, ws_size); grid = -1; return; }
        int dev = 0, cus = 0, per_cu = 0;
        hipGetDevice(&dev); hipDeviceGetAttribute(&cus, hipDeviceAttributeMultiprocessorCount, dev);
        if (hipFuncSetAttribute((const void*)mega_fwd, hipFuncAttributeMaxDynamicSharedMemorySize, LDS_BYTES) != hipSuccess) { fprintf(stderr, "kernel_launch: hipFuncSetAttribute failed\n"); grid = -1; return; }
        if (hipOccupancyMaxActiveBlocksPerMultiprocessor(&per_cu, (const void*)mega_fwd, 512, LDS_BYTES) != hipSuccess || per_cu < 1) { fprintf(stderr, "kernel_launch: occupancy query says %d\n", per_cu); per_cu = 1; }
        (void)hipGetLastError();
        grid = cus * 1;
        fprintf(stderr, "kernel_launch: cus %d per_cu %d grid %d ws %zu\n", cus, per_cu, grid, ws_size);
    }
    if (grid < 0) return;
    if (hipMemsetAsync((char*)d_ws + WS_BAR, 0, 131072, stream) != hipSuccess) { fprintf(stderr, "kernel_launch: memset failed\n"); return; }
    Args a{};
    for (int i = 0; i < 33; ++i) a.in[i] = (const float*)d_in[i];
    a.out = (float*)d_out; a.ws = (unsigned char*)d_ws;
#if MK_MULTI
    for (int ph = 0; ph < N_PHASES; ++ph) { a.ph_lo = ph; a.ph_hi = ph + 1; hipLaunchKernelGGL(mega_fwd, dim3(grid), dim3(512), LDS_BYTES, stream, a); }
#else
    a.ph_lo = 0; a.ph_hi = N_PHASES;
    void* kargs[] = {&a};
    hipError_t e = hipLaunchCooperativeKernel((const void*)mega_fwd, dim3(grid), dim3(512), kargs, LDS_BYTES, stream);
    if (e != hipSuccess) fprintf(stderr, "cooperative launch failed: %s (grid %d)\n", hipGetErrorString(e), grid);
#endif
}
```
